# Optimizing an MI355X kernel written in HIP

```python
import math
import jax
import jax.numpy as jnp
from jax import lax
import numpy as np

D_MODEL = 1024
BATCH = 4
SEQ = 8192
DEPTH = 2
DEC_BATCH = 32
DEC_SEQ = 4
PAST_LEN = 16384
PAGE_SIZE = 128

N_AB_LAYERS = (DEPTH + 1) // 2
N_C_LAYERS = DEPTH // 2
MIX_WIDTH = D_MODEL
POOL_WIDTH = MIX_WIDTH // 2
POOL_WINDOWS = (2, 4, 8, 16)
POOL_GROUP = POOL_WIDTH // len(POOL_WINDOWS)
POOL_STATE = max(POOL_WINDOWS) - 1
SSM_WIDTH = MIX_WIDTH - POOL_WIDTH
SSM_GROUP = 16
SSM_GROUPS = SSM_WIDTH // SSM_GROUP
SSM_STATE = 64
SSM_CHUNK = 128
ATT_HEADS = 16
HEAD_DIM = 64
ATT_WIDTH = ATT_HEADS * HEAD_DIM
DILATED_PATTERNS = ((128, 1), (512, 4), (2048, 16))
MAX_WINDOW = max(w for w, _ in DILATED_PATTERNS)
ATT_BLOCK = 128
FFN_HIDDEN = -(-(8 * D_MODEL) // (3 * 256)) * 256
RMS_EPS = 1e-6

kernel_name = 'hybrid_pool_s5_dilated_attn_step'


def rms_norm(x, g):
    xf = x.astype(jnp.float32)
    y = xf * lax.rsqrt(jnp.mean(xf * xf, axis=-1, keepdims=True) + RMS_EPS)
    return (y * g.astype(jnp.float32)).astype(x.dtype)


def swiglu_ffn(x, w_gate, w_up, w_down):
    return (jax.nn.silu(x @ w_gate) * (x @ w_up)) @ w_down


def pool_mixer(u, prev, pos, w_grp, scale):
    b, t, c = u.shape
    ext = jnp.concatenate([prev.astype(u.dtype), u], axis=1)
    cs = jnp.pad(jnp.cumsum(ext.astype(jnp.float32), axis=1), ((0, 0), (1, 0), (0, 0)))
    uf = u.astype(jnp.float32)
    lo = POOL_STATE + 1
    groups = []
    for g, w in enumerate(POOL_WINDOWS):
        sl = slice(g * POOL_GROUP, (g + 1) * POOL_GROUP)
        win_sum = cs[:, lo:lo + t, sl] - cs[:, lo - w:lo - w + t, sl]
        count = jnp.minimum(pos + 1, w).astype(jnp.float32)[None, :, None]
        groups.append(win_sum / count - uf[..., sl])
    d = jnp.stack(groups, axis=2)
    y = jnp.einsum('btgc,gce->btge', d, w_grp.astype(jnp.float32)).reshape(b, t, c)
    return y * scale.astype(jnp.float32), ext[:, -POOL_STATE:]


def _linear_recurrence_combine(e1, e2):
    a1, b1 = e1
    a2, b2 = e2
    return a1 * a2, a2 * b1 + b2


def s5_mixer(u, h0, lam_re, lam_im, log_dt, b_re, b_im, c_re, c_im, d_skip):
    b, t, c = u.shape
    f32 = jnp.float32
    lam = lax.complex(lam_re.astype(f32), lam_im.astype(f32))
    dt = jnp.exp(log_dt.astype(f32))[:, None]
    lam_bar = jnp.exp(lam * dt)
    b_mat = lax.complex(b_re.astype(f32), b_im.astype(f32))
    b_bar = ((lam_bar - 1.0) / lam)[..., None] * b_mat
    c_mat = lax.complex(c_re.astype(f32), c_im.astype(f32))
    uf = u.astype(f32)
    chunk = math.gcd(t, SSM_CHUNK)
    u_chunks = jnp.moveaxis(uf.reshape(b, t // chunk, chunk, SSM_GROUPS, SSM_GROUP), 1, 0)

    def step(h, u_c):
        bu = jnp.einsum('gpi,bcgi->bcgp', b_bar, u_c.astype(jnp.complex64))
        bu = bu.at[:, 0].add(lam_bar * h)
        a = jnp.broadcast_to(lam_bar, bu.shape)
        _, hs = lax.associative_scan(_linear_recurrence_combine, (a, bu), axis=1)
        y_c = jnp.einsum('gip,bcgp->bcgi', c_mat, hs).real
        return hs[:, -1], y_c

    h_last, y_chunks = lax.scan(step, h0, u_chunks)
    y = jnp.moveaxis(y_chunks, 0, 1).reshape(b, t, c) + d_skip.astype(f32) * uf
    return y, h_last


def mixer_ab(xn, pool_prev, h0, pos, w_in, pool_w, pool_scale, lam_re, lam_im, log_dt,
             b_re, b_im, c_re, c_im, d_skip, w_glu, b_glu, w_out):
    proj = xn @ w_in
    u_pool, u_ssm = proj[..., :POOL_WIDTH], proj[..., POOL_WIDTH:]
    y_pool, pool_state = pool_mixer(u_pool, pool_prev, pos, pool_w, pool_scale)
    y_ssm, h_last = s5_mixer(u_ssm, h0, lam_re, lam_im, log_dt, b_re, b_im, c_re, c_im, d_skip)
    z = jax.nn.gelu(y_ssm)
    y_ssm = z * jax.nn.sigmoid(z @ w_glu.astype(jnp.float32) + b_glu.astype(jnp.float32))
    y = jnp.concatenate([y_pool, y_ssm], axis=-1).astype(xn.dtype) @ w_out
    return y, pool_state, h_last


def _softmax_stats(sc, valid):
    sc = jnp.where(valid, sc, -jnp.inf)
    m = jnp.max(sc, axis=-1, keepdims=True)
    p = jnp.exp(sc - m)
    l = jnp.sum(p, axis=-1)
    return p, l, m[..., 0] + jnp.log(l)


def _merge_patterns(outs, lses):
    w = jax.nn.softmax(jnp.stack(lses), axis=0)
    return jnp.sum(w[..., None] * jnp.stack(outs), axis=0)


def _to_strided(a, dil):
    b, s = a.shape[:2]
    a = a.reshape((b, s // dil, dil) + a.shape[2:])
    a = jnp.moveaxis(a, 2, 1)
    return a.reshape((b * dil, s // dil) + a.shape[3:])


def _from_strided(a, b, dil):
    n, l = a.shape[:2]
    a = a.reshape((b, dil, l) + a.shape[2:])
    a = jnp.moveaxis(a, 1, 2)
    return a.reshape((b, l * dil) + a.shape[3:])


def _split_qkv(xn, w_qkv):
    b, t, _ = xn.shape
    qkv = (xn @ w_qkv).reshape(b, t, 3, ATT_HEADS, HEAD_DIM)
    return qkv[:, :, 0], qkv[:, :, 1], qkv[:, :, 2]


def dilated_branch_prompt(q, k, v, window, dil):
    b, s, h, e = q.shape
    span = window // dil
    qs, ks, vs = _to_strided(q, dil), _to_strided(k, dil), _to_strided(v, dil)
    l_sub = qs.shape[1]
    nb = -(-l_sub // ATT_BLOCK)
    extra = nb * ATT_BLOCK - l_sub
    qs = jnp.pad(qs, ((0, 0), (0, extra), (0, 0), (0, 0)))
    ks = jnp.pad(ks, ((0, 0), (ATT_BLOCK, extra), (0, 0), (0, 0)))
    vs = jnp.pad(vs, ((0, 0), (ATT_BLOCK, extra), (0, 0), (0, 0)))
    qi = jnp.arange(ATT_BLOCK)[:, None]
    kj = jnp.arange(2 * ATT_BLOCK)[None, :]
    dist = ATT_BLOCK + qi - kj
    band = (dist >= 0) & (dist <= span)
    scale = HEAD_DIM ** -0.5

    def one_block(blk):
        start = blk * ATT_BLOCK
        qb = lax.dynamic_slice_in_dim(qs, start, ATT_BLOCK, axis=1)
        kb = lax.dynamic_slice_in_dim(ks, start, 2 * ATT_BLOCK, axis=1)
        vb = lax.dynamic_slice_in_dim(vs, start, 2 * ATT_BLOCK, axis=1)
        valid = band & (start - ATT_BLOCK + kj >= 0)
        sc = jnp.einsum('nqhe,nkhe->nhqk', qb, kb, preferred_element_type=jnp.float32) * scale
        p, den, lse = _softmax_stats(sc, valid)
        o = jnp.einsum('nhqk,nkhe->nqhe', p, vb.astype(jnp.float32)) / jnp.swapaxes(den, 1, 2)[..., None]
        return o, jnp.swapaxes(lse, 1, 2)

    o_blk, lse_blk = lax.map(one_block, jnp.arange(nb))
    n = qs.shape[0]
    o = jnp.moveaxis(o_blk, 0, 1).reshape(n, nb * ATT_BLOCK, h, e)[:, :l_sub]
    lse = jnp.moveaxis(lse_blk, 0, 1).reshape(n, nb * ATT_BLOCK, h)[:, :l_sub]
    return _from_strided(o, b, dil), _from_strided(lse, b, dil)


def mixer_c_prompt(xn, w_qkv, w_o):
    q, k, v = _split_qkv(xn, w_qkv)
    outs, lses = [], []
    for window, dil in DILATED_PATTERNS:
        o, lse = dilated_branch_prompt(q, k, v, window, dil)
        outs.append(o)
        lses.append(lse)
    b, t = xn.shape[:2]
    y = _merge_patterns(outs, lses).reshape(b, t, ATT_WIDTH).astype(xn.dtype) @ w_o
    keep = min(MAX_WINDOW, t)
    return y, k[:, -keep:], v[:, -keep:]


def mixer_c_sample(xn, cache_k, cache_v, w_qkv, w_o):
    q, k, v = _split_qkv(xn, w_qkv)
    b, t = xn.shape[:2]
    buf = cache_k.shape[1]
    kk = jnp.concatenate([cache_k, k.astype(cache_k.dtype)], axis=1)
    vv = jnp.concatenate([cache_v, v.astype(cache_v.dtype)], axis=1)
    scale = HEAD_DIM ** -0.5
    outs, lses = [], []
    for window, dil in DILATED_PATTERNS:
        span = window // dil
        idx = buf + jnp.arange(t)[:, None] - dil * jnp.arange(span + 1)[None, :]
        valid = idx >= 0
        idx = jnp.maximum(idx, 0)
        kg, vg = kk[:, idx], vv[:, idx]
        sc = jnp.einsum('bthe,btjhe->bhtj', q, kg, preferred_element_type=jnp.float32) * scale
        p, den, lse = _softmax_stats(sc, valid[None, None])
        o = jnp.einsum('bhtj,btjhe->bthe', p, vg.astype(jnp.float32)) / jnp.swapaxes(den, 1, 2)[..., None]
        outs.append(o)
        lses.append(jnp.swapaxes(lse, 1, 2))
    y = _merge_patterns(outs, lses).reshape(b, t, ATT_WIDTH).astype(xn.dtype) @ w_o
    return y, k, v


def setup_inputs(seed: int = 0) -> dict:
    key = jax.random.key(seed)
    ks = jax.random.split(key, 26)
    f32 = jnp.float32

    def nrm(k, shape, scale):
        return jax.random.normal(k, shape, f32) * scale

    buf = min(MAX_WINDOW, PAST_LEN)
    return {
        'x_prompt': nrm(ks[0], (BATCH, SEQ, D_MODEL), 1.0),
        'x_sample': nrm(ks[1], (DEC_BATCH, DEC_SEQ, D_MODEL), 1.0),
        'state_pool': nrm(ks[2], (N_AB_LAYERS, DEC_BATCH, POOL_STATE, POOL_WIDTH), 1.0),
        'state_s5': nrm(ks[3], (N_AB_LAYERS, DEC_BATCH, SSM_GROUPS, SSM_STATE, 2), 0.1),
        'cache_k': nrm(ks[4], (N_C_LAYERS, DEC_BATCH, buf, ATT_HEADS, HEAD_DIM), 1.0),
        'cache_v': nrm(ks[5], (N_C_LAYERS, DEC_BATCH, buf, ATT_HEADS, HEAD_DIM), 1.0),
        'norm_gains': 1.0 + nrm(ks[6], (DEPTH, 4, D_MODEL), 0.1),
        'ab_w_in': nrm(ks[7], (N_AB_LAYERS, D_MODEL, MIX_WIDTH), D_MODEL ** -0.5),
        'ab_pool_w': nrm(ks[8], (N_AB_LAYERS, len(POOL_WINDOWS), POOL_GROUP, POOL_GROUP), POOL_GROUP ** -0.5),
        'ab_pool_scale': 1.0 + nrm(ks[9], (N_AB_LAYERS, POOL_WIDTH), 0.1),
        'ab_lambda_re': -0.5 + nrm(ks[10], (N_AB_LAYERS, SSM_GROUPS, SSM_STATE), 0.01),
        'ab_lambda_im': math.pi * jnp.arange(SSM_STATE, dtype=f32) + nrm(ks[11], (N_AB_LAYERS, SSM_GROUPS, SSM_STATE), 0.01),
        'ab_log_dt': jax.random.uniform(ks[12], (N_AB_LAYERS, SSM_GROUPS), f32, math.log(1e-3), math.log(1e-1)),
        'ab_b_re': nrm(ks[13], (N_AB_LAYERS, SSM_GROUPS, SSM_STATE, SSM_GROUP), (2 * SSM_GROUP) ** -0.5),
        'ab_b_im': nrm(ks[14], (N_AB_LAYERS, SSM_GROUPS, SSM_STATE, SSM_GROUP), (2 * SSM_GROUP) ** -0.5),
        'ab_c_re': nrm(ks[15], (N_AB_LAYERS, SSM_GROUPS, SSM_GROUP, SSM_STATE), SSM_STATE ** -0.5),
        'ab_c_im': nrm(ks[16], (N_AB_LAYERS, SSM_GROUPS, SSM_GROUP, SSM_STATE), SSM_STATE ** -0.5),
        'ab_d': nrm(ks[17], (N_AB_LAYERS, SSM_WIDTH), 1.0),
        'ab_w_glu': nrm(ks[18], (N_AB_LAYERS, SSM_WIDTH, SSM_WIDTH), SSM_WIDTH ** -0.5),
        'ab_b_glu': nrm(ks[19], (N_AB_LAYERS, SSM_WIDTH), 0.01),
        'ab_w_out': nrm(ks[20], (N_AB_LAYERS, MIX_WIDTH, D_MODEL), MIX_WIDTH ** -0.5),
        'c_w_qkv': nrm(ks[21], (N_C_LAYERS, D_MODEL, 3 * ATT_WIDTH), D_MODEL ** -0.5),
        'c_w_o': nrm(ks[22], (N_C_LAYERS, ATT_WIDTH, D_MODEL), ATT_WIDTH ** -0.5),
        'ffn_w_gate': nrm(ks[23], (DEPTH, D_MODEL, FFN_HIDDEN), D_MODEL ** -0.5),
        'ffn_w_up': nrm(ks[24], (DEPTH, D_MODEL, FFN_HIDDEN), D_MODEL ** -0.5),
        'ffn_w_down': nrm(ks[25], (DEPTH, FFN_HIDDEN, D_MODEL), FFN_HIDDEN ** -0.5),
    }


def reference(x_prompt, x_sample, state_pool, state_s5, cache_k, cache_v, norm_gains,
              ab_w_in, ab_pool_w, ab_pool_scale, ab_lambda_re, ab_lambda_im, ab_log_dt,
              ab_b_re, ab_b_im, ab_c_re, ab_c_im, ab_d, ab_w_glu, ab_b_glu, ab_w_out,
              c_w_qkv, c_w_o, ffn_w_gate, ffn_w_up, ffn_w_down):
    hp, hs = x_prompt, x_sample
    pos_p = jnp.arange(hp.shape[1])
    pos_s = PAST_LEN + jnp.arange(hs.shape[1])
    pool_p_list, s5_p_list, k_p_list, v_p_list = [], [], [], []
    pool_s_list, s5_s_list, k_s_list, v_s_list = [], [], [], []
    for layer in range(DEPTH):
        i = layer // 2
        g = norm_gains[layer]
        xp, xs = rms_norm(hp, g[0]), rms_norm(hs, g[0])
        if layer % 2 == 0:
            ab = (ab_w_in[i], ab_pool_w[i], ab_pool_scale[i], ab_lambda_re[i], ab_lambda_im[i],
                  ab_log_dt[i], ab_b_re[i], ab_b_im[i], ab_c_re[i], ab_c_im[i], ab_d[i],
                  ab_w_glu[i], ab_b_glu[i], ab_w_out[i])
            pool0 = jnp.zeros((hp.shape[0], POOL_STATE, POOL_WIDTH), hp.dtype)
            h0_p = jnp.zeros((hp.shape[0], SSM_GROUPS, SSM_STATE), jnp.complex64)
            h0_s = lax.complex(state_s5[i, ..., 0].astype(jnp.float32), state_s5[i, ..., 1].astype(jnp.float32))
            y_p, pool_p, h_p = mixer_ab(xp, pool0, h0_p, pos_p, *ab)
            y_s, pool_s, h_s = mixer_ab(xs, state_pool[i], h0_s, pos_s, *ab)
            pool_p_list.append(pool_p)
            pool_s_list.append(pool_s.astype(state_pool.dtype))
            s5_p_list.append(jnp.stack([h_p.real, h_p.imag], axis=-1).astype(state_s5.dtype))
            s5_s_list.append(jnp.stack([h_s.real, h_s.imag], axis=-1).astype(state_s5.dtype))
        else:
            y_p, k_p, v_p = mixer_c_prompt(xp, c_w_qkv[i], c_w_o[i])
            y_s, k_s, v_s = mixer_c_sample(xs, cache_k[i], cache_v[i], c_w_qkv[i], c_w_o[i])
            k_p_list.append(k_p)
            v_p_list.append(v_p)
            k_s_list.append(k_s.astype(cache_k.dtype))
            v_s_list.append(v_s.astype(cache_v.dtype))
        hp = hp + rms_norm(y_p, g[1])
        hs = hs + rms_norm(y_s, g[1])
        hp = hp + rms_norm(swiglu_ffn(rms_norm(hp, g[2]), ffn_w_gate[layer], ffn_w_up[layer], ffn_w_down[layer]), g[3])
        hs = hs + rms_norm(swiglu_ffn(rms_norm(hs, g[2]), ffn_w_gate[layer], ffn_w_up[layer], ffn_w_down[layer]), g[3])
    pool_prompt = jnp.stack(pool_p_list)
    s5_prompt = jnp.stack(s5_p_list)
    k_prompt = jnp.stack(k_p_list)
    v_prompt = jnp.stack(v_p_list)
    pool_sample = jnp.stack(pool_s_list)
    s5_sample = jnp.stack(s5_s_list)
    k_sample = jnp.stack(k_s_list)
    v_sample = jnp.stack(v_s_list)
    return (hp, hs, pool_prompt, s5_prompt, k_prompt, v_prompt, pool_sample, s5_sample, k_sample, v_sample)
```

```cpp
#include <hip/hip_runtime.h>
#include <hip/hip_cooperative_groups.h>
#include <cstdio>
#include <cstdint>
namespace cg = cooperative_groups;

#define LAS __attribute__((address_space(3)))
#define DI __device__ __forceinline__
typedef unsigned short bf16_t;
typedef short bf16x8 __attribute__((ext_vector_type(8)));
typedef short s16x4 __attribute__((ext_vector_type(4)));
typedef float f32x4 __attribute__((ext_vector_type(4)));
typedef unsigned u32x4 __attribute__((ext_vector_type(4)));
typedef unsigned u32x2 __attribute__((ext_vector_type(2)));
typedef __bf16 bf2_t __attribute__((ext_vector_type(2)));

constexpr int NP = 32768, NS = 128, NT = NP + NS, MT = 33024, DM = 1024, FF = 2816, TP = 8192;
constexpr float EPS = 1e-6f;
constexpr int LDS_BYTES = 131072;
constexpr size_t O_YP = 0, O_YS = 33554432, O_POOLP = 33685504, O_S5P = 33716224, O_KP = 33732608, O_VP = 42121216,
                 O_POOLS = 50509824, O_S5S = 50755584, O_KS = 50886656, O_VS = 51017728;
constexpr size_t MiB = 1u << 20;
constexpr size_t WS_WIN = 0, WS_WOUT = 2 * MiB, WS_WGLU = 4 * MiB, WS_WPOOL = 4 * MiB + 512 * 1024, WS_WO = 5 * MiB, WS_WQKV = 7 * MiB,
                 WS_GU0 = 13 * MiB, WS_GU1 = 24 * MiB, WS_DN0 = 35 * MiB, WS_DN1 = 41 * MiB, WS_BT1 = 47 * MiB, WS_BT2 = 51 * MiB,
                 WS_ROWSS = 57 * MiB, WS_USS = 60 * MiB, WS_LSE = 61 * MiB, WS_XN = 68 * MiB, WS_Y = 133 * MiB, WS_H = 198 * MiB,
                 WS_X = 328 * MiB;
constexpr size_t WS_AP = WS_X, WS_S = WS_X + 48 * MiB, WS_UPOOL = WS_X + 80 * MiB, WS_D = WS_X + 145 * MiB, WS_Z = WS_X + 178 * MiB,
                 WS_YCAT = WS_X + 211 * MiB;
constexpr size_t WS_HACT = WS_X;
constexpr size_t WS_Q = WS_X, WS_K = WS_X + 65 * MiB, WS_V = WS_X + 130 * MiB, WS_OP = WS_X + 195 * MiB, WS_ATT = WS_X + 389 * MiB;
constexpr size_t WS_END = WS_X + 454 * MiB;

struct Params { const float* in[26]; float* out; unsigned char* ws; int ph_lo, ph_hi; };

DI unsigned pk2(float lo, float hi) { bf2_t v; v.x = (__bf16)lo; v.y = (__bf16)hi; return __builtin_bit_cast(unsigned, v); }
DI float bflo(unsigned w) { return __uint_as_float(w << 16); }
DI float bfhi(unsigned w) { return __uint_as_float(w & 0xffff0000u); }
DI float bf2f(bf16_t b) { return __uint_as_float((unsigned)b << 16); }
DI float wave_sum(float v) {
#pragma unroll
    for (int o = 1; o < 64; o <<= 1) v += __shfl_xor(v, o);
    return v;
}
DI float wave_max(float v) {
#pragma unroll
    for (int o = 1; o < 64; o <<= 1) v = fmaxf(v, __shfl_xor(v, o));
    return v;
}
DI float sigmoidf_(float x) { return 1.0f / (1.0f + __expf(-x)); }
DI float gelu_tanh(float y) { const float u = 0.7978845608028654f * (y + 0.044715f * y * y * y); return y / (1.0f + __expf(-2.0f * u)); }
DI void sincos_acc(float a, float& s, float& c) {
    if (fabsf(a) < 0.5f) {
        const float a2 = a * a;
        s = a * (1.f - a2 * (1.f / 6.f) * (1.f - a2 * (1.f / 20.f) * (1.f - a2 * (1.f / 42.f))));
        c = 1.f - a2 * 0.5f * (1.f - a2 * (1.f / 12.f) * (1.f - a2 * (1.f / 30.f) * (1.f - a2 * (1.f / 56.f))));
    } else {
        float r = a * 0.15915494309189535f; r -= floorf(r);
        s = __builtin_amdgcn_sinf(r); c = __builtin_amdgcn_cosf(r);
    }
}
#define LDS_WAIT() asm volatile("s_waitcnt lgkmcnt(0)" ::: "memory")
#define VM_WAIT() asm volatile("s_waitcnt vmcnt(0)" ::: "memory")

constexpr int BM = 256, BK = 64, HALF = 128, NXCD = 8, WGM = 8;
typedef f32x4 Acc[2][2][4][2];
DI int lds_byte(int r, int c) { const int st = (r >> 4) * 2 + (c >> 5), rr = r & 15, cc = c & 31, ob = rr * 64 + cc * 2; return st * 1024 + (ob ^ (((ob >> 9) & 1) << 5)); }
DI void stage_rc(int b, int& R, int& C) { const int st = b / 1024, sb = b % 1024, swz = sb ^ (((sb >> 9) & 1) << 5); R = (st >> 1) * 16 + swz / 64; C = (st & 1) * 32 + (swz % 64) / 2; }

DI bool unit_next(int i, int G, int c, int nM, int nN, int& pm, int& pn) {
    const int nwg = nM * nN; const long L = (long)i * G + c; if (L >= nwg) return false;
    int wgid = (int)L; { const int q = nwg / NXCD, r = nwg % NXCD, xcd = wgid % NXCD, off = wgid / NXCD; wgid = (xcd < r ? xcd * (q + 1) : r * (q + 1) + (xcd - r) * q) + off; }
    const int nig = WGM * nN, gid = wgid / nig, fm = gid * WGM, gsz = (nM - fm) < WGM ? (nM - fm) : WGM;
    pm = fm + ((wgid % nig) % gsz); pn = (wgid % nig) / gsz; return true;
}

template <class Epi>
DI void gemm_tile(LAS unsigned char* lds, const bf16_t* A, int lda, const bf16_t* Bt, int ldb, int K, const Epi& E) {
    const int tid = threadIdx.x, wid = __builtin_amdgcn_readfirstlane(tid >> 6), lane = tid & 63, wr = wid >> 2, wc = wid & 3, fr = lane & 15, fq = lane >> 4;
    unsigned offA[2], offB[2];
#pragma unroll
    for (int i = 0; i < 2; ++i) { int R, C; stage_rc(tid * 16 + i * 8192, R, C); offA[i] = (unsigned)(R * lda + C) * 2u; offB[i] = (unsigned)(R * ldb + C) * 2u; }
    const unsigned ldsw = (unsigned)wid * 1024u;
    const size_t hA = (size_t)HALF * lda * 2, hB = (size_t)HALF * ldb * 2;
    const char* cA = (const char*)A; const char* cB = (const char*)Bt;
    const int aoff = lds_byte(wr * 64 + fr, fq * 8), boff = lds_byte(wc * 32 + fr, fq * 8);
#define SA(b, h) (((b) * 2 + (h)) * 16384)
#define SB(b, h) ((4 + (b) * 2 + (h)) * 16384)
#define STG(bufoff, gbase, voff) do { _Pragma("unroll") for (int _i = 0; _i < 2; ++_i) { unsigned _vo = (voff)[_i]; asm volatile("" : "+v"(_vo)); \
        __builtin_amdgcn_global_load_lds((const unsigned*)((gbase) + _vo), (LAS unsigned*)(lds + (bufoff) + ldsw + _i * 8192), 16, 0, 0); } } while (0)
#define STA(b, h, kt) STG(SA(b, h), cA + (h) * hA + (size_t)(kt) * 128, offA)
#define STB(b, h, kt) STG(SB(b, h), cB + (h) * hB + (size_t)(kt) * 128, offB)
#define LDA(dst, b, h) do { _Pragma("unroll") for (int m = 0; m < 4; ++m) _Pragma("unroll") for (int k = 0; k < 2; ++k) dst[m][k] = *(const LAS bf16x8*)(lds + SA(b, h) + aoff + m * 2048 + k * 1024); } while (0)
#define LDB(dst, b, h) do { _Pragma("unroll") for (int n = 0; n < 2; ++n) _Pragma("unroll") for (int k = 0; k < 2; ++k) dst[n][k] = *(const LAS bf16x8*)(lds + SB(b, h) + boff + n * 2048 + k * 1024); } while (0)
#define MMA(ai, bj, Af, Bf) do { __builtin_amdgcn_s_setprio(1); _Pragma("unroll") for (int m = 0; m < 4; ++m) _Pragma("unroll") for (int n = 0; n < 2; ++n) _Pragma("unroll") for (int k = 0; k < 2; ++k) \
        acc[ai][bj][m][n] = __builtin_amdgcn_mfma_f32_16x16x32_bf16(Bf[n][k], Af[m][k], acc[ai][bj][m][n], 0, 0, 0); __builtin_amdgcn_s_setprio(0); } while (0)
#define WAIT_V(n) asm volatile("s_waitcnt vmcnt(" #n ")" ::: "memory")
#define WAIT_L(n) asm volatile("s_waitcnt lgkmcnt(" #n ")" ::: "memory")
#define BAR __builtin_amdgcn_s_barrier()
#define SCHED __builtin_amdgcn_sched_barrier(0)
    Acc acc;
#pragma unroll
    for (int a = 0; a < 2; ++a)
#pragma unroll
        for (int b = 0; b < 2; ++b)
#pragma unroll
            for (int m = 0; m < 4; ++m)
#pragma unroll
                for (int n = 0; n < 2; ++n) acc[a][b][m][n] = (f32x4){0.f, 0.f, 0.f, 0.f};
    bf16x8 At[4][2], B0[2][2], B1[2][2];
    const int nt = K / BK;
    STB(0, 0, 0); STA(0, 0, 0); STB(0, 1, 0); STA(0, 1, 0);
    if (wr == 1) BAR;
    WAIT_V(4); BAR;
    STB(1, 0, 1); STA(1, 0, 1); STB(1, 1, 1);
    WAIT_V(6); BAR;
    for (int t = 0; t < nt - 2; t += 2) {
        LDB(B0, 0, 0); SCHED; LDA(At, 0, 0); STA(1, 1, t + 1);
        WAIT_L(8); BAR; WAIT_L(0); MMA(0, 0, At, B0); BAR; SCHED;
        LDB(B1, 0, 1); STB(0, 0, t + 2);
        BAR; WAIT_L(0); MMA(0, 1, At, B1); BAR;
        LDA(At, 0, 1); STA(0, 0, t + 2);
        BAR; WAIT_L(0); MMA(1, 0, At, B0); BAR; SCHED;
        STB(0, 1, t + 2);
        WAIT_V(6); BAR; MMA(1, 1, At, B1); BAR;
        LDB(B0, 1, 0); SCHED; LDA(At, 1, 0); STA(0, 1, t + 2);
        WAIT_L(8); BAR; WAIT_L(0); MMA(0, 0, At, B0); BAR; SCHED;
        LDB(B1, 1, 1); STB(1, 0, t + 3);
        BAR; WAIT_L(0); MMA(0, 1, At, B1); BAR;
        LDA(At, 1, 1); STA(1, 0, t + 3);
        BAR; WAIT_L(0); MMA(1, 0, At, B0); BAR; SCHED;
        STB(1, 1, t + 3);
        WAIT_V(6); BAR; MMA(1, 1, At, B1); BAR;
    }
    { LDB(B0, 0, 0); LDA(At, 0, 0); STA(1, 1, nt - 1);
      BAR; WAIT_L(0); MMA(0, 0, At, B0); BAR;
      LDB(B1, 0, 1); BAR; WAIT_L(0); MMA(0, 1, At, B1); BAR;
      LDA(At, 0, 1); WAIT_V(4); BAR; WAIT_L(0); MMA(1, 0, At, B0); MMA(1, 1, At, B1); BAR; }
    { LDB(B0, 1, 0); LDA(At, 1, 0); WAIT_V(2); BAR; WAIT_L(0); MMA(0, 0, At, B0); BAR;
      LDB(B1, 1, 1); WAIT_V(0); BAR; WAIT_L(0); MMA(0, 1, At, B1); BAR;
      LDA(At, 1, 1); BAR; WAIT_L(0); MMA(1, 0, At, B0); MMA(1, 1, At, B1); BAR; }
    if (wr == 0) BAR;
    E(acc, wr, wc, fr, fq);
    VM_WAIT();
#undef SA
#undef SB
#undef STG
#undef STA
#undef STB
#undef LDA
#undef LDB
#undef MMA
#undef WAIT_V
#undef WAIT_L
#undef BAR
#undef SCHED
}

#define EPI_ROWS(...) _Pragma("unroll") for (int ai = 0; ai < 2; ++ai) _Pragma("unroll") for (int m = 0; m < 4; ++m) { const int rr = ai * 128 + wr * 64 + m * 16 + fr; __VA_ARGS__ asm volatile("" ::: "memory"); }
#define EPI_COLS(...) _Pragma("unroll") for (int bj = 0; bj < 2; ++bj) _Pragma("unroll") for (int n = 0; n < 2; ++n) { const int cc = bj * 128 + wc * 32 + n * 16 + 4 * fq; const f32x4 v = acc[ai][bj][m][n]; __VA_ARGS__ }

struct EpiProj {
    float* upool; bf16_t* Ap; float* uss; int row0, col0;
    DI void operator()(const Acc& acc, int wr, int wc, int fr, int fq) const {
        if (col0 < 512) {
            EPI_ROWS(const size_t row = row0 + rr; EPI_COLS(*(f32x4*)(upool + row * 512 + col0 + cc) = v;))
        } else {
            EPI_ROWS(const int row = row0 + rr;
                EPI_COLS(const int c2 = col0 - 512 + cc; const int g = c2 >> 4, i = c2 & 15;
                    if (row < NP) { u32x2 w; w.x = pk2(v[0], v[1]); w.y = pk2(v[2], v[3]);
                        *(u32x2*)(Ap + ((size_t)g * 2048 + (row >> 4)) * 384 + 128 + (row & 15) * 16 + i) = w; }
                    else if (row < NT) { *(f32x4*)(uss + (size_t)(row - NP) * 512 + c2) = v; }))
        }
    }
};
struct EpiS1 {
    float* S; int g, row0;
    DI void operator()(const Acc& acc, int wr, int wc, int fr, int fq) const {
        EPI_ROWS(const size_t row = (size_t)g * 2048 + row0 + rr;
            _Pragma("unroll") for (int n = 0; n < 2; ++n) { const int cc = wc * 32 + n * 16 + 4 * fq; *(f32x4*)(S + row * 128 + cc) = acc[ai][0][m][n]; })
    }
};
struct EpiPool {
    bf16_t* ycat; const float* scale; int row0, col0;
    DI void operator()(const Acc& acc, int wr, int wc, int fr, int fq) const {
        EPI_ROWS(const size_t row = row0 + rr;
            EPI_COLS(const int col = col0 + cc; const f32x4 s = *(const f32x4*)(scale + col); u32x2 w; w.x = pk2(v[0] * s[0], v[1] * s[1]); w.y = pk2(v[2] * s[2], v[3] * s[3]);
                *(u32x2*)(ycat + row * 1024 + col) = w;))
    }
};
struct EpiS2 {
    bf16_t* z; const bf16_t* Ap; const float* dskip; int g, row0;
    DI void operator()(const Acc& acc, int wr, int wc, int fr, int fq) const {
        EPI_ROWS(const int chunk = row0 + rr; const bf16_t* ap = Ap + ((size_t)g * 2048 + chunk) * 384 + 128;
            EPI_COLS(const int r = cc >> 4, i = cc & 15; const u32x2 uw = *(const u32x2*)(ap + cc); const f32x4 d = *(const f32x4*)(dskip + g * 16 + i);
                const float y0 = v[0] + d[0] * bflo(uw.x), y1 = v[1] + d[1] * bfhi(uw.x), y2 = v[2] + d[2] * bflo(uw.y), y3 = v[3] + d[3] * bfhi(uw.y);
                u32x2 w; w.x = pk2(gelu_tanh(y0), gelu_tanh(y1)); w.y = pk2(gelu_tanh(y2), gelu_tanh(y3));
                *(u32x2*)(z + ((size_t)chunk * 16 + r) * 512 + g * 16 + i) = w;))
    }
};
struct EpiGlu {
    bf16_t* ycat; const bf16_t* z; const float* bglu; int row0, col0;
    DI void operator()(const Acc& acc, int wr, int wc, int fr, int fq) const {
        EPI_ROWS(const size_t row = row0 + rr;
            EPI_COLS(const int col = col0 + cc; const u32x2 zw = *(const u32x2*)(z + row * 512 + col); const f32x4 b = *(const f32x4*)(bglu + col);
                u32x2 w; w.x = pk2(bflo(zw.x) * sigmoidf_(v[0] + b[0]), bfhi(zw.x) * sigmoidf_(v[1] + b[1]));
                w.y = pk2(bflo(zw.y) * sigmoidf_(v[2] + b[2]), bfhi(zw.y) * sigmoidf_(v[3] + b[3]));
                *(u32x2*)(ycat + row * 1024 + 512 + col) = w;))
    }
};
struct EpiY {
    bf16_t* y; float* rowss; int row0, col0;
    DI void operator()(const Acc& acc, int wr, int wc, int fr, int fq) const {
        EPI_ROWS(const size_t row = row0 + rr; float ss = 0.f;
            EPI_COLS(u32x2 w; w.x = pk2(v[0], v[1]); w.y = pk2(v[2], v[3]); *(u32x2*)(y + row * 1024 + col0 + cc) = w;
                ss += (v[0] * v[0] + v[1] * v[1]) + (v[2] * v[2] + v[3] * v[3]);)
            ss += __shfl_xor(ss, 16); ss += __shfl_xor(ss, 32);
            if (fq == 0) rowss[row * 16 + (col0 >> 8) * 4 + wc] = ss;)
    }
};
struct EpiGU {
    bf16_t* hact; int row0, hb;
    DI void operator()(const Acc& acc, int wr, int wc, int fr, int fq) const {
        EPI_ROWS(const size_t row = row0 + rr;
            _Pragma("unroll") for (int n = 0; n < 2; ++n) { const int cc = wc * 32 + n * 16 + 4 * fq; const f32x4 a = acc[ai][0][m][n], u = acc[ai][1][m][n];
                u32x2 w; w.x = pk2(a[0] * sigmoidf_(a[0]) * u[0], a[1] * sigmoidf_(a[1]) * u[1]); w.y = pk2(a[2] * sigmoidf_(a[2]) * u[2], a[3] * sigmoidf_(a[3]) * u[3]);
                *(u32x2*)(hact + row * FF + hb * 128 + cc) = w; })
    }
};
struct EpiQKV {
    bf16_t* qkv; float* out; int row0, col0;
    DI void operator()(const Acc& acc, int wr, int wc, int fr, int fq) const {
        const int which = col0 >> 10; const int cb = col0 & 1023; const float sc = which == 0 ? 0.125f : 1.0f;
        bf16_t* dst = qkv + (size_t)which * (65 * MiB / 2);
        float* op = out + (which == 1 ? O_KP : O_VP); float* os = out + (which == 1 ? O_KS : O_VS);
        EPI_ROWS(const int row = row0 + rr;
            EPI_COLS(const int col = cb + cc; u32x2 w; w.x = pk2(v[0] * sc, v[1] * sc); w.y = pk2(v[2] * sc, v[3] * sc);
                *(u32x2*)(dst + (size_t)row * 1024 + col) = w;
                if (which != 0) {
                    if (row < NP) { const int tb = row & (TP - 1); if (tb >= TP - 2048) *(f32x4*)(op + ((size_t)(row >> 13) * 2048 + (tb - (TP - 2048))) * 1024 + col) = v; }
                    else if (row < NT) *(f32x4*)(os + (size_t)(row - NP) * 1024 + col) = v;
                }))
    }
};

DI void transpose_item(const float* W, int N, int k0, int n0, bf16_t* WT, int ldt, int orow0, int ocol0, LAS float* scr, int lane) {
#pragma unroll 8
    for (int i = 0; i < 32; ++i) { const int kk = 2 * i + (lane >> 5); scr[kk * 33 + (lane & 31)] = W[(size_t)(k0 + kk) * N + n0 + (lane & 31)]; }
    LDS_WAIT();
    const int c = lane & 7;
#pragma unroll
    for (int j = 0; j < 4; ++j) { const int n = (lane >> 3) + 8 * j; const LAS float* s = scr + (8 * c) * 33 + n;
        u32x4 o; o.x = pk2(s[0 * 33], s[1 * 33]); o.y = pk2(s[2 * 33], s[3 * 33]); o.z = pk2(s[4 * 33], s[5 * 33]); o.w = pk2(s[6 * 33], s[7 * 33]);
        *(u32x4*)(WT + (size_t)(orow0 + n) * ldt + ocol0 + 8 * c) = o; }
    LDS_WAIT();
}
DI void tr_plain(const float* W, int K, int N, bf16_t* WT, int item, LAS float* scr, int lane) {
    const int nblk = N / 32, kb = item / nblk, nb = item % nblk; transpose_item(W, N, 64 * kb, 32 * nb, WT, K, 32 * nb, 64 * kb, scr, lane);
}

DI const float* in_row(const Params& p, int r) { return r < NP ? p.in[0] + (size_t)r * DM : p.in[1] + (size_t)(r - NP) * DM; }

DI void norm_row(const float* xr, const float* g, bf16_t* o, int lane) {
    f32x4 v[4]; float s = 0.f;
#pragma unroll
    for (int j = 0; j < 4; ++j) { v[j] = *(const f32x4*)(xr + 4 * lane + 256 * j); s += (v[j][0] * v[j][0] + v[j][1] * v[j][1]) + (v[j][2] * v[j][2] + v[j][3] * v[j][3]); }
    const float r = rsqrtf(wave_sum(s) * (1.f / DM) + EPS);
#pragma unroll
    for (int j = 0; j < 4; ++j) { const f32x4 gg = *(const f32x4*)(g + 4 * lane + 256 * j); u32x2 w; w.x = pk2(v[j][0] * r * gg[0], v[j][1] * r * gg[1]); w.y = pk2(v[j][2] * r * gg[2], v[j][3] * r * gg[3]);
        *(u32x2*)(o + 4 * lane + 256 * j) = w; }
}
DI void res_row(const float* hin, const bf16_t* y, const float* rss, const float* gpost, const float* gnext, float* hout, bf16_t* xn, int lane) {
    float ss = rss[lane & 15];
    ss += __shfl_xor(ss, 1); ss += __shfl_xor(ss, 2); ss += __shfl_xor(ss, 4); ss += __shfl_xor(ss, 8);
    const float r1 = rsqrtf(ss * (1.f / DM) + EPS);
    f32x4 h[4]; float s2 = 0.f;
#pragma unroll
    for (int j = 0; j < 4; ++j) { const int c = 4 * lane + 256 * j; const f32x4 hv = *(const f32x4*)(hin + c); const u32x2 yw = *(const u32x2*)(y + c); const f32x4 gp = *(const f32x4*)(gpost + c);
        h[j][0] = hv[0] + bflo(yw.x) * r1 * gp[0]; h[j][1] = hv[1] + bfhi(yw.x) * r1 * gp[1]; h[j][2] = hv[2] + bflo(yw.y) * r1 * gp[2]; h[j][3] = hv[3] + bfhi(yw.y) * r1 * gp[3];
        s2 += (h[j][0] * h[j][0] + h[j][1] * h[j][1]) + (h[j][2] * h[j][2] + h[j][3] * h[j][3]);
        *(f32x4*)(hout + c) = h[j]; }
    if (xn) {
        const float r2 = rsqrtf(wave_sum(s2) * (1.f / DM) + EPS);
#pragma unroll
        for (int j = 0; j < 4; ++j) { const int c = 4 * lane + 256 * j; const f32x4 gn = *(const f32x4*)(gnext + c); u32x2 w; w.x = pk2(h[j][0] * r2 * gn[0], h[j][1] * r2 * gn[1]); w.y = pk2(h[j][2] * r2 * gn[2], h[j][3] * r2 * gn[3]);
            *(u32x2*)(xn + c) = w; }
    }
}

DI void s5_tables(const Params& p, int g, LAS unsigned char* lds, bf16_t* Bt1, bf16_t* Bt2) {
    LAS float* pwr = (LAS float*)lds;
    LAS float* pwi = pwr + 17 * 64;
    LAS float* bbr = pwi + 17 * 64;
    LAS float* bbi = bbr + 1024;
    LAS float* cr = bbi + 1024;
    LAS float* ci = cr + 1024;
    LAS float* Kd = ci + 1024;
    const int tid = threadIdx.x;
    const float dt = __expf(p.in[12][g]);
    const float* lre = p.in[10] + g * 64; const float* lim = p.in[11] + g * 64;
    for (int it = tid; it < 17 * 64; it += 512) { const int d = it >> 6, q = it & 63; const float zr = lre[q] * dt * (float)d, zi = lim[q] * dt * (float)d;
        float s, c; sincos_acc(zi, s, c); const float mag = __expf(zr); pwr[it] = mag * c; pwi[it] = mag * s; }
    for (int it = tid; it < 1024; it += 512) { const int q = it >> 4, i = it & 15;
        const float lr = lre[q], li = lim[q], zr = lr * dt, zi = li * dt;
        float s, c, sh, ch; sincos_acc(zi, s, c); sincos_acc(0.5f * zi, sh, ch);
        const float em1 = expm1f(zr); const float nr = em1 * c - 2.f * sh * sh, ni = (em1 + 1.f) * s;
        const float den = 1.f / (lr * lr + li * li); const float fr_ = (nr * lr + ni * li) * den, fi_ = (ni * lr - nr * li) * den;
        const float br = p.in[13][(size_t)g * 1024 + it], bi = p.in[14][(size_t)g * 1024 + it];
        bbr[it] = fr_ * br - fi_ * bi; bbi[it] = fr_ * bi + fi_ * br;
        cr[it] = p.in[15][(size_t)g * 1024 + it]; ci[it] = p.in[16][(size_t)g * 1024 + it]; }
    __syncthreads();
    for (int it = tid; it < 4096; it += 512) { const int d = it >> 8, i = (it >> 4) & 15, j = it & 15; float a = 0.f;
        for (int q = 0; q < 64; ++q) { const float c_r = cr[i * 64 + q], c_i = ci[i * 64 + q], p_r = pwr[d * 64 + q], p_i = pwi[d * 64 + q];
            const float xr = c_r * p_r - c_i * p_i, xi = c_r * p_i + c_i * p_r; a += xr * bbr[q * 16 + j] - xi * bbi[q * 16 + j]; }
        Kd[it] = a; }
    __syncthreads();
    for (int it = tid; it < 256 * 32; it += 512) { const int n = it >> 5, k0 = (it & 31) * 8; float v[8];
#pragma unroll
        for (int e = 0; e < 8; ++e) { const int k = k0 + e, s = k >> 4, i = k & 15; float val = 0.f;
            if (n < 128) { const int q = n & 63; const float p_r = pwr[(15 - s) * 64 + q], p_i = pwi[(15 - s) * 64 + q], b_r = bbr[q * 16 + i], b_i = bbi[q * 16 + i];
                val = n < 64 ? (p_r * b_r - p_i * b_i) : (p_r * b_i + p_i * b_r); }
            v[e] = val; }
        u32x4 o; o.x = pk2(v[0], v[1]); o.y = pk2(v[2], v[3]); o.z = pk2(v[4], v[5]); o.w = pk2(v[6], v[7]);
        *(u32x4*)(Bt1 + (size_t)n * 256 + k0) = o; }
    for (int it = tid; it < 256 * 48; it += 512) { const int n = it / 48, k0 = (it % 48) * 8; const int r = n >> 4, i = n & 15; float v[8];
#pragma unroll
        for (int e = 0; e < 8; ++e) { const int k = k0 + e; float val;
            if (k < 128) { const int q = k & 63; const float c_r = cr[i * 64 + q], c_i = ci[i * 64 + q], p_r = pwr[(r + 1) * 64 + q], p_i = pwi[(r + 1) * 64 + q];
                val = k < 64 ? (c_r * p_r - c_i * p_i) : -(c_r * p_i + c_i * p_r); }
            else { const int kk = k - 128, s = kk >> 4, j = kk & 15; val = s <= r ? Kd[(r - s) * 256 + i * 16 + j] : 0.f; }
            v[e] = val; }
        u32x4 o; o.x = pk2(v[0], v[1]); o.y = pk2(v[2], v[3]); o.z = pk2(v[4], v[5]); o.w = pk2(v[6], v[7]);
        *(u32x4*)(Bt2 + (size_t)n * 384 + k0) = o; }
    __syncthreads();
}

DI void s5_sample_unit(const Params& p, int u, const float* uss, bf16_t* z, int lane) {
    const int g = u & 31, b = u >> 5;
    const float dt = __expf(p.in[12][g]);
    const float lr = p.in[10][g * 64 + lane], li = p.in[11][g * 64 + lane], zr = lr * dt, zi = li * dt;
    float s, c, sh, ch; sincos_acc(zi, s, c); sincos_acc(0.5f * zi, sh, ch);
    const float em1 = expm1f(zr); const float nr = em1 * c - 2.f * sh * sh, ni = (em1 + 1.f) * s;
    const float lbr = nr + 1.f, lbi = ni;
    const float den = 1.f / (lr * lr + li * li); const float fr_ = (nr * lr + ni * li) * den, fi_ = (ni * lr - nr * li) * den;
    float hr = p.in[3][(((size_t)b * 32 + g) * 64 + lane) * 2], hi = p.in[3][(((size_t)b * 32 + g) * 64 + lane) * 2 + 1];
    const float* bre = p.in[13] + ((size_t)g * 64 + lane) * 16; const float* bim = p.in[14] + ((size_t)g * 64 + lane) * 16;
    const float* cre = p.in[15] + (size_t)g * 1024 + lane; const float* cim = p.in[16] + (size_t)g * 1024 + lane;
    for (int t = 0; t < 4; ++t) {
        const float* ur = uss + (size_t)(b * 4 + t) * 512 + g * 16;
        float bur = 0.f, bui = 0.f;
#pragma unroll
        for (int i = 0; i < 16; ++i) { const float uv = ur[i]; const float br = bre[i], bi = bim[i]; bur += (fr_ * br - fi_ * bi) * uv; bui += (fr_ * bi + fi_ * br) * uv; }
        const float n_r = lbr * hr - lbi * hi + bur, n_i = lbr * hi + lbi * hr + bui; hr = n_r; hi = n_i;
        float yv = 0.f;
#pragma unroll
        for (int i = 0; i < 16; ++i) { float a = cre[i * 64] * hr - cim[i * 64] * hi; a = wave_sum(a); if (lane == i) yv = a; }
        if (lane < 16) { const float y = yv + p.in[17][g * 16 + lane] * ur[lane]; z[(size_t)(NP + b * 4 + t) * 512 + g * 16 + lane] = (bf16_t)(pk2(gelu_tanh(y), 0.f) & 0xffffu); }
    }
    float* o = p.out + O_S5S + (((size_t)b * 32 + g) * 64 + lane) * 2; o[0] = hr; o[1] = hi;
}

constexpr int NQ = 2;
DI void attn_prompt_unit(int u, const bf16_t* Q, const bf16_t* Kb, const bf16_t* Vb, bf16_t* Op, float* lse, LAS unsigned char* vl, int lane) {
    const int tile = u & 255, h = (u >> 8) & 15, b = (u >> 12) & 3, pat = u >> 14;
    const int dsh = pat * 2, dil = 1 << dsh;
    const int rho = tile & (dil - 1), lt = tile >> dsh, l0 = lt * 32;
    const int i = lane & 15, g = lane >> 4;
    const size_t rowbase = (size_t)b * TP + rho;
    bf16x8 qf[NQ][2];
#pragma unroll
    for (int qb = 0; qb < NQ; ++qb) { const bf16_t* q = Q + (rowbase + (size_t)dil * (l0 + 16 * qb + i)) * 1024 + h * 64 + 8 * g; qf[qb][0] = *(const bf16x8*)q; qf[qb][1] = *(const bf16x8*)(q + 32); }
    f32x4 o[NQ][4]; float mrun[NQ], lsum[NQ];
#pragma unroll
    for (int qb = 0; qb < NQ; ++qb) { mrun[qb] = -1e30f; lsum[qb] = 0.f;
#pragma unroll
        for (int db = 0; db < 4; ++db) o[qb][db] = (f32x4){0.f, 0.f, 0.f, 0.f}; }
    const unsigned vbase = (unsigned)(size_t)vl;
    const unsigned traddr = vbase + (unsigned)((4 * g + (i >> 2)) * 144 + (4 * (i & 3)) * 2);
    for (int ks = 0; ks < 4 + NQ / 2; ++ks) {
        const int kbase = l0 - 128 + 32 * ks;
#pragma unroll
        for (int n = 0; n < 4; ++n) { const int c = lane + 64 * n, kr = c >> 3, ch = c & 7; int lk = kbase + kr; lk = lk < 0 ? 0 : lk;
            const u32x4 v = *(const u32x4*)(Vb + (rowbase + (size_t)dil * lk) * 1024 + h * 64 + ch * 8);
            *(LAS u32x4*)(vl + kr * 144 + ch * 16) = v; }
        bf16x8 kf[2][2];
#pragma unroll
        for (int kbl = 0; kbl < 2; ++kbl) { int lk = kbase + 16 * kbl + i; lk = lk < 0 ? 0 : lk; const bf16_t* kp = Kb + (rowbase + (size_t)dil * lk) * 1024 + h * 64 + 8 * g;
            kf[kbl][0] = *(const bf16x8*)kp; kf[kbl][1] = *(const bf16x8*)(kp + 32); }
        f32x4 st[2][NQ];
#pragma unroll
        for (int kbl = 0; kbl < 2; ++kbl)
#pragma unroll
            for (int qb = 0; qb < NQ; ++qb) { f32x4 a = (f32x4){0.f, 0.f, 0.f, 0.f};
                a = __builtin_amdgcn_mfma_f32_16x16x32_bf16(kf[kbl][0], qf[qb][0], a, 0, 0, 0);
                a = __builtin_amdgcn_mfma_f32_16x16x32_bf16(kf[kbl][1], qf[qb][1], a, 0, 0, 0); st[kbl][qb] = a; }
        bf16x8 pf[NQ];
#pragma unroll
        for (int qb = 0; qb < NQ; ++qb) {
            const int lq = l0 + 16 * qb + i; float mx = -INFINITY;
#pragma unroll
            for (int kbl = 0; kbl < 2; ++kbl)
#pragma unroll
                for (int r = 0; r < 4; ++r) { const int lk = kbase + 16 * kbl + 4 * g + r; const bool ok = (lk >= 0) && (lk <= lq) && (lq - lk <= 128);
                    const float s = ok ? st[kbl][qb][r] : -INFINITY; st[kbl][qb][r] = s; mx = fmaxf(mx, s); }
            mx = fmaxf(mx, __shfl_xor(mx, 16)); mx = fmaxf(mx, __shfl_xor(mx, 32));
            const float mn = fmaxf(mrun[qb], mx); const float alpha = __expf(mrun[qb] - mn); mrun[qb] = mn;
            float ps = 0.f;
#pragma unroll
            for (int kbl = 0; kbl < 2; ++kbl)
#pragma unroll
                for (int r = 0; r < 4; ++r) { const float pv = __expf(st[kbl][qb][r] - mn); st[kbl][qb][r] = pv; ps += pv; }
            lsum[qb] = lsum[qb] * alpha + ps;
#pragma unroll
            for (int db = 0; db < 4; ++db) o[qb][db] = o[qb][db] * alpha;
            u32x4 pw; pw.x = pk2(st[0][qb][0], st[0][qb][1]); pw.y = pk2(st[0][qb][2], st[0][qb][3]); pw.z = pk2(st[1][qb][0], st[1][qb][1]); pw.w = pk2(st[1][qb][2], st[1][qb][3]);
            pf[qb] = __builtin_bit_cast(bf16x8, pw);
        }
        s16x4 lo[4], hi[4];
        asm volatile("s_waitcnt vmcnt(0) lgkmcnt(0)\n\t"
                     "ds_read_b64_tr_b16 %0, %8\n\tds_read_b64_tr_b16 %1, %8 offset:32\n\tds_read_b64_tr_b16 %2, %8 offset:64\n\tds_read_b64_tr_b16 %3, %8 offset:96\n\t"
                     "ds_read_b64_tr_b16 %4, %8 offset:2304\n\tds_read_b64_tr_b16 %5, %8 offset:2336\n\tds_read_b64_tr_b16 %6, %8 offset:2368\n\tds_read_b64_tr_b16 %7, %8 offset:2400\n\t"
                     "s_waitcnt lgkmcnt(0)"
                     : "=&v"(lo[0]), "=&v"(lo[1]), "=&v"(lo[2]), "=&v"(lo[3]), "=&v"(hi[0]), "=&v"(hi[1]), "=&v"(hi[2]), "=&v"(hi[3]) : "v"(traddr) : "memory");
#pragma unroll
        for (int db = 0; db < 4; ++db) { const bf16x8 vf = __builtin_shufflevector(lo[db], hi[db], 0, 1, 2, 3, 4, 5, 6, 7);
#pragma unroll
            for (int qb = 0; qb < NQ; ++qb) o[qb][db] = __builtin_amdgcn_mfma_f32_16x16x32_bf16(vf, pf[qb], o[qb][db], 0, 0, 0); }
    }
#pragma unroll
    for (int qb = 0; qb < NQ; ++qb) {
        float l = lsum[qb]; l += __shfl_xor(l, 16); l += __shfl_xor(l, 32);
        const float inv = 1.f / l; const size_t row = (size_t)pat * MT + rowbase + (size_t)dil * (l0 + 16 * qb + i);
#pragma unroll
        for (int db = 0; db < 4; ++db) { const f32x4 v = o[qb][db] * inv; u32x2 w; w.x = pk2(v[0], v[1]); w.y = pk2(v[2], v[3]); *(u32x2*)(Op + row * 1024 + h * 64 + 16 * db + 4 * g) = w; }
        if (g == 0) lse[row * 16 + h] = mrun[qb] + __logf(l);
    }
}

DI void attn_sample_unit(const Params& p, int u, const bf16_t* Q, const bf16_t* Kb, const bf16_t* Vb, bf16_t* att, LAS float* sl, int lane) {
    const int h = u & 15, t = (u >> 4) & 3, b = u >> 6;
    const size_t qrow = (size_t)NP + b * 4 + t;
    const float* ck = p.in[4]; const float* cv = p.in[5];
    sl[lane] = bf2f(Q[qrow * 1024 + h * 64 + lane]);
    LDS_WAIT();
    float mx = -INFINITY;
#pragma unroll 1
    for (int e = 0; e < 9; ++e) { const int pat = e / 3, r = e - 3 * pat; const int dil = 1 << (2 * pat);
        const int j = lane + 64 * r; const bool valid = j <= 128; const int idx = 2048 + t - dil * (valid ? j : 0);
        float dot = 0.f;
        if (idx >= 2048) { const bf16_t* kp = Kb + ((size_t)NP + b * 4 + (idx - 2048)) * 1024 + h * 64;
#pragma unroll 8
            for (int d = 0; d < 64; ++d) dot += sl[d] * bf2f(kp[d]); }
        else { const float* kp = ck + (((size_t)b * 2048 + idx) * 16 + h) * 64;
#pragma unroll
            for (int d4 = 0; d4 < 16; ++d4) { const f32x4 kv = *(const f32x4*)(kp + 4 * d4); const f32x4 qv = *(const LAS f32x4*)(sl + 4 * d4); dot += (kv[0] * qv[0] + kv[1] * qv[1]) + (kv[2] * qv[2] + kv[3] * qv[3]); } }
        if (valid) { sl[64 + pat * 192 + j] = dot; mx = fmaxf(mx, dot); } }
    mx = wave_max(mx);
    LDS_WAIT();
    float ls = 0.f;
#pragma unroll 1
    for (int e = 0; e < 9; ++e) { const int pat = e / 3, r = e - 3 * pat; const int j = lane + 64 * r;
        if (j <= 128) { const float pv = __expf(sl[64 + pat * 192 + j] - mx); sl[64 + pat * 192 + j] = pv; ls += pv; } }
    ls = wave_sum(ls);
    LDS_WAIT();
    float acc = 0.f;
#pragma unroll
    for (int pat = 0; pat < 3; ++pat) { const int dil = 1 << (2 * pat);
#pragma unroll 8
        for (int j = 0; j <= 128; ++j) { const int idx = 2048 + t - dil * j; const float pv = sl[64 + pat * 192 + j];
            const float vv = idx >= 2048 ? bf2f(Vb[((size_t)NP + b * 4 + (idx - 2048)) * 1024 + h * 64 + lane]) : cv[(((size_t)b * 2048 + idx) * 16 + h) * 64 + lane];
            acc += pv * vv; } }
    att[qrow * 1024 + h * 64 + lane] = (bf16_t)(pk2(acc / ls, 0.f) & 0xffffu);
    LDS_WAIT();
}


#define w_in_t ((bf16_t*)(ws + WS_WIN))
#define w_out_t ((bf16_t*)(ws + WS_WOUT))
#define w_glu_t ((bf16_t*)(ws + WS_WGLU))
#define w_pool_t ((bf16_t*)(ws + WS_WPOOL))
#define w_o_t ((bf16_t*)(ws + WS_WO))
#define w_qkv_t ((bf16_t*)(ws + WS_WQKV))
#define Bt1 ((bf16_t*)(ws + WS_BT1))
#define Bt2 ((bf16_t*)(ws + WS_BT2))
#define rowss ((float*)(ws + WS_ROWSS))
#define uss ((float*)(ws + WS_USS))
#define lse ((float*)(ws + WS_LSE))
#define xn ((bf16_t*)(ws + WS_XN))
#define ybuf ((bf16_t*)(ws + WS_Y))
#define hbuf ((float*)(ws + WS_H))
#define Ap ((bf16_t*)(ws + WS_AP))
#define Sbuf ((float*)(ws + WS_S))
#define upool ((float*)(ws + WS_UPOOL))
#define dbuf ((bf16_t*)(ws + WS_D))
#define zbuf ((bf16_t*)(ws + WS_Z))
#define ycat ((bf16_t*)(ws + WS_YCAT))
#define hact ((bf16_t*)(ws + WS_HACT))
#define Qb ((bf16_t*)(ws + WS_Q))
#define Kb ((bf16_t*)(ws + WS_K))
#define Vb ((bf16_t*)(ws + WS_V))
#define Op ((bf16_t*)(ws + WS_OP))
#define att ((bf16_t*)(ws + WS_ATT))
#define gains (p.in[6])
#ifndef PHMASK
#define PHMASK 0xFFFFFFFFu
#endif
#define PHASE_BEGIN(k) if (((PHMASK >> (k)) & 1u) && p.ph_lo <= (k) && (k) < p.ph_hi) {
#define PHASE_END(k) } if (p.ph_lo <= (k) && (k) + 1 < p.ph_hi) grid.sync();

template <int layer>
DI void layer_tail(const Params& p, LAS unsigned char* lds, cg::grid_group& grid, const int bx, const int G, const int gw, const int NGW, const int lane) {
    unsigned char* ws = p.ws;
    constexpr int pb = 6 + layer * 8;
    const float* gl = gains + (size_t)layer * 4 * DM;
        PHASE_BEGIN(pb)
        { const bf16_t* A = layer == 0 ? ycat : att; const bf16_t* W = layer == 0 ? w_out_t : w_o_t;
          int pm, pn; for (int i = 0; unit_next(i, G, bx, 129, 4, pm, pn); ++i) {
            EpiY E{ybuf, rowss, pm * 256, pn * 256};
            gemm_tile(lds, A + (size_t)pm * 256 * DM, DM, W + (size_t)pn * 256 * DM, DM, DM, E); } }
        PHASE_END(pb)
        PHASE_BEGIN(pb + 1)
        { for (int r = gw; r < NT; r += NGW) { const float* hin = layer == 0 ? in_row(p, r) : hbuf + (size_t)r * DM;
            res_row(hin, ybuf + (size_t)r * DM, rowss + (size_t)r * 16, gl + DM, gl + 2 * DM, hbuf + (size_t)r * DM, xn + (size_t)r * DM, lane); } }
        PHASE_END(pb + 1)
        PHASE_BEGIN(pb + 2)
        { const bf16_t* W = (const bf16_t*)(ws + (layer ? WS_GU1 : WS_GU0));
          int pm, pn; for (int i = 0; unit_next(i, G, bx, 129, 22, pm, pn); ++i) {
            EpiGU E{hact, pm * 256, pn};
            gemm_tile(lds, xn + (size_t)pm * 256 * DM, DM, W + (size_t)pn * 256 * DM, DM, DM, E); } }
        PHASE_END(pb + 2)
        PHASE_BEGIN(pb + 3)
        { const bf16_t* W = (const bf16_t*)(ws + (layer ? WS_DN1 : WS_DN0));
          int pm, pn; for (int i = 0; unit_next(i, G, bx, 129, 4, pm, pn); ++i) {
            EpiY E{ybuf, rowss, pm * 256, pn * 256};
            gemm_tile(lds, hact + (size_t)pm * 256 * FF, FF, W + (size_t)pn * 256 * FF, FF, FF, E); } }
        PHASE_END(pb + 3)
        PHASE_BEGIN(pb + 4)
        { for (int r = gw; r < NT; r += NGW) {
            float* hout = layer == 0 ? hbuf + (size_t)r * DM : (r < NP ? p.out + O_YP + (size_t)r * DM : p.out + O_YS + (size_t)(r - NP) * DM);
            res_row(hbuf + (size_t)r * DM, ybuf + (size_t)r * DM, rowss + (size_t)r * 16, gl + 3 * DM, gains + 4 * DM, hout, layer == 0 ? xn + (size_t)r * DM : nullptr, lane); } }
        PHASE_END(pb + 4)
    }

__global__ void __launch_bounds__(512, 2) mega(Params p) {
    extern __shared__ __attribute__((aligned(16))) unsigned char lds_raw[];
    LAS unsigned char* lds = (LAS unsigned char*)lds_raw;
    cg::grid_group grid = cg::this_grid();
    const int tid = threadIdx.x, lane = tid & 63, wave = __builtin_amdgcn_readfirstlane(tid >> 6);
    const int G = gridDim.x, bx = blockIdx.x;
    const int gw = bx * 8 + wave, NGW = G * 8;
    const int gt = bx * 512 + tid, NGT = G * 512;
    unsigned char* ws = p.ws;

    PHASE_BEGIN(0)
    {
        if (bx < 32) { s5_tables(p, bx, lds, Bt1 + (size_t)bx * 65536, Bt2 + (size_t)bx * 98304); }
        LAS float* scr = (LAS float*)(lds + wave * 16384);
        constexpr int I_IN = 512, I_OUT = 512, I_GLU = 128, I_POOL = 32, I_O = 512, I_QKV = 1536, I_G = 1408, I_D = 1408;
        constexpr int NITEMS = I_IN + I_OUT + I_GLU + I_POOL + I_O + I_QKV + 4 * I_G + 2 * I_D;
        for (int it = gw; it < NITEMS; it += NGW) {
            int r = it;
            if (r < I_IN) { tr_plain(p.in[7], 1024, 1024, w_in_t, r, scr, lane); continue; } r -= I_IN;
            if (r < I_OUT) { tr_plain(p.in[20], 1024, 1024, w_out_t, r, scr, lane); continue; } r -= I_OUT;
            if (r < I_GLU) { tr_plain(p.in[18], 512, 512, w_glu_t, r, scr, lane); continue; } r -= I_GLU;
            if (r < I_POOL) { const int gg = r >> 3, q = r & 7, kb = q >> 2, nb = q & 3;
                transpose_item(p.in[8] + (size_t)gg * 16384, 128, 64 * kb, 32 * nb, w_pool_t, 256, gg * 128 + 32 * nb, (gg & 1) * 128 + 64 * kb, scr, lane); continue; } r -= I_POOL;
            if (r < I_O) { tr_plain(p.in[22], 1024, 1024, w_o_t, r, scr, lane); continue; } r -= I_O;
            if (r < I_QKV) { tr_plain(p.in[21], 1024, 3072, w_qkv_t, r, scr, lane); continue; } r -= I_QKV;
            if (r < 4 * I_G) { const int which = r / I_G, q = r % I_G; const int layer = which >> 1, up = which & 1;
                const float* W = p.in[up ? 24 : 23] + (size_t)layer * 1024 * FF; bf16_t* WT = (bf16_t*)(ws + (layer ? WS_GU1 : WS_GU0));
                const int nblk = FF / 32, kb = q / nblk, nb = q % nblk, n0 = 32 * nb;
                transpose_item(W, FF, 64 * kb, n0, WT, 1024, (n0 >> 7) * 256 + up * 128 + (n0 & 127), 64 * kb, scr, lane); continue; } r -= 4 * I_G;
            { const int layer = r / I_D, q = r % I_D; tr_plain(p.in[25] + (size_t)layer * FF * 1024, FF, 1024, (bf16_t*)(ws + (layer ? WS_DN1 : WS_DN0)), q, scr, lane); }
        }
        for (int it = gt; it < 512 * 16; it += NGT) { const int n = it >> 4, c8 = it & 15; const int gg = n >> 7;
            *(u32x4*)(w_pool_t + (size_t)n * 256 + ((gg & 1) ^ 1) * 128 + c8 * 8) = (u32x4){0u, 0u, 0u, 0u}; }
        for (int r = gw; r < MT; r += NGW) {
            if (r < NT) norm_row(in_row(p, r), gains, xn + (size_t)r * DM, lane);
            else { for (int j = 0; j < 4; ++j) *(u32x2*)(xn + (size_t)r * DM + 4 * lane + 256 * j) = (u32x2){0u, 0u}; }
        }
    }
    PHASE_END(0)

    PHASE_BEGIN(1)
    { int pm, pn; for (int i = 0; unit_next(i, G, bx, 129, 4, pm, pn); ++i) {
        EpiProj E{upool, Ap, uss, pm * 256, pn * 256};
        gemm_tile(lds, xn + (size_t)pm * 256 * DM, DM, w_in_t + (size_t)pn * 256 * DM, DM, DM, E); } }
    PHASE_END(1)

    PHASE_BEGIN(2)
    {
        for (int L = bx; L < 256; L += G) { const int g = L >> 3, mt = L & 7;
            EpiS1 E{Sbuf, g, mt * 256};
            gemm_tile(lds, Ap + ((size_t)g * 2048 + mt * 256) * 384 + 128, 384, Bt1 + (size_t)g * 65536, 256, 256, E); }
        for (int u = gw; u < 1024; u += NGW) s5_sample_unit(p, u, uss, zbuf, lane);
        for (int it = gt; it < (NP / 16) * 128; it += NGT) { const int cq = it & 127, run = it >> 7; const int c = cq * 4, gi = c >> 7, w = 2 << gi;
            const int t0 = run * 16, tb0 = t0 & (TP - 1); const float* up = upool + (size_t)t0 * 512 + c;
            f32x4 sum = (f32x4){0.f, 0.f, 0.f, 0.f};
            for (int s = 1; s < w; ++s) if (tb0 - s >= 0) sum += *(const f32x4*)(up - (size_t)s * 512);
            for (int k = 0; k < 16; ++k) { const f32x4 uv = *(const f32x4*)(up + (size_t)k * 512); sum += uv; const int tb = tb0 + k; const int cnt = tb + 1 < w ? tb + 1 : w;
                const f32x4 dv = sum * (1.0f / (float)cnt) - uv; u32x2 o; o.x = pk2(dv[0], dv[1]); o.y = pk2(dv[2], dv[3]); *(u32x2*)(dbuf + (size_t)(t0 + k) * 512 + c) = o;
                if (tb - w + 1 >= 0) sum -= *(const f32x4*)(up + (size_t)(k - w + 1) * 512);
                if (tb >= TP - 15) *(f32x4*)(p.out + O_POOLP + ((size_t)(t0 >> 13) * 15 + (tb - (TP - 15))) * 512 + c) = uv; } }
        for (int it = gt; it < 32 * 128; it += NGT) { const int cq = it & 127, b = it >> 7; const int c = cq * 4, gi = c >> 7, w = 2 << gi;
            const float* sp = p.in[2] + (size_t)b * 15 * 512 + c; const float* up = upool + (size_t)(NP + b * 4) * 512 + c;
            for (int t = 0; t < 4; ++t) { f32x4 sum = (f32x4){0.f, 0.f, 0.f, 0.f};
                for (int s = 0; s < w; ++s) { const int e = 15 + t - s; sum += e >= 15 ? *(const f32x4*)(up + (size_t)(e - 15) * 512) : *(const f32x4*)(sp + (size_t)e * 512); }
                const f32x4 uv = *(const f32x4*)(up + (size_t)t * 512); const f32x4 dv = sum * (1.0f / (float)w) - uv;
                u32x2 o; o.x = pk2(dv[0], dv[1]); o.y = pk2(dv[2], dv[3]); *(u32x2*)(dbuf + (size_t)(NP + b * 4 + t) * 512 + c) = o; }
            for (int r = 0; r < 15; ++r) { const f32x4 v = r < 11 ? *(const f32x4*)(sp + (size_t)(r + 4) * 512) : *(const f32x4*)(up + (size_t)(r - 11) * 512);
                *(f32x4*)(p.out + O_POOLS + ((size_t)b * 15 + r) * 512 + c) = v; } }
    }
    PHASE_END(2)

    PHASE_BEGIN(3)
    {
        if (wave == 0 && bx < 128) { const int b = bx >> 5, g = bx & 31;
            const float dt = __expf(p.in[12][g]); const float zr = p.in[10][g * 64 + lane] * dt * 16.f, zi = p.in[11][g * 64 + lane] * dt * 16.f;
            float s, c; sincos_acc(zi, s, c); const float mag = __expf(zr); const float c_r = mag * c, c_i = mag * s;
            const float* Sp = Sbuf + ((size_t)g * 2048 + b * 512) * 128 + lane; bf16_t* Hp = Ap + ((size_t)g * 2048 + b * 512) * 384 + lane;
            float hr = 0.f, hi = 0.f;
            for (int c0 = 0; c0 < 512; c0 += 16) { float sr[16], si[16];
#pragma unroll
                for (int k = 0; k < 16; ++k) { sr[k] = Sp[(size_t)(c0 + k) * 128]; si[k] = Sp[(size_t)(c0 + k) * 128 + 64]; }
#pragma unroll
                for (int k = 0; k < 16; ++k) { const unsigned w = pk2(hr, hi); Hp[(size_t)(c0 + k) * 384] = (bf16_t)(w & 0xffffu); Hp[(size_t)(c0 + k) * 384 + 64] = (bf16_t)(w >> 16);
                    const float n_r = c_r * hr - c_i * hi + sr[k], n_i = c_r * hi + c_i * hr + si[k]; hr = n_r; hi = n_i; } }
            float* o = p.out + O_S5P + (((size_t)b * 32 + g) * 64 + lane) * 2; o[0] = hr; o[1] = hi;
        }
        __syncthreads();
        int pm, pn; for (int i = 0; unit_next(i, G, bx, 129, 2, pm, pn); ++i) {
            EpiPool E{ycat, p.in[9], pm * 256, pn * 256};
            gemm_tile(lds, dbuf + (size_t)pm * 256 * 512 + pn * 256, 512, w_pool_t + (size_t)pn * 256 * 256, 256, 256, E); }
    }
    PHASE_END(3)

    PHASE_BEGIN(4)
    { for (int L = bx; L < 256; L += G) { const int g = L >> 3, mt = L & 7;
        EpiS2 E{zbuf, Ap, p.in[17], g, mt * 256};
        gemm_tile(lds, Ap + ((size_t)g * 2048 + mt * 256) * 384, 384, Bt2 + (size_t)g * 98304, 384, 384, E); } }
    PHASE_END(4)

    PHASE_BEGIN(5)
    { int pm, pn; for (int i = 0; unit_next(i, G, bx, 129, 2, pm, pn); ++i) {
        EpiGlu E{ycat, zbuf, p.in[19], pm * 256, pn * 256};
        gemm_tile(lds, zbuf + (size_t)pm * 256 * 512, 512, w_glu_t + (size_t)pn * 256 * 512, 512, 512, E); } }
    PHASE_END(5)

    layer_tail<0>(p, lds, grid, bx, G, gw, NGW, lane);
            PHASE_BEGIN(11)
            { int pm, pn; for (int i = 0; unit_next(i, G, bx, 129, 12, pm, pn); ++i) {
                EpiQKV E{Qb, p.out, pm * 256, pn * 256};
                gemm_tile(lds, xn + (size_t)pm * 256 * DM, DM, w_qkv_t + (size_t)pn * 256 * DM, DM, DM, E); } }
            PHASE_END(11)
            PHASE_BEGIN(12)
            {
                for (int u = gw; u < 2048; u += NGW) attn_sample_unit(p, u, Qb, Kb, Vb, att, (LAS float*)(lds + wave * 8192), lane);
                for (int u = gw; u < 3 * 16384; u += NGW) attn_prompt_unit(u, Qb, Kb, Vb, Op, lse, lds + wave * 8192, lane);
            }
            PHASE_END(12)
            PHASE_BEGIN(13)
            { for (int it = gt; it < NP * 128; it += NGT) { const int c8 = it & 127, row = it >> 7, h = c8 >> 3;
                const float l0 = lse[(size_t)row * 16 + h], l1 = lse[((size_t)MT + row) * 16 + h], l2 = lse[((size_t)2 * MT + row) * 16 + h];
                const float mx = fmaxf(l0, fmaxf(l1, l2)); float w0 = __expf(l0 - mx), w1 = __expf(l1 - mx), w2 = __expf(l2 - mx); const float inv = 1.f / (w0 + w1 + w2); w0 *= inv; w1 *= inv; w2 *= inv;
                const u32x4 a = *(const u32x4*)(Op + (size_t)row * 1024 + c8 * 8), b = *(const u32x4*)(Op + ((size_t)MT + row) * 1024 + c8 * 8), c = *(const u32x4*)(Op + ((size_t)2 * MT + row) * 1024 + c8 * 8);
                u32x4 o;
                o.x = pk2(w0 * bflo(a.x) + w1 * bflo(b.x) + w2 * bflo(c.x), w0 * bfhi(a.x) + w1 * bfhi(b.x) + w2 * bfhi(c.x));
                o.y = pk2(w0 * bflo(a.y) + w1 * bflo(b.y) + w2 * bflo(c.y), w0 * bfhi(a.y) + w1 * bfhi(b.y) + w2 * bfhi(c.y));
                o.z = pk2(w0 * bflo(a.z) + w1 * bflo(b.z) + w2 * bflo(c.z), w0 * bfhi(a.z) + w1 * bfhi(b.z) + w2 * bfhi(c.z));
                o.w = pk2(w0 * bflo(a.w) + w1 * bflo(b.w) + w2 * bflo(c.w), w0 * bfhi(a.w) + w1 * bfhi(b.w) + w2 * bfhi(c.w));
                *(u32x4*)(att + (size_t)row * 1024 + c8 * 8) = o; } }
            PHASE_END(13)
            layer_tail<1>(p, lds, grid, bx, G, gw, NGW, lane);
}

constexpr int NPHASES = 19;

extern "C" void kernel_launch(void* const* d_in, const int* in_sizes, int n_in, void* d_out, int out_size, void* d_ws, size_t ws_size, hipStream_t stream) {
    static int grid = 0;
    if (grid == 0) {
        int dev = 0, cus = 0, per_cu = 0;
        hipGetDevice(&dev);
        hipDeviceGetAttribute(&cus, hipDeviceAttributeMultiprocessorCount, dev);
        hipFuncSetAttribute((const void*)mega, hipFuncAttributeMaxDynamicSharedMemorySize, LDS_BYTES);
        hipOccupancyMaxActiveBlocksPerMultiprocessor(&per_cu, (const void*)mega, 512, LDS_BYTES);
        if (per_cu < 1) per_cu = 1;
        grid = cus * 1;
        if (ws_size < WS_END) fprintf(stderr, "kernel_launch: workspace too small: %zu < %zu\n", ws_size, (size_t)WS_END);
        fprintf(stderr, "kernel_launch: cus %d per_cu %d grid %d n_in %d out %d ws %zu\n", cus, per_cu, grid, n_in, out_size, ws_size);
    }
    Params p{};
    for (int i = 0; i < 26; ++i) p.in[i] = (const float*)d_in[i];
    p.out = (float*)d_out; p.ws = (unsigned char*)d_ws; p.ph_lo = 0; p.ph_hi = NPHASES;
    void* args[] = {&p};
    hipError_t e = hipLaunchCooperativeKernel((const void*)mega, dim3(grid), dim3(512), args, LDS_BYTES, stream);
    if (e != hipSuccess) fprintf(stderr, "cooperative launch failed: %s (grid %d)\n", hipGetErrorString(e), grid);
}
```

```cpp
#include <hip/hip_runtime.h>
#include <hip/hip_cooperative_groups.h>
#include <cstdio>
#include <cstdint>
namespace cg = cooperative_groups;

#define LAS __attribute__((address_space(3)))
#define DI __device__ __forceinline__
typedef unsigned short bf16_t;
typedef short bf16x8 __attribute__((ext_vector_type(8)));
typedef short s16x4 __attribute__((ext_vector_type(4)));
typedef float f32x4 __attribute__((ext_vector_type(4)));
typedef unsigned u32x4 __attribute__((ext_vector_type(4)));
typedef unsigned u32x2 __attribute__((ext_vector_type(2)));
typedef __bf16 bf2_t __attribute__((ext_vector_type(2)));

constexpr int NP = 32768, NS = 128, NT = NP + NS, MT = 33024, DM = 1024, FF = 2816, TP = 8192;
constexpr float EPS = 1e-6f;
constexpr int LDS_BYTES = 131072 + 256;
constexpr size_t O_YP = 0, O_YS = 33554432, O_POOLP = 33685504, O_S5P = 33716224, O_KP = 33732608, O_VP = 42121216,
                 O_POOLS = 50509824, O_S5S = 50755584, O_KS = 50886656, O_VS = 51017728;
constexpr size_t MiB = 1u << 20;
constexpr size_t WS_WIN = 0, WS_WOUT = 2 * MiB, WS_WGLU = 4 * MiB, WS_WPOOL = 4 * MiB + 512 * 1024, WS_WO = 5 * MiB, WS_WQKV = 7 * MiB,
                 WS_GU0 = 13 * MiB, WS_GU1 = 24 * MiB, WS_DN0 = 35 * MiB, WS_DN1 = 41 * MiB, WS_BT1 = 47 * MiB, WS_BT2 = 51 * MiB,
                 WS_ROWSS = 57 * MiB, WS_USS = 60 * MiB, WS_LSE = 61 * MiB, WS_XN = 68 * MiB, WS_Y = 133 * MiB, WS_H = 198 * MiB,
                 WS_X = 328 * MiB;
constexpr size_t WS_AP = WS_X, WS_S = WS_X + 48 * MiB, WS_UPOOL = WS_X + 80 * MiB, WS_D = WS_X + 145 * MiB, WS_Z = WS_X + 178 * MiB,
                 WS_YCAT = WS_X + 211 * MiB;
constexpr size_t WS_HACT = WS_X;
constexpr size_t WS_Q = WS_X, WS_K = WS_X + 65 * MiB, WS_V = WS_X + 130 * MiB, WS_OP = WS_X + 195 * MiB, WS_ATT = WS_X + 389 * MiB;
constexpr size_t WS_END = WS_X + 454 * MiB;
constexpr size_t WS_CTL = 60 * MiB + 512 * 1024;

struct Params { const float* in[26]; float* out; unsigned char* ws; int ph_lo, ph_hi; };

DI unsigned pk2(float lo, float hi) { bf2_t v; v.x = (__bf16)lo; v.y = (__bf16)hi; return __builtin_bit_cast(unsigned, v); }
DI float bflo(unsigned w) { return __uint_as_float(w << 16); }
DI float bfhi(unsigned w) { return __uint_as_float(w & 0xffff0000u); }
DI float bf2f(bf16_t b) { return __uint_as_float((unsigned)b << 16); }
DI float wave_sum(float v) {
#pragma unroll
    for (int o = 1; o < 64; o <<= 1) v += __shfl_xor(v, o);
    return v;
}
DI float wave_max(float v) {
#pragma unroll
    for (int o = 1; o < 64; o <<= 1) v = fmaxf(v, __shfl_xor(v, o));
    return v;
}
DI float sigmoidf_(float x) { return 1.0f / (1.0f + __expf(-x)); }
DI float gelu_tanh(float y) { const float u = 0.7978845608028654f * (y + 0.044715f * y * y * y); return y / (1.0f + __expf(-2.0f * u)); }
DI void sincos_acc(float a, float& s, float& c) {
    if (fabsf(a) < 0.5f) {
        const float a2 = a * a;
        s = a * (1.f - a2 * (1.f / 6.f) * (1.f - a2 * (1.f / 20.f) * (1.f - a2 * (1.f / 42.f))));
        c = 1.f - a2 * 0.5f * (1.f - a2 * (1.f / 12.f) * (1.f - a2 * (1.f / 30.f) * (1.f - a2 * (1.f / 56.f))));
    } else {
        float r = a * 0.15915494309189535f; r -= floorf(r);
        s = __builtin_amdgcn_sinf(r); c = __builtin_amdgcn_cosf(r);
    }
}
#define LDS_WAIT() asm volatile("s_waitcnt lgkmcnt(0)" ::: "memory")
#define VM_WAIT() asm volatile("s_waitcnt vmcnt(0)" ::: "memory")

constexpr int BM = 256, BK = 64, HALF = 128, NXCD = 8, WGM = 8;
typedef f32x4 Acc[2][2][4][2];
DI int lds_byte(int r, int c) { const int st = (r >> 4) * 2 + (c >> 5), rr = r & 15, cc = c & 31, ob = rr * 64 + cc * 2; return st * 1024 + (ob ^ (((ob >> 9) & 1) << 5)); }
DI void stage_rc(int b, int& R, int& C) { const int st = b / 1024, sb = b % 1024, swz = sb ^ (((sb >> 9) & 1) << 5); R = (st >> 1) * 16 + swz / 64; C = (st & 1) * 32 + (swz % 64) / 2; }

DI bool unit_next(int i, int G, int c, int nM, int nN, int& pm, int& pn) {
    const int nwg = nM * nN; const long L = (long)i * G + c; if (L >= nwg) return false;
    int wgid = (int)L; { const int q = nwg / NXCD, r = nwg % NXCD, xcd = wgid % NXCD, off = wgid / NXCD; wgid = (xcd < r ? xcd * (q + 1) : r * (q + 1) + (xcd - r) * q) + off; }
    const int nig = WGM * nN, gid = wgid / nig, fm = gid * WGM, gsz = (nM - fm) < WGM ? (nM - fm) : WGM;
    pm = fm + ((wgid % nig) % gsz); pn = (wgid % nig) / gsz; return true;
}

template <class Epi>
DI void gemm_tile(LAS unsigned char* lds, const bf16_t* A, int lda, const bf16_t* Bt, int ldb, int K, const Epi& E) {
    const int tid = threadIdx.x, wid = __builtin_amdgcn_readfirstlane(tid >> 6), lane = tid & 63, wr = wid >> 2, wc = wid & 3, fr = lane & 15, fq = lane >> 4;
    unsigned offA[2], offB[2];
#pragma unroll
    for (int i = 0; i < 2; ++i) { int R, C; stage_rc(tid * 16 + i * 8192, R, C); offA[i] = (unsigned)(R * lda + C) * 2u; offB[i] = (unsigned)(R * ldb + C) * 2u; }
    const unsigned ldsw = (unsigned)wid * 1024u;
    const unsigned hA = (unsigned)(HALF * lda * 2), hB = (unsigned)(HALF * ldb * 2);
    const char* cA = (const char*)A; const char* cB = (const char*)Bt;
    const int aoff = lds_byte(wr * 64 + fr, fq * 8), boff = lds_byte(wc * 32 + fr, fq * 8);
#define SA(b, h) (((b) * 2 + (h)) * 16384)
#define SB(b, h) ((4 + (b) * 2 + (h)) * 16384)
#define STG(bufoff, gbase, soff, voff) do { _Pragma("unroll") for (int _i = 0; _i < 2; ++_i) { unsigned _vo = (voff)[_i]; asm volatile("" : "+v"(_vo)); _vo += (unsigned)(soff); \
        __builtin_amdgcn_global_load_lds((const unsigned*)((gbase) + _vo), (LAS unsigned*)(lds + (bufoff) + ldsw + _i * 8192), 16, 0, 0); } } while (0)
#define STA(b, h, kt) STG(SA(b, h), cA, (h) * hA + (unsigned)(kt) * 128u, offA)
#define STB(b, h, kt) STG(SB(b, h), cB, (h) * hB + (unsigned)(kt) * 128u, offB)
#define LDA(dst, b, h) do { _Pragma("unroll") for (int m = 0; m < 4; ++m) _Pragma("unroll") for (int k = 0; k < 2; ++k) dst[m][k] = *(const LAS bf16x8*)(lds + SA(b, h) + aoff + m * 2048 + k * 1024); } while (0)
#define LDB(dst, b, h) do { _Pragma("unroll") for (int n = 0; n < 2; ++n) _Pragma("unroll") for (int k = 0; k < 2; ++k) dst[n][k] = *(const LAS bf16x8*)(lds + SB(b, h) + boff + n * 2048 + k * 1024); } while (0)
#define MMA(ai, bj, Af, Bf) do { __builtin_amdgcn_s_setprio(1); _Pragma("unroll") for (int m = 0; m < 4; ++m) _Pragma("unroll") for (int n = 0; n < 2; ++n) _Pragma("unroll") for (int k = 0; k < 2; ++k) \
        acc[ai][bj][m][n] = __builtin_amdgcn_mfma_f32_16x16x32_bf16(Bf[n][k], Af[m][k], acc[ai][bj][m][n], 0, 0, 0); __builtin_amdgcn_s_setprio(0); } while (0)
#define WAIT_V(n) asm volatile("s_waitcnt vmcnt(" #n ")" ::: "memory")
#define WAIT_L(n) asm volatile("s_waitcnt lgkmcnt(" #n ")" ::: "memory")
#define BAR __builtin_amdgcn_s_barrier()
#define SCHED __builtin_amdgcn_sched_barrier(0)
    Acc acc;
#pragma unroll
    for (int a = 0; a < 2; ++a)
#pragma unroll
        for (int b = 0; b < 2; ++b)
#pragma unroll
            for (int m = 0; m < 4; ++m)
#pragma unroll
                for (int n = 0; n < 2; ++n) acc[a][b][m][n] = (f32x4){0.f, 0.f, 0.f, 0.f};
    bf16x8 At[4][2], B0[2][2], B1[2][2];
    const int nt = K / BK;
    STB(0, 0, 0); STA(0, 0, 0); STB(0, 1, 0); STA(0, 1, 0);
    if (wr == 1) BAR;
    WAIT_V(4); BAR;
    STB(1, 0, 1); STA(1, 0, 1); STB(1, 1, 1);
    WAIT_V(6); BAR;
    for (int t = 0; t < nt - 2; t += 2) {
        LDB(B0, 0, 0); SCHED; LDA(At, 0, 0); STA(1, 1, t + 1);
        WAIT_L(8); BAR; WAIT_L(0); MMA(0, 0, At, B0); BAR; SCHED;
        LDB(B1, 0, 1); STB(0, 0, t + 2);
        BAR; WAIT_L(0); MMA(0, 1, At, B1); BAR;
        LDA(At, 0, 1); STA(0, 0, t + 2);
        BAR; WAIT_L(0); MMA(1, 0, At, B0); BAR; SCHED;
        STB(0, 1, t + 2);
        WAIT_V(6); BAR; MMA(1, 1, At, B1); BAR;
        LDB(B0, 1, 0); SCHED; LDA(At, 1, 0); STA(0, 1, t + 2);
        WAIT_L(8); BAR; WAIT_L(0); MMA(0, 0, At, B0); BAR; SCHED;
        LDB(B1, 1, 1); STB(1, 0, t + 3);
        BAR; WAIT_L(0); MMA(0, 1, At, B1); BAR;
        LDA(At, 1, 1); STA(1, 0, t + 3);
        BAR; WAIT_L(0); MMA(1, 0, At, B0); BAR; SCHED;
        STB(1, 1, t + 3);
        WAIT_V(6); BAR; MMA(1, 1, At, B1); BAR;
    }
    { LDB(B0, 0, 0); LDA(At, 0, 0); STA(1, 1, nt - 1);
      BAR; WAIT_L(0); MMA(0, 0, At, B0); BAR;
      LDB(B1, 0, 1); BAR; WAIT_L(0); MMA(0, 1, At, B1); BAR;
      LDA(At, 0, 1); WAIT_V(4); BAR; WAIT_L(0); MMA(1, 0, At, B0); MMA(1, 1, At, B1); BAR; }
    { LDB(B0, 1, 0); LDA(At, 1, 0); WAIT_V(2); BAR; WAIT_L(0); MMA(0, 0, At, B0); BAR;
      LDB(B1, 1, 1); WAIT_V(0); BAR; WAIT_L(0); MMA(0, 1, At, B1); BAR;
      LDA(At, 1, 1); BAR; WAIT_L(0); MMA(1, 0, At, B0); MMA(1, 1, At, B1); BAR; }
    if (wr == 0) BAR;
    E(acc, wr, wc, fr, fq);
    VM_WAIT();
#undef SA
#undef SB
#undef STG
#undef STA
#undef STB
#undef LDA
#undef LDB
#undef MMA
#undef WAIT_V
#undef WAIT_L
#undef BAR
#undef SCHED
}

#define EPI_ROWS(...) _Pragma("unroll") for (int ai = 0; ai < 2; ++ai) _Pragma("unroll") for (int m = 0; m < 4; ++m) { const int rr = ai * 128 + wr * 64 + m * 16 + fr; __VA_ARGS__ asm volatile("" ::: "memory"); }
#define EPI_COLS(...) _Pragma("unroll") for (int bj = 0; bj < 2; ++bj) _Pragma("unroll") for (int n = 0; n < 2; ++n) { const int cc = bj * 128 + wc * 32 + n * 16 + 4 * fq; const f32x4 v = acc[ai][bj][m][n]; __VA_ARGS__ }

struct EpiProj {
    float* upool; bf16_t* Ap; float* uss; int row0, col0;
    DI void operator()(const Acc& acc, int wr, int wc, int fr, int fq) const {
        if (col0 < 512) {
            EPI_ROWS(const size_t row = row0 + rr; EPI_COLS(*(f32x4*)(upool + row * 512 + col0 + cc) = v;))
        } else {
            EPI_ROWS(const int row = row0 + rr;
                EPI_COLS(const int c2 = col0 - 512 + cc; const int g = c2 >> 4, i = c2 & 15;
                    if (row < NP) { u32x2 w; w.x = pk2(v[0], v[1]); w.y = pk2(v[2], v[3]);
                        *(u32x2*)(Ap + ((size_t)g * 2048 + (row >> 4)) * 384 + 128 + (row & 15) * 16 + i) = w; }
                    else if (row < NT) { *(f32x4*)(uss + (size_t)(row - NP) * 512 + c2) = v; }))
        }
    }
};
struct EpiS1 {
    float* S; int g, row0;
    DI void operator()(const Acc& acc, int wr, int wc, int fr, int fq) const {
        EPI_ROWS(const size_t row = (size_t)g * 2048 + row0 + rr;
            _Pragma("unroll") for (int n = 0; n < 2; ++n) { const int cc = wc * 32 + n * 16 + 4 * fq; *(f32x4*)(S + row * 128 + cc) = acc[ai][0][m][n]; })
    }
};
struct EpiPool {
    bf16_t* ycat; const float* scale; int row0, col0;
    DI void operator()(const Acc& acc, int wr, int wc, int fr, int fq) const {
        EPI_ROWS(const size_t row = row0 + rr;
            EPI_COLS(const int col = col0 + cc; const f32x4 s = *(const f32x4*)(scale + col); u32x2 w; w.x = pk2(v[0] * s[0], v[1] * s[1]); w.y = pk2(v[2] * s[2], v[3] * s[3]);
                *(u32x2*)(ycat + row * 1024 + col) = w;))
    }
};
struct EpiS2 {
    bf16_t* z; const bf16_t* Ap; const float* dskip; int g, row0;
    DI void operator()(const Acc& acc, int wr, int wc, int fr, int fq) const {
        EPI_ROWS(const int chunk = row0 + rr; const bf16_t* ap = Ap + ((size_t)g * 2048 + chunk) * 384 + 128;
            EPI_COLS(const int r = cc >> 4, i = cc & 15; const u32x2 uw = *(const u32x2*)(ap + cc); const f32x4 d = *(const f32x4*)(dskip + g * 16 + i);
                const float y0 = v[0] + d[0] * bflo(uw.x), y1 = v[1] + d[1] * bfhi(uw.x), y2 = v[2] + d[2] * bflo(uw.y), y3 = v[3] + d[3] * bfhi(uw.y);
                u32x2 w; w.x = pk2(gelu_tanh(y0), gelu_tanh(y1)); w.y = pk2(gelu_tanh(y2), gelu_tanh(y3));
                *(u32x2*)(z + ((size_t)chunk * 16 + r) * 512 + g * 16 + i) = w;))
    }
};
struct EpiGlu {
    bf16_t* ycat; const bf16_t* z; const float* bglu; int row0, col0;
    DI void operator()(const Acc& acc, int wr, int wc, int fr, int fq) const {
        EPI_ROWS(const size_t row = row0 + rr;
            EPI_COLS(const int col = col0 + cc; const u32x2 zw = *(const u32x2*)(z + row * 512 + col); const f32x4 b = *(const f32x4*)(bglu + col);
                u32x2 w; w.x = pk2(bflo(zw.x) * sigmoidf_(v[0] + b[0]), bfhi(zw.x) * sigmoidf_(v[1] + b[1]));
                w.y = pk2(bflo(zw.y) * sigmoidf_(v[2] + b[2]), bfhi(zw.y) * sigmoidf_(v[3] + b[3]));
                *(u32x2*)(ycat + row * 1024 + 512 + col) = w;))
    }
};
struct EpiY {
    bf16_t* y; float* rowss; int row0, col0;
    DI void operator()(const Acc& acc, int wr, int wc, int fr, int fq) const {
        EPI_ROWS(const size_t row = row0 + rr; float ss = 0.f;
            EPI_COLS(u32x2 w; w.x = pk2(v[0], v[1]); w.y = pk2(v[2], v[3]); *(u32x2*)(y + row * 1024 + col0 + cc) = w;
                ss += (v[0] * v[0] + v[1] * v[1]) + (v[2] * v[2] + v[3] * v[3]);)
            ss += __shfl_xor(ss, 16); ss += __shfl_xor(ss, 32);
            if (fq == 0) rowss[row * 16 + (col0 >> 8) * 4 + wc] = ss;)
    }
};
struct EpiGU {
    bf16_t* hact; int row0, hb;
    DI void operator()(const Acc& acc, int wr, int wc, int fr, int fq) const {
        EPI_ROWS(const size_t row = row0 + rr;
            _Pragma("unroll") for (int n = 0; n < 2; ++n) { const int cc = wc * 32 + n * 16 + 4 * fq; const f32x4 a = acc[ai][0][m][n], u = acc[ai][1][m][n];
                u32x2 w; w.x = pk2(a[0] * sigmoidf_(a[0]) * u[0], a[1] * sigmoidf_(a[1]) * u[1]); w.y = pk2(a[2] * sigmoidf_(a[2]) * u[2], a[3] * sigmoidf_(a[3]) * u[3]);
                *(u32x2*)(hact + row * FF + hb * 128 + cc) = w; })
    }
};
struct EpiQKV {
    bf16_t* qkv; float* out; int row0, col0;
    DI void operator()(const Acc& acc, int wr, int wc, int fr, int fq) const {
        const int which = col0 >> 10; const int cb = col0 & 1023; const float sc = which == 0 ? 0.125f : 1.0f;
        bf16_t* dst = qkv + (size_t)which * (65 * MiB / 2);
        float* op = out + (which == 1 ? O_KP : O_VP); float* os = out + (which == 1 ? O_KS : O_VS);
        EPI_ROWS(const int row = row0 + rr;
            EPI_COLS(const int col = cb + cc; u32x2 w; w.x = pk2(v[0] * sc, v[1] * sc); w.y = pk2(v[2] * sc, v[3] * sc);
                *(u32x2*)(dst + (size_t)row * 1024 + col) = w;
                if (which != 0) {
                    if (row < NP) { const int tb = row & (TP - 1); if (tb >= TP - 2048) *(f32x4*)(op + ((size_t)(row >> 13) * 2048 + (tb - (TP - 2048))) * 1024 + col) = v; }
                    else if (row < NT) *(f32x4*)(os + (size_t)(row - NP) * 1024 + col) = v;
                }))
    }
};

DI void transpose_item(const float* W, int N, int k0, int n0, bf16_t* WT, int ldt, int orow0, int ocol0, LAS float* scr, int lane) {
#pragma unroll 8
    for (int i = 0; i < 32; ++i) { const int kk = 2 * i + (lane >> 5); scr[kk * 33 + (lane & 31)] = W[(size_t)(k0 + kk) * N + n0 + (lane & 31)]; }
    LDS_WAIT();
    const int c = lane & 7;
#pragma unroll
    for (int j = 0; j < 4; ++j) { const int n = (lane >> 3) + 8 * j; const LAS float* s = scr + (8 * c) * 33 + n;
        u32x4 o; o.x = pk2(s[0 * 33], s[1 * 33]); o.y = pk2(s[2 * 33], s[3 * 33]); o.z = pk2(s[4 * 33], s[5 * 33]); o.w = pk2(s[6 * 33], s[7 * 33]);
        *(u32x4*)(WT + (size_t)(orow0 + n) * ldt + ocol0 + 8 * c) = o; }
    LDS_WAIT();
}
DI void tr_plain(const float* W, int K, int N, bf16_t* WT, int item, LAS float* scr, int lane) {
    const int nblk = N / 32, kb = item / nblk, nb = item % nblk; transpose_item(W, N, 64 * kb, 32 * nb, WT, K, 32 * nb, 64 * kb, scr, lane);
}

DI const float* in_row(const Params& p, int r) { return r < NP ? p.in[0] + (size_t)r * DM : p.in[1] + (size_t)(r - NP) * DM; }

DI void norm_row(const float* xr, const float* g, bf16_t* o, int lane) {
    f32x4 v[4]; float s = 0.f;
#pragma unroll
    for (int j = 0; j < 4; ++j) { v[j] = *(const f32x4*)(xr + 4 * lane + 256 * j); s += (v[j][0] * v[j][0] + v[j][1] * v[j][1]) + (v[j][2] * v[j][2] + v[j][3] * v[j][3]); }
    const float r = rsqrtf(wave_sum(s) * (1.f / DM) + EPS);
#pragma unroll
    for (int j = 0; j < 4; ++j) { const f32x4 gg = *(const f32x4*)(g + 4 * lane + 256 * j); u32x2 w; w.x = pk2(v[j][0] * r * gg[0], v[j][1] * r * gg[1]); w.y = pk2(v[j][2] * r * gg[2], v[j][3] * r * gg[3]);
        *(u32x2*)(o + 4 * lane + 256 * j) = w; }
}
DI void res_row(const float* hin, const bf16_t* y, const float* rss, const float* gpost, const float* gnext, float* hout, bf16_t* xn, int lane) {
    float ss = rss[lane & 15];
    ss += __shfl_xor(ss, 1); ss += __shfl_xor(ss, 2); ss += __shfl_xor(ss, 4); ss += __shfl_xor(ss, 8);
    const float r1 = rsqrtf(ss * (1.f / DM) + EPS);
    f32x4 h[4]; float s2 = 0.f;
#pragma unroll
    for (int j = 0; j < 4; ++j) { const int c = 4 * lane + 256 * j; const f32x4 hv = *(const f32x4*)(hin + c); const u32x2 yw = *(const u32x2*)(y + c); const f32x4 gp = *(const f32x4*)(gpost + c);
        h[j][0] = hv[0] + bflo(yw.x) * r1 * gp[0]; h[j][1] = hv[1] + bfhi(yw.x) * r1 * gp[1]; h[j][2] = hv[2] + bflo(yw.y) * r1 * gp[2]; h[j][3] = hv[3] + bfhi(yw.y) * r1 * gp[3];
        s2 += (h[j][0] * h[j][0] + h[j][1] * h[j][1]) + (h[j][2] * h[j][2] + h[j][3] * h[j][3]);
        *(f32x4*)(hout + c) = h[j]; }
    if (xn) {
        const float r2 = rsqrtf(wave_sum(s2) * (1.f / DM) + EPS);
#pragma unroll
        for (int j = 0; j < 4; ++j) { const int c = 4 * lane + 256 * j; const f32x4 gn = *(const f32x4*)(gnext + c); u32x2 w; w.x = pk2(h[j][0] * r2 * gn[0], h[j][1] * r2 * gn[1]); w.y = pk2(h[j][2] * r2 * gn[2], h[j][3] * r2 * gn[3]);
            *(u32x2*)(xn + c) = w; }
    }
}

DI void s5_tables(const Params& p, int g, LAS unsigned char* lds, bf16_t* Bt1, bf16_t* Bt2) {
    LAS float* pwr = (LAS float*)lds;
    LAS float* pwi = pwr + 17 * 64;
    LAS float* bbr = pwi + 17 * 64;
    LAS float* bbi = bbr + 1024;
    LAS float* cr = bbi + 1024;
    LAS float* ci = cr + 1024;
    LAS float* Kd = ci + 1024;
    const int tid = threadIdx.x;
    const float dt = __expf(p.in[12][g]);
    const float* lre = p.in[10] + g * 64; const float* lim = p.in[11] + g * 64;
    for (int it = tid; it < 17 * 64; it += 512) { const int d = it >> 6, q = it & 63; const float zr = lre[q] * dt * (float)d, zi = lim[q] * dt * (float)d;
        float s, c; sincos_acc(zi, s, c); const float mag = __expf(zr); pwr[it] = mag * c; pwi[it] = mag * s; }
    for (int it = tid; it < 1024; it += 512) { const int q = it >> 4, i = it & 15;
        const float lr = lre[q], li = lim[q], zr = lr * dt, zi = li * dt;
        float s, c, sh, ch; sincos_acc(zi, s, c); sincos_acc(0.5f * zi, sh, ch);
        const float em1 = expm1f(zr); const float nr = em1 * c - 2.f * sh * sh, ni = (em1 + 1.f) * s;
        const float den = 1.f / (lr * lr + li * li); const float fr_ = (nr * lr + ni * li) * den, fi_ = (ni * lr - nr * li) * den;
        const float br = p.in[13][(size_t)g * 1024 + it], bi = p.in[14][(size_t)g * 1024 + it];
        bbr[it] = fr_ * br - fi_ * bi; bbi[it] = fr_ * bi + fi_ * br;
        cr[it] = p.in[15][(size_t)g * 1024 + it]; ci[it] = p.in[16][(size_t)g * 1024 + it]; }
    __syncthreads();
    for (int it = tid; it < 4096; it += 512) { const int d = it >> 8, i = (it >> 4) & 15, j = it & 15; float a = 0.f;
        for (int q = 0; q < 64; ++q) { const float c_r = cr[i * 64 + q], c_i = ci[i * 64 + q], p_r = pwr[d * 64 + q], p_i = pwi[d * 64 + q];
            const float xr = c_r * p_r - c_i * p_i, xi = c_r * p_i + c_i * p_r; a += xr * bbr[q * 16 + j] - xi * bbi[q * 16 + j]; }
        Kd[it] = a; }
    __syncthreads();
    for (int it = tid; it < 256 * 32; it += 512) { const int n = it >> 5, k0 = (it & 31) * 8; float v[8];
#pragma unroll
        for (int e = 0; e < 8; ++e) { const int k = k0 + e, s = k >> 4, i = k & 15; float val = 0.f;
            if (n < 128) { const int q = n & 63; const float p_r = pwr[(15 - s) * 64 + q], p_i = pwi[(15 - s) * 64 + q], b_r = bbr[q * 16 + i], b_i = bbi[q * 16 + i];
                val = n < 64 ? (p_r * b_r - p_i * b_i) : (p_r * b_i + p_i * b_r); }
            v[e] = val; }
        u32x4 o; o.x = pk2(v[0], v[1]); o.y = pk2(v[2], v[3]); o.z = pk2(v[4], v[5]); o.w = pk2(v[6], v[7]);
        *(u32x4*)(Bt1 + (size_t)n * 256 + k0) = o; }
    for (int it = tid; it < 256 * 48; it += 512) { const int n = it / 48, k0 = (it % 48) * 8; const int r = n >> 4, i = n & 15; float v[8];
#pragma unroll
        for (int e = 0; e < 8; ++e) { const int k = k0 + e; float val;
            if (k < 128) { const int q = k & 63; const float c_r = cr[i * 64 + q], c_i = ci[i * 64 + q], p_r = pwr[(r + 1) * 64 + q], p_i = pwi[(r + 1) * 64 + q];
                val = k < 64 ? (c_r * p_r - c_i * p_i) : -(c_r * p_i + c_i * p_r); }
            else { const int kk = k - 128, s = kk >> 4, j = kk & 15; val = s <= r ? Kd[(r - s) * 256 + i * 16 + j] : 0.f; }
            v[e] = val; }
        u32x4 o; o.x = pk2(v[0], v[1]); o.y = pk2(v[2], v[3]); o.z = pk2(v[4], v[5]); o.w = pk2(v[6], v[7]);
        *(u32x4*)(Bt2 + (size_t)n * 384 + k0) = o; }
    __syncthreads();
}

DI void s5_sample_unit(const Params& p, int u, const float* uss, bf16_t* z, int lane) {
    const int g = u & 31, b = u >> 5;
    const float dt = __expf(p.in[12][g]);
    const float lr = p.in[10][g * 64 + lane], li = p.in[11][g * 64 + lane], zr = lr * dt, zi = li * dt;
    float s, c, sh, ch; sincos_acc(zi, s, c); sincos_acc(0.5f * zi, sh, ch);
    const float em1 = expm1f(zr); const float nr = em1 * c - 2.f * sh * sh, ni = (em1 + 1.f) * s;
    const float lbr = nr + 1.f, lbi = ni;
    const float den = 1.f / (lr * lr + li * li); const float fr_ = (nr * lr + ni * li) * den, fi_ = (ni * lr - nr * li) * den;
    float hr = p.in[3][(((size_t)b * 32 + g) * 64 + lane) * 2], hi = p.in[3][(((size_t)b * 32 + g) * 64 + lane) * 2 + 1];
    const float* bre = p.in[13] + ((size_t)g * 64 + lane) * 16; const float* bim = p.in[14] + ((size_t)g * 64 + lane) * 16;
    const float* cre = p.in[15] + (size_t)g * 1024 + lane; const float* cim = p.in[16] + (size_t)g * 1024 + lane;
    for (int t = 0; t < 4; ++t) {
        const float* ur = uss + (size_t)(b * 4 + t) * 512 + g * 16;
        float bur = 0.f, bui = 0.f;
#pragma unroll
        for (int i = 0; i < 16; ++i) { const float uv = ur[i]; const float br = bre[i], bi = bim[i]; bur += (fr_ * br - fi_ * bi) * uv; bui += (fr_ * bi + fi_ * br) * uv; }
        const float n_r = lbr * hr - lbi * hi + bur, n_i = lbr * hi + lbi * hr + bui; hr = n_r; hi = n_i;
        float yv = 0.f;
#pragma unroll
        for (int i = 0; i < 16; ++i) { float a = cre[i * 64] * hr - cim[i * 64] * hi; a = wave_sum(a); if (lane == i) yv = a; }
        if (lane < 16) { const float y = yv + p.in[17][g * 16 + lane] * ur[lane]; z[(size_t)(NP + b * 4 + t) * 512 + g * 16 + lane] = (bf16_t)(pk2(gelu_tanh(y), 0.f) & 0xffffu); }
    }
    float* o = p.out + O_S5S + (((size_t)b * 32 + g) * 64 + lane) * 2; o[0] = hr; o[1] = hi;
}

constexpr int NQ = 2;
DI void attn_prompt_unit(int u, const bf16_t* Q, const bf16_t* Kb, const bf16_t* Vb, bf16_t* Op, float* lse, LAS unsigned char* vl, int lane) {
    const int tile = u & 255, h = (u >> 8) & 15, b = (u >> 12) & 3, pat = u >> 14;
    const int dsh = pat * 2, dil = 1 << dsh;
    const int rho = tile & (dil - 1), lt = tile >> dsh, l0 = lt * 32;
    const int i = lane & 15, g = lane >> 4;
    const size_t rowbase = (size_t)b * TP + rho;
    bf16x8 qf[NQ][2];
#pragma unroll
    for (int qb = 0; qb < NQ; ++qb) { const bf16_t* q = Q + (rowbase + (size_t)dil * (l0 + 16 * qb + i)) * 1024 + h * 64 + 8 * g; qf[qb][0] = *(const bf16x8*)q; qf[qb][1] = *(const bf16x8*)(q + 32); }
    f32x4 o[NQ][4]; float mrun[NQ], lsum[NQ];
#pragma unroll
    for (int qb = 0; qb < NQ; ++qb) { mrun[qb] = -1e30f; lsum[qb] = 0.f;
#pragma unroll
        for (int db = 0; db < 4; ++db) o[qb][db] = (f32x4){0.f, 0.f, 0.f, 0.f}; }
    const unsigned vbase = (unsigned)(size_t)vl;
    const unsigned traddr = vbase + (unsigned)((4 * g + (i >> 2)) * 144 + (4 * (i & 3)) * 2);
    for (int ks = 0; ks < 4 + NQ / 2; ++ks) {
        const int kbase = l0 - 128 + 32 * ks;
#pragma unroll
        for (int n = 0; n < 4; ++n) { const int c = lane + 64 * n, kr = c >> 3, ch = c & 7; int lk = kbase + kr; lk = lk < 0 ? 0 : lk;
            const u32x4 v = *(const u32x4*)(Vb + (rowbase + (size_t)dil * lk) * 1024 + h * 64 + ch * 8);
            *(LAS u32x4*)(vl + kr * 144 + ch * 16) = v; }
        bf16x8 kf[2][2];
#pragma unroll
        for (int kbl = 0; kbl < 2; ++kbl) { int lk = kbase + 16 * kbl + i; lk = lk < 0 ? 0 : lk; const bf16_t* kp = Kb + (rowbase + (size_t)dil * lk) * 1024 + h * 64 + 8 * g;
            kf[kbl][0] = *(const bf16x8*)kp; kf[kbl][1] = *(const bf16x8*)(kp + 32); }
        f32x4 st[2][NQ];
#pragma unroll
        for (int kbl = 0; kbl < 2; ++kbl)
#pragma unroll
            for (int qb = 0; qb < NQ; ++qb) { f32x4 a = (f32x4){0.f, 0.f, 0.f, 0.f};
                a = __builtin_amdgcn_mfma_f32_16x16x32_bf16(kf[kbl][0], qf[qb][0], a, 0, 0, 0);
                a = __builtin_amdgcn_mfma_f32_16x16x32_bf16(kf[kbl][1], qf[qb][1], a, 0, 0, 0); st[kbl][qb] = a; }
        bf16x8 pf[NQ];
#pragma unroll
        for (int qb = 0; qb < NQ; ++qb) {
            const int lq = l0 + 16 * qb + i; float mx = -INFINITY;
#pragma unroll
            for (int kbl = 0; kbl < 2; ++kbl)
#pragma unroll
                for (int r = 0; r < 4; ++r) { const int lk = kbase + 16 * kbl + 4 * g + r; const bool ok = (lk >= 0) && (lk <= lq) && (lq - lk <= 128);
                    const float s = ok ? st[kbl][qb][r] : -INFINITY; st[kbl][qb][r] = s; mx = fmaxf(mx, s); }
            mx = fmaxf(mx, __shfl_xor(mx, 16)); mx = fmaxf(mx, __shfl_xor(mx, 32));
            const float mn = fmaxf(mrun[qb], mx); const float alpha = __expf(mrun[qb] - mn); mrun[qb] = mn;
            float ps = 0.f;
#pragma unroll
            for (int kbl = 0; kbl < 2; ++kbl)
#pragma unroll
                for (int r = 0; r < 4; ++r) { const float pv = __expf(st[kbl][qb][r] - mn); st[kbl][qb][r] = pv; ps += pv; }
            lsum[qb] = lsum[qb] * alpha + ps;
#pragma unroll
            for (int db = 0; db < 4; ++db) o[qb][db] = o[qb][db] * alpha;
            u32x4 pw; pw.x = pk2(st[0][qb][0], st[0][qb][1]); pw.y = pk2(st[0][qb][2], st[0][qb][3]); pw.z = pk2(st[1][qb][0], st[1][qb][1]); pw.w = pk2(st[1][qb][2], st[1][qb][3]);
            pf[qb] = __builtin_bit_cast(bf16x8, pw);
        }
        s16x4 lo[4], hi[4];
        asm volatile("s_waitcnt vmcnt(0) lgkmcnt(0)\n\t"
                     "ds_read_b64_tr_b16 %0, %8\n\tds_read_b64_tr_b16 %1, %8 offset:32\n\tds_read_b64_tr_b16 %2, %8 offset:64\n\tds_read_b64_tr_b16 %3, %8 offset:96\n\t"
                     "ds_read_b64_tr_b16 %4, %8 offset:2304\n\tds_read_b64_tr_b16 %5, %8 offset:2336\n\tds_read_b64_tr_b16 %6, %8 offset:2368\n\tds_read_b64_tr_b16 %7, %8 offset:2400\n\t"
                     "s_waitcnt lgkmcnt(0)"
                     : "=&v"(lo[0]), "=&v"(lo[1]), "=&v"(lo[2]), "=&v"(lo[3]), "=&v"(hi[0]), "=&v"(hi[1]), "=&v"(hi[2]), "=&v"(hi[3]) : "v"(traddr) : "memory");
#pragma unroll
        for (int db = 0; db < 4; ++db) { const bf16x8 vf = __builtin_shufflevector(lo[db], hi[db], 0, 1, 2, 3, 4, 5, 6, 7);
#pragma unroll
            for (int qb = 0; qb < NQ; ++qb) o[qb][db] = __builtin_amdgcn_mfma_f32_16x16x32_bf16(vf, pf[qb], o[qb][db], 0, 0, 0); }
    }
#pragma unroll
    for (int qb = 0; qb < NQ; ++qb) {
        float l = lsum[qb]; l += __shfl_xor(l, 16); l += __shfl_xor(l, 32);
        const float inv = 1.f / l; const size_t row = (size_t)pat * MT + rowbase + (size_t)dil * (l0 + 16 * qb + i);
#pragma unroll
        for (int db = 0; db < 4; ++db) { const f32x4 v = o[qb][db] * inv; u32x2 w; w.x = pk2(v[0], v[1]); w.y = pk2(v[2], v[3]); *(u32x2*)(Op + row * 1024 + h * 64 + 16 * db + 4 * g) = w; }
        if (g == 0) lse[row * 16 + h] = mrun[qb] + __logf(l);
    }
}

DI void attn_sample_unit(const Params& p, int u, const bf16_t* Q, const bf16_t* Kb, const bf16_t* Vb, bf16_t* att, LAS float* sl, int lane) {
    const int h = u & 15, t = (u >> 4) & 3, b = u >> 6;
    const size_t qrow = (size_t)NP + b * 4 + t;
    const float* ck = p.in[4]; const float* cv = p.in[5];
    sl[lane] = bf2f(Q[qrow * 1024 + h * 64 + lane]);
    LDS_WAIT();
    float mx = -INFINITY;
#pragma unroll 1
    for (int e = 0; e < 9; ++e) { const int pat = e / 3, r = e - 3 * pat; const int dil = 1 << (2 * pat);
        const int j = lane + 64 * r; const bool valid = j <= 128; const int idx = 2048 + t - dil * (valid ? j : 0);
        float dot = 0.f;
        if (idx >= 2048) { const bf16_t* kp = Kb + ((size_t)NP + b * 4 + (idx - 2048)) * 1024 + h * 64;
#pragma unroll 8
            for (int d = 0; d < 64; ++d) dot += sl[d] * bf2f(kp[d]); }
        else { const float* kp = ck + (((size_t)b * 2048 + idx) * 16 + h) * 64;
#pragma unroll
            for (int d4 = 0; d4 < 16; ++d4) { const f32x4 kv = *(const f32x4*)(kp + 4 * d4); const f32x4 qv = *(const LAS f32x4*)(sl + 4 * d4); dot += (kv[0] * qv[0] + kv[1] * qv[1]) + (kv[2] * qv[2] + kv[3] * qv[3]); } }
        if (valid) { sl[64 + pat * 192 + j] = dot; mx = fmaxf(mx, dot); } }
    mx = wave_max(mx);
    LDS_WAIT();
    float ls = 0.f;
#pragma unroll 1
    for (int e = 0; e < 9; ++e) { const int pat = e / 3, r = e - 3 * pat; const int j = lane + 64 * r;
        if (j <= 128) { const float pv = __expf(sl[64 + pat * 192 + j] - mx); sl[64 + pat * 192 + j] = pv; ls += pv; } }
    ls = wave_sum(ls);
    LDS_WAIT();
    float acc = 0.f;
#pragma unroll
    for (int pat = 0; pat < 3; ++pat) { const int dil = 1 << (2 * pat);
#pragma unroll 8
        for (int j = 0; j <= 128; ++j) { const int idx = 2048 + t - dil * j; const float pv = sl[64 + pat * 192 + j];
            const float vv = idx >= 2048 ? bf2f(Vb[((size_t)NP + b * 4 + (idx - 2048)) * 1024 + h * 64 + lane]) : cv[(((size_t)b * 2048 + idx) * 16 + h) * 64 + lane];
            acc += pv * vv; } }
    att[qrow * 1024 + h * 64 + lane] = (bf16_t)(pk2(acc / ls, 0.f) & 0xffffu);
    LDS_WAIT();
}


#define XB_TMO      128
#define XB_XCNT(j)  (256  + 64 * (j))
#define XB_XSUB(j)  (1280 + 64 * (j))
#define XB_XGEN(j)  (2304 + 64 * (j))
#define XB_TOP      3328
#define XB_TOPGEN   3392
#define XCD_BAR_WORDS 3456
#define XB_SPIN_CAP (1u << 22)
DI unsigned xb_ld(unsigned* p)              { return __hip_atomic_load(p, __ATOMIC_RELAXED, __HIP_MEMORY_SCOPE_AGENT); }
DI unsigned xb_add(unsigned* p, unsigned v) { return __hip_atomic_fetch_add(p, v, __ATOMIC_RELAXED, __HIP_MEMORY_SCOPE_AGENT); }
DI unsigned xb_xcc_id() { return (unsigned)__builtin_amdgcn_s_getreg((3 << 11) | 20) & 0xFu; }
#define XB_SPIN(cond, bar) do { unsigned _sp = 0; while (cond) { __builtin_amdgcn_s_sleep(1); \
    if ((++_sp & 255u) == 0u) { if (xb_ld(&(bar)[XB_TMO])) break; if (_sp > XB_SPIN_CAP) { atomicAdd(&(bar)[XB_TMO], 1u); break; } } } } while (0)
struct XcdBarrier { unsigned* bar; unsigned x; volatile LAS unsigned* st; };
DI XcdBarrier xcd_barrier_post(unsigned* bar, volatile LAS unsigned* st) {
    XcdBarrier b; b.bar = bar; b.x = xb_xcc_id(); b.st = st;
    if (threadIdx.x == 0) (void)xb_add(&bar[XB_XCNT(b.x)], 1u);
    return b;
}
DI void xcd_barrier_complete(unsigned* bar, unsigned x, unsigned& nloc, unsigned& nx) {
    const unsigned G = gridDim.x * gridDim.y * gridDim.z;
    unsigned sum, cnt, mine, sp = 0u;
    for (;;) {
        sum = 0u; cnt = 0u; mine = 0u;
#pragma unroll
        for (unsigned j = 0; j < 16; ++j) { const unsigned c = xb_ld(&bar[XB_XCNT(j)]); sum += c; cnt += (c > 0u) ? 1u : 0u; mine = (j == x) ? c : mine; }
        if (sum == G) break;
        __builtin_amdgcn_s_sleep(1);
        if ((++sp & 255u) == 0u) { if (xb_ld(&bar[XB_TMO])) break; if (sp > XB_SPIN_CAP) { atomicAdd(&bar[XB_TMO], 1u); break; } }
    }
    nloc = mine > 0u ? mine : 1u; nx = cnt > 0u ? cnt : 1u;
}
DI void xcd_barrier(const XcdBarrier& b) {
    asm volatile("s_waitcnt vmcnt(0)" ::: "memory");
    __syncthreads();
    if (threadIdx.x == 0) {
        unsigned* bar = b.bar;
        __builtin_amdgcn_s_waitcnt(0);
        unsigned nloc = b.st[0], nx = b.st[1];
        if (nloc == 0u) { xcd_barrier_complete(bar, b.x, nloc, nx); b.st[0] = nloc; b.st[1] = nx; }
        const unsigned old = xb_add(&bar[XB_XSUB(b.x)], 1u);
        const unsigned gen = old / nloc;
        if (old + 1u == (gen + 1u) * nloc) {
            __builtin_amdgcn_fence(__ATOMIC_RELEASE, "agent");
            asm volatile("s_waitcnt vmcnt(0)" ::: "memory");
            const unsigned og = xb_add(&bar[XB_TOP], 1u);
            const unsigned tg = og / nx;
            if (og + 1u == (tg + 1u) * nx) xb_add(&bar[XB_TOPGEN], 1u);
            else XB_SPIN(xb_ld(&bar[XB_TOPGEN]) == tg, bar);
            __builtin_amdgcn_fence(__ATOMIC_ACQUIRE, "agent");
            xb_add(&bar[XB_XGEN(b.x)], 1u);
            asm volatile("s_waitcnt vmcnt(0)" ::: "memory");
        } else {
            XB_SPIN(xb_ld(&bar[XB_XGEN(b.x)]) == gen, bar);
            __builtin_amdgcn_fence(__ATOMIC_ACQUIRE, "agent");
            asm volatile("s_waitcnt vmcnt(0)" ::: "memory");
        }
    }
    __syncthreads();
}

#define w_in_t ((bf16_t*)(ws + WS_WIN))
#define w_out_t ((bf16_t*)(ws + WS_WOUT))
#define w_glu_t ((bf16_t*)(ws + WS_WGLU))
#define w_pool_t ((bf16_t*)(ws + WS_WPOOL))
#define w_o_t ((bf16_t*)(ws + WS_WO))
#define w_qkv_t ((bf16_t*)(ws + WS_WQKV))
#define Bt1 ((bf16_t*)(ws + WS_BT1))
#define Bt2 ((bf16_t*)(ws + WS_BT2))
#define rowss ((float*)(ws + WS_ROWSS))
#define uss ((float*)(ws + WS_USS))
#define lse ((float*)(ws + WS_LSE))
#define xn ((bf16_t*)(ws + WS_XN))
#define ybuf ((bf16_t*)(ws + WS_Y))
#define hbuf ((float*)(ws + WS_H))
#define Ap ((bf16_t*)(ws + WS_AP))
#define Sbuf ((float*)(ws + WS_S))
#define upool ((float*)(ws + WS_UPOOL))
#define dbuf ((bf16_t*)(ws + WS_D))
#define zbuf ((bf16_t*)(ws + WS_Z))
#define ycat ((bf16_t*)(ws + WS_YCAT))
#define hact ((bf16_t*)(ws + WS_HACT))
#define Qb ((bf16_t*)(ws + WS_Q))
#define Kb ((bf16_t*)(ws + WS_K))
#define Vb ((bf16_t*)(ws + WS_V))
#define Op ((bf16_t*)(ws + WS_OP))
#define att ((bf16_t*)(ws + WS_ATT))
#define gains (p.in[6])
#ifndef PHMASK
#define PHMASK 0xFFFFFFFFu
#endif
#ifndef DUPMASK
#define DUPMASK 0u
#endif
#define PHASE_BEGIN(k) if (((PHMASK >> (k)) & 1u) && p.ph_lo <= (k) && (k) < p.ph_hi) { for (int _rep = 0; _rep < 1 + (int)((DUPMASK >> (k)) & 1u); ++_rep) { if (_rep) __syncthreads();
#define PHASE_END(k) } } if (p.ph_lo <= (k) && (k) + 1 < p.ph_hi) { if ((k) == 0) { grid.sync(); xbar = xcd_barrier_post((unsigned*)(p.ws + WS_CTL), (volatile LAS unsigned*)(lds + 131072)); } else xcd_barrier(xbar); }

template <int layer>
DI void layer_tail(const Params& p, LAS unsigned char* lds, cg::grid_group& grid, XcdBarrier& xbar, const int bx, const int G, const int gw, const int NGW, const int lane) {
    unsigned char* ws = p.ws;
    constexpr int pb = 6 + layer * 8;
    const float* gl = gains + (size_t)layer * 4 * DM;
        PHASE_BEGIN(pb)
        { const bf16_t* A = layer == 0 ? ycat : att; const bf16_t* W = layer == 0 ? w_out_t : w_o_t;
          int pm, pn; for (int i = 0; unit_next(i, G, bx, 129, 4, pm, pn); ++i) {
            EpiY E{ybuf, rowss, pm * 256, pn * 256};
            gemm_tile(lds, A + (size_t)pm * 256 * DM, DM, W + (size_t)pn * 256 * DM, DM, DM, E); } }
        PHASE_END(pb)
        PHASE_BEGIN(pb + 1)
        { for (int r = gw; r < NT; r += NGW) { const float* hin = layer == 0 ? in_row(p, r) : hbuf + (size_t)r * DM;
            res_row(hin, ybuf + (size_t)r * DM, rowss + (size_t)r * 16, gl + DM, gl + 2 * DM, hbuf + (size_t)r * DM, xn + (size_t)r * DM, lane); } }
        PHASE_END(pb + 1)
        PHASE_BEGIN(pb + 2)
        { const bf16_t* W = (const bf16_t*)(ws + (layer ? WS_GU1 : WS_GU0));
          int pm, pn; for (int i = 0; unit_next(i, G, bx, 129, 22, pm, pn); ++i) {
            EpiGU E{hact, pm * 256, pn};
            gemm_tile(lds, xn + (size_t)pm * 256 * DM, DM, W + (size_t)pn * 256 * DM, DM, DM, E); } }
        PHASE_END(pb + 2)
        PHASE_BEGIN(pb + 3)
        { const bf16_t* W = (const bf16_t*)(ws + (layer ? WS_DN1 : WS_DN0));
          int pm, pn; for (int i = 0; unit_next(i, G, bx, 129, 4, pm, pn); ++i) {
            EpiY E{ybuf, rowss, pm * 256, pn * 256};
            gemm_tile(lds, hact + (size_t)pm * 256 * FF, FF, W + (size_t)pn * 256 * FF, FF, FF, E); } }
        PHASE_END(pb + 3)
        PHASE_BEGIN(pb + 4)
        { for (int r = gw; r < NT; r += NGW) {
            float* hout = layer == 0 ? hbuf + (size_t)r * DM : (r < NP ? p.out + O_YP + (size_t)r * DM : p.out + O_YS + (size_t)(r - NP) * DM);
            res_row(hbuf + (size_t)r * DM, ybuf + (size_t)r * DM, rowss + (size_t)r * 16, gl + 3 * DM, gains + 4 * DM, hout, layer == 0 ? xn + (size_t)r * DM : nullptr, lane); } }
        PHASE_END(pb + 4)
    }

__global__ void __launch_bounds__(512, 2) mega(Params p) {
    extern __shared__ __attribute__((aligned(16))) unsigned char lds_raw[];
    LAS unsigned char* lds = (LAS unsigned char*)lds_raw;
    cg::grid_group grid = cg::this_grid();
    const int tid = threadIdx.x, lane = tid & 63, wave = __builtin_amdgcn_readfirstlane(tid >> 6);
    const int G = gridDim.x, bx = blockIdx.x;
    const int gw = bx * 8 + wave, NGW = G * 8;
    const int gt = bx * 512 + tid, NGT = G * 512;
    unsigned char* ws = p.ws;
    XcdBarrier xbar; xbar.bar = (unsigned*)(ws + WS_CTL); xbar.x = 0; xbar.st = (volatile LAS unsigned*)(lds + 131072);
    if (tid < 64) ((LAS unsigned*)(lds + 131072))[tid] = 0u;
    if (bx == 0) { for (int i = tid; i < 4096; i += 512) ((unsigned*)(ws + WS_CTL))[i] = 0u; }
    __syncthreads();

    PHASE_BEGIN(0)
    {
        if (bx < 32) { s5_tables(p, bx, lds, Bt1 + (size_t)bx * 65536, Bt2 + (size_t)bx * 98304); }
        LAS float* scr = (LAS float*)(lds + wave * 16384);
        constexpr int I_IN = 512, I_OUT = 512, I_GLU = 128, I_POOL = 32, I_O = 512, I_QKV = 1536, I_G = 1408, I_D = 1408;
        constexpr int NITEMS = I_IN + I_OUT + I_GLU + I_POOL + I_O + I_QKV + 4 * I_G + 2 * I_D;
        for (int it = gw; it < NITEMS; it += NGW) {
            int r = it;
            if (r < I_IN) { tr_plain(p.in[7], 1024, 1024, w_in_t, r, scr, lane); continue; } r -= I_IN;
            if (r < I_OUT) { tr_plain(p.in[20], 1024, 1024, w_out_t, r, scr, lane); continue; } r -= I_OUT;
            if (r < I_GLU) { tr_plain(p.in[18], 512, 512, w_glu_t, r, scr, lane); continue; } r -= I_GLU;
            if (r < I_POOL) { const int gg = r >> 3, q = r & 7, kb = q >> 2, nb = q & 3;
                transpose_item(p.in[8] + (size_t)gg * 16384, 128, 64 * kb, 32 * nb, w_pool_t, 256, gg * 128 + 32 * nb, (gg & 1) * 128 + 64 * kb, scr, lane); continue; } r -= I_POOL;
            if (r < I_O) { tr_plain(p.in[22], 1024, 1024, w_o_t, r, scr, lane); continue; } r -= I_O;
            if (r < I_QKV) { tr_plain(p.in[21], 1024, 3072, w_qkv_t, r, scr, lane); continue; } r -= I_QKV;
            if (r < 4 * I_G) { const int which = r / I_G, q = r % I_G; const int layer = which >> 1, up = which & 1;
                const float* W = p.in[up ? 24 : 23] + (size_t)layer * 1024 * FF; bf16_t* WT = (bf16_t*)(ws + (layer ? WS_GU1 : WS_GU0));
                const int nblk = FF / 32, kb = q / nblk, nb = q % nblk, n0 = 32 * nb;
                transpose_item(W, FF, 64 * kb, n0, WT, 1024, (n0 >> 7) * 256 + up * 128 + (n0 & 127), 64 * kb, scr, lane); continue; } r -= 4 * I_G;
            { const int layer = r / I_D, q = r % I_D; tr_plain(p.in[25] + (size_t)layer * FF * 1024, FF, 1024, (bf16_t*)(ws + (layer ? WS_DN1 : WS_DN0)), q, scr, lane); }
        }
        for (int it = gt; it < 512 * 16; it += NGT) { const int n = it >> 4, c8 = it & 15; const int gg = n >> 7;
            *(u32x4*)(w_pool_t + (size_t)n * 256 + ((gg & 1) ^ 1) * 128 + c8 * 8) = (u32x4){0u, 0u, 0u, 0u}; }
        for (int r = gw; r < MT; r += NGW) {
            if (r < NT) norm_row(in_row(p, r), gains, xn + (size_t)r * DM, lane);
            else { for (int j = 0; j < 4; ++j) *(u32x2*)(xn + (size_t)r * DM + 4 * lane + 256 * j) = (u32x2){0u, 0u}; }
        }
    }
    PHASE_END(0)

    PHASE_BEGIN(1)
    { int pm, pn; for (int i = 0; unit_next(i, G, bx, 129, 4, pm, pn); ++i) {
        EpiProj E{upool, Ap, uss, pm * 256, pn * 256};
        gemm_tile(lds, xn + (size_t)pm * 256 * DM, DM, w_in_t + (size_t)pn * 256 * DM, DM, DM, E); } }
    PHASE_END(1)

    PHASE_BEGIN(2)
    {
        for (int L = bx; L < 256; L += G) { const int g = L >> 3, mt = L & 7;
            EpiS1 E{Sbuf, g, mt * 256};
            gemm_tile(lds, Ap + ((size_t)g * 2048 + mt * 256) * 384 + 128, 384, Bt1 + (size_t)g * 65536, 256, 256, E); }
        for (int u = gw; u < 1024; u += NGW) s5_sample_unit(p, u, uss, zbuf, lane);
        for (int it = gt; it < (NP / 16) * 128; it += NGT) { const int cq = it & 127, run = it >> 7; const int c = cq * 4, gi = c >> 7, w = 2 << gi;
            const int t0 = run * 16, tb0 = t0 & (TP - 1); const float* up = upool + (size_t)t0 * 512 + c;
            f32x4 sum = (f32x4){0.f, 0.f, 0.f, 0.f};
            for (int s = 1; s < w; ++s) if (tb0 - s >= 0) sum += *(const f32x4*)(up - (size_t)s * 512);
            for (int k = 0; k < 16; ++k) { const f32x4 uv = *(const f32x4*)(up + (size_t)k * 512); sum += uv; const int tb = tb0 + k; const int cnt = tb + 1 < w ? tb + 1 : w;
                const f32x4 dv = sum * (1.0f / (float)cnt) - uv; u32x2 o; o.x = pk2(dv[0], dv[1]); o.y = pk2(dv[2], dv[3]); *(u32x2*)(dbuf + (size_t)(t0 + k) * 512 + c) = o;
                if (tb - w + 1 >= 0) sum -= *(const f32x4*)(up + (size_t)(k - w + 1) * 512);
                if (tb >= TP - 15) *(f32x4*)(p.out + O_POOLP + ((size_t)(t0 >> 13) * 15 + (tb - (TP - 15))) * 512 + c) = uv; } }
        for (int it = gt; it < 32 * 128; it += NGT) { const int cq = it & 127, b = it >> 7; const int c = cq * 4, gi = c >> 7, w = 2 << gi;
            const float* sp = p.in[2] + (size_t)b * 15 * 512 + c; const float* up = upool + (size_t)(NP + b * 4) * 512 + c;
            for (int t = 0; t < 4; ++t) { f32x4 sum = (f32x4){0.f, 0.f, 0.f, 0.f};
                for (int s = 0; s < w; ++s) { const int e = 15 + t - s; sum += e >= 15 ? *(const f32x4*)(up + (size_t)(e - 15) * 512) : *(const f32x4*)(sp + (size_t)e * 512); }
                const f32x4 uv = *(const f32x4*)(up + (size_t)t * 512); const f32x4 dv = sum * (1.0f / (float)w) - uv;
                u32x2 o; o.x = pk2(dv[0], dv[1]); o.y = pk2(dv[2], dv[3]); *(u32x2*)(dbuf + (size_t)(NP + b * 4 + t) * 512 + c) = o; }
            for (int r = 0; r < 15; ++r) { const f32x4 v = r < 11 ? *(const f32x4*)(sp + (size_t)(r + 4) * 512) : *(const f32x4*)(up + (size_t)(r - 11) * 512);
                *(f32x4*)(p.out + O_POOLS + ((size_t)b * 15 + r) * 512 + c) = v; } }
    }
    PHASE_END(2)

    PHASE_BEGIN(3)
    {
        if (wave == 0 && bx < 128) { const int b = bx >> 5, g = bx & 31;
            const float dt = __expf(p.in[12][g]); const float zr = p.in[10][g * 64 + lane] * dt * 16.f, zi = p.in[11][g * 64 + lane] * dt * 16.f;
            float s, c; sincos_acc(zi, s, c); const float mag = __expf(zr); const float c_r = mag * c, c_i = mag * s;
            const float* Sp = Sbuf + ((size_t)g * 2048 + b * 512) * 128 + lane; bf16_t* Hp = Ap + ((size_t)g * 2048 + b * 512) * 384 + lane;
            float hr = 0.f, hi = 0.f;
            for (int c0 = 0; c0 < 512; c0 += 16) { float sr[16], si[16];
#pragma unroll
                for (int k = 0; k < 16; ++k) { sr[k] = Sp[(size_t)(c0 + k) * 128]; si[k] = Sp[(size_t)(c0 + k) * 128 + 64]; }
#pragma unroll
                for (int k = 0; k < 16; ++k) { const unsigned w = pk2(hr, hi); Hp[(size_t)(c0 + k) * 384] = (bf16_t)(w & 0xffffu); Hp[(size_t)(c0 + k) * 384 + 64] = (bf16_t)(w >> 16);
                    const float n_r = c_r * hr - c_i * hi + sr[k], n_i = c_r * hi + c_i * hr + si[k]; hr = n_r; hi = n_i; } }
            float* o = p.out + O_S5P + (((size_t)b * 32 + g) * 64 + lane) * 2; o[0] = hr; o[1] = hi;
        }
        __syncthreads();
        int pm, pn; for (int i = 0; unit_next(i, G, bx, 129, 2, pm, pn); ++i) {
            EpiPool E{ycat, p.in[9], pm * 256, pn * 256};
            gemm_tile(lds, dbuf + (size_t)pm * 256 * 512 + pn * 256, 512, w_pool_t + (size_t)pn * 256 * 256, 256, 256, E); }
    }
    PHASE_END(3)

    PHASE_BEGIN(4)
    { for (int L = bx; L < 256; L += G) { const int g = L >> 3, mt = L & 7;
        EpiS2 E{zbuf, Ap, p.in[17], g, mt * 256};
        gemm_tile(lds, Ap + ((size_t)g * 2048 + mt * 256) * 384, 384, Bt2 + (size_t)g * 98304, 384, 384, E); } }
    PHASE_END(4)

    PHASE_BEGIN(5)
    { int pm, pn; for (int i = 0; unit_next(i, G, bx, 129, 2, pm, pn); ++i) {
        EpiGlu E{ycat, zbuf, p.in[19], pm * 256, pn * 256};
        gemm_tile(lds, zbuf + (size_t)pm * 256 * 512, 512, w_glu_t + (size_t)pn * 256 * 512, 512, 512, E); } }
    PHASE_END(5)

    layer_tail<0>(p, lds, grid, xbar, bx, G, gw, NGW, lane);
            PHASE_BEGIN(11)
            { int pm, pn; for (int i = 0; unit_next(i, G, bx, 129, 12, pm, pn); ++i) {
                EpiQKV E{Qb, p.out, pm * 256, pn * 256};
                gemm_tile(lds, xn + (size_t)pm * 256 * DM, DM, w_qkv_t + (size_t)pn * 256 * DM, DM, DM, E); } }
            PHASE_END(11)
            PHASE_BEGIN(12)
            {
                for (int u = gw; u < 2048; u += NGW) attn_sample_unit(p, u, Qb, Kb, Vb, att, (LAS float*)(lds + wave * 8192), lane);
                for (int u = gw; u < 3 * 16384; u += NGW) attn_prompt_unit(u, Qb, Kb, Vb, Op, lse, lds + wave * 8192, lane);
            }
            PHASE_END(12)
            PHASE_BEGIN(13)
            { for (int it = gt; it < NP * 128; it += NGT) { const int c8 = it & 127, row = it >> 7, h = c8 >> 3;
                const float l0 = lse[(size_t)row * 16 + h], l1 = lse[((size_t)MT + row) * 16 + h], l2 = lse[((size_t)2 * MT + row) * 16 + h];
                const float mx = fmaxf(l0, fmaxf(l1, l2)); float w0 = __expf(l0 - mx), w1 = __expf(l1 - mx), w2 = __expf(l2 - mx); const float inv = 1.f / (w0 + w1 + w2); w0 *= inv; w1 *= inv; w2 *= inv;
                const u32x4 a = *(const u32x4*)(Op + (size_t)row * 1024 + c8 * 8), b = *(const u32x4*)(Op + ((size_t)MT + row) * 1024 + c8 * 8), c = *(const u32x4*)(Op + ((size_t)2 * MT + row) * 1024 + c8 * 8);
                u32x4 o;
                o.x = pk2(w0 * bflo(a.x) + w1 * bflo(b.x) + w2 * bflo(c.x), w0 * bfhi(a.x) + w1 * bfhi(b.x) + w2 * bfhi(c.x));
                o.y = pk2(w0 * bflo(a.y) + w1 * bflo(b.y) + w2 * bflo(c.y), w0 * bfhi(a.y) + w1 * bfhi(b.y) + w2 * bfhi(c.y));
                o.z = pk2(w0 * bflo(a.z) + w1 * bflo(b.z) + w2 * bflo(c.z), w0 * bfhi(a.z) + w1 * bfhi(b.z) + w2 * bfhi(c.z));
                o.w = pk2(w0 * bflo(a.w) + w1 * bflo(b.w) + w2 * bflo(c.w), w0 * bfhi(a.w) + w1 * bfhi(b.w) + w2 * bfhi(c.w));
                *(u32x4*)(att + (size_t)row * 1024 + c8 * 8) = o; } }
            PHASE_END(13)
            layer_tail<1>(p, lds, grid, xbar, bx, G, gw, NGW, lane);
}

constexpr int NPHASES = 19;

extern "C" void kernel_launch(void* const* d_in, const int* in_sizes, int n_in, void* d_out, int out_size, void* d_ws, size_t ws_size, hipStream_t stream) {
    static int grid = 0;
    if (grid == 0) {
        int dev = 0, cus = 0, per_cu = 0;
        hipGetDevice(&dev);
        hipDeviceGetAttribute(&cus, hipDeviceAttributeMultiprocessorCount, dev);
        hipFuncSetAttribute((const void*)mega, hipFuncAttributeMaxDynamicSharedMemorySize, LDS_BYTES);
        hipOccupancyMaxActiveBlocksPerMultiprocessor(&per_cu, (const void*)mega, 512, LDS_BYTES);
        if (per_cu < 1) per_cu = 1;
        grid = cus * 1;
        if (ws_size < WS_END) fprintf(stderr, "kernel_launch: workspace too small: %zu < %zu\n", ws_size, (size_t)WS_END);
        fprintf(stderr, "kernel_launch: cus %d per_cu %d grid %d n_in %d out %d ws %zu\n", cus, per_cu, grid, n_in, out_size, ws_size);
    }
    Params p{};
    for (int i = 0; i < 26; ++i) p.in[i] = (const float*)d_in[i];
    p.out = (float*)d_out; p.ws = (unsigned char*)d_ws; p.ph_lo = 0; p.ph_hi = NPHASES;
    void* args[] = {&p};
    hipError_t e = hipLaunchCooperativeKernel((const void*)mega, dim3(grid), dim3(512), args, LDS_BYTES, stream);
    if (e != hipSuccess) fprintf(stderr, "cooperative launch failed: %s (grid %d)\n", hipGetErrorString(e), grid);
}
```

```cpp
#include <hip/hip_runtime.h>
#include <hip/hip_cooperative_groups.h>
#include <cstdio>
#include <cstdint>
namespace cg = cooperative_groups;

#define LAS __attribute__((address_space(3)))
#define DI __device__ __forceinline__
typedef unsigned short bf16_t;
typedef short bf16x8 __attribute__((ext_vector_type(8)));
typedef short s16x4 __attribute__((ext_vector_type(4)));
typedef float f32x4 __attribute__((ext_vector_type(4)));
typedef unsigned u32x4 __attribute__((ext_vector_type(4)));
typedef unsigned u32x2 __attribute__((ext_vector_type(2)));
typedef __bf16 bf2_t __attribute__((ext_vector_type(2)));

constexpr int NP = 32768, NS = 128, NT = NP + NS, MT = 33024, DM = 1024, FF = 2816, TP = 8192;
constexpr float EPS = 1e-6f;
constexpr int LDS_BYTES = 157696 + 256;
constexpr size_t O_YP = 0, O_YS = 33554432, O_POOLP = 33685504, O_S5P = 33716224, O_KP = 33732608, O_VP = 42121216,
                 O_POOLS = 50509824, O_S5S = 50755584, O_KS = 50886656, O_VS = 51017728;
constexpr size_t MiB = 1u << 20;
constexpr size_t WS_WIN = 0, WS_WOUT = 2 * MiB, WS_WGLU = 4 * MiB, WS_WPOOL = 4 * MiB + 512 * 1024, WS_WO = 5 * MiB, WS_WQKV = 7 * MiB,
                 WS_GU0 = 13 * MiB, WS_GU1 = 24 * MiB, WS_DN0 = 35 * MiB, WS_DN1 = 41 * MiB, WS_BT1 = 47 * MiB, WS_BT2 = 51 * MiB,
                 WS_ROWSS = 57 * MiB, WS_USS = 60 * MiB, WS_LSE = 61 * MiB, WS_XN = 68 * MiB, WS_Y = 133 * MiB, WS_H = 198 * MiB,
                 WS_X = 328 * MiB;
constexpr size_t WS_AP = WS_X, WS_S = WS_X + 48 * MiB, WS_UPOOL = WS_X + 80 * MiB, WS_D = WS_X + 145 * MiB, WS_Z = WS_X + 178 * MiB,
                 WS_YCAT = WS_X + 211 * MiB;
constexpr size_t WS_HACT = WS_X;
constexpr size_t WS_Q = WS_X, WS_K = WS_X + 65 * MiB, WS_V = WS_X + 130 * MiB, WS_OP = WS_X + 195 * MiB, WS_ATT = WS_X + 389 * MiB;
constexpr size_t WS_END = WS_X + 454 * MiB;
constexpr size_t WS_CTL = 60 * MiB + 512 * 1024;

struct Params { const float* in[26]; float* out; unsigned char* ws; int ph_lo, ph_hi; };

DI unsigned pk2(float lo, float hi) { bf2_t v; v.x = (__bf16)lo; v.y = (__bf16)hi; return __builtin_bit_cast(unsigned, v); }
DI float bflo(unsigned w) { return __uint_as_float(w << 16); }
DI float bfhi(unsigned w) { return __uint_as_float(w & 0xffff0000u); }
DI float bf2f(bf16_t b) { return __uint_as_float((unsigned)b << 16); }
DI float wave_sum(float v) {
#pragma unroll
    for (int o = 1; o < 64; o <<= 1) v += __shfl_xor(v, o);
    return v;
}
DI float wave_max(float v) {
#pragma unroll
    for (int o = 1; o < 64; o <<= 1) v = fmaxf(v, __shfl_xor(v, o));
    return v;
}
DI float sigmoidf_(float x) { return __builtin_amdgcn_rcpf(1.0f + __builtin_amdgcn_exp2f(-1.4426950408889634f * x)); }
DI float gelu_tanh(float y) { const float u = 0.7978845608028654f * (y + 0.044715f * y * y * y); return y * __builtin_amdgcn_rcpf(1.0f + __builtin_amdgcn_exp2f(-2.0f * 1.4426950408889634f * u)); }
DI void sincos_acc(float a, float& s, float& c) {
    if (fabsf(a) < 0.5f) {
        const float a2 = a * a;
        s = a * (1.f - a2 * (1.f / 6.f) * (1.f - a2 * (1.f / 20.f) * (1.f - a2 * (1.f / 42.f))));
        c = 1.f - a2 * 0.5f * (1.f - a2 * (1.f / 12.f) * (1.f - a2 * (1.f / 30.f) * (1.f - a2 * (1.f / 56.f))));
    } else {
        float r = a * 0.15915494309189535f; r -= floorf(r);
        s = __builtin_amdgcn_sinf(r); c = __builtin_amdgcn_cosf(r);
    }
}
DI int lane_id() { int l; asm volatile("v_mbcnt_lo_u32_b32 %0, -1, 0\n\tv_mbcnt_hi_u32_b32 %0, -1, %0" : "=v"(l)); return l; }
#define LDS_WAIT() asm volatile("s_waitcnt lgkmcnt(0)" ::: "memory")
#define VM_WAIT() asm volatile("s_waitcnt vmcnt(0)" ::: "memory")

constexpr int BM = 256, BK = 64, HALF = 128, NXCD = 8, WGM = 8;
typedef f32x4 Acc[2][2][4][2];
DI int lds_byte(int r, int c) { const int st = (r >> 4) * 2 + (c >> 5), rr = r & 15, cc = c & 31, ob = rr * 64 + cc * 2; return st * 1024 + (ob ^ (((ob >> 9) & 1) << 5)); }
DI void stage_rc(int b, int& R, int& C) { const int st = b / 1024, sb = b % 1024, swz = sb ^ (((sb >> 9) & 1) << 5); R = (st >> 1) * 16 + swz / 64; C = (st & 1) * 32 + (swz % 64) / 2; }

DI bool unit_next(int i, int G, int c, int nM, int nN, int& pm, int& pn) {
    const int nwg = nM * nN; const long L = (long)i * G + c; if (L >= nwg) return false;
    int wgid = (int)L; { const int q = nwg / NXCD, r = nwg % NXCD, xcd = wgid % NXCD, off = wgid / NXCD; wgid = (xcd < r ? xcd * (q + 1) : r * (q + 1) + (xcd - r) * q) + off; }
    const int nig = WGM * nN, gid = wgid / nig, fm = gid * WGM, gsz = (nM - fm) < WGM ? (nM - fm) : WGM;
    pm = fm + ((wgid % nig) % gsz); pn = (wgid % nig) / gsz; return true;
}

template <class Units>
DI void gemm_phase(LAS unsigned char* lds, const int wid, const int lda, const int ldb, const int K, const Units& U) {
    typedef typename Units::Epi Epi;
    const int lane = lane_id(), tid = wid * 64 + lane, wr = wid >> 2, wc = wid & 3, fr = lane & 15, fq = lane >> 4;
    unsigned offA, offB;
    { int R, C; stage_rc(tid * 16, R, C); offA = (unsigned)(R * lda + C) * 2u; offB = (unsigned)(R * ldb + C) * 2u; }
    const unsigned ldsw = (unsigned)wid * 1024u;
    const unsigned hA = (unsigned)(HALF * lda * 2), hB = (unsigned)(HALF * ldb * 2), dA = (unsigned)(64 * lda * 2), dB = (unsigned)(64 * ldb * 2);
    const int aoff = lds_byte(wr * 64 + fr, fq * 8), boff = lds_byte(wc * 32 + fr, fq * 8);
#define SA(b, h) (((b) * 2 + (h)) * 16384)
#define SB(b, h) ((4 + (b) * 2 + (h)) * 16384)
#define STG(bufoff, gbase, soff, voff, dlt) do { _Pragma("unroll") for (int _i = 0; _i < 2; ++_i) { unsigned _vo = (voff); asm volatile("" : "+v"(_vo)); _vo += (unsigned)(soff) + (unsigned)_i * (dlt); \
        __builtin_amdgcn_global_load_lds((const unsigned*)((gbase) + _vo), (LAS unsigned*)(lds + (bufoff) + ldsw + _i * 8192), 16, 0, 0); } } while (0)
#define STA(b, h, base, kt) STG(SA(b, h), base, (h) * hA + (unsigned)(kt) * 128u, offA, dA)
#define STB(b, h, base, kt) STG(SB(b, h), base, (h) * hB + (unsigned)(kt) * 128u, offB, dB)
#define LDA(dst, b, h) do { _Pragma("unroll") for (int m = 0; m < 4; ++m) _Pragma("unroll") for (int k = 0; k < 2; ++k) dst[m][k] = *(const LAS bf16x8*)(lds + SA(b, h) + aoff + m * 2048 + k * 1024); } while (0)
#define LDB(dst, b, h) do { _Pragma("unroll") for (int n = 0; n < 2; ++n) _Pragma("unroll") for (int k = 0; k < 2; ++k) dst[n][k] = *(const LAS bf16x8*)(lds + SB(b, h) + boff + n * 2048 + k * 1024); } while (0)
#define MMA(ai, bj, Af, Bf) do { __builtin_amdgcn_s_setprio(1); _Pragma("unroll") for (int m = 0; m < 4; ++m) _Pragma("unroll") for (int n = 0; n < 2; ++n) _Pragma("unroll") for (int k = 0; k < 2; ++k) \
        acc[ai][bj][m][n] = __builtin_amdgcn_mfma_f32_16x16x32_bf16(Bf[n][k], Af[m][k], acc[ai][bj][m][n], 0, 0, 0); __builtin_amdgcn_s_setprio(0); } while (0)
#define WAIT_V(n) asm volatile("s_waitcnt vmcnt(" #n ")" ::: "memory")
#define WAIT_L(n) asm volatile("s_waitcnt lgkmcnt(" #n ")" ::: "memory")
#define BAR __builtin_amdgcn_s_barrier()
#define SCHED __builtin_amdgcn_sched_barrier(0)
#define ZERO_ACC() do { _Pragma("unroll") for (int a = 0; a < 2; ++a) _Pragma("unroll") for (int b = 0; b < 2; ++b) _Pragma("unroll") for (int m = 0; m < 4; ++m) _Pragma("unroll") for (int n = 0; n < 2; ++n) acc[a][b][m][n] = (f32x4){0.f, 0.f, 0.f, 0.f}; } while (0)
    const bf16_t* pa; const bf16_t* pb; Epi Ecur, Enxt;
    if (!U.get(0, pa, pb, Ecur)) return;
    const char* cA = (const char*)pa; const char* cB = (const char*)pb;
    Acc acc; ZERO_ACC();
    bf16x8 At[4][2], B0[2][2], B1[2][2];
    const int nt = K / BK;
    STB(0, 0, cB, 0); STB(0, 1, cB, 0); STA(0, 0, cA, 0); STA(0, 1, cA, 0);
    if (wr == 1) BAR;
    WAIT_V(2); BAR;
    STB(1, 0, cB, 1); STA(1, 0, cA, 1); STB(1, 1, cB, 1);
    WAIT_V(6); BAR;
    for (int ui = 0;; ++ui) {
        const bool has_next = U.get(ui + 1, pa, pb, Enxt);
        const char* nA = has_next ? (const char*)pa : cA; const char* nB = has_next ? (const char*)pb : cB;
        for (int t = 0; t < nt; t += 2) {
            const bool last = (t == nt - 2);
            const char* a2 = last ? nA : cA; const char* b2 = last ? nB : cB; const int k2 = last ? 0 : t + 2, k3 = k2 + 1;
            LDB(B0, 0, 0); LDB(B1, 0, 1); SCHED; LDA(At, 0, 0); STA(1, 1, cA, t + 1);
            WAIT_V(8); WAIT_L(0); BAR; MMA(0, 0, At, B0); MMA(0, 1, At, B1); BAR; SCHED;
            LDA(At, 0, 1); STB(0, 0, b2, k2); STB(0, 1, b2, k2); STA(0, 0, a2, k2);
            WAIT_V(8); WAIT_L(0); BAR; MMA(1, 0, At, B0); MMA(1, 1, At, B1); BAR; SCHED;
            LDB(B0, 1, 0); LDB(B1, 1, 1); SCHED; LDA(At, 1, 0); STA(0, 1, a2, k2);
            WAIT_V(8); WAIT_L(0); BAR; MMA(0, 0, At, B0); MMA(0, 1, At, B1); BAR; SCHED;
            LDA(At, 1, 1); STB(1, 0, b2, k3); STB(1, 1, b2, k3); STA(1, 0, a2, k3);
            WAIT_V(8); WAIT_L(0); BAR; MMA(1, 0, At, B0); MMA(1, 1, At, B1); BAR; SCHED;
        }
        Ecur(acc, wr, wc, fr, fq);
        if (!has_next) break;
        ZERO_ACC();
        cA = nA; cB = nB; Ecur = Enxt;
    }
    WAIT_V(0);
    if (wr == 0) BAR;
    BAR;
#undef ZERO_ACC
#undef SA
#undef SB
#undef STG
#undef STA
#undef STB
#undef LDA
#undef LDB
#undef MMA
#undef WAIT_V
#undef WAIT_L
#undef BAR
#undef SCHED
}

#define EPI_ROWS(...) _Pragma("unroll") for (int ai = 0; ai < 2; ++ai) _Pragma("unroll") for (int m = 0; m < 4; ++m) { const int rr = ai * 128 + wr * 64 + m * 16 + fr; __VA_ARGS__ }
#define EPI_COLS(...) _Pragma("unroll") for (int bj = 0; bj < 2; ++bj) _Pragma("unroll") for (int n = 0; n < 2; ++n) { const int cc = bj * 128 + wc * 32 + n * 16 + 4 * fq; const f32x4 v = acc[ai][bj][m][n]; __VA_ARGS__ }

struct EpiProj {
    float* upool; bf16_t* Ap; float* uss; int row0, col0;
    DI void set(int pm, int pn) { row0 = pm * 256; col0 = pn * 256; }
    DI void elem(int row, int col, const f32x4 v) const {
        if (col < 512) *(f32x4*)(upool + (size_t)row * 512 + col) = v; else *(f32x4*)(uss + (size_t)(row - NP) * 512 + (col - 512)) = v; }
    DI void operator()(const Acc& acc, int wr, int wc, int fr, int fq) const {
        if (col0 < 512) {
            EPI_ROWS(const size_t row = row0 + rr; EPI_COLS(*(f32x4*)(upool + row * 512 + col0 + cc) = v;))
        } else {
            EPI_ROWS(const int row = row0 + rr;
                EPI_COLS(const int c2 = col0 - 512 + cc; const int g = c2 >> 4, i = c2 & 15;
                    if (row < NP) { u32x2 w; w.x = pk2(v[0], v[1]); w.y = pk2(v[2], v[3]);
                        *(u32x2*)(Ap + ((size_t)g * 2048 + (row >> 4)) * 384 + 128 + (row & 15) * 16 + i) = w; }
                    else if (row < NT) { *(f32x4*)(uss + (size_t)(row - NP) * 512 + c2) = v; }))
        }
    }
};
struct EpiS1 {
    float* S; int g, row0;
    DI void set(int mt, int gg) { row0 = mt * 256; g = gg; }
    DI void operator()(const Acc& acc, int wr, int wc, int fr, int fq) const {
        EPI_ROWS(const size_t row = (size_t)g * 2048 + row0 + rr;
            _Pragma("unroll") for (int n = 0; n < 2; ++n) { const int cc = wc * 32 + n * 16 + 4 * fq; *(f32x4*)(S + row * 128 + cc) = acc[ai][0][m][n]; })
    }
};
struct EpiPool {
    bf16_t* ycat; const float* scale; int row0, col0;
    DI void set(int pm, int pn) { row0 = pm * 256; col0 = pn * 256; }
    DI void elem(int row, int col, const f32x4 v) const { const f32x4 s = *(const f32x4*)(scale + col); u32x2 w; w.x = pk2(v[0] * s[0], v[1] * s[1]); w.y = pk2(v[2] * s[2], v[3] * s[3]);
        *(u32x2*)(ycat + (size_t)row * 1024 + col) = w; }
    DI void operator()(const Acc& acc, int wr, int wc, int fr, int fq) const {
        EPI_ROWS(const size_t row = row0 + rr;
            EPI_COLS(const int col = col0 + cc; const f32x4 s = *(const f32x4*)(scale + col); u32x2 w; w.x = pk2(v[0] * s[0], v[1] * s[1]); w.y = pk2(v[2] * s[2], v[3] * s[3]);
                *(u32x2*)(ycat + row * 1024 + col) = w;))
    }
};
struct EpiS2 {
    bf16_t* z; const bf16_t* Ap; const float* dskip; int g, row0;
    DI void set(int mt, int gg) { row0 = mt * 256; g = gg; }
    DI void operator()(const Acc& acc, int wr, int wc, int fr, int fq) const {
        EPI_ROWS(const int chunk = row0 + rr; const bf16_t* ap = Ap + ((size_t)g * 2048 + chunk) * 384 + 128;
            EPI_COLS(const int r = cc >> 4, i = cc & 15; const u32x2 uw = *(const u32x2*)(ap + cc); const f32x4 d = *(const f32x4*)(dskip + g * 16 + i);
                const float y0 = v[0] + d[0] * bflo(uw.x), y1 = v[1] + d[1] * bfhi(uw.x), y2 = v[2] + d[2] * bflo(uw.y), y3 = v[3] + d[3] * bfhi(uw.y);
                u32x2 w; w.x = pk2(gelu_tanh(y0), gelu_tanh(y1)); w.y = pk2(gelu_tanh(y2), gelu_tanh(y3));
                *(u32x2*)(z + ((size_t)chunk * 16 + r) * 512 + g * 16 + i) = w;))
    }
};
struct EpiGlu {
    bf16_t* ycat; const bf16_t* z; const float* bglu; int row0, col0;
    DI void set(int pm, int pn) { row0 = pm * 256; col0 = pn * 256; }
    DI void elem(int row, int col, const f32x4 v) const { const u32x2 zw = *(const u32x2*)(z + (size_t)row * 512 + col); const f32x4 b = *(const f32x4*)(bglu + col);
        u32x2 w; w.x = pk2(bflo(zw.x) * sigmoidf_(v[0] + b[0]), bfhi(zw.x) * sigmoidf_(v[1] + b[1])); w.y = pk2(bflo(zw.y) * sigmoidf_(v[2] + b[2]), bfhi(zw.y) * sigmoidf_(v[3] + b[3]));
        *(u32x2*)(ycat + (size_t)row * 1024 + 512 + col) = w; }
    DI void operator()(const Acc& acc, int wr, int wc, int fr, int fq) const {
        EPI_ROWS(const size_t row = row0 + rr;
            EPI_COLS(const int col = col0 + cc; const u32x2 zw = *(const u32x2*)(z + row * 512 + col); const f32x4 b = *(const f32x4*)(bglu + col);
                u32x2 w; w.x = pk2(bflo(zw.x) * sigmoidf_(v[0] + b[0]), bfhi(zw.x) * sigmoidf_(v[1] + b[1]));
                w.y = pk2(bflo(zw.y) * sigmoidf_(v[2] + b[2]), bfhi(zw.y) * sigmoidf_(v[3] + b[3]));
                *(u32x2*)(ycat + row * 1024 + 512 + col) = w;))
    }
};
struct EpiY {
    bf16_t* y; int row0, col0;
    DI void set(int pm, int pn) { row0 = pm * 256; col0 = pn * 256; }
    DI void elem(int row, int col, const f32x4 v) const { u32x2 w; w.x = pk2(v[0], v[1]); w.y = pk2(v[2], v[3]); *(u32x2*)(y + (size_t)row * 1024 + col) = w; }
    DI void operator()(const Acc& acc, int wr, int wc, int fr, int fq) const {
        EPI_ROWS(const int row = row0 + rr; EPI_COLS(elem(row, col0 + cc, v);))
    }
};
struct EpiGU {
    bf16_t* hact; int row0, hb;
    DI void set(int pm, int pn) { row0 = pm * 256; hb = pn; }
    DI void elem2(int row, int col, const f32x4 a, const f32x4 u) const { u32x2 w; w.x = pk2(a[0] * sigmoidf_(a[0]) * u[0], a[1] * sigmoidf_(a[1]) * u[1]); w.y = pk2(a[2] * sigmoidf_(a[2]) * u[2], a[3] * sigmoidf_(a[3]) * u[3]);
        *(u32x2*)(hact + (size_t)row * FF + col) = w; }
    DI void operator()(const Acc& acc, int wr, int wc, int fr, int fq) const {
        EPI_ROWS(const size_t row = row0 + rr;
            _Pragma("unroll") for (int n = 0; n < 2; ++n) { const int cc = wc * 32 + n * 16 + 4 * fq; const f32x4 a = acc[ai][0][m][n], u = acc[ai][1][m][n];
                u32x2 w; w.x = pk2(a[0] * sigmoidf_(a[0]) * u[0], a[1] * sigmoidf_(a[1]) * u[1]); w.y = pk2(a[2] * sigmoidf_(a[2]) * u[2], a[3] * sigmoidf_(a[3]) * u[3]);
                *(u32x2*)(hact + row * FF + hb * 128 + cc) = w; })
    }
};
struct EpiQKV {
    bf16_t* qkv; float* out; int row0, col0;
    DI void set(int pm, int pn) { row0 = pm * 256; col0 = pn * 256; }
    DI void elem(int row, int colg, const f32x4 v) const {
        const int which = colg >> 10, col = colg & 1023; const float sc = which == 0 ? 0.125f * 1.4426950408889634f : 1.0f;
        u32x2 w; w.x = pk2(v[0] * sc, v[1] * sc); w.y = pk2(v[2] * sc, v[3] * sc);
        *(u32x2*)(qkv + (size_t)which * (65 * MiB / 2) + (size_t)row * 1024 + col) = w;
        if (which != 0) *(f32x4*)(out + (which == 1 ? O_KS : O_VS) + (size_t)(row - NP) * 1024 + col) = v; }
    DI void operator()(const Acc& acc, int wr, int wc, int fr, int fq) const {
        const int which = col0 >> 10; const int cb = col0 & 1023; const float sc = which == 0 ? 0.125f * 1.4426950408889634f : 1.0f;
        bf16_t* dst = qkv + (size_t)which * (65 * MiB / 2);
        float* op = out + (which == 1 ? O_KP : O_VP); float* os = out + (which == 1 ? O_KS : O_VS);
        EPI_ROWS(const int row = row0 + rr;
            EPI_COLS(const int col = cb + cc; u32x2 w; w.x = pk2(v[0] * sc, v[1] * sc); w.y = pk2(v[2] * sc, v[3] * sc);
                *(u32x2*)(dst + (size_t)row * 1024 + col) = w;
                if (which != 0) {
                    if (row < NP) { const int tb = row & (TP - 1); if (tb >= TP - 2048) *(f32x4*)(op + ((size_t)(row >> 13) * 2048 + (tb - (TP - 2048))) * 1024 + col) = v; }
                    else if (row < NT) *(f32x4*)(os + (size_t)(row - NP) * 1024 + col) = v;
                }))
    }
};


template <class EpiT> struct UStd {
    typedef EpiT Epi; const bf16_t* A; const bf16_t* Bt; size_t astep, bstep; int acolstep, nM, nN, G, c; EpiT proto;
    DI bool get(int i, const bf16_t*& a, const bf16_t*& b, EpiT& e) const { int pm, pn; if (!unit_next(i, G, c, nM, nN, pm, pn)) return false;
        a = A + (size_t)pm * astep + (size_t)pn * acolstep; b = Bt + (size_t)pn * bstep; e = proto; e.set(pm, pn); return true; }
};
template <class EpiT> struct US5 {
    typedef EpiT Epi; const bf16_t* A; const bf16_t* Bt; size_t bstep; int G, c; EpiT proto;
    DI bool get(int i, const bf16_t*& a, const bf16_t*& b, EpiT& e) const { const int L = c + i * G; if (L >= 256) return false; const int g = L >> 3, mt = L & 7;
        a = A + ((size_t)g * 2048 + mt * 256) * 384; b = Bt + (size_t)g * bstep; e = proto; e.set(mt, g); return true; }
};

DI f32x4 mini_acc(const bf16_t* Arow, const bf16_t* Brow, int K) {
    f32x4 acc = (f32x4){0.f, 0.f, 0.f, 0.f};
    int k0 = 0;
    for (; k0 + 512 <= K; k0 += 512) { bf16x8 a[16], b[16];
#pragma unroll
        for (int e = 0; e < 16; ++e) { a[e] = *(const bf16x8*)(Arow + k0 + 32 * e); b[e] = *(const bf16x8*)(Brow + k0 + 32 * e); }
#pragma unroll
        for (int e = 0; e < 16; ++e) acc = __builtin_amdgcn_mfma_f32_16x16x32_bf16(b[e], a[e], acc, 0, 0, 0); }
    if (k0 < K) { bf16x8 a[8], b[8];
#pragma unroll
        for (int e = 0; e < 8; ++e) { a[e] = *(const bf16x8*)(Arow + k0 + 32 * e); b[e] = *(const bf16x8*)(Brow + k0 + 32 * e); }
#pragma unroll
        for (int e = 0; e < 8; ++e) acc = __builtin_amdgcn_mfma_f32_16x16x32_bf16(b[e], a[e], acc, 0, 0, 0); }
    return acc;
}
DI void mini_acc2(const bf16_t* Arow, const bf16_t* Bg, const bf16_t* Bu, int K, f32x4& ga, f32x4& ua) {
    ga = (f32x4){0.f, 0.f, 0.f, 0.f}; ua = ga;
    for (int k0 = 0; k0 < K; k0 += 256) { bf16x8 a[8], g[8], u[8];
#pragma unroll
        for (int e = 0; e < 8; ++e) { a[e] = *(const bf16x8*)(Arow + k0 + 32 * e); g[e] = *(const bf16x8*)(Bg + k0 + 32 * e); u[e] = *(const bf16x8*)(Bu + k0 + 32 * e); }
#pragma unroll
        for (int e = 0; e < 8; ++e) { ga = __builtin_amdgcn_mfma_f32_16x16x32_bf16(g[e], a[e], ga, 0, 0, 0); ua = __builtin_amdgcn_mfma_f32_16x16x32_bf16(u[e], a[e], ua, 0, 0, 0); } }
}
template <class Epi>
DI void mini_gemm(const bf16_t* A, int lda, const bf16_t* Bt, int ldb, int K, int N, int acol_per_256, const Epi& E, int bx, int G, int wave, int lane) {
    const int fr = lane & 15, fq = lane >> 4; const int row = NP + 16 * wave + fr;
    for (int q = bx; q < N / 16; q += G) {
        const bf16_t* Arow = A + (size_t)row * lda + ((16 * q) >> 8) * acol_per_256 + 8 * fq;
        const bf16_t* Brow = Bt + (size_t)(16 * q + fr) * ldb + 8 * fq;
        const f32x4 acc = mini_acc(Arow, Brow, K);
        E.elem(row, 16 * q + 4 * fq, acc); }
}
DI void mini_gemm_gu(const bf16_t* A, const bf16_t* Bt, const EpiGU& E, int bx, int G, int wave, int lane) {
    const int fr = lane & 15, fq = lane >> 4; const int row = NP + 16 * wave + fr;
    for (int q = bx; q < FF / 16; q += G) { const int hcol = 16 * q; const int brow = (hcol >> 7) * 256 + (hcol & 127) + fr;
        const bf16_t* Arow = A + (size_t)row * DM + 8 * fq;
        f32x4 ga, ua; mini_acc2(Arow, Bt + (size_t)brow * DM + 8 * fq, Bt + (size_t)(brow + 128) * DM + 8 * fq, DM, ga, ua);
        E.elem2(row, hcol + 4 * fq, ga, ua); }
}
DI void transpose_item(const float* W, int N, int k0, int n0, bf16_t* WT, int ldt, int orow0, int ocol0, LAS float* scr, int lane) {
#pragma unroll 16
    for (int i = 0; i < 32; ++i) { const int kk = 2 * i + (lane >> 5); scr[kk * 33 + (lane & 31)] = W[(size_t)(k0 + kk) * N + n0 + (lane & 31)]; }
    LDS_WAIT();
    const int c = lane & 7;
#pragma unroll
    for (int j = 0; j < 4; ++j) { const int n = (lane >> 3) + 8 * j; const LAS float* s = scr + (8 * c) * 33 + n;
        u32x4 o; o.x = pk2(s[0 * 33], s[1 * 33]); o.y = pk2(s[2 * 33], s[3 * 33]); o.z = pk2(s[4 * 33], s[5 * 33]); o.w = pk2(s[6 * 33], s[7 * 33]);
        *(u32x4*)(WT + (size_t)(orow0 + n) * ldt + ocol0 + 8 * c) = o; }
    LDS_WAIT();
}
DI void tr_plain(const float* W, int K, int N, bf16_t* WT, int item, LAS float* scr, int lane) {
    const int nblk = N / 32, kb = item / nblk, nb = item % nblk; transpose_item(W, N, 64 * kb, 32 * nb, WT, K, 32 * nb, 64 * kb, scr, lane);
}

DI const float* in_row(const Params& p, int r) { return r < NP ? p.in[0] + (size_t)r * DM : p.in[1] + (size_t)(r - NP) * DM; }

DI void norm_row(const float* xr, const float* g, bf16_t* o, int lane) {
    f32x4 v[4]; float s = 0.f;
#pragma unroll
    for (int j = 0; j < 4; ++j) { v[j] = *(const f32x4*)(xr + 4 * lane + 256 * j); s += (v[j][0] * v[j][0] + v[j][1] * v[j][1]) + (v[j][2] * v[j][2] + v[j][3] * v[j][3]); }
    const float r = rsqrtf(wave_sum(s) * (1.f / DM) + EPS);
#pragma unroll
    for (int j = 0; j < 4; ++j) { const f32x4 gg = *(const f32x4*)(g + 4 * lane + 256 * j); u32x2 w; w.x = pk2(v[j][0] * r * gg[0], v[j][1] * r * gg[1]); w.y = pk2(v[j][2] * r * gg[2], v[j][3] * r * gg[3]);
        *(u32x2*)(o + 4 * lane + 256 * j) = w; }
}
DI void norm_row2(const float* xa, const float* xb, const float* g, bf16_t* oa, bf16_t* ob, int lane) {
    f32x4 va[4], vb[4]; float sa = 0.f, sb = 0.f;
#pragma unroll
    for (int j = 0; j < 4; ++j) { va[j] = *(const f32x4*)(xa + 4 * lane + 256 * j); vb[j] = *(const f32x4*)(xb + 4 * lane + 256 * j); }
#pragma unroll
    for (int j = 0; j < 4; ++j) { sa += (va[j][0] * va[j][0] + va[j][1] * va[j][1]) + (va[j][2] * va[j][2] + va[j][3] * va[j][3]); sb += (vb[j][0] * vb[j][0] + vb[j][1] * vb[j][1]) + (vb[j][2] * vb[j][2] + vb[j][3] * vb[j][3]); }
    const float ra = rsqrtf(wave_sum(sa) * (1.f / DM) + EPS), rb = rsqrtf(wave_sum(sb) * (1.f / DM) + EPS);
#pragma unroll
    for (int j = 0; j < 4; ++j) { const f32x4 gg = *(const f32x4*)(g + 4 * lane + 256 * j); u32x2 w;
        w.x = pk2(va[j][0] * ra * gg[0], va[j][1] * ra * gg[1]); w.y = pk2(va[j][2] * ra * gg[2], va[j][3] * ra * gg[3]); *(u32x2*)(oa + 4 * lane + 256 * j) = w;
        w.x = pk2(vb[j][0] * rb * gg[0], vb[j][1] * rb * gg[1]); w.y = pk2(vb[j][2] * rb * gg[2], vb[j][3] * rb * gg[3]); *(u32x2*)(ob + 4 * lane + 256 * j) = w; }
}
template <bool INB, bool OUTB>
DI void res_row(const void* hin_, const bf16_t* y, const float* gpost, const float* gnext, void* hout_, bf16_t* xn, int lane) {
    u32x2 yw[4]; float ss = 0.f;
#pragma unroll
    for (int j = 0; j < 4; ++j) { yw[j] = *(const u32x2*)(y + 4 * lane + 256 * j); const float a = bflo(yw[j].x), b = bfhi(yw[j].x), c = bflo(yw[j].y), d = bfhi(yw[j].y); ss += (a * a + b * b) + (c * c + d * d); }
    const float r1 = rsqrtf(wave_sum(ss) * (1.f / DM) + EPS);
    f32x4 h[4]; float s2 = 0.f;
#pragma unroll
    for (int j = 0; j < 4; ++j) { const int c = 4 * lane + 256 * j; f32x4 hv;
        if (INB) { const u32x2 hw = *(const u32x2*)((const bf16_t*)hin_ + c); hv = (f32x4){bflo(hw.x), bfhi(hw.x), bflo(hw.y), bfhi(hw.y)}; } else hv = *(const f32x4*)((const float*)hin_ + c);
        const f32x4 gp = *(const f32x4*)(gpost + c);
        h[j][0] = hv[0] + bflo(yw[j].x) * r1 * gp[0]; h[j][1] = hv[1] + bfhi(yw[j].x) * r1 * gp[1]; h[j][2] = hv[2] + bflo(yw[j].y) * r1 * gp[2]; h[j][3] = hv[3] + bfhi(yw[j].y) * r1 * gp[3];
        if (OUTB) { u32x2 w; w.x = pk2(h[j][0], h[j][1]); w.y = pk2(h[j][2], h[j][3]); *(u32x2*)((bf16_t*)hout_ + c) = w;
            h[j] = (f32x4){bflo(w.x), bfhi(w.x), bflo(w.y), bfhi(w.y)}; }
        else *(f32x4*)((float*)hout_ + c) = h[j];
        s2 += (h[j][0] * h[j][0] + h[j][1] * h[j][1]) + (h[j][2] * h[j][2] + h[j][3] * h[j][3]); }
    if (xn) {
        const float r2 = rsqrtf(wave_sum(s2) * (1.f / DM) + EPS);
#pragma unroll
        for (int j = 0; j < 4; ++j) { const int c = 4 * lane + 256 * j; const f32x4 gn = *(const f32x4*)(gnext + c); u32x2 w; w.x = pk2(h[j][0] * r2 * gn[0], h[j][1] * r2 * gn[1]); w.y = pk2(h[j][2] * r2 * gn[2], h[j][3] * r2 * gn[3]);
            *(u32x2*)(xn + c) = w; }
    }
}

template <bool INB, bool OUTB, int R>
DI void res_rows(const void* const (&hin_)[R], const bf16_t* const (&y)[R], const float* gpost, const float* gnext, void* const (&hout_)[R], bf16_t* const (&xn)[R], const bool has_xn, int lane) {
    u32x2 yw[R][4]; f32x4 hv[R][4];
#pragma unroll
    for (int q = 0; q < R; ++q)
#pragma unroll
        for (int j = 0; j < 4; ++j) { const int c = 4 * lane + 256 * j; yw[q][j] = *(const u32x2*)(y[q] + c);
            if (INB) { const u32x2 hw = *(const u32x2*)((const bf16_t*)hin_[q] + c); hv[q][j] = (f32x4){bflo(hw.x), bfhi(hw.x), bflo(hw.y), bfhi(hw.y)}; } else hv[q][j] = *(const f32x4*)((const float*)hin_[q] + c); }
    f32x4 gp[4];
#pragma unroll
    for (int j = 0; j < 4; ++j) gp[j] = *(const f32x4*)(gpost + 4 * lane + 256 * j);
#pragma unroll
    for (int q = 0; q < R; ++q) {
        float ss = 0.f;
#pragma unroll
        for (int j = 0; j < 4; ++j) { const float a = bflo(yw[q][j].x), b = bfhi(yw[q][j].x), c = bflo(yw[q][j].y), d = bfhi(yw[q][j].y); ss += (a * a + b * b) + (c * c + d * d); }
        const float r1 = rsqrtf(wave_sum(ss) * (1.f / DM) + EPS);
        float s2 = 0.f;
#pragma unroll
        for (int j = 0; j < 4; ++j) { const int c = 4 * lane + 256 * j; f32x4 h;
            h[0] = hv[q][j][0] + bflo(yw[q][j].x) * r1 * gp[j][0]; h[1] = hv[q][j][1] + bfhi(yw[q][j].x) * r1 * gp[j][1]; h[2] = hv[q][j][2] + bflo(yw[q][j].y) * r1 * gp[j][2]; h[3] = hv[q][j][3] + bfhi(yw[q][j].y) * r1 * gp[j][3];
            if (OUTB) { u32x2 w; w.x = pk2(h[0], h[1]); w.y = pk2(h[2], h[3]); *(u32x2*)((bf16_t*)hout_[q] + c) = w; h = (f32x4){bflo(w.x), bfhi(w.x), bflo(w.y), bfhi(w.y)}; }
            else *(f32x4*)((float*)hout_[q] + c) = h;
            s2 += (h[0] * h[0] + h[1] * h[1]) + (h[2] * h[2] + h[3] * h[3]); hv[q][j] = h; }
        if (has_xn) { const float r2 = rsqrtf(wave_sum(s2) * (1.f / DM) + EPS);
#pragma unroll
            for (int j = 0; j < 4; ++j) { const int c = 4 * lane + 256 * j; const f32x4 gn = *(const f32x4*)(gnext + c); u32x2 w; w.x = pk2(hv[q][j][0] * r2 * gn[0], hv[q][j][1] * r2 * gn[1]); w.y = pk2(hv[q][j][2] * r2 * gn[2], hv[q][j][3] * r2 * gn[3]);
                *(u32x2*)(xn[q] + c) = w; } }
    }
}

struct RowPass { int mode; const float* gpost; const float* gnext; const float* xp; const float* xs; bf16_t* h16; const bf16_t* y; bf16_t* xnp; float* out;
    DI void row(int r, int lane) const {
        const bf16_t* yr = y + (size_t)r * DM; bf16_t* hr = h16 + (size_t)r * DM;
        if (mode == 0) res_row<false, true>(r < NP ? xp + (size_t)r * DM : xs + (size_t)(r - NP) * DM, yr, gpost, gnext, hr, xnp + (size_t)r * DM, lane);
        else if (mode == 1) res_row<true, true>(hr, yr, gpost, gnext, hr, xnp + (size_t)r * DM, lane);
        else res_row<true, false>(hr, yr, gpost, gnext, r < NP ? out + O_YP + (size_t)r * DM : out + O_YS + (size_t)(r - NP) * DM, nullptr, lane);
    }
    DI void rows4(int r0, int lane) const {
        const void* hin[4]; const bf16_t* yr[4]; void* ho[4]; bf16_t* xo[4];
#pragma unroll
        for (int q = 0; q < 4; ++q) { const size_t o = (size_t)(r0 + q) * DM; yr[q] = y + o; xo[q] = xnp + o;
            hin[q] = mode == 0 ? (const void*)(xp + o) : (const void*)(h16 + o); ho[q] = mode == 2 ? (void*)(out + O_YP + o) : (void*)(h16 + o); }
        if (mode == 0) res_rows<false, true, 4>(hin, yr, gpost, gnext, ho, xo, true, lane);
        else if (mode == 1) res_rows<true, true, 4>(hin, yr, gpost, gnext, ho, xo, true, lane);
        else res_rows<true, false, 4>(hin, yr, gpost, gnext, ho, xo, false, lane);
    }
    DI void rows8(int r0, int lane) const {
        const void* hin[8]; const bf16_t* yr[8]; void* ho[8]; bf16_t* xo[8];
#pragma unroll
        for (int q = 0; q < 8; ++q) { const size_t o = (size_t)(r0 + q) * DM; yr[q] = y + o; xo[q] = xnp + o;
            hin[q] = mode == 0 ? (const void*)(xp + o) : (const void*)(h16 + o); ho[q] = mode == 2 ? (void*)(out + O_YP + o) : (void*)(h16 + o); }
        if (mode == 0) res_rows<false, true, 8>(hin, yr, gpost, gnext, ho, xo, true, lane);
        else if (mode == 1) res_rows<true, true, 8>(hin, yr, gpost, gnext, ho, xo, true, lane);
        else res_rows<true, false, 8>(hin, yr, gpost, gnext, ho, xo, false, lane);
    }
};

DI void s5_tables(const Params& p, int g, LAS unsigned char* lds, bf16_t* Bt1, bf16_t* Bt2, const int tid) {
    LAS float* pwr = (LAS float*)lds;
    LAS float* pwi = pwr + 17 * 64;
    LAS float* bbr = pwi + 17 * 64;
    LAS float* bbi = bbr + 1024;
    LAS float* cr = bbi + 1024;
    LAS float* ci = cr + 1024;
    LAS float* Kd = ci + 1024;
    const float dt = __expf(p.in[12][g]);
    const float* lre = p.in[10] + g * 64; const float* lim = p.in[11] + g * 64;
    for (int it = tid; it < 17 * 64; it += 512) { const int d = it >> 6, q = it & 63; const float zr = lre[q] * dt * (float)d, zi = lim[q] * dt * (float)d;
        float s, c; sincos_acc(zi, s, c); const float mag = __expf(zr); pwr[it] = mag * c; pwi[it] = mag * s; }
    for (int it = tid; it < 1024; it += 512) { const int q = it >> 4, i = it & 15;
        const float lr = lre[q], li = lim[q], zr = lr * dt, zi = li * dt;
        float s, c, sh, ch; sincos_acc(zi, s, c); sincos_acc(0.5f * zi, sh, ch);
        const float em1 = expm1f(zr); const float nr = em1 * c - 2.f * sh * sh, ni = (em1 + 1.f) * s;
        const float den = 1.f / (lr * lr + li * li); const float fr_ = (nr * lr + ni * li) * den, fi_ = (ni * lr - nr * li) * den;
        const float br = p.in[13][(size_t)g * 1024 + it], bi = p.in[14][(size_t)g * 1024 + it];
        bbr[it] = fr_ * br - fi_ * bi; bbi[it] = fr_ * bi + fi_ * br;
        cr[it] = p.in[15][(size_t)g * 1024 + it]; ci[it] = p.in[16][(size_t)g * 1024 + it]; }
    __syncthreads();
    for (int it = tid; it < 4096; it += 512) { const int d = it >> 8, i = (it >> 4) & 15, j = it & 15; float a = 0.f;
        for (int q = 0; q < 64; ++q) { const float c_r = cr[i * 64 + q], c_i = ci[i * 64 + q], p_r = pwr[d * 64 + q], p_i = pwi[d * 64 + q];
            const float xr = c_r * p_r - c_i * p_i, xi = c_r * p_i + c_i * p_r; a += xr * bbr[q * 16 + j] - xi * bbi[q * 16 + j]; }
        Kd[it] = a; }
    __syncthreads();
    for (int it = tid; it < 256 * 32; it += 512) { const int n = it >> 5, k0 = (it & 31) * 8; float v[8];
#pragma unroll
        for (int e = 0; e < 8; ++e) { const int k = k0 + e, s = k >> 4, i = k & 15; float val = 0.f;
            if (n < 128) { const int q = n & 63; const float p_r = pwr[(15 - s) * 64 + q], p_i = pwi[(15 - s) * 64 + q], b_r = bbr[q * 16 + i], b_i = bbi[q * 16 + i];
                val = n < 64 ? (p_r * b_r - p_i * b_i) : (p_r * b_i + p_i * b_r); }
            v[e] = val; }
        u32x4 o; o.x = pk2(v[0], v[1]); o.y = pk2(v[2], v[3]); o.z = pk2(v[4], v[5]); o.w = pk2(v[6], v[7]);
        *(u32x4*)(Bt1 + (size_t)n * 256 + k0) = o; }
    for (int it = tid; it < 256 * 48; it += 512) { const int n = it / 48, k0 = (it % 48) * 8; const int r = n >> 4, i = n & 15; float v[8];
#pragma unroll
        for (int e = 0; e < 8; ++e) { const int k = k0 + e; float val;
            if (k < 128) { const int q = k & 63; const float c_r = cr[i * 64 + q], c_i = ci[i * 64 + q], p_r = pwr[(r + 1) * 64 + q], p_i = pwi[(r + 1) * 64 + q];
                val = k < 64 ? (c_r * p_r - c_i * p_i) : -(c_r * p_i + c_i * p_r); }
            else { const int kk = k - 128, s = kk >> 4, j = kk & 15; val = s <= r ? Kd[(r - s) * 256 + i * 16 + j] : 0.f; }
            v[e] = val; }
        u32x4 o; o.x = pk2(v[0], v[1]); o.y = pk2(v[2], v[3]); o.z = pk2(v[4], v[5]); o.w = pk2(v[6], v[7]);
        *(u32x4*)(Bt2 + (size_t)n * 384 + k0) = o; }
    __syncthreads();
}

DI void s5_sample_unit(const Params& p, int u, const float* uss, bf16_t* z, int lane) {
    const int g = u & 31, b = u >> 5;
    const float dt = __expf(p.in[12][g]);
    const float lr = p.in[10][g * 64 + lane], li = p.in[11][g * 64 + lane], zr = lr * dt, zi = li * dt;
    float s, c, sh, ch; sincos_acc(zi, s, c); sincos_acc(0.5f * zi, sh, ch);
    const float em1 = expm1f(zr); const float nr = em1 * c - 2.f * sh * sh, ni = (em1 + 1.f) * s;
    const float lbr = nr + 1.f, lbi = ni;
    const float den = 1.f / (lr * lr + li * li); const float fr_ = (nr * lr + ni * li) * den, fi_ = (ni * lr - nr * li) * den;
    float hr = p.in[3][(((size_t)b * 32 + g) * 64 + lane) * 2], hi = p.in[3][(((size_t)b * 32 + g) * 64 + lane) * 2 + 1];
    const float* bre = p.in[13] + ((size_t)g * 64 + lane) * 16; const float* bim = p.in[14] + ((size_t)g * 64 + lane) * 16;
    const float* cre = p.in[15] + (size_t)g * 1024 + lane; const float* cim = p.in[16] + (size_t)g * 1024 + lane;
    for (int t = 0; t < 4; ++t) {
        const float* ur = uss + (size_t)(b * 4 + t) * 512 + g * 16;
        float bur = 0.f, bui = 0.f;
#pragma unroll
        for (int i = 0; i < 16; ++i) { const float uv = ur[i]; const float br = bre[i], bi = bim[i]; bur += (fr_ * br - fi_ * bi) * uv; bui += (fr_ * bi + fi_ * br) * uv; }
        const float n_r = lbr * hr - lbi * hi + bur, n_i = lbr * hi + lbi * hr + bui; hr = n_r; hi = n_i;
        float yv = 0.f;
#pragma unroll
        for (int i = 0; i < 16; ++i) { float a = cre[i * 64] * hr - cim[i * 64] * hi; a = wave_sum(a); if (lane == i) yv = a; }
        if (lane < 16) { const float y = yv + p.in[17][g * 16 + lane] * ur[lane]; z[(size_t)(NP + b * 4 + t) * 512 + g * 16 + lane] = (bf16_t)(pk2(gelu_tanh(y), 0.f) & 0xffffu); }
    }
    float* o = p.out + O_S5S + (((size_t)b * 32 + g) * 64 + lane) * 2; o[0] = hr; o[1] = hi;
}

constexpr int ATT_BUF = 69632, ATT_VOFF = 34816, ATT_OST = 2 * ATT_BUF, LDS_CTL = ATT_OST + 8 * 2304;
struct AttUnit { int pat, b, h, dil, l0; size_t rowbase; };
DI AttUnit att_decode(int bu) { AttUnit u; const int tile = bu & 63; u.h = (bu >> 6) & 15; u.b = (bu >> 10) & 3; u.pat = bu >> 12; const int dsh = u.pat * 2; u.dil = 1 << dsh;
    const int rho = tile & (u.dil - 1); u.l0 = (tile >> dsh) * 128; u.rowbase = (size_t)u.b * TP + rho; return u; }
DI void att_stage(const AttUnit& u, const bf16_t* Kb, const bf16_t* Vb, LAS unsigned char* buf, int wave, int lane) {
    const int lmax = (TP >> (2 * u.pat)) - 1;
    for (int n = wave; n < 34; n += 8) { const int r0 = n * 8; const int row = r0 + (lane >> 3); const int c = (lane & 7) ^ (row & 7);
        int lk = u.l0 - 128 + row; lk = lk < 0 ? 0 : (lk > lmax ? lmax : lk); const size_t off = (u.rowbase + (size_t)u.dil * lk) * 1024 + u.h * 64 + c * 8;
        __builtin_amdgcn_global_load_lds((const unsigned*)(Kb + off), (LAS unsigned*)(buf + r0 * 128), 16, 0, 0);
        __builtin_amdgcn_global_load_lds((const unsigned*)(Vb + off), (LAS unsigned*)(buf + ATT_VOFF + r0 * 128), 16, 0, 0); }
}
DI void att_loadq(const AttUnit& u, const bf16_t* Q, int wave, int lane, bf16x8 (&qf)[2]) {
    const int i = lane & 15, g = lane >> 4; const bf16_t* q = Q + (u.rowbase + (size_t)u.dil * (u.l0 + 16 * wave + i)) * 1024 + u.h * 64 + 8 * g;
    qf[0] = *(const bf16x8*)q; qf[1] = *(const bf16x8*)(q + 32);
}
DI void att_compute(const AttUnit& u, const bf16x8 (&qf)[2], LAS unsigned char* buf, LAS unsigned char* ost, bf16_t* Op, float* lse, int wave, int lane) {
    const int i = lane & 15, g = lane >> 4;
    const int Lw = u.l0 + 16 * wave;
    unsigned koff[2][2], voff[4];
#pragma unroll
    for (int kbl = 0; kbl < 2; ++kbl)
#pragma unroll
        for (int s = 0; s < 2; ++s) koff[kbl][s] = (unsigned)((16 * wave + 16 * kbl + i) * 128 + (((4 * s + g) ^ (i & 7)) * 16));
    { const int q = i >> 2, pp = i & 3, r = 4 * g + q;
#pragma unroll
      for (int db = 0; db < 4; ++db) voff[db] = (unsigned)((16 * wave + r) * 128 + (((2 * db + (pp >> 1)) ^ (r & 7)) * 16) + 8 * (pp & 1)); }
    f32x4 st[5][2];
#pragma unroll
    for (int ks = 0; ks < 5; ++ks)
#pragma unroll
        for (int kbl = 0; kbl < 2; ++kbl) {
            if (ks == 4 && kbl == 1) { st[ks][kbl] = (f32x4){0.f, 0.f, 0.f, 0.f}; continue; }
            const bf16x8 k0 = *(const LAS bf16x8*)(buf + ks * 4096 + koff[kbl][0]), k1 = *(const LAS bf16x8*)(buf + ks * 4096 + koff[kbl][1]);
            f32x4 a = (f32x4){0.f, 0.f, 0.f, 0.f};
            a = __builtin_amdgcn_mfma_f32_16x16x32_bf16(k0, qf[0], a, 0, 0, 0);
            a = __builtin_amdgcn_mfma_f32_16x16x32_bf16(k1, qf[1], a, 0, 0, 0); st[ks][kbl] = a; }
#pragma unroll
    for (int r = 0; r < 4; ++r) { if (i > 4 * g + r) st[0][0][r] = -INFINITY; if (4 * g + r > i) st[4][0][r] = -INFINITY; }
    if (Lw < 128) {
#pragma unroll
        for (int ks = 0; ks < 4; ++ks)
#pragma unroll
            for (int kbl = 0; kbl < 2; ++kbl)
#pragma unroll
                for (int r = 0; r < 4; ++r) if (Lw - 128 + 32 * ks + 16 * kbl + 4 * g + r < 0) st[ks][kbl][r] = -INFINITY; }
    float mx = -INFINITY;
#pragma unroll
    for (int ks = 0; ks < 5; ++ks)
#pragma unroll
        for (int kbl = 0; kbl < 2; ++kbl) { if (ks == 4 && kbl == 1) continue;
#pragma unroll
            for (int r = 0; r < 4; ++r) mx = fmaxf(mx, st[ks][kbl][r]); }
    mx = fmaxf(mx, __shfl_xor(mx, 16)); mx = fmaxf(mx, __shfl_xor(mx, 32));
    float ps = 0.f; bf16x8 pf[5];
#pragma unroll
    for (int ks = 0; ks < 5; ++ks) {
#pragma unroll
        for (int kbl = 0; kbl < 2; ++kbl) { if (ks == 4 && kbl == 1) continue;
#pragma unroll
            for (int r = 0; r < 4; ++r) { const float pv = __builtin_amdgcn_exp2f(st[ks][kbl][r] - mx); st[ks][kbl][r] = pv; ps += pv; } }
        u32x4 pw; pw.x = pk2(st[ks][0][0], st[ks][0][1]); pw.y = pk2(st[ks][0][2], st[ks][0][3]); pw.z = pk2(st[ks][1][0], st[ks][1][1]); pw.w = pk2(st[ks][1][2], st[ks][1][3]);
        pf[ks] = __builtin_bit_cast(bf16x8, pw); }
    ps += __shfl_xor(ps, 16); ps += __shfl_xor(ps, 32);
    f32x4 o[4];
#pragma unroll
    for (int db = 0; db < 4; ++db) o[db] = (f32x4){0.f, 0.f, 0.f, 0.f};
    const unsigned vb = (unsigned)(size_t)buf + (unsigned)ATT_VOFF;
#pragma unroll
    for (int ks = 0; ks < 5; ++ks) {
        s16x4 lo[4], hi[4]; const unsigned va = vb + ks * 4096;
        asm volatile("ds_read_b64_tr_b16 %0, %8\n\tds_read_b64_tr_b16 %1, %9\n\tds_read_b64_tr_b16 %2, %10\n\tds_read_b64_tr_b16 %3, %11\n\t"
                     "ds_read_b64_tr_b16 %4, %8 offset:2048\n\tds_read_b64_tr_b16 %5, %9 offset:2048\n\tds_read_b64_tr_b16 %6, %10 offset:2048\n\tds_read_b64_tr_b16 %7, %11 offset:2048\n\t"
                     "s_waitcnt lgkmcnt(0)"
                     : "=&v"(lo[0]), "=&v"(lo[1]), "=&v"(lo[2]), "=&v"(lo[3]), "=&v"(hi[0]), "=&v"(hi[1]), "=&v"(hi[2]), "=&v"(hi[3])
                     : "v"(va + voff[0]), "v"(va + voff[1]), "v"(va + voff[2]), "v"(va + voff[3]) : "memory");
#pragma unroll
        for (int db = 0; db < 4; ++db) { const bf16x8 vf = __builtin_shufflevector(lo[db], hi[db], 0, 1, 2, 3, 4, 5, 6, 7);
            o[db] = __builtin_amdgcn_mfma_f32_16x16x32_bf16(vf, pf[ks], o[db], 0, 0, 0); }
    }
    const float inv = 1.f / ps;
#pragma unroll
    for (int db = 0; db < 4; ++db) { const f32x4 v = o[db] * inv; u32x2 w; w.x = pk2(v[0], v[1]); w.y = pk2(v[2], v[3]); *(LAS u32x2*)(ost + i * 144 + (16 * db + 4 * g) * 2) = w; }
    const size_t orow0 = (size_t)u.pat * MT + u.rowbase;
    if (g == 0) lse[(orow0 + (size_t)u.dil * (Lw + i)) * 16 + u.h] = mx + __builtin_amdgcn_logf(ps);
    LDS_WAIT();
#pragma unroll
    for (int n = 0; n < 2; ++n) { const int c = lane + 64 * n, rr = c >> 3, ch = c & 7; const u32x4 v = *(const LAS u32x4*)(ost + rr * 144 + ch * 16);
        *(u32x4*)(Op + (orow0 + (size_t)u.dil * (Lw + rr)) * 1024 + u.h * 64 + ch * 8) = v; }
    LDS_WAIT();
}
DI void attn_prompt_phase(const bf16_t* Q, const bf16_t* Kb, const bf16_t* Vb, bf16_t* Op, float* lse, LAS unsigned char* lds, int bx, int G, int wave, int lane) {
    constexpr int NU = 3 * 4096;
    int bu = bx; if (bu >= NU) return;
    AttUnit u = att_decode(bu); bf16x8 qn[2];
    att_stage(u, Kb, Vb, lds, wave, lane); att_loadq(u, Q, wave, lane, qn);
    int par = 0;
    for (;;) {
        asm volatile("s_waitcnt vmcnt(0)" ::: "memory");
        __syncthreads();
        bf16x8 qf[2]; qf[0] = qn[0]; qf[1] = qn[1];
        const AttUnit cur = u; const int nb = bu + G; const bool more = nb < NU;
        if (more) { u = att_decode(nb); att_stage(u, Kb, Vb, lds + (par ^ 1) * ATT_BUF, wave, lane); att_loadq(u, Q, wave, lane, qn); }
        att_compute(cur, qf, lds + par * ATT_BUF, lds + ATT_OST + wave * 2304, Op, lse, wave, lane);
        if (!more) break;
        bu = nb; par ^= 1;
    }
    __syncthreads();
}

DI void attn_sample_unit(const Params& p, int u, const bf16_t* Q, const bf16_t* Kb, const bf16_t* Vb, bf16_t* att, LAS float* sl, int lane) {
    const int h = u & 15, t = (u >> 4) & 3, b = u >> 6;
    const size_t qrow = (size_t)NP + b * 4 + t;
    const float* ck = p.in[4]; const float* cv = p.in[5];
    sl[lane] = bf2f(Q[qrow * 1024 + h * 64 + lane]);
    LDS_WAIT();
    float mx = -INFINITY;
#pragma unroll 1
    for (int e = 0; e < 9; ++e) { const int pat = e / 3, r = e - 3 * pat; const int dil = 1 << (2 * pat);
        const int j = lane + 64 * r; const bool valid = j <= 128; const int idx = 2048 + t - dil * (valid ? j : 0);
        float dot = 0.f;
        if (idx >= 2048) { const bf16_t* kp = Kb + ((size_t)NP + b * 4 + (idx - 2048)) * 1024 + h * 64;
#pragma unroll
            for (int d8 = 0; d8 < 8; ++d8) { const u32x4 kw = *(const u32x4*)(kp + 8 * d8); const f32x4 q0 = *(const LAS f32x4*)(sl + 8 * d8), q1 = *(const LAS f32x4*)(sl + 8 * d8 + 4);
                dot += (bflo(kw.x) * q0[0] + bfhi(kw.x) * q0[1]) + (bflo(kw.y) * q0[2] + bfhi(kw.y) * q0[3]) + (bflo(kw.z) * q1[0] + bfhi(kw.z) * q1[1]) + (bflo(kw.w) * q1[2] + bfhi(kw.w) * q1[3]); } }
        else { const float* kp = ck + (((size_t)b * 2048 + idx) * 16 + h) * 64;
#pragma unroll
            for (int d4 = 0; d4 < 16; ++d4) { const f32x4 kv = *(const f32x4*)(kp + 4 * d4); const f32x4 qv = *(const LAS f32x4*)(sl + 4 * d4); dot += (kv[0] * qv[0] + kv[1] * qv[1]) + (kv[2] * qv[2] + kv[3] * qv[3]); } }
        if (valid) { sl[64 + pat * 192 + j] = dot; mx = fmaxf(mx, dot); } }
    mx = wave_max(mx);
    LDS_WAIT();
    float ls = 0.f;
#pragma unroll 1
    for (int e = 0; e < 9; ++e) { const int pat = e / 3, r = e - 3 * pat; const int j = lane + 64 * r;
        if (j <= 128) { const float pv = __builtin_amdgcn_exp2f(sl[64 + pat * 192 + j] - mx); sl[64 + pat * 192 + j] = pv; ls += pv; } }
    ls = wave_sum(ls);
    LDS_WAIT();
    { const int kg = lane >> 4, d4 = lane & 15; f32x4 acc = (f32x4){0.f, 0.f, 0.f, 0.f};
#pragma unroll 1
      for (int pat = 0; pat < 3; ++pat) { const int dil = 1 << (2 * pat);
#pragma unroll
        for (int jj = 0; jj < 33; ++jj) { const int j = kg + 4 * jj; int idx = 2048 + t - dil * j; const bool use = (j <= 128) && (idx < 2048);
            idx = idx < 0 ? 0 : (idx > 2047 ? 2047 : idx); const float pv = use ? sl[64 + pat * 192 + (j > 128 ? 128 : j)] : 0.f;
            const f32x4 vv = *(const f32x4*)(cv + (((size_t)b * 2048 + idx) * 16 + h) * 64 + 4 * d4);
            acc += vv * pv; }
        if (kg == 0) { for (int j = 0; dil * j <= t; ++j) { const int idx = 2048 + t - dil * j; const float pv = sl[64 + pat * 192 + j];
            const u32x2 w = *(const u32x2*)(Vb + ((size_t)NP + b * 4 + (idx - 2048)) * 1024 + h * 64 + 4 * d4);
            acc += (f32x4){bflo(w.x), bfhi(w.x), bflo(w.y), bfhi(w.y)} * pv; } } }
#pragma unroll
      for (int e = 0; e < 4; ++e) { float a = acc[e]; a += __shfl_xor(a, 16); a += __shfl_xor(a, 32); acc[e] = a; }
      const float inv = 1.f / ls;
      if (kg == 0) { u32x2 w; w.x = pk2(acc[0] * inv, acc[1] * inv); w.y = pk2(acc[2] * inv, acc[3] * inv); *(u32x2*)(att + qrow * 1024 + h * 64 + 4 * d4) = w; } }
    LDS_WAIT();
}


#define XB_TMO      128
#define XB_XCNT(j)  (256  + 64 * (j))
#define XB_XSUB(j)  (1280 + 64 * (j))
#define XB_XGEN(j)  (2304 + 64 * (j))
#define XB_TOP      3328
#define XB_TOPGEN   3392
#define XCD_BAR_WORDS 3456
#define XB_SPIN_CAP (1u << 22)
DI unsigned xb_ld(unsigned* p)              { return __hip_atomic_load(p, __ATOMIC_RELAXED, __HIP_MEMORY_SCOPE_AGENT); }
DI unsigned xb_add(unsigned* p, unsigned v) { return __hip_atomic_fetch_add(p, v, __ATOMIC_RELAXED, __HIP_MEMORY_SCOPE_AGENT); }
DI unsigned xb_xcc_id() { return (unsigned)__builtin_amdgcn_s_getreg((3 << 11) | 20) & 0xFu; }
#define XB_SPIN(cond, bar) do { unsigned _sp = 0; while (cond) { __builtin_amdgcn_s_sleep(1); \
    if ((++_sp & 255u) == 0u) { if (xb_ld(&(bar)[XB_TMO])) break; if (_sp > XB_SPIN_CAP) { atomicAdd(&(bar)[XB_TMO], 1u); break; } } } } while (0)
struct XcdBarrier { unsigned* bar; unsigned x; volatile LAS unsigned* st; bool w0; };
DI XcdBarrier xcd_barrier_post(unsigned* bar, volatile LAS unsigned* st, const bool w0) {
    XcdBarrier b; b.bar = bar; b.x = xb_xcc_id(); b.st = st; b.w0 = w0;
    if (w0 && lane_id() == 0) (void)xb_add(&bar[XB_XCNT(b.x)], 1u);
    return b;
}
DI void xcd_barrier_complete(unsigned* bar, unsigned x, unsigned& nloc, unsigned& nx) {
    const unsigned G = gridDim.x * gridDim.y * gridDim.z;
    unsigned sum, cnt, mine, sp = 0u;
    for (;;) {
        sum = 0u; cnt = 0u; mine = 0u;
#pragma unroll
        for (unsigned j = 0; j < 16; ++j) { const unsigned c = xb_ld(&bar[XB_XCNT(j)]); sum += c; cnt += (c > 0u) ? 1u : 0u; mine = (j == x) ? c : mine; }
        if (sum == G) break;
        __builtin_amdgcn_s_sleep(1);
        if ((++sp & 255u) == 0u) { if (xb_ld(&bar[XB_TMO])) break; if (sp > XB_SPIN_CAP) { atomicAdd(&bar[XB_TMO], 1u); break; } }
    }
    nloc = mine > 0u ? mine : 1u; nx = cnt > 0u ? cnt : 1u;
}
DI void xcd_barrier(const XcdBarrier& b) {
    asm volatile("s_waitcnt vmcnt(0)" ::: "memory");
    __syncthreads();
    if (b.w0 && lane_id() == 0) {
        unsigned* bar = b.bar;
        __builtin_amdgcn_s_waitcnt(0);
        unsigned nloc = b.st[0], nx = b.st[1];
        if (nloc == 0u) { xcd_barrier_complete(bar, b.x, nloc, nx); b.st[0] = nloc; b.st[1] = nx; }
        const unsigned old = xb_add(&bar[XB_XSUB(b.x)], 1u);
        const unsigned gen = old / nloc;
        if (old + 1u == (gen + 1u) * nloc) {
            __builtin_amdgcn_fence(__ATOMIC_RELEASE, "agent");
            asm volatile("s_waitcnt vmcnt(0)" ::: "memory");
            const unsigned og = xb_add(&bar[XB_TOP], 1u);
            const unsigned tg = og / nx;
            if (og + 1u == (tg + 1u) * nx) xb_add(&bar[XB_TOPGEN], 1u);
            else XB_SPIN(xb_ld(&bar[XB_TOPGEN]) == tg, bar);
            __builtin_amdgcn_fence(__ATOMIC_ACQUIRE, "agent");
            xb_add(&bar[XB_XGEN(b.x)], 1u);
            asm volatile("s_waitcnt vmcnt(0)" ::: "memory");
        } else {
            XB_SPIN(xb_ld(&bar[XB_XGEN(b.x)]) == gen, bar);
            __builtin_amdgcn_fence(__ATOMIC_ACQUIRE, "agent");
            asm volatile("s_waitcnt vmcnt(0)" ::: "memory");
        }
    }
    __syncthreads();
}

#define w_in_t ((bf16_t*)(ws + WS_WIN))
#define w_out_t ((bf16_t*)(ws + WS_WOUT))
#define w_glu_t ((bf16_t*)(ws + WS_WGLU))
#define w_pool_t ((bf16_t*)(ws + WS_WPOOL))
#define w_o_t ((bf16_t*)(ws + WS_WO))
#define w_qkv_t ((bf16_t*)(ws + WS_WQKV))
#define Bt1 ((bf16_t*)(ws + WS_BT1))
#define Bt2 ((bf16_t*)(ws + WS_BT2))
#define rowss ((float*)(ws + WS_ROWSS))
#define uss ((float*)(ws + WS_USS))
#define lse ((float*)(ws + WS_LSE))
#define xn ((bf16_t*)(ws + WS_XN))
#define ybuf ((bf16_t*)(ws + WS_Y))
#define hbuf16 ((bf16_t*)(ws + WS_H))
#define Ap ((bf16_t*)(ws + WS_AP))
#define Sbuf ((float*)(ws + WS_S))
#define upool ((float*)(ws + WS_UPOOL))
#define dbuf ((bf16_t*)(ws + WS_D))
#define zbuf ((bf16_t*)(ws + WS_Z))
#define ycat ((bf16_t*)(ws + WS_YCAT))
#define hact ((bf16_t*)(ws + WS_HACT))
#define Qb ((bf16_t*)(ws + WS_Q))
#define Kb ((bf16_t*)(ws + WS_K))
#define Vb ((bf16_t*)(ws + WS_V))
#define Op ((bf16_t*)(ws + WS_OP))
#define att ((bf16_t*)(ws + WS_ATT))
#define gains (p.in[6])
#ifndef PHMASK
#define PHMASK 0xFFFFFFFFu
#endif
#ifndef DUPMASK
#define DUPMASK 0u
#endif
#define PHASE_BEGIN(k) if (((PHMASK >> (k)) & 1u) && p.ph_lo <= (k) && (k) < p.ph_hi) { for (int _rep = 0; _rep < 1 + (int)((DUPMASK >> (k)) & 1u); ++_rep) { if (_rep) __syncthreads(); const int lane = lane_id(); const int tid = wave * 64 + lane; const int gt = bx * 512 + tid; (void)gt;
#define PHASE_END(k) } } if (p.ph_lo <= (k) && (k) + 1 < p.ph_hi) { if ((k) == 0) { grid.sync(); xbar = xcd_barrier_post((unsigned*)(p.ws + WS_CTL), (volatile LAS unsigned*)(lds + 157696), wave == 0); } else xcd_barrier(xbar); }

template <int layer>
DI void layer_tail(const Params& p, LAS unsigned char* lds, cg::grid_group& grid, XcdBarrier& xbar, const int bx, const int G, const int gw, const int NGW, const int wave) {
    unsigned char* ws = p.ws;
    constexpr int pb = 6 + layer * 8;
    const float* gl = gains + (size_t)layer * 4 * DM;
        PHASE_BEGIN(pb)
        { const bf16_t* A = layer == 0 ? ycat : att; const bf16_t* W = layer == 0 ? w_out_t : w_o_t;
          { UStd<EpiY> U{A, W, (size_t)256 * DM, (size_t)256 * DM, 0, 128, 4, G, bx, EpiY{ybuf, 0, 0}};
            gemm_phase(lds, wave, DM, DM, DM, U); }
          { EpiY E{ybuf, 0, 0}; mini_gemm(A, DM, W, DM, DM, 1024, 0, E, bx, G, wave, lane); } }
        PHASE_END(pb)
        PHASE_BEGIN(pb + 1)
        { const RowPass rp{layer == 0 ? 0 : 1, gl + DM, gl + 2 * DM, p.in[0], p.in[1], hbuf16, ybuf, xn, p.out};
          for (int q = gw; q < NP / 4; q += NGW) rp.rows4(q * 4, lane);
          for (int r = NP + (NGW - 1 - gw); r < NT; r += NGW) rp.row(r, lane); }
        PHASE_END(pb + 1)
        PHASE_BEGIN(pb + 2)
        { const bf16_t* W = (const bf16_t*)(ws + (layer ? WS_GU1 : WS_GU0));
          { UStd<EpiGU> U{xn, W, (size_t)256 * DM, (size_t)256 * DM, 0, 128, 22, G, bx, EpiGU{hact, 0, 0}};
            gemm_phase(lds, wave, DM, DM, DM, U); }
          { EpiGU E{hact, 0, 0}; mini_gemm_gu(xn, W, E, bx, G, wave, lane); } }
        PHASE_END(pb + 2)
        PHASE_BEGIN(pb + 3)
        { const bf16_t* W = (const bf16_t*)(ws + (layer ? WS_DN1 : WS_DN0));
          { UStd<EpiY> U{hact, W, (size_t)256 * FF, (size_t)256 * FF, 0, 128, 4, G, bx, EpiY{ybuf, 0, 0}};
            gemm_phase(lds, wave, FF, FF, FF, U); }
          { EpiY E{ybuf, 0, 0}; mini_gemm(hact, FF, W, FF, FF, 1024, 0, E, bx, G, wave, lane); } }
        PHASE_END(pb + 3)
        PHASE_BEGIN(pb + 4)
        { const RowPass rp{layer == 0 ? 1 : 2, gl + 3 * DM, gains + 4 * DM, p.in[0], p.in[1], hbuf16, ybuf, xn, p.out};
          for (int q = gw; q < NP / 4; q += NGW) rp.rows4(q * 4, lane);
          for (int r = NP + (NGW - 1 - gw); r < NT; r += NGW) rp.row(r, lane); }
        PHASE_END(pb + 4)
    }

__global__ void __launch_bounds__(512, 2) mega(Params p) {
    extern __shared__ __attribute__((aligned(16))) unsigned char lds_raw[];
    LAS unsigned char* lds = (LAS unsigned char*)lds_raw;
    cg::grid_group grid = cg::this_grid();
    const int wave = __builtin_amdgcn_readfirstlane((int)threadIdx.x >> 6);
    const int G = gridDim.x, bx = blockIdx.x;
    const int gw = bx * 8 + wave, NGW = G * 8;
    const int NGT = G * 512;
    unsigned char* ws = p.ws;
    XcdBarrier xbar; xbar.bar = (unsigned*)(ws + WS_CTL); xbar.x = 0; xbar.st = (volatile LAS unsigned*)(lds + 157696); xbar.w0 = wave == 0;
    { const int tid = wave * 64 + lane_id();
      if (tid < 64) ((LAS unsigned*)(lds + 157696))[tid] = 0u;
      if (bx == 0) { for (int i = tid; i < 4096; i += 512) ((unsigned*)(ws + WS_CTL))[i] = 0u; } }
    __syncthreads();

    PHASE_BEGIN(0)
    {
        if (bx < 32) { s5_tables(p, bx, lds, Bt1 + (size_t)bx * 65536, Bt2 + (size_t)bx * 98304, tid); }
        LAS float* scr = (LAS float*)(lds + wave * 16384);
        constexpr int I_IN = 512, I_OUT = 512, I_GLU = 128, I_POOL = 32, I_O = 512, I_QKV = 1536, I_G = 1408, I_D = 1408;
        constexpr int NITEMS = I_IN + I_OUT + I_GLU + I_POOL + I_O + I_QKV + 4 * I_G + 2 * I_D;
        for (int it = gw; it < NITEMS; it += NGW) {
            int r = it;
            if (r < I_IN) { tr_plain(p.in[7], 1024, 1024, w_in_t, r, scr, lane); continue; } r -= I_IN;
            if (r < I_OUT) { tr_plain(p.in[20], 1024, 1024, w_out_t, r, scr, lane); continue; } r -= I_OUT;
            if (r < I_GLU) { tr_plain(p.in[18], 512, 512, w_glu_t, r, scr, lane); continue; } r -= I_GLU;
            if (r < I_POOL) { const int gg = r >> 3, q = r & 7, kb = q >> 2, nb = q & 3;
                transpose_item(p.in[8] + (size_t)gg * 16384, 128, 64 * kb, 32 * nb, w_pool_t, 256, gg * 128 + 32 * nb, (gg & 1) * 128 + 64 * kb, scr, lane); continue; } r -= I_POOL;
            if (r < I_O) { tr_plain(p.in[22], 1024, 1024, w_o_t, r, scr, lane); continue; } r -= I_O;
            if (r < I_QKV) { tr_plain(p.in[21], 1024, 3072, w_qkv_t, r, scr, lane); continue; } r -= I_QKV;
            if (r < 4 * I_G) { const int which = r / I_G, q = r % I_G; const int layer = which >> 1, up = which & 1;
                const float* W = p.in[up ? 24 : 23] + (size_t)layer * 1024 * FF; bf16_t* WT = (bf16_t*)(ws + (layer ? WS_GU1 : WS_GU0));
                const int nblk = FF / 32, kb = q / nblk, nb = q % nblk, n0 = 32 * nb;
                transpose_item(W, FF, 64 * kb, n0, WT, 1024, (n0 >> 7) * 256 + up * 128 + (n0 & 127), 64 * kb, scr, lane); continue; } r -= 4 * I_G;
            { const int layer = r / I_D, q = r % I_D; tr_plain(p.in[25] + (size_t)layer * FF * 1024, FF, 1024, (bf16_t*)(ws + (layer ? WS_DN1 : WS_DN0)), q, scr, lane); }
        }
        for (int it = gt; it < 512 * 16; it += NGT) { const int n = it >> 4, c8 = it & 15; const int gg = n >> 7;
            *(u32x4*)(w_pool_t + (size_t)n * 256 + ((gg & 1) ^ 1) * 128 + c8 * 8) = (u32x4){0u, 0u, 0u, 0u}; }
        if (bx >= 32 || G <= 32) { const int gwn = G > 32 ? (bx - 32) * 8 + wave : gw, ngwn = G > 32 ? (G - 32) * 8 : NGW;
          for (int r = gwn; r < NT; r += 2 * ngwn) { const int r2 = r + ngwn; const bool two = r2 < NT;
            norm_row2(in_row(p, r), in_row(p, two ? r2 : r), gains, xn + (size_t)r * DM, xn + (size_t)(two ? r2 : r) * DM, lane); } }
    }
    PHASE_END(0)

    PHASE_BEGIN(1)
    { UStd<EpiProj> U{xn, w_in_t, (size_t)256 * DM, (size_t)256 * DM, 0, 128, 4, G, bx, EpiProj{upool, Ap, uss, 0, 0}};
      gemm_phase(lds, wave, DM, DM, DM, U);
      { EpiProj E{upool, Ap, uss, 0, 0}; mini_gemm(xn, DM, w_in_t, DM, DM, 1024, 0, E, bx, G, wave, lane); } }
    PHASE_END(1)

    PHASE_BEGIN(2)
    {
        { US5<EpiS1> U{Ap + 128, Bt1, (size_t)65536, G, bx, EpiS1{Sbuf, 0, 0}};
          gemm_phase(lds, wave, 384, 256, 256, U); }
        for (int u = gw; u < 1024; u += NGW) s5_sample_unit(p, u, uss, zbuf, lane);
        for (int it = gt; it < (NP / 16) * 128; it += NGT) { const int cq = it & 127, run = it >> 7; const int c = cq * 4, gi = c >> 7, w = 2 << gi;
            const int t0 = run * 16, tb0 = t0 & (TP - 1); const float* up = upool + (size_t)t0 * 512 + c;
            f32x4 e[31];
#pragma unroll
            for (int k = 0; k < 31; ++k) { const int rel = k - 15; e[k] = (rel >= 1 - w && tb0 + rel >= 0) ? *(const f32x4*)(up + (ptrdiff_t)rel * 512) : (f32x4){0.f, 0.f, 0.f, 0.f}; }
            f32x4 sum = (f32x4){0.f, 0.f, 0.f, 0.f};
#pragma unroll
            for (int k = 0; k < 15; ++k) sum += e[k];
#pragma unroll
            for (int k = 0; k < 16; ++k) { const f32x4 uv = e[15 + k]; sum += uv; const int tb = tb0 + k; const int cnt = tb + 1 < w ? tb + 1 : w;
                const f32x4 dv = sum * (1.0f / (float)cnt) - uv; u32x2 o; o.x = pk2(dv[0], dv[1]); o.y = pk2(dv[2], dv[3]); *(u32x2*)(dbuf + (size_t)(t0 + k) * 512 + c) = o;
                f32x4 out_ = (f32x4){0.f, 0.f, 0.f, 0.f};
                if (w == 2) out_ = e[15 + k - 1]; else if (w == 4) out_ = e[15 + k - 3]; else if (w == 8) out_ = e[15 + k - 7]; else out_ = e[15 + k - 15];
                sum -= out_;
                if (tb >= TP - 15) *(f32x4*)(p.out + O_POOLP + ((size_t)(t0 >> 13) * 15 + (tb - (TP - 15))) * 512 + c) = uv; } }
        for (int it = gt; it < 32 * 128; it += NGT) { const int cq = it & 127, b = it >> 7; const int c = cq * 4, gi = c >> 7, w = 2 << gi;
            const float* sp = p.in[2] + (size_t)b * 15 * 512 + c; const float* up = upool + (size_t)(NP + b * 4) * 512 + c;
            for (int t = 0; t < 4; ++t) { f32x4 sum = (f32x4){0.f, 0.f, 0.f, 0.f};
                for (int s = 0; s < w; ++s) { const int e = 15 + t - s; sum += e >= 15 ? *(const f32x4*)(up + (size_t)(e - 15) * 512) : *(const f32x4*)(sp + (size_t)e * 512); }
                const f32x4 uv = *(const f32x4*)(up + (size_t)t * 512); const f32x4 dv = sum * (1.0f / (float)w) - uv;
                u32x2 o; o.x = pk2(dv[0], dv[1]); o.y = pk2(dv[2], dv[3]); *(u32x2*)(dbuf + (size_t)(NP + b * 4 + t) * 512 + c) = o; }
            for (int r = 0; r < 15; ++r) { const f32x4 v = r < 11 ? *(const f32x4*)(sp + (size_t)(r + 4) * 512) : *(const f32x4*)(up + (size_t)(r - 11) * 512);
                *(f32x4*)(p.out + O_POOLS + ((size_t)b * 15 + r) * 512 + c) = v; } }
    }
    PHASE_END(2)

    PHASE_BEGIN(3)
    {
        { const bool act = bx < 128; const int b = (bx >> 5) & 3, g = bx & 31;
          LAS float* ex = (LAS float*)lds;
          float c_r = 1.f, c_i = 0.f, hr = 0.f, hi = 0.f;
          const float* Sp = Sbuf + ((size_t)g * 2048 + b * 512 + wave * 64) * 128 + lane; bf16_t* Hp = Ap + ((size_t)g * 2048 + b * 512 + wave * 64) * 384 + lane;
          if (act) {
            const float dt = __expf(p.in[12][g]); const float zr = p.in[10][g * 64 + lane] * dt * 16.f, zi = p.in[11][g * 64 + lane] * dt * 16.f;
            float sn, cs; sincos_acc(zi, sn, cs); const float mag = __expf(zr); c_r = mag * cs; c_i = mag * sn;
            for (int c0 = 0; c0 < 64; c0 += 16) { float sr[16], si[16];
#pragma unroll
                for (int k = 0; k < 16; ++k) { sr[k] = Sp[(size_t)(c0 + k) * 128]; si[k] = Sp[(size_t)(c0 + k) * 128 + 64]; }
#pragma unroll
                for (int k = 0; k < 16; ++k) { const float n_r = c_r * hr - c_i * hi + sr[k], n_i = c_r * hi + c_i * hr + si[k]; hr = n_r; hi = n_i; } }
            ex[(wave * 64 + lane) * 2] = hr; ex[(wave * 64 + lane) * 2 + 1] = hi;
          }
          __syncthreads();
          if (act) {
            float l_r = c_r, l_i = c_i;
#pragma unroll
            for (int e = 0; e < 6; ++e) { const float t_r = l_r * l_r - l_i * l_i, t_i = 2.f * l_r * l_i; l_r = t_r; l_i = t_i; }
            hr = 0.f; hi = 0.f;
            for (int sg = 0; sg < wave; ++sg) { const float e_r = ex[(sg * 64 + lane) * 2], e_i = ex[(sg * 64 + lane) * 2 + 1];
                const float n_r = l_r * hr - l_i * hi + e_r, n_i = l_r * hi + l_i * hr + e_i; hr = n_r; hi = n_i; }
            for (int c0 = 0; c0 < 64; c0 += 16) { float sr[16], si[16];
#pragma unroll
                for (int k = 0; k < 16; ++k) { sr[k] = Sp[(size_t)(c0 + k) * 128]; si[k] = Sp[(size_t)(c0 + k) * 128 + 64]; }
#pragma unroll
                for (int k = 0; k < 16; ++k) { const unsigned w = pk2(hr, hi); Hp[(size_t)(c0 + k) * 384] = (bf16_t)(w & 0xffffu); Hp[(size_t)(c0 + k) * 384 + 64] = (bf16_t)(w >> 16);
                    const float n_r = c_r * hr - c_i * hi + sr[k], n_i = c_r * hi + c_i * hr + si[k]; hr = n_r; hi = n_i; } }
            if (wave == 7) { float* o = p.out + O_S5P + (((size_t)b * 32 + g) * 64 + lane) * 2; o[0] = hr; o[1] = hi; }
          }
        }
        __syncthreads();
        { UStd<EpiPool> U{dbuf, w_pool_t, (size_t)256 * 512, (size_t)256 * 256, 256, 128, 2, G, bx, EpiPool{ycat, p.in[9], 0, 0}};
          gemm_phase(lds, wave, 512, 256, 256, U); }
        { EpiPool E{ycat, p.in[9], 0, 0}; mini_gemm(dbuf, 512, w_pool_t, 256, 256, 512, 256, E, bx, G, wave, lane); }
    }
    PHASE_END(3)

    PHASE_BEGIN(4)
    { US5<EpiS2> U{Ap, Bt2, (size_t)98304, G, bx, EpiS2{zbuf, Ap, p.in[17], 0, 0}};
      gemm_phase(lds, wave, 384, 384, 384, U); }
    PHASE_END(4)

    PHASE_BEGIN(5)
    { UStd<EpiGlu> U{zbuf, w_glu_t, (size_t)256 * 512, (size_t)256 * 512, 0, 128, 2, G, bx, EpiGlu{ycat, zbuf, p.in[19], 0, 0}};
      gemm_phase(lds, wave, 512, 512, 512, U);
      { EpiGlu E{ycat, zbuf, p.in[19], 0, 0}; mini_gemm(zbuf, 512, w_glu_t, 512, 512, 512, 0, E, bx, G, wave, lane); } }
    PHASE_END(5)

    layer_tail<0>(p, lds, grid, xbar, bx, G, gw, NGW, wave);
            PHASE_BEGIN(11)
            { UStd<EpiQKV> U{xn, w_qkv_t, (size_t)256 * DM, (size_t)256 * DM, 0, 128, 12, G, bx, EpiQKV{Qb, p.out, 0, 0}};
              gemm_phase(lds, wave, DM, DM, DM, U);
              { EpiQKV E{Qb, p.out, 0, 0}; mini_gemm(xn, DM, w_qkv_t, DM, DM, 3072, 0, E, bx, G, wave, lane); } }
            PHASE_END(11)
            PHASE_BEGIN(12)
            {
                attn_prompt_phase(Qb, Kb, Vb, Op, lse, lds, bx, G, wave, lane);
            }
            PHASE_END(12)
            PHASE_BEGIN(13)
            {
              for (int pass = 0; pass < 2; ++pass) { const bool do_sample = (pass == 0) == ((wave & 1) == 0);
              if (do_sample) { for (int u = gw; u < 2048; u += NGW) attn_sample_unit(p, u, Qb, Kb, Vb, att, (LAS float*)(lds + wave * 8192), lane); }
              else for (int it = gt; it < NP * 128; it += NGT) { const int c8 = it & 127, row = it >> 7, h = c8 >> 3;
                const float l0 = lse[(size_t)row * 16 + h], l1 = lse[((size_t)MT + row) * 16 + h], l2 = lse[((size_t)2 * MT + row) * 16 + h];
                const float mx = fmaxf(l0, fmaxf(l1, l2)); float w0 = __builtin_amdgcn_exp2f(l0 - mx), w1 = __builtin_amdgcn_exp2f(l1 - mx), w2 = __builtin_amdgcn_exp2f(l2 - mx); const float inv = 1.f / (w0 + w1 + w2); w0 *= inv; w1 *= inv; w2 *= inv;
                const u32x4 a = *(const u32x4*)(Op + (size_t)row * 1024 + c8 * 8), b = *(const u32x4*)(Op + ((size_t)MT + row) * 1024 + c8 * 8), c = *(const u32x4*)(Op + ((size_t)2 * MT + row) * 1024 + c8 * 8);
                u32x4 o;
                o.x = pk2(w0 * bflo(a.x) + w1 * bflo(b.x) + w2 * bflo(c.x), w0 * bfhi(a.x) + w1 * bfhi(b.x) + w2 * bfhi(c.x));
                o.y = pk2(w0 * bflo(a.y) + w1 * bflo(b.y) + w2 * bflo(c.y), w0 * bfhi(a.y) + w1 * bfhi(b.y) + w2 * bfhi(c.y));
                o.z = pk2(w0 * bflo(a.z) + w1 * bflo(b.z) + w2 * bflo(c.z), w0 * bfhi(a.z) + w1 * bfhi(b.z) + w2 * bfhi(c.z));
                o.w = pk2(w0 * bflo(a.w) + w1 * bflo(b.w) + w2 * bflo(c.w), w0 * bfhi(a.w) + w1 * bfhi(b.w) + w2 * bfhi(c.w));
                *(u32x4*)(att + (size_t)row * 1024 + c8 * 8) = o; } } }
            PHASE_END(13)
            layer_tail<1>(p, lds, grid, xbar, bx, G, gw, NGW, wave);
}

constexpr int NPHASES = 19;

extern "C" void kernel_launch(void* const* d_in, const int* in_sizes, int n_in, void* d_out, int out_size, void* d_ws, size_t ws_size, hipStream_t stream) {
    static int grid = 0;
    if (grid == 0) {
        int dev = 0, cus = 0, per_cu = 0;
        hipGetDevice(&dev);
        hipDeviceGetAttribute(&cus, hipDeviceAttributeMultiprocessorCount, dev);
        hipFuncSetAttribute((const void*)mega, hipFuncAttributeMaxDynamicSharedMemorySize, LDS_BYTES);
        hipOccupancyMaxActiveBlocksPerMultiprocessor(&per_cu, (const void*)mega, 512, LDS_BYTES);
        if (per_cu < 1) per_cu = 1;
        grid = cus * 1;
        if (ws_size < WS_END) fprintf(stderr, "kernel_launch: workspace too small: %zu < %zu\n", ws_size, (size_t)WS_END);
        fprintf(stderr, "kernel_launch: cus %d per_cu %d grid %d n_in %d out %d ws %zu\n", cus, per_cu, grid, n_in, out_size, ws_size);
    }
    Params p{};
    for (int i = 0; i < 26; ++i) p.in[i] = (const float*)d_in[i];
    p.out = (float*)d_out; p.ws = (unsigned char*)d_ws; p.ph_lo = 0; p.ph_hi = NPHASES;
    void* args[] = {&p};
    hipError_t e = hipLaunchCooperativeKernel((const void*)mega, dim3(grid), dim3(512), args, LDS_BYTES, stream);
    if (e != hipSuccess) fprintf(stderr, "cooperative launch failed: %s (grid %d)\n", hipGetErrorString(e), grid);
}
```

```cpp
#include <hip/hip_runtime.h>
#include <hip/hip_cooperative_groups.h>
#include <cstdio>
#include <cstdint>
namespace cg = cooperative_groups;

#define LAS __attribute__((address_space(3)))
#define DI __device__ __forceinline__
typedef unsigned short bf16_t;
typedef short bf16x8 __attribute__((ext_vector_type(8)));
typedef short s16x4 __attribute__((ext_vector_type(4)));
typedef float f32x4 __attribute__((ext_vector_type(4)));
typedef unsigned u32x4 __attribute__((ext_vector_type(4)));
typedef unsigned u32x2 __attribute__((ext_vector_type(2)));
typedef __bf16 bf2_t __attribute__((ext_vector_type(2)));

constexpr int NP = 32768, NS = 128, NT = NP + NS, MT = 33024, DM = 1024, FF = 2816, TP = 8192;
constexpr float EPS = 1e-6f;
constexpr int LDS_BYTES = 157696 + 256;
constexpr size_t O_YP = 0, O_YS = 33554432, O_POOLP = 33685504, O_S5P = 33716224, O_KP = 33732608, O_VP = 42121216,
                 O_POOLS = 50509824, O_S5S = 50755584, O_KS = 50886656, O_VS = 51017728;
constexpr size_t MiB = 1u << 20;
constexpr size_t WS_WIN = 0, WS_WOUT = 2 * MiB, WS_WGLU = 4 * MiB, WS_WPOOL = 4 * MiB + 512 * 1024, WS_WO = 5 * MiB, WS_WQKV = 7 * MiB,
                 WS_GU0 = 13 * MiB, WS_GU1 = 24 * MiB, WS_DN0 = 35 * MiB, WS_DN1 = 41 * MiB, WS_BT1 = 47 * MiB, WS_BT2 = 51 * MiB,
                 WS_ROWSS = 57 * MiB, WS_USS = 60 * MiB, WS_LSE = 61 * MiB, WS_XN = 68 * MiB, WS_Y = 133 * MiB, WS_H = 198 * MiB,
                 WS_X = 328 * MiB;
constexpr size_t WS_AP = WS_X, WS_S = WS_X + 48 * MiB, WS_UPOOL = WS_X + 80 * MiB, WS_D = WS_X + 145 * MiB, WS_Z = WS_X + 178 * MiB,
                 WS_YCAT = WS_X + 211 * MiB;
constexpr size_t WS_HACT = WS_X;
constexpr size_t WS_Q = WS_X, WS_K = WS_X + 65 * MiB, WS_V = WS_X + 130 * MiB, WS_OP = WS_X + 195 * MiB, WS_ATT = WS_X + 389 * MiB;
constexpr size_t WS_END = WS_X + 454 * MiB;
constexpr size_t WS_CTL = 60 * MiB + 512 * 1024;

struct Params { const float* in[26]; float* out; unsigned char* ws; int ph_lo, ph_hi; };

DI unsigned pk2(float lo, float hi) { bf2_t v; v.x = (__bf16)lo; v.y = (__bf16)hi; return __builtin_bit_cast(unsigned, v); }
DI float bflo(unsigned w) { return __uint_as_float(w << 16); }
DI float bfhi(unsigned w) { return __uint_as_float(w & 0xffff0000u); }
DI float bf2f(bf16_t b) { return __uint_as_float((unsigned)b << 16); }
DI float wave_sum(float v) {
#pragma unroll
    for (int o = 1; o < 64; o <<= 1) v += __shfl_xor(v, o);
    return v;
}
DI float wave_max(float v) {
#pragma unroll
    for (int o = 1; o < 64; o <<= 1) v = fmaxf(v, __shfl_xor(v, o));
    return v;
}
DI float sigmoidf_(float x) { return __builtin_amdgcn_rcpf(1.0f + __builtin_amdgcn_exp2f(-1.4426950408889634f * x)); }
DI float gelu_tanh(float y) { const float u = 0.7978845608028654f * (y + 0.044715f * y * y * y); return y * __builtin_amdgcn_rcpf(1.0f + __builtin_amdgcn_exp2f(-2.0f * 1.4426950408889634f * u)); }
DI void sincos_acc(float a, float& s, float& c) {
    if (fabsf(a) < 0.5f) {
        const float a2 = a * a;
        s = a * (1.f - a2 * (1.f / 6.f) * (1.f - a2 * (1.f / 20.f) * (1.f - a2 * (1.f / 42.f))));
        c = 1.f - a2 * 0.5f * (1.f - a2 * (1.f / 12.f) * (1.f - a2 * (1.f / 30.f) * (1.f - a2 * (1.f / 56.f))));
    } else {
        float r = a * 0.15915494309189535f; r -= floorf(r);
        s = __builtin_amdgcn_sinf(r); c = __builtin_amdgcn_cosf(r);
    }
}
DI int lane_id() { int l; asm volatile("v_mbcnt_lo_u32_b32 %0, -1, 0\n\tv_mbcnt_hi_u32_b32 %0, -1, %0" : "=v"(l)); return l; }
#define LDS_WAIT() asm volatile("s_waitcnt lgkmcnt(0)" ::: "memory")
#define VM_WAIT() asm volatile("s_waitcnt vmcnt(0)" ::: "memory")

constexpr int BM = 256, BK = 64, HALF = 128, NXCD = 8, WGM = 8;
typedef f32x4 Acc[2][2][4][2];
DI int lds_byte(int r, int c) { const int st = (r >> 4) * 2 + (c >> 5), rr = r & 15, cc = c & 31, ob = rr * 64 + cc * 2; return st * 1024 + (ob ^ (((ob >> 9) & 1) << 5)); }
DI void stage_rc(int b, int& R, int& C) { const int st = b / 1024, sb = b % 1024, swz = sb ^ (((sb >> 9) & 1) << 5); R = (st >> 1) * 16 + swz / 64; C = (st & 1) * 32 + (swz % 64) / 2; }

DI bool unit_next(int i, int G, int c, int nM, int nN, int& pm, int& pn) {
    const int nwg = nM * nN; const long L = (long)i * G + c; if (L >= nwg) return false;
    int wgid = (int)L; { const int q = nwg / NXCD, r = nwg % NXCD, xcd = wgid % NXCD, off = wgid / NXCD; wgid = (xcd < r ? xcd * (q + 1) : r * (q + 1) + (xcd - r) * q) + off; }
    const int nig = WGM * nN, gid = wgid / nig, fm = gid * WGM, gsz = (nM - fm) < WGM ? (nM - fm) : WGM;
    pm = fm + ((wgid % nig) % gsz); pn = (wgid % nig) / gsz; return true;
}

template <class Units>
DI void gemm_phase(LAS unsigned char* lds, const int wid, const int lda, const int ldb, const int K, const Units& U) {
    typedef typename Units::Epi Epi;
    const int lane = lane_id(), tid = wid * 64 + lane, wr = wid >> 2, wc = wid & 3, fr = lane & 15, fq = lane >> 4;
    unsigned offA, offB;
    { int R, C; stage_rc(tid * 16, R, C); offA = (unsigned)(R * lda + C) * 2u; offB = (unsigned)(R * ldb + C) * 2u; }
    const unsigned ldsw = (unsigned)wid * 1024u;
    const unsigned hA = (unsigned)(HALF * lda * 2), hB = (unsigned)(HALF * ldb * 2), dA = (unsigned)(64 * lda * 2), dB = (unsigned)(64 * ldb * 2);
    const int aoff = lds_byte(wr * 64 + fr, fq * 8), boff = lds_byte(wc * 32 + fr, fq * 8);
#define SA(b, h) (((b) * 2 + (h)) * 16384)
#define SB(b, h) ((4 + (b) * 2 + (h)) * 16384)
#define STG(bufoff, gbase, soff, voff, dlt) do { _Pragma("unroll") for (int _i = 0; _i < 2; ++_i) { unsigned _vo = (voff); asm volatile("" : "+v"(_vo)); _vo += (unsigned)(soff) + (unsigned)_i * (dlt); \
        __builtin_amdgcn_global_load_lds((const unsigned*)((gbase) + _vo), (LAS unsigned*)(lds + (bufoff) + ldsw + _i * 8192), 16, 0, 0); } } while (0)
#define STA(b, h, base, kt) STG(SA(b, h), base, (h) * hA + (unsigned)(kt) * 128u, offA, dA)
#define STB(b, h, base, kt) STG(SB(b, h), base, (h) * hB + (unsigned)(kt) * 128u, offB, dB)
#define LDA(dst, b, h) do { _Pragma("unroll") for (int m = 0; m < 4; ++m) _Pragma("unroll") for (int k = 0; k < 2; ++k) dst[m][k] = *(const LAS bf16x8*)(lds + SA(b, h) + aoff + m * 2048 + k * 1024); } while (0)
#define LDB(dst, b, h) do { _Pragma("unroll") for (int n = 0; n < 2; ++n) _Pragma("unroll") for (int k = 0; k < 2; ++k) dst[n][k] = *(const LAS bf16x8*)(lds + SB(b, h) + boff + n * 2048 + k * 1024); } while (0)
#define MMA(ai, bj, Af, Bf) do { __builtin_amdgcn_s_setprio(1); _Pragma("unroll") for (int m = 0; m < 4; ++m) _Pragma("unroll") for (int n = 0; n < 2; ++n) _Pragma("unroll") for (int k = 0; k < 2; ++k) \
        acc[ai][bj][m][n] = __builtin_amdgcn_mfma_f32_16x16x32_bf16(Bf[n][k], Af[m][k], acc[ai][bj][m][n], 0, 0, 0); __builtin_amdgcn_s_setprio(0); } while (0)
#define WAIT_V(n) asm volatile("s_waitcnt vmcnt(" #n ")" ::: "memory")
#define WAIT_L(n) asm volatile("s_waitcnt lgkmcnt(" #n ")" ::: "memory")
#define BAR __builtin_amdgcn_s_barrier()
#define SCHED __builtin_amdgcn_sched_barrier(0)
#define ZERO_ACC() do { _Pragma("unroll") for (int a = 0; a < 2; ++a) _Pragma("unroll") for (int b = 0; b < 2; ++b) _Pragma("unroll") for (int m = 0; m < 4; ++m) _Pragma("unroll") for (int n = 0; n < 2; ++n) acc[a][b][m][n] = (f32x4){0.f, 0.f, 0.f, 0.f}; } while (0)
    const bf16_t* pa; const bf16_t* pb; Epi Ecur, Enxt;
    if (!U.get(0, pa, pb, Ecur)) return;
    const char* cA = (const char*)pa; const char* cB = (const char*)pb;
    Acc acc; ZERO_ACC();
    bf16x8 At[4][2], B0[2][2], B1[2][2];
    const int nt = K / BK;
    STB(0, 0, cB, 0); STB(0, 1, cB, 0); STA(0, 0, cA, 0); STA(0, 1, cA, 0);
    if (wr == 1) BAR;
    WAIT_V(2); BAR;
    STB(1, 0, cB, 1); STA(1, 0, cA, 1); STB(1, 1, cB, 1);
    WAIT_V(6); BAR;
    for (int ui = 0;; ++ui) {
        const bool has_next = U.get(ui + 1, pa, pb, Enxt);
        const char* nA = has_next ? (const char*)pa : cA; const char* nB = has_next ? (const char*)pb : cB;
        for (int t = 0; t < nt; t += 2) {
            const bool last = (t == nt - 2);
            const char* a2 = last ? nA : cA; const char* b2 = last ? nB : cB; const int k2 = last ? 0 : t + 2, k3 = k2 + 1;
            LDB(B0, 0, 0); LDB(B1, 0, 1); SCHED; LDA(At, 0, 0); STA(1, 1, cA, t + 1);
            WAIT_V(8); WAIT_L(0); BAR; MMA(0, 0, At, B0); MMA(0, 1, At, B1); BAR; SCHED;
            LDA(At, 0, 1); STB(0, 0, b2, k2); STB(0, 1, b2, k2); STA(0, 0, a2, k2);
            WAIT_V(8); WAIT_L(0); BAR; MMA(1, 0, At, B0); MMA(1, 1, At, B1); BAR; SCHED;
            LDB(B0, 1, 0); LDB(B1, 1, 1); SCHED; LDA(At, 1, 0); STA(0, 1, a2, k2);
            WAIT_V(8); WAIT_L(0); BAR; MMA(0, 0, At, B0); MMA(0, 1, At, B1); BAR; SCHED;
            LDA(At, 1, 1); STB(1, 0, b2, k3); STB(1, 1, b2, k3); STA(1, 0, a2, k3);
            WAIT_V(8); WAIT_L(0); BAR; MMA(1, 0, At, B0); MMA(1, 1, At, B1); BAR; SCHED;
        }
        if (wr == 0) BAR;
        Ecur(acc, wr, wc, fr, fq);
        if (!has_next) break;
        ZERO_ACC();
        cA = nA; cB = nB; Ecur = Enxt;
        if (wr == 1) BAR;
    }
    WAIT_V(0);
    BAR;
#undef ZERO_ACC
#undef SA
#undef SB
#undef STG
#undef STA
#undef STB
#undef LDA
#undef LDB
#undef MMA
#undef WAIT_V
#undef WAIT_L
#undef BAR
#undef SCHED
}

#define EPI_ROWS(...) _Pragma("unroll") for (int ai = 0; ai < 2; ++ai) _Pragma("unroll") for (int m = 0; m < 4; ++m) { const int rr = ai * 128 + wr * 64 + m * 16 + fr; __VA_ARGS__ }
#define EPI_COLS(...) _Pragma("unroll") for (int bj = 0; bj < 2; ++bj) _Pragma("unroll") for (int n = 0; n < 2; ++n) { const int cc = bj * 128 + wc * 32 + n * 16 + 4 * fq; const f32x4 v = acc[ai][bj][m][n]; __VA_ARGS__ }

struct EpiProj {
    float* upool; bf16_t* Ap; float* uss; int row0, col0;
    DI void set(int pm, int pn) { row0 = pm * 256; col0 = pn * 256; }
    DI void elem(int row, int col, const f32x4 v) const {
        if (col < 512) *(f32x4*)(upool + (size_t)row * 512 + col) = v; else *(f32x4*)(uss + (size_t)(row - NP) * 512 + (col - 512)) = v; }
    DI void operator()(const Acc& acc, int wr, int wc, int fr, int fq) const {
        if (col0 < 512) {
            EPI_ROWS(const size_t row = row0 + rr; EPI_COLS(*(f32x4*)(upool + row * 512 + col0 + cc) = v;))
        } else {
            EPI_ROWS(const int row = row0 + rr;
                EPI_COLS(const int c2 = col0 - 512 + cc; const int g = c2 >> 4, i = c2 & 15;
                    if (row < NP) { u32x2 w; w.x = pk2(v[0], v[1]); w.y = pk2(v[2], v[3]);
                        *(u32x2*)(Ap + ((size_t)g * 2048 + (row >> 4)) * 384 + 128 + (row & 15) * 16 + i) = w; }
                    else if (row < NT) { *(f32x4*)(uss + (size_t)(row - NP) * 512 + c2) = v; }))
        }
    }
};
struct EpiS1 {
    float* S; int g, row0;
    DI void set(int mt, int gg) { row0 = mt * 256; g = gg; }
    DI void operator()(const Acc& acc, int wr, int wc, int fr, int fq) const {
        EPI_ROWS(const size_t row = (size_t)g * 2048 + row0 + rr;
            _Pragma("unroll") for (int n = 0; n < 2; ++n) { const int cc = wc * 32 + n * 16 + 4 * fq; *(f32x4*)(S + row * 128 + cc) = acc[ai][0][m][n]; })
    }
};
struct EpiPool {
    bf16_t* ycat; const float* scale; int row0, col0;
    DI void set(int pm, int pn) { row0 = pm * 256; col0 = pn * 256; }
    DI void elem(int row, int col, const f32x4 v) const { const f32x4 s = *(const f32x4*)(scale + col); u32x2 w; w.x = pk2(v[0] * s[0], v[1] * s[1]); w.y = pk2(v[2] * s[2], v[3] * s[3]);
        *(u32x2*)(ycat + (size_t)row * 1024 + col) = w; }
    DI void operator()(const Acc& acc, int wr, int wc, int fr, int fq) const {
        EPI_ROWS(const size_t row = row0 + rr;
            EPI_COLS(const int col = col0 + cc; const f32x4 s = *(const f32x4*)(scale + col); u32x2 w; w.x = pk2(v[0] * s[0], v[1] * s[1]); w.y = pk2(v[2] * s[2], v[3] * s[3]);
                *(u32x2*)(ycat + row * 1024 + col) = w;))
    }
};
struct EpiS2 {
    bf16_t* z; const bf16_t* Ap; const float* dskip; int g, row0;
    DI void set(int mt, int gg) { row0 = mt * 256; g = gg; }
    DI void operator()(const Acc& acc, int wr, int wc, int fr, int fq) const {
        EPI_ROWS(const int chunk = row0 + rr; const bf16_t* ap = Ap + ((size_t)g * 2048 + chunk) * 384 + 128;
            EPI_COLS(const int r = cc >> 4, i = cc & 15; const u32x2 uw = *(const u32x2*)(ap + cc); const f32x4 d = *(const f32x4*)(dskip + g * 16 + i);
                const float y0 = v[0] + d[0] * bflo(uw.x), y1 = v[1] + d[1] * bfhi(uw.x), y2 = v[2] + d[2] * bflo(uw.y), y3 = v[3] + d[3] * bfhi(uw.y);
                u32x2 w; w.x = pk2(gelu_tanh(y0), gelu_tanh(y1)); w.y = pk2(gelu_tanh(y2), gelu_tanh(y3));
                *(u32x2*)(z + ((size_t)chunk * 16 + r) * 512 + g * 16 + i) = w;))
    }
};
struct EpiGlu {
    bf16_t* ycat; const bf16_t* z; const float* bglu; int row0, col0;
    DI void set(int pm, int pn) { row0 = pm * 256; col0 = pn * 256; }
    DI void elem(int row, int col, const f32x4 v) const { const u32x2 zw = *(const u32x2*)(z + (size_t)row * 512 + col); const f32x4 b = *(const f32x4*)(bglu + col);
        u32x2 w; w.x = pk2(bflo(zw.x) * sigmoidf_(v[0] + b[0]), bfhi(zw.x) * sigmoidf_(v[1] + b[1])); w.y = pk2(bflo(zw.y) * sigmoidf_(v[2] + b[2]), bfhi(zw.y) * sigmoidf_(v[3] + b[3]));
        *(u32x2*)(ycat + (size_t)row * 1024 + 512 + col) = w; }
    DI void operator()(const Acc& acc, int wr, int wc, int fr, int fq) const {
        EPI_ROWS(const size_t row = row0 + rr;
            EPI_COLS(const int col = col0 + cc; const u32x2 zw = *(const u32x2*)(z + row * 512 + col); const f32x4 b = *(const f32x4*)(bglu + col);
                u32x2 w; w.x = pk2(bflo(zw.x) * sigmoidf_(v[0] + b[0]), bfhi(zw.x) * sigmoidf_(v[1] + b[1]));
                w.y = pk2(bflo(zw.y) * sigmoidf_(v[2] + b[2]), bfhi(zw.y) * sigmoidf_(v[3] + b[3]));
                *(u32x2*)(ycat + row * 1024 + 512 + col) = w;))
    }
};
struct EpiY {
    bf16_t* y; int row0, col0;
    DI void set(int pm, int pn) { row0 = pm * 256; col0 = pn * 256; }
    DI void elem(int row, int col, const f32x4 v) const { u32x2 w; w.x = pk2(v[0], v[1]); w.y = pk2(v[2], v[3]); *(u32x2*)(y + (size_t)row * 1024 + col) = w; }
    DI void operator()(const Acc& acc, int wr, int wc, int fr, int fq) const {
        EPI_ROWS(const int row = row0 + rr; EPI_COLS(elem(row, col0 + cc, v);))
    }
};
struct EpiGU {
    bf16_t* hact; int row0, hb;
    DI void set(int pm, int pn) { row0 = pm * 256; hb = pn; }
    DI void elem2(int row, int col, const f32x4 a, const f32x4 u) const { u32x2 w; w.x = pk2(a[0] * sigmoidf_(a[0]) * u[0], a[1] * sigmoidf_(a[1]) * u[1]); w.y = pk2(a[2] * sigmoidf_(a[2]) * u[2], a[3] * sigmoidf_(a[3]) * u[3]);
        *(u32x2*)(hact + (size_t)row * FF + col) = w; }
    DI void operator()(const Acc& acc, int wr, int wc, int fr, int fq) const {
        EPI_ROWS(const size_t row = row0 + rr;
            _Pragma("unroll") for (int n = 0; n < 2; ++n) { const int cc = wc * 32 + n * 16 + 4 * fq; const f32x4 a = acc[ai][0][m][n], u = acc[ai][1][m][n];
                u32x2 w; w.x = pk2(a[0] * sigmoidf_(a[0]) * u[0], a[1] * sigmoidf_(a[1]) * u[1]); w.y = pk2(a[2] * sigmoidf_(a[2]) * u[2], a[3] * sigmoidf_(a[3]) * u[3]);
                *(u32x2*)(hact + row * FF + hb * 128 + cc) = w; })
    }
};
struct EpiQKV {
    bf16_t* qkv; float* out; int row0, col0;
    DI void set(int pm, int pn) { row0 = pm * 256; col0 = pn * 256; }
    DI void elem(int row, int colg, const f32x4 v) const {
        const int which = colg >> 10, col = colg & 1023; const float sc = which == 0 ? 0.125f * 1.4426950408889634f : 1.0f;
        u32x2 w; w.x = pk2(v[0] * sc, v[1] * sc); w.y = pk2(v[2] * sc, v[3] * sc);
        *(u32x2*)(qkv + (size_t)which * (65 * MiB / 2) + (size_t)row * 1024 + col) = w;
        if (which != 0) *(f32x4*)(out + (which == 1 ? O_KS : O_VS) + (size_t)(row - NP) * 1024 + col) = v; }
    DI void operator()(const Acc& acc, int wr, int wc, int fr, int fq) const {
        const int which = col0 >> 10; const int cb = col0 & 1023; const float sc = which == 0 ? 0.125f * 1.4426950408889634f : 1.0f;
        bf16_t* dst = qkv + (size_t)which * (65 * MiB / 2);
        float* op = out + (which == 1 ? O_KP : O_VP); float* os = out + (which == 1 ? O_KS : O_VS);
        EPI_ROWS(const int row = row0 + rr;
            EPI_COLS(const int col = cb + cc; u32x2 w; w.x = pk2(v[0] * sc, v[1] * sc); w.y = pk2(v[2] * sc, v[3] * sc);
                *(u32x2*)(dst + (size_t)row * 1024 + col) = w;
                if (which != 0) {
                    if (row < NP) { const int tb = row & (TP - 1); if (tb >= TP - 2048) *(f32x4*)(op + ((size_t)(row >> 13) * 2048 + (tb - (TP - 2048))) * 1024 + col) = v; }
                    else if (row < NT) *(f32x4*)(os + (size_t)(row - NP) * 1024 + col) = v;
                }))
    }
};


template <class EpiT> struct UStd {
    typedef EpiT Epi; const bf16_t* A; const bf16_t* Bt; size_t astep, bstep; int acolstep, nM, nN, G, c; EpiT proto;
    DI bool get(int i, const bf16_t*& a, const bf16_t*& b, EpiT& e) const { int pm, pn; if (!unit_next(i, G, c, nM, nN, pm, pn)) return false;
        a = A + (size_t)pm * astep + (size_t)pn * acolstep; b = Bt + (size_t)pn * bstep; e = proto; e.set(pm, pn); return true; }
};
template <class EpiT> struct US5 {
    typedef EpiT Epi; const bf16_t* A; const bf16_t* Bt; size_t bstep; int G, c; EpiT proto;
    DI bool get(int i, const bf16_t*& a, const bf16_t*& b, EpiT& e) const { const int L = c + i * G; if (L >= 256) return false; const int g = L >> 3, mt = L & 7;
        a = A + ((size_t)g * 2048 + mt * 256) * 384; b = Bt + (size_t)g * bstep; e = proto; e.set(mt, g); return true; }
};

DI f32x4 mini_acc(const bf16_t* Arow, const bf16_t* Brow, int K) {
    f32x4 acc = (f32x4){0.f, 0.f, 0.f, 0.f};
    int k0 = 0;
    for (; k0 + 512 <= K; k0 += 512) { bf16x8 a[16], b[16];
#pragma unroll
        for (int e = 0; e < 16; ++e) { a[e] = *(const bf16x8*)(Arow + k0 + 32 * e); b[e] = *(const bf16x8*)(Brow + k0 + 32 * e); }
#pragma unroll
        for (int e = 0; e < 16; ++e) acc = __builtin_amdgcn_mfma_f32_16x16x32_bf16(b[e], a[e], acc, 0, 0, 0); }
    if (k0 < K) { bf16x8 a[8], b[8];
#pragma unroll
        for (int e = 0; e < 8; ++e) { a[e] = *(const bf16x8*)(Arow + k0 + 32 * e); b[e] = *(const bf16x8*)(Brow + k0 + 32 * e); }
#pragma unroll
        for (int e = 0; e < 8; ++e) acc = __builtin_amdgcn_mfma_f32_16x16x32_bf16(b[e], a[e], acc, 0, 0, 0); }
    return acc;
}
DI void mini_acc2(const bf16_t* Arow, const bf16_t* Bg, const bf16_t* Bu, int K, f32x4& ga, f32x4& ua) {
    ga = (f32x4){0.f, 0.f, 0.f, 0.f}; ua = ga;
    for (int k0 = 0; k0 < K; k0 += 256) { bf16x8 a[8], g[8], u[8];
#pragma unroll
        for (int e = 0; e < 8; ++e) { a[e] = *(const bf16x8*)(Arow + k0 + 32 * e); g[e] = *(const bf16x8*)(Bg + k0 + 32 * e); u[e] = *(const bf16x8*)(Bu + k0 + 32 * e); }
#pragma unroll
        for (int e = 0; e < 8; ++e) { ga = __builtin_amdgcn_mfma_f32_16x16x32_bf16(g[e], a[e], ga, 0, 0, 0); ua = __builtin_amdgcn_mfma_f32_16x16x32_bf16(u[e], a[e], ua, 0, 0, 0); } }
}
template <class Epi>
DI void mini_gemm(const bf16_t* A, int lda, const bf16_t* Bt, int ldb, int K, int N, int acol_per_256, const Epi& E, int bx, int G, int wave, int lane) {
    const int fr = lane & 15, fq = lane >> 4; const int row = NP + 16 * wave + fr;
    for (int q = bx; q < N / 16; q += G) {
        const bf16_t* Arow = A + (size_t)row * lda + ((16 * q) >> 8) * acol_per_256 + 8 * fq;
        const bf16_t* Brow = Bt + (size_t)(16 * q + fr) * ldb + 8 * fq;
        const f32x4 acc = mini_acc(Arow, Brow, K);
        E.elem(row, 16 * q + 4 * fq, acc); }
}
DI void mini_gemm_gu(const bf16_t* A, const bf16_t* Bt, const EpiGU& E, int bx, int G, int wave, int lane) {
    const int fr = lane & 15, fq = lane >> 4; const int row = NP + 16 * wave + fr;
    for (int q = bx; q < FF / 16; q += G) { const int hcol = 16 * q; const int brow = (hcol >> 7) * 256 + (hcol & 127) + fr;
        const bf16_t* Arow = A + (size_t)row * DM + 8 * fq;
        f32x4 ga, ua; mini_acc2(Arow, Bt + (size_t)brow * DM + 8 * fq, Bt + (size_t)(brow + 128) * DM + 8 * fq, DM, ga, ua);
        E.elem2(row, hcol + 4 * fq, ga, ua); }
}
DI void transpose_item(const float* W, int N, int k0, int n0, bf16_t* WT, int ldt, int orow0, int ocol0, LAS float* scr, int lane) {
#pragma unroll 16
    for (int i = 0; i < 32; ++i) { const int kk = 2 * i + (lane >> 5); scr[kk * 33 + (lane & 31)] = W[(size_t)(k0 + kk) * N + n0 + (lane & 31)]; }
    LDS_WAIT();
    const int c = lane & 7;
#pragma unroll
    for (int j = 0; j < 4; ++j) { const int n = (lane >> 3) + 8 * j; const LAS float* s = scr + (8 * c) * 33 + n;
        u32x4 o; o.x = pk2(s[0 * 33], s[1 * 33]); o.y = pk2(s[2 * 33], s[3 * 33]); o.z = pk2(s[4 * 33], s[5 * 33]); o.w = pk2(s[6 * 33], s[7 * 33]);
        *(u32x4*)(WT + (size_t)(orow0 + n) * ldt + ocol0 + 8 * c) = o; }
    LDS_WAIT();
}
DI void tr_plain(const float* W, int K, int N, bf16_t* WT, int item, LAS float* scr, int lane) {
    const int nblk = N / 32, kb = item / nblk, nb = item % nblk; transpose_item(W, N, 64 * kb, 32 * nb, WT, K, 32 * nb, 64 * kb, scr, lane);
}

DI const float* in_row(const Params& p, int r) { return r < NP ? p.in[0] + (size_t)r * DM : p.in[1] + (size_t)(r - NP) * DM; }

DI void norm_row(const float* xr, const float* g, bf16_t* o, int lane) {
    f32x4 v[4]; float s = 0.f;
#pragma unroll
    for (int j = 0; j < 4; ++j) { v[j] = *(const f32x4*)(xr + 4 * lane + 256 * j); s += (v[j][0] * v[j][0] + v[j][1] * v[j][1]) + (v[j][2] * v[j][2] + v[j][3] * v[j][3]); }
    const float r = rsqrtf(wave_sum(s) * (1.f / DM) + EPS);
#pragma unroll
    for (int j = 0; j < 4; ++j) { const f32x4 gg = *(const f32x4*)(g + 4 * lane + 256 * j); u32x2 w; w.x = pk2(v[j][0] * r * gg[0], v[j][1] * r * gg[1]); w.y = pk2(v[j][2] * r * gg[2], v[j][3] * r * gg[3]);
        *(u32x2*)(o + 4 * lane + 256 * j) = w; }
}
DI void norm_row2(const float* xa, const float* xb, const float* g, bf16_t* oa, bf16_t* ob, int lane) {
    f32x4 va[4], vb[4]; float sa = 0.f, sb = 0.f;
#pragma unroll
    for (int j = 0; j < 4; ++j) { va[j] = *(const f32x4*)(xa + 4 * lane + 256 * j); vb[j] = *(const f32x4*)(xb + 4 * lane + 256 * j); }
#pragma unroll
    for (int j = 0; j < 4; ++j) { sa += (va[j][0] * va[j][0] + va[j][1] * va[j][1]) + (va[j][2] * va[j][2] + va[j][3] * va[j][3]); sb += (vb[j][0] * vb[j][0] + vb[j][1] * vb[j][1]) + (vb[j][2] * vb[j][2] + vb[j][3] * vb[j][3]); }
    const float ra = rsqrtf(wave_sum(sa) * (1.f / DM) + EPS), rb = rsqrtf(wave_sum(sb) * (1.f / DM) + EPS);
#pragma unroll
    for (int j = 0; j < 4; ++j) { const f32x4 gg = *(const f32x4*)(g + 4 * lane + 256 * j); u32x2 w;
        w.x = pk2(va[j][0] * ra * gg[0], va[j][1] * ra * gg[1]); w.y = pk2(va[j][2] * ra * gg[2], va[j][3] * ra * gg[3]); *(u32x2*)(oa + 4 * lane + 256 * j) = w;
        w.x = pk2(vb[j][0] * rb * gg[0], vb[j][1] * rb * gg[1]); w.y = pk2(vb[j][2] * rb * gg[2], vb[j][3] * rb * gg[3]); *(u32x2*)(ob + 4 * lane + 256 * j) = w; }
}
template <bool INB, bool OUTB>
DI void res_row(const void* hin_, const bf16_t* y, const float* gpost, const float* gnext, void* hout_, bf16_t* xn, int lane) {
    u32x2 yw[4]; float ss = 0.f;
#pragma unroll
    for (int j = 0; j < 4; ++j) { yw[j] = *(const u32x2*)(y + 4 * lane + 256 * j); const float a = bflo(yw[j].x), b = bfhi(yw[j].x), c = bflo(yw[j].y), d = bfhi(yw[j].y); ss += (a * a + b * b) + (c * c + d * d); }
    const float r1 = rsqrtf(wave_sum(ss) * (1.f / DM) + EPS);
    f32x4 h[4]; float s2 = 0.f;
#pragma unroll
    for (int j = 0; j < 4; ++j) { const int c = 4 * lane + 256 * j; f32x4 hv;
        if (INB) { const u32x2 hw = *(const u32x2*)((const bf16_t*)hin_ + c); hv = (f32x4){bflo(hw.x), bfhi(hw.x), bflo(hw.y), bfhi(hw.y)}; } else hv = *(const f32x4*)((const float*)hin_ + c);
        const f32x4 gp = *(const f32x4*)(gpost + c);
        h[j][0] = hv[0] + bflo(yw[j].x) * r1 * gp[0]; h[j][1] = hv[1] + bfhi(yw[j].x) * r1 * gp[1]; h[j][2] = hv[2] + bflo(yw[j].y) * r1 * gp[2]; h[j][3] = hv[3] + bfhi(yw[j].y) * r1 * gp[3];
        if (OUTB) { u32x2 w; w.x = pk2(h[j][0], h[j][1]); w.y = pk2(h[j][2], h[j][3]); *(u32x2*)((bf16_t*)hout_ + c) = w;
            h[j] = (f32x4){bflo(w.x), bfhi(w.x), bflo(w.y), bfhi(w.y)}; }
        else *(f32x4*)((float*)hout_ + c) = h[j];
        s2 += (h[j][0] * h[j][0] + h[j][1] * h[j][1]) + (h[j][2] * h[j][2] + h[j][3] * h[j][3]); }
    if (xn) {
        const float r2 = rsqrtf(wave_sum(s2) * (1.f / DM) + EPS);
#pragma unroll
        for (int j = 0; j < 4; ++j) { const int c = 4 * lane + 256 * j; const f32x4 gn = *(const f32x4*)(gnext + c); u32x2 w; w.x = pk2(h[j][0] * r2 * gn[0], h[j][1] * r2 * gn[1]); w.y = pk2(h[j][2] * r2 * gn[2], h[j][3] * r2 * gn[3]);
            *(u32x2*)(xn + c) = w; }
    }
}

template <bool INB, bool OUTB, int R>
DI void res_rows(const void* const (&hin_)[R], const bf16_t* const (&y)[R], const float* gpost, const float* gnext, void* const (&hout_)[R], bf16_t* const (&xn)[R], const bool has_xn, int lane) {
    u32x2 yw[R][4]; f32x4 hv[R][4];
#pragma unroll
    for (int q = 0; q < R; ++q)
#pragma unroll
        for (int j = 0; j < 4; ++j) { const int c = 4 * lane + 256 * j; yw[q][j] = *(const u32x2*)(y[q] + c);
            if (INB) { const u32x2 hw = *(const u32x2*)((const bf16_t*)hin_[q] + c); hv[q][j] = (f32x4){bflo(hw.x), bfhi(hw.x), bflo(hw.y), bfhi(hw.y)}; } else hv[q][j] = *(const f32x4*)((const float*)hin_[q] + c); }
    f32x4 gp[4];
#pragma unroll
    for (int j = 0; j < 4; ++j) gp[j] = *(const f32x4*)(gpost + 4 * lane + 256 * j);
#pragma unroll
    for (int q = 0; q < R; ++q) {
        float ss = 0.f;
#pragma unroll
        for (int j = 0; j < 4; ++j) { const float a = bflo(yw[q][j].x), b = bfhi(yw[q][j].x), c = bflo(yw[q][j].y), d = bfhi(yw[q][j].y); ss += (a * a + b * b) + (c * c + d * d); }
        const float r1 = rsqrtf(wave_sum(ss) * (1.f / DM) + EPS);
        float s2 = 0.f;
#pragma unroll
        for (int j = 0; j < 4; ++j) { const int c = 4 * lane + 256 * j; f32x4 h;
            h[0] = hv[q][j][0] + bflo(yw[q][j].x) * r1 * gp[j][0]; h[1] = hv[q][j][1] + bfhi(yw[q][j].x) * r1 * gp[j][1]; h[2] = hv[q][j][2] + bflo(yw[q][j].y) * r1 * gp[j][2]; h[3] = hv[q][j][3] + bfhi(yw[q][j].y) * r1 * gp[j][3];
            if (OUTB) { u32x2 w; w.x = pk2(h[0], h[1]); w.y = pk2(h[2], h[3]); *(u32x2*)((bf16_t*)hout_[q] + c) = w; h = (f32x4){bflo(w.x), bfhi(w.x), bflo(w.y), bfhi(w.y)}; }
            else *(f32x4*)((float*)hout_[q] + c) = h;
            s2 += (h[0] * h[0] + h[1] * h[1]) + (h[2] * h[2] + h[3] * h[3]); hv[q][j] = h; }
        if (has_xn) { const float r2 = rsqrtf(wave_sum(s2) * (1.f / DM) + EPS);
#pragma unroll
            for (int j = 0; j < 4; ++j) { const int c = 4 * lane + 256 * j; const f32x4 gn = *(const f32x4*)(gnext + c); u32x2 w; w.x = pk2(hv[q][j][0] * r2 * gn[0], hv[q][j][1] * r2 * gn[1]); w.y = pk2(hv[q][j][2] * r2 * gn[2], hv[q][j][3] * r2 * gn[3]);
                *(u32x2*)(xn[q] + c) = w; } }
    }
}

struct RowPass { int mode; const float* gpost; const float* gnext; const float* xp; const float* xs; bf16_t* h16; const bf16_t* y; bf16_t* xnp; float* out;
    DI void row(int r, int lane) const {
        const bf16_t* yr = y + (size_t)r * DM; bf16_t* hr = h16 + (size_t)r * DM;
        if (mode == 0) res_row<false, true>(r < NP ? xp + (size_t)r * DM : xs + (size_t)(r - NP) * DM, yr, gpost, gnext, hr, xnp + (size_t)r * DM, lane);
        else if (mode == 1) res_row<true, true>(hr, yr, gpost, gnext, hr, xnp + (size_t)r * DM, lane);
        else res_row<true, false>(hr, yr, gpost, gnext, r < NP ? out + O_YP + (size_t)r * DM : out + O_YS + (size_t)(r - NP) * DM, nullptr, lane);
    }
    DI void rows4(int r0, int lane) const {
        const void* hin[4]; const bf16_t* yr[4]; void* ho[4]; bf16_t* xo[4];
#pragma unroll
        for (int q = 0; q < 4; ++q) { const size_t o = (size_t)(r0 + q) * DM; yr[q] = y + o; xo[q] = xnp + o;
            hin[q] = mode == 0 ? (const void*)(xp + o) : (const void*)(h16 + o); ho[q] = mode == 2 ? (void*)(out + O_YP + o) : (void*)(h16 + o); }
        if (mode == 0) res_rows<false, true, 4>(hin, yr, gpost, gnext, ho, xo, true, lane);
        else if (mode == 1) res_rows<true, true, 4>(hin, yr, gpost, gnext, ho, xo, true, lane);
        else res_rows<true, false, 4>(hin, yr, gpost, gnext, ho, xo, false, lane);
    }
    DI void rows8(int r0, int lane) const {
        const void* hin[8]; const bf16_t* yr[8]; void* ho[8]; bf16_t* xo[8];
#pragma unroll
        for (int q = 0; q < 8; ++q) { const size_t o = (size_t)(r0 + q) * DM; yr[q] = y + o; xo[q] = xnp + o;
            hin[q] = mode == 0 ? (const void*)(xp + o) : (const void*)(h16 + o); ho[q] = mode == 2 ? (void*)(out + O_YP + o) : (void*)(h16 + o); }
        if (mode == 0) res_rows<false, true, 8>(hin, yr, gpost, gnext, ho, xo, true, lane);
        else if (mode == 1) res_rows<true, true, 8>(hin, yr, gpost, gnext, ho, xo, true, lane);
        else res_rows<true, false, 8>(hin, yr, gpost, gnext, ho, xo, false, lane);
    }
};

DI void s5_tables(const Params& p, int g, LAS unsigned char* lds, bf16_t* Bt1, bf16_t* Bt2, const int tid) {
    LAS float* pwr = (LAS float*)lds;
    LAS float* pwi = pwr + 17 * 64;
    LAS float* bbr = pwi + 17 * 64;
    LAS float* bbi = bbr + 1024;
    LAS float* cr = bbi + 1024;
    LAS float* ci = cr + 1024;
    LAS float* Kd = ci + 1024;
    const float dt = __expf(p.in[12][g]);
    const float* lre = p.in[10] + g * 64; const float* lim = p.in[11] + g * 64;
    for (int it = tid; it < 17 * 64; it += 512) { const int d = it >> 6, q = it & 63; const float zr = lre[q] * dt * (float)d, zi = lim[q] * dt * (float)d;
        float s, c; sincos_acc(zi, s, c); const float mag = __expf(zr); pwr[it] = mag * c; pwi[it] = mag * s; }
    for (int it = tid; it < 1024; it += 512) { const int q = it >> 4, i = it & 15;
        const float lr = lre[q], li = lim[q], zr = lr * dt, zi = li * dt;
        float s, c, sh, ch; sincos_acc(zi, s, c); sincos_acc(0.5f * zi, sh, ch);
        const float em1 = expm1f(zr); const float nr = em1 * c - 2.f * sh * sh, ni = (em1 + 1.f) * s;
        const float den = 1.f / (lr * lr + li * li); const float fr_ = (nr * lr + ni * li) * den, fi_ = (ni * lr - nr * li) * den;
        const float br = p.in[13][(size_t)g * 1024 + it], bi = p.in[14][(size_t)g * 1024 + it];
        bbr[it] = fr_ * br - fi_ * bi; bbi[it] = fr_ * bi + fi_ * br;
        cr[it] = p.in[15][(size_t)g * 1024 + it]; ci[it] = p.in[16][(size_t)g * 1024 + it]; }
    __syncthreads();
    for (int it = tid; it < 4096; it += 512) { const int d = it >> 8, i = (it >> 4) & 15, j = it & 15; float a = 0.f;
        for (int q = 0; q < 64; ++q) { const float c_r = cr[i * 64 + q], c_i = ci[i * 64 + q], p_r = pwr[d * 64 + q], p_i = pwi[d * 64 + q];
            const float xr = c_r * p_r - c_i * p_i, xi = c_r * p_i + c_i * p_r; a += xr * bbr[q * 16 + j] - xi * bbi[q * 16 + j]; }
        Kd[it] = a; }
    __syncthreads();
    for (int it = tid; it < 256 * 32; it += 512) { const int n = it >> 5, k0 = (it & 31) * 8; float v[8];
#pragma unroll
        for (int e = 0; e < 8; ++e) { const int k = k0 + e, s = k >> 4, i = k & 15; float val = 0.f;
            if (n < 128) { const int q = n & 63; const float p_r = pwr[(15 - s) * 64 + q], p_i = pwi[(15 - s) * 64 + q], b_r = bbr[q * 16 + i], b_i = bbi[q * 16 + i];
                val = n < 64 ? (p_r * b_r - p_i * b_i) : (p_r * b_i + p_i * b_r); }
            v[e] = val; }
        u32x4 o; o.x = pk2(v[0], v[1]); o.y = pk2(v[2], v[3]); o.z = pk2(v[4], v[5]); o.w = pk2(v[6], v[7]);
        *(u32x4*)(Bt1 + (size_t)n * 256 + k0) = o; }
    for (int it = tid; it < 256 * 48; it += 512) { const int n = it / 48, k0 = (it % 48) * 8; const int r = n >> 4, i = n & 15; float v[8];
#pragma unroll
        for (int e = 0; e < 8; ++e) { const int k = k0 + e; float val;
            if (k < 128) { const int q = k & 63; const float c_r = cr[i * 64 + q], c_i = ci[i * 64 + q], p_r = pwr[(r + 1) * 64 + q], p_i = pwi[(r + 1) * 64 + q];
                val = k < 64 ? (c_r * p_r - c_i * p_i) : -(c_r * p_i + c_i * p_r); }
            else { const int kk = k - 128, s = kk >> 4, j = kk & 15; val = s <= r ? Kd[(r - s) * 256 + i * 16 + j] : 0.f; }
            v[e] = val; }
        u32x4 o; o.x = pk2(v[0], v[1]); o.y = pk2(v[2], v[3]); o.z = pk2(v[4], v[5]); o.w = pk2(v[6], v[7]);
        *(u32x4*)(Bt2 + (size_t)n * 384 + k0) = o; }
    __syncthreads();
}

DI void s5_sample_unit(const Params& p, int u, const float* uss, bf16_t* z, int lane) {
    const int g = u & 31, b = u >> 5;
    const float dt = __expf(p.in[12][g]);
    const float lr = p.in[10][g * 64 + lane], li = p.in[11][g * 64 + lane], zr = lr * dt, zi = li * dt;
    float s, c, sh, ch; sincos_acc(zi, s, c); sincos_acc(0.5f * zi, sh, ch);
    const float em1 = expm1f(zr); const float nr = em1 * c - 2.f * sh * sh, ni = (em1 + 1.f) * s;
    const float lbr = nr + 1.f, lbi = ni;
    const float den = 1.f / (lr * lr + li * li); const float fr_ = (nr * lr + ni * li) * den, fi_ = (ni * lr - nr * li) * den;
    float hr = p.in[3][(((size_t)b * 32 + g) * 64 + lane) * 2], hi = p.in[3][(((size_t)b * 32 + g) * 64 + lane) * 2 + 1];
    const float* bre = p.in[13] + ((size_t)g * 64 + lane) * 16; const float* bim = p.in[14] + ((size_t)g * 64 + lane) * 16;
    const float* cre = p.in[15] + (size_t)g * 1024 + lane; const float* cim = p.in[16] + (size_t)g * 1024 + lane;
    for (int t = 0; t < 4; ++t) {
        const float* ur = uss + (size_t)(b * 4 + t) * 512 + g * 16;
        float bur = 0.f, bui = 0.f;
#pragma unroll
        for (int i = 0; i < 16; ++i) { const float uv = ur[i]; const float br = bre[i], bi = bim[i]; bur += (fr_ * br - fi_ * bi) * uv; bui += (fr_ * bi + fi_ * br) * uv; }
        const float n_r = lbr * hr - lbi * hi + bur, n_i = lbr * hi + lbi * hr + bui; hr = n_r; hi = n_i;
        float yv = 0.f;
#pragma unroll
        for (int i = 0; i < 16; ++i) { float a = cre[i * 64] * hr - cim[i * 64] * hi; a = wave_sum(a); if (lane == i) yv = a; }
        if (lane < 16) { const float y = yv + p.in[17][g * 16 + lane] * ur[lane]; z[(size_t)(NP + b * 4 + t) * 512 + g * 16 + lane] = (bf16_t)(pk2(gelu_tanh(y), 0.f) & 0xffffu); }
    }
    float* o = p.out + O_S5S + (((size_t)b * 32 + g) * 64 + lane) * 2; o[0] = hr; o[1] = hi;
}

constexpr int ATT_BUF = 69632, ATT_VOFF = 34816, ATT_OST = 2 * ATT_BUF, LDS_CTL = ATT_OST + 8 * 2304;
struct AttUnit { int pat, b, h, dil, l0; size_t rowbase; };
DI AttUnit att_decode(int bu) { AttUnit u; const int tile = bu & 63; u.h = (bu >> 6) & 15; u.b = (bu >> 10) & 3; u.pat = bu >> 12; const int dsh = u.pat * 2; u.dil = 1 << dsh;
    const int rho = tile & (u.dil - 1); u.l0 = (tile >> dsh) * 128; u.rowbase = (size_t)u.b * TP + rho; return u; }
DI void att_stage(const AttUnit& u, const bf16_t* Kb, const bf16_t* Vb, LAS unsigned char* buf, int wave, int lane) {
    const int lmax = (TP >> (2 * u.pat)) - 1;
    for (int n = wave; n < 34; n += 8) { const int r0 = n * 8; const int row = r0 + (lane >> 3); const int c = (lane & 7) ^ (row & 7);
        int lk = u.l0 - 128 + row; lk = lk < 0 ? 0 : (lk > lmax ? lmax : lk); const size_t off = (u.rowbase + (size_t)u.dil * lk) * 1024 + u.h * 64 + c * 8;
        __builtin_amdgcn_global_load_lds((const unsigned*)(Kb + off), (LAS unsigned*)(buf + r0 * 128), 16, 0, 0);
        __builtin_amdgcn_global_load_lds((const unsigned*)(Vb + off), (LAS unsigned*)(buf + ATT_VOFF + r0 * 128), 16, 0, 0); }
}
DI void att_loadq(const AttUnit& u, const bf16_t* Q, int wave, int lane, bf16x8 (&qf)[2]) {
    const int i = lane & 15, g = lane >> 4; const bf16_t* q = Q + (u.rowbase + (size_t)u.dil * (u.l0 + 16 * wave + i)) * 1024 + u.h * 64 + 8 * g;
    qf[0] = *(const bf16x8*)q; qf[1] = *(const bf16x8*)(q + 32);
}
DI void att_compute(const AttUnit& u, const bf16x8 (&qf)[2], LAS unsigned char* buf, LAS unsigned char* ost, bf16_t* Op, float* lse, int wave, int lane) {
    const int i = lane & 15, g = lane >> 4;
    const int Lw = u.l0 + 16 * wave;
    unsigned koff[2][2], voff[4];
#pragma unroll
    for (int kbl = 0; kbl < 2; ++kbl)
#pragma unroll
        for (int s = 0; s < 2; ++s) koff[kbl][s] = (unsigned)((16 * wave + 16 * kbl + i) * 128 + (((4 * s + g) ^ (i & 7)) * 16));
    { const int q = i >> 2, pp = i & 3, r = 4 * g + q;
#pragma unroll
      for (int db = 0; db < 4; ++db) voff[db] = (unsigned)((16 * wave + r) * 128 + (((2 * db + (pp >> 1)) ^ (r & 7)) * 16) + 8 * (pp & 1)); }
    f32x4 st[5][2];
#pragma unroll
    for (int ks = 0; ks < 5; ++ks)
#pragma unroll
        for (int kbl = 0; kbl < 2; ++kbl) {
            if (ks == 4 && kbl == 1) { st[ks][kbl] = (f32x4){0.f, 0.f, 0.f, 0.f}; continue; }
            const bf16x8 k0 = *(const LAS bf16x8*)(buf + ks * 4096 + koff[kbl][0]), k1 = *(const LAS bf16x8*)(buf + ks * 4096 + koff[kbl][1]);
            f32x4 a = (f32x4){0.f, 0.f, 0.f, 0.f};
            a = __builtin_amdgcn_mfma_f32_16x16x32_bf16(k0, qf[0], a, 0, 0, 0);
            a = __builtin_amdgcn_mfma_f32_16x16x32_bf16(k1, qf[1], a, 0, 0, 0); st[ks][kbl] = a; }
#pragma unroll
    for (int r = 0; r < 4; ++r) { if (i > 4 * g + r) st[0][0][r] = -INFINITY; if (4 * g + r > i) st[4][0][r] = -INFINITY; }
    if (Lw < 128) {
#pragma unroll
        for (int ks = 0; ks < 4; ++ks)
#pragma unroll
            for (int kbl = 0; kbl < 2; ++kbl)
#pragma unroll
                for (int r = 0; r < 4; ++r) if (Lw - 128 + 32 * ks + 16 * kbl + 4 * g + r < 0) st[ks][kbl][r] = -INFINITY; }
    float mx = -INFINITY;
#pragma unroll
    for (int ks = 0; ks < 5; ++ks)
#pragma unroll
        for (int kbl = 0; kbl < 2; ++kbl) { if (ks == 4 && kbl == 1) continue;
#pragma unroll
            for (int r = 0; r < 4; ++r) mx = fmaxf(mx, st[ks][kbl][r]); }
    mx = fmaxf(mx, __shfl_xor(mx, 16)); mx = fmaxf(mx, __shfl_xor(mx, 32));
    float ps = 0.f; bf16x8 pf[5];
#pragma unroll
    for (int ks = 0; ks < 5; ++ks) {
#pragma unroll
        for (int kbl = 0; kbl < 2; ++kbl) { if (ks == 4 && kbl == 1) continue;
#pragma unroll
            for (int r = 0; r < 4; ++r) { const float pv = __builtin_amdgcn_exp2f(st[ks][kbl][r] - mx); st[ks][kbl][r] = pv; ps += pv; } }
        u32x4 pw; pw.x = pk2(st[ks][0][0], st[ks][0][1]); pw.y = pk2(st[ks][0][2], st[ks][0][3]); pw.z = pk2(st[ks][1][0], st[ks][1][1]); pw.w = pk2(st[ks][1][2], st[ks][1][3]);
        pf[ks] = __builtin_bit_cast(bf16x8, pw); }
    ps += __shfl_xor(ps, 16); ps += __shfl_xor(ps, 32);
    f32x4 o[4];
#pragma unroll
    for (int db = 0; db < 4; ++db) o[db] = (f32x4){0.f, 0.f, 0.f, 0.f};
    const unsigned vb = (unsigned)(size_t)buf + (unsigned)ATT_VOFF;
#pragma unroll
    for (int ks = 0; ks < 5; ++ks) {
        s16x4 lo[4], hi[4]; const unsigned va = vb + ks * 4096;
        asm volatile("ds_read_b64_tr_b16 %0, %8\n\tds_read_b64_tr_b16 %1, %9\n\tds_read_b64_tr_b16 %2, %10\n\tds_read_b64_tr_b16 %3, %11\n\t"
                     "ds_read_b64_tr_b16 %4, %8 offset:2048\n\tds_read_b64_tr_b16 %5, %9 offset:2048\n\tds_read_b64_tr_b16 %6, %10 offset:2048\n\tds_read_b64_tr_b16 %7, %11 offset:2048\n\t"
                     "s_waitcnt lgkmcnt(0)"
                     : "=&v"(lo[0]), "=&v"(lo[1]), "=&v"(lo[2]), "=&v"(lo[3]), "=&v"(hi[0]), "=&v"(hi[1]), "=&v"(hi[2]), "=&v"(hi[3])
                     : "v"(va + voff[0]), "v"(va + voff[1]), "v"(va + voff[2]), "v"(va + voff[3]) : "memory");
#pragma unroll
        for (int db = 0; db < 4; ++db) { const bf16x8 vf = __builtin_shufflevector(lo[db], hi[db], 0, 1, 2, 3, 4, 5, 6, 7);
            o[db] = __builtin_amdgcn_mfma_f32_16x16x32_bf16(vf, pf[ks], o[db], 0, 0, 0); }
    }
    const float inv = 1.f / ps;
#pragma unroll
    for (int db = 0; db < 4; ++db) { const f32x4 v = o[db] * inv; u32x2 w; w.x = pk2(v[0], v[1]); w.y = pk2(v[2], v[3]); *(LAS u32x2*)(ost + i * 144 + (16 * db + 4 * g) * 2) = w; }
    const size_t orow0 = (size_t)u.pat * MT + u.rowbase;
    if (g == 0) lse[(orow0 + (size_t)u.dil * (Lw + i)) * 16 + u.h] = mx + __builtin_amdgcn_logf(ps);
    LDS_WAIT();
#pragma unroll
    for (int n = 0; n < 2; ++n) { const int c = lane + 64 * n, rr = c >> 3, ch = c & 7; const u32x4 v = *(const LAS u32x4*)(ost + rr * 144 + ch * 16);
        *(u32x4*)(Op + (orow0 + (size_t)u.dil * (Lw + rr)) * 1024 + u.h * 64 + ch * 8) = v; }
    LDS_WAIT();
}
DI void attn_prompt_phase(const bf16_t* Q, const bf16_t* Kb, const bf16_t* Vb, bf16_t* Op, float* lse, LAS unsigned char* lds, int bx, int G, int wave, int lane) {
    constexpr int NU = 3 * 4096;
    int bu = bx; if (bu >= NU) return;
    AttUnit u = att_decode(bu); bf16x8 qn[2];
    att_stage(u, Kb, Vb, lds, wave, lane); att_loadq(u, Q, wave, lane, qn);
    int par = 0;
    for (;;) {
        asm volatile("s_waitcnt vmcnt(0)" ::: "memory");
        __syncthreads();
        bf16x8 qf[2]; qf[0] = qn[0]; qf[1] = qn[1];
        const AttUnit cur = u; const int nb = bu + G; const bool more = nb < NU;
        if (more) { u = att_decode(nb); att_stage(u, Kb, Vb, lds + (par ^ 1) * ATT_BUF, wave, lane); att_loadq(u, Q, wave, lane, qn); }
        att_compute(cur, qf, lds + par * ATT_BUF, lds + ATT_OST + wave * 2304, Op, lse, wave, lane);
        if (!more) break;
        bu = nb; par ^= 1;
    }
    __syncthreads();
}

DI void attn_sample_unit(const Params& p, int u, const bf16_t* Q, const bf16_t* Kb, const bf16_t* Vb, bf16_t* att, LAS float* sl, int lane) {
    const int h = u & 15, t = (u >> 4) & 3, b = u >> 6;
    const size_t qrow = (size_t)NP + b * 4 + t;
    const float* ck = p.in[4]; const float* cv = p.in[5];
    sl[lane] = bf2f(Q[qrow * 1024 + h * 64 + lane]);
    LDS_WAIT();
    float mx = -INFINITY;
#pragma unroll 1
    for (int e = 0; e < 9; ++e) { const int pat = e / 3, r = e - 3 * pat; const int dil = 1 << (2 * pat);
        const int j = lane + 64 * r; const bool valid = j <= 128; const int idx = 2048 + t - dil * (valid ? j : 0);
        float dot = 0.f;
        if (idx >= 2048) { const bf16_t* kp = Kb + ((size_t)NP + b * 4 + (idx - 2048)) * 1024 + h * 64;
#pragma unroll
            for (int d8 = 0; d8 < 8; ++d8) { const u32x4 kw = *(const u32x4*)(kp + 8 * d8); const f32x4 q0 = *(const LAS f32x4*)(sl + 8 * d8), q1 = *(const LAS f32x4*)(sl + 8 * d8 + 4);
                dot += (bflo(kw.x) * q0[0] + bfhi(kw.x) * q0[1]) + (bflo(kw.y) * q0[2] + bfhi(kw.y) * q0[3]) + (bflo(kw.z) * q1[0] + bfhi(kw.z) * q1[1]) + (bflo(kw.w) * q1[2] + bfhi(kw.w) * q1[3]); } }
        else { const float* kp = ck + (((size_t)b * 2048 + idx) * 16 + h) * 64;
#pragma unroll
            for (int d4 = 0; d4 < 16; ++d4) { const f32x4 kv = *(const f32x4*)(kp + 4 * d4); const f32x4 qv = *(const LAS f32x4*)(sl + 4 * d4); dot += (kv[0] * qv[0] + kv[1] * qv[1]) + (kv[2] * qv[2] + kv[3] * qv[3]); } }
        if (valid) { sl[64 + pat * 192 + j] = dot; mx = fmaxf(mx, dot); } }
    mx = wave_max(mx);
    LDS_WAIT();
    float ls = 0.f;
#pragma unroll 1
    for (int e = 0; e < 9; ++e) { const int pat = e / 3, r = e - 3 * pat; const int j = lane + 64 * r;
        if (j <= 128) { const float pv = __builtin_amdgcn_exp2f(sl[64 + pat * 192 + j] - mx); sl[64 + pat * 192 + j] = pv; ls += pv; } }
    ls = wave_sum(ls);
    LDS_WAIT();
    { const int kg = lane >> 4, d4 = lane & 15; f32x4 acc = (f32x4){0.f, 0.f, 0.f, 0.f};
#pragma unroll 1
      for (int pat = 0; pat < 3; ++pat) { const int dil = 1 << (2 * pat);
#pragma unroll
        for (int jj = 0; jj < 33; ++jj) { const int j = kg + 4 * jj; int idx = 2048 + t - dil * j; const bool use = (j <= 128) && (idx < 2048);
            idx = idx < 0 ? 0 : (idx > 2047 ? 2047 : idx); const float pv = use ? sl[64 + pat * 192 + (j > 128 ? 128 : j)] : 0.f;
            const f32x4 vv = *(const f32x4*)(cv + (((size_t)b * 2048 + idx) * 16 + h) * 64 + 4 * d4);
            acc += vv * pv; }
        if (kg == 0) { for (int j = 0; dil * j <= t; ++j) { const int idx = 2048 + t - dil * j; const float pv = sl[64 + pat * 192 + j];
            const u32x2 w = *(const u32x2*)(Vb + ((size_t)NP + b * 4 + (idx - 2048)) * 1024 + h * 64 + 4 * d4);
            acc += (f32x4){bflo(w.x), bfhi(w.x), bflo(w.y), bfhi(w.y)} * pv; } } }
#pragma unroll
      for (int e = 0; e < 4; ++e) { float a = acc[e]; a += __shfl_xor(a, 16); a += __shfl_xor(a, 32); acc[e] = a; }
      const float inv = 1.f / ls;
      if (kg == 0) { u32x2 w; w.x = pk2(acc[0] * inv, acc[1] * inv); w.y = pk2(acc[2] * inv, acc[3] * inv); *(u32x2*)(att + qrow * 1024 + h * 64 + 4 * d4) = w; } }
    LDS_WAIT();
}


#define XB_TMO      128
#define XB_XCNT(j)  (256  + 64 * (j))
#define XB_XSUB(j)  (1280 + 64 * (j))
#define XB_XGEN(j)  (2304 + 64 * (j))
#define XB_TOP      3328
#define XB_TOPGEN   3392
#define XCD_BAR_WORDS 3456
#define XB_SPIN_CAP (1u << 22)
DI unsigned xb_ld(unsigned* p)              { return __hip_atomic_load(p, __ATOMIC_RELAXED, __HIP_MEMORY_SCOPE_AGENT); }
DI unsigned xb_add(unsigned* p, unsigned v) { return __hip_atomic_fetch_add(p, v, __ATOMIC_RELAXED, __HIP_MEMORY_SCOPE_AGENT); }
DI unsigned xb_xcc_id() { return (unsigned)__builtin_amdgcn_s_getreg((3 << 11) | 20) & 0xFu; }
#define XB_SPIN(cond, bar) do { unsigned _sp = 0; while (cond) { __builtin_amdgcn_s_sleep(1); \
    if ((++_sp & 255u) == 0u) { if (xb_ld(&(bar)[XB_TMO])) break; if (_sp > XB_SPIN_CAP) { atomicAdd(&(bar)[XB_TMO], 1u); break; } } } } while (0)
struct XcdBarrier { unsigned* bar; unsigned x; volatile LAS unsigned* st; bool w0; };
DI XcdBarrier xcd_barrier_post(unsigned* bar, volatile LAS unsigned* st, const bool w0) {
    XcdBarrier b; b.bar = bar; b.x = xb_xcc_id(); b.st = st; b.w0 = w0;
    if (w0 && lane_id() == 0) (void)xb_add(&bar[XB_XCNT(b.x)], 1u);
    return b;
}
DI void xcd_barrier_complete(unsigned* bar, unsigned x, unsigned& nloc, unsigned& nx) {
    const unsigned G = gridDim.x * gridDim.y * gridDim.z;
    unsigned sum, cnt, mine, sp = 0u;
    for (;;) {
        sum = 0u; cnt = 0u; mine = 0u;
#pragma unroll
        for (unsigned j = 0; j < 16; ++j) { const unsigned c = xb_ld(&bar[XB_XCNT(j)]); sum += c; cnt += (c > 0u) ? 1u : 0u; mine = (j == x) ? c : mine; }
        if (sum == G) break;
        __builtin_amdgcn_s_sleep(1);
        if ((++sp & 255u) == 0u) { if (xb_ld(&bar[XB_TMO])) break; if (sp > XB_SPIN_CAP) { atomicAdd(&bar[XB_TMO], 1u); break; } }
    }
    nloc = mine > 0u ? mine : 1u; nx = cnt > 0u ? cnt : 1u;
}
DI void xcd_barrier(const XcdBarrier& b) {
    asm volatile("s_waitcnt vmcnt(0)" ::: "memory");
    __syncthreads();
    if (b.w0 && lane_id() == 0) {
        unsigned* bar = b.bar;
        __builtin_amdgcn_s_waitcnt(0);
        unsigned nloc = b.st[0], nx = b.st[1];
        if (nloc == 0u) { xcd_barrier_complete(bar, b.x, nloc, nx); b.st[0] = nloc; b.st[1] = nx; }
        const unsigned old = xb_add(&bar[XB_XSUB(b.x)], 1u);
        const unsigned gen = old / nloc;
        if (old + 1u == (gen + 1u) * nloc) {
            __builtin_amdgcn_fence(__ATOMIC_RELEASE, "agent");
            asm volatile("s_waitcnt vmcnt(0)" ::: "memory");
            const unsigned og = xb_add(&bar[XB_TOP], 1u);
            const unsigned tg = og / nx;
            if (og + 1u == (tg + 1u) * nx) xb_add(&bar[XB_TOPGEN], 1u);
            else XB_SPIN(xb_ld(&bar[XB_TOPGEN]) == tg, bar);
            __builtin_amdgcn_fence(__ATOMIC_ACQUIRE, "agent");
            xb_add(&bar[XB_XGEN(b.x)], 1u);
            asm volatile("s_waitcnt vmcnt(0)" ::: "memory");
        } else {
            XB_SPIN(xb_ld(&bar[XB_XGEN(b.x)]) == gen, bar);
            __builtin_amdgcn_fence(__ATOMIC_ACQUIRE, "agent");
            asm volatile("s_waitcnt vmcnt(0)" ::: "memory");
        }
    }
    __syncthreads();
}

#define w_in_t ((bf16_t*)(ws + WS_WIN))
#define w_out_t ((bf16_t*)(ws + WS_WOUT))
#define w_glu_t ((bf16_t*)(ws + WS_WGLU))
#define w_pool_t ((bf16_t*)(ws + WS_WPOOL))
#define w_o_t ((bf16_t*)(ws + WS_WO))
#define w_qkv_t ((bf16_t*)(ws + WS_WQKV))
#define Bt1 ((bf16_t*)(ws + WS_BT1))
#define Bt2 ((bf16_t*)(ws + WS_BT2))
#define rowss ((float*)(ws + WS_ROWSS))
#define uss ((float*)(ws + WS_USS))
#define lse ((float*)(ws + WS_LSE))
#define xn ((bf16_t*)(ws + WS_XN))
#define ybuf ((bf16_t*)(ws + WS_Y))
#define hbuf16 ((bf16_t*)(ws + WS_H))
#define Ap ((bf16_t*)(ws + WS_AP))
#define Sbuf ((float*)(ws + WS_S))
#define upool ((float*)(ws + WS_UPOOL))
#define dbuf ((bf16_t*)(ws + WS_D))
#define zbuf ((bf16_t*)(ws + WS_Z))
#define ycat ((bf16_t*)(ws + WS_YCAT))
#define hact ((bf16_t*)(ws + WS_HACT))
#define Qb ((bf16_t*)(ws + WS_Q))
#define Kb ((bf16_t*)(ws + WS_K))
#define Vb ((bf16_t*)(ws + WS_V))
#define Op ((bf16_t*)(ws + WS_OP))
#define att ((bf16_t*)(ws + WS_ATT))
#define gains (p.in[6])
#ifndef PHMASK
#define PHMASK 0xFFFFFFFFu
#endif
#ifndef DUPMASK
#define DUPMASK 0u
#endif
#define PHASE_BEGIN(k) if (((PHMASK >> (k)) & 1u) && p.ph_lo <= (k) && (k) < p.ph_hi) { for (int _rep = 0; _rep < 1 + (int)((DUPMASK >> (k)) & 1u); ++_rep) { if (_rep) __syncthreads(); const int lane = lane_id(); const int tid = wave * 64 + lane; const int gt = bx * 512 + tid; (void)gt;
#define PHASE_END(k) } } if (p.ph_lo <= (k) && (k) + 1 < p.ph_hi) { if ((k) == 0) { grid.sync(); xbar = xcd_barrier_post((unsigned*)(p.ws + WS_CTL), (volatile LAS unsigned*)(lds + 157696), wave == 0); } else xcd_barrier(xbar); }

template <int layer>
DI void layer_tail(const Params& p, LAS unsigned char* lds, cg::grid_group& grid, XcdBarrier& xbar, const int bx, const int G, const int gw, const int NGW, const int wave) {
    unsigned char* ws = p.ws;
    constexpr int pb = 6 + layer * 8;
    const float* gl = gains + (size_t)layer * 4 * DM;
        PHASE_BEGIN(pb)
        { const bf16_t* A = layer == 0 ? ycat : att; const bf16_t* W = layer == 0 ? w_out_t : w_o_t;
          { UStd<EpiY> U{A, W, (size_t)256 * DM, (size_t)256 * DM, 0, 128, 4, G, bx, EpiY{ybuf, 0, 0}};
            gemm_phase(lds, wave, DM, DM, DM, U); }
          { EpiY E{ybuf, 0, 0}; mini_gemm(A, DM, W, DM, DM, 1024, 0, E, bx, G, wave, lane); } }
        PHASE_END(pb)
        PHASE_BEGIN(pb + 1)
        { const RowPass rp{layer == 0 ? 0 : 1, gl + DM, gl + 2 * DM, p.in[0], p.in[1], hbuf16, ybuf, xn, p.out};
          for (int q = gw; q < NP / 4; q += NGW) rp.rows4(q * 4, lane);
          for (int r = NP + (NGW - 1 - gw); r < NT; r += NGW) rp.row(r, lane); }
        PHASE_END(pb + 1)
        PHASE_BEGIN(pb + 2)
        { const bf16_t* W = (const bf16_t*)(ws + (layer ? WS_GU1 : WS_GU0));
          { UStd<EpiGU> U{xn, W, (size_t)256 * DM, (size_t)256 * DM, 0, 128, 22, G, bx, EpiGU{hact, 0, 0}};
            gemm_phase(lds, wave, DM, DM, DM, U); }
          { EpiGU E{hact, 0, 0}; mini_gemm_gu(xn, W, E, bx, G, wave, lane); } }
        PHASE_END(pb + 2)
        PHASE_BEGIN(pb + 3)
        { const bf16_t* W = (const bf16_t*)(ws + (layer ? WS_DN1 : WS_DN0));
          { UStd<EpiY> U{hact, W, (size_t)256 * FF, (size_t)256 * FF, 0, 128, 4, G, bx, EpiY{ybuf, 0, 0}};
            gemm_phase(lds, wave, FF, FF, FF, U); }
          { EpiY E{ybuf, 0, 0}; mini_gemm(hact, FF, W, FF, FF, 1024, 0, E, bx, G, wave, lane); } }
        PHASE_END(pb + 3)
        PHASE_BEGIN(pb + 4)
        { const RowPass rp{layer == 0 ? 1 : 2, gl + 3 * DM, gains + 4 * DM, p.in[0], p.in[1], hbuf16, ybuf, xn, p.out};
          for (int q = gw; q < NP / 4; q += NGW) rp.rows4(q * 4, lane);
          for (int r = NP + (NGW - 1 - gw); r < NT; r += NGW) rp.row(r, lane); }
        PHASE_END(pb + 4)
    }

__global__ void __launch_bounds__(512, 2) mega(Params p) {
    extern __shared__ __attribute__((aligned(16))) unsigned char lds_raw[];
    LAS unsigned char* lds = (LAS unsigned char*)lds_raw;
    cg::grid_group grid = cg::this_grid();
    const int wave = __builtin_amdgcn_readfirstlane((int)threadIdx.x >> 6);
    const int G = gridDim.x, bx = blockIdx.x;
    const int gw = bx * 8 + wave, NGW = G * 8;
    const int NGT = G * 512;
    unsigned char* ws = p.ws;
    XcdBarrier xbar; xbar.bar = (unsigned*)(ws + WS_CTL); xbar.x = 0; xbar.st = (volatile LAS unsigned*)(lds + 157696); xbar.w0 = wave == 0;
    { const int tid = wave * 64 + lane_id();
      if (tid < 64) ((LAS unsigned*)(lds + 157696))[tid] = 0u;
      if (bx == 0) { for (int i = tid; i < 4096; i += 512) ((unsigned*)(ws + WS_CTL))[i] = 0u; } }
    __syncthreads();

    PHASE_BEGIN(0)
    {
        if (bx < 32) { s5_tables(p, bx, lds, Bt1 + (size_t)bx * 65536, Bt2 + (size_t)bx * 98304, tid); }
        LAS float* scr = (LAS float*)(lds + wave * 16384);
        constexpr int I_IN = 512, I_OUT = 512, I_GLU = 128, I_POOL = 32, I_O = 512, I_QKV = 1536, I_G = 1408, I_D = 1408;
        constexpr int NITEMS = I_IN + I_OUT + I_GLU + I_POOL + I_O + I_QKV + 4 * I_G + 2 * I_D;
        for (int it = gw; it < NITEMS; it += NGW) {
            int r = it;
            if (r < I_IN) { tr_plain(p.in[7], 1024, 1024, w_in_t, r, scr, lane); continue; } r -= I_IN;
            if (r < I_OUT) { tr_plain(p.in[20], 1024, 1024, w_out_t, r, scr, lane); continue; } r -= I_OUT;
            if (r < I_GLU) { tr_plain(p.in[18], 512, 512, w_glu_t, r, scr, lane); continue; } r -= I_GLU;
            if (r < I_POOL) { const int gg = r >> 3, q = r & 7, kb = q >> 2, nb = q & 3;
                transpose_item(p.in[8] + (size_t)gg * 16384, 128, 64 * kb, 32 * nb, w_pool_t, 256, gg * 128 + 32 * nb, (gg & 1) * 128 + 64 * kb, scr, lane); continue; } r -= I_POOL;
            if (r < I_O) { tr_plain(p.in[22], 1024, 1024, w_o_t, r, scr, lane); continue; } r -= I_O;
            if (r < I_QKV) { tr_plain(p.in[21], 1024, 3072, w_qkv_t, r, scr, lane); continue; } r -= I_QKV;
            if (r < 4 * I_G) { const int which = r / I_G, q = r % I_G; const int layer = which >> 1, up = which & 1;
                const float* W = p.in[up ? 24 : 23] + (size_t)layer * 1024 * FF; bf16_t* WT = (bf16_t*)(ws + (layer ? WS_GU1 : WS_GU0));
                const int nblk = FF / 32, kb = q / nblk, nb = q % nblk, n0 = 32 * nb;
                transpose_item(W, FF, 64 * kb, n0, WT, 1024, (n0 >> 7) * 256 + up * 128 + (n0 & 127), 64 * kb, scr, lane); continue; } r -= 4 * I_G;
            { const int layer = r / I_D, q = r % I_D; tr_plain(p.in[25] + (size_t)layer * FF * 1024, FF, 1024, (bf16_t*)(ws + (layer ? WS_DN1 : WS_DN0)), q, scr, lane); }
        }
        for (int it = gt; it < 512 * 16; it += NGT) { const int n = it >> 4, c8 = it & 15; const int gg = n >> 7;
            *(u32x4*)(w_pool_t + (size_t)n * 256 + ((gg & 1) ^ 1) * 128 + c8 * 8) = (u32x4){0u, 0u, 0u, 0u}; }
        if (bx >= 32 || G <= 32) { const int gwn = G > 32 ? (bx - 32) * 8 + wave : gw, ngwn = G > 32 ? (G - 32) * 8 : NGW;
          for (int r = gwn; r < NT; r += 2 * ngwn) { const int r2 = r + ngwn; const bool two = r2 < NT;
            norm_row2(in_row(p, r), in_row(p, two ? r2 : r), gains, xn + (size_t)r * DM, xn + (size_t)(two ? r2 : r) * DM, lane); } }
    }
    PHASE_END(0)

    PHASE_BEGIN(1)
    { UStd<EpiProj> U{xn, w_in_t, (size_t)256 * DM, (size_t)256 * DM, 0, 128, 4, G, bx, EpiProj{upool, Ap, uss, 0, 0}};
      gemm_phase(lds, wave, DM, DM, DM, U);
      { EpiProj E{upool, Ap, uss, 0, 0}; mini_gemm(xn, DM, w_in_t, DM, DM, 1024, 0, E, bx, G, wave, lane); } }
    PHASE_END(1)

    PHASE_BEGIN(2)
    {
        { US5<EpiS1> U{Ap + 128, Bt1, (size_t)65536, G, bx, EpiS1{Sbuf, 0, 0}};
          gemm_phase(lds, wave, 384, 256, 256, U); }
        for (int u = gw; u < 1024; u += NGW) s5_sample_unit(p, u, uss, zbuf, lane);
        for (int it = gt; it < (NP / 16) * 128; it += NGT) { const int cq = it & 127, run = it >> 7; const int c = cq * 4, gi = c >> 7, w = 2 << gi;
            const int t0 = run * 16, tb0 = t0 & (TP - 1); const float* up = upool + (size_t)t0 * 512 + c;
            f32x4 e[31];
#pragma unroll
            for (int k = 0; k < 31; ++k) { const int rel = k - 15; e[k] = (rel >= 1 - w && tb0 + rel >= 0) ? *(const f32x4*)(up + (ptrdiff_t)rel * 512) : (f32x4){0.f, 0.f, 0.f, 0.f}; }
            f32x4 sum = (f32x4){0.f, 0.f, 0.f, 0.f};
#pragma unroll
            for (int k = 0; k < 15; ++k) sum += e[k];
#pragma unroll
            for (int k = 0; k < 16; ++k) { const f32x4 uv = e[15 + k]; sum += uv; const int tb = tb0 + k; const int cnt = tb + 1 < w ? tb + 1 : w;
                const f32x4 dv = sum * (1.0f / (float)cnt) - uv; u32x2 o; o.x = pk2(dv[0], dv[1]); o.y = pk2(dv[2], dv[3]); *(u32x2*)(dbuf + (size_t)(t0 + k) * 512 + c) = o;
                f32x4 out_ = (f32x4){0.f, 0.f, 0.f, 0.f};
                if (w == 2) out_ = e[15 + k - 1]; else if (w == 4) out_ = e[15 + k - 3]; else if (w == 8) out_ = e[15 + k - 7]; else out_ = e[15 + k - 15];
                sum -= out_;
                if (tb >= TP - 15) *(f32x4*)(p.out + O_POOLP + ((size_t)(t0 >> 13) * 15 + (tb - (TP - 15))) * 512 + c) = uv; } }
        for (int it = gt; it < 32 * 128; it += NGT) { const int cq = it & 127, b = it >> 7; const int c = cq * 4, gi = c >> 7, w = 2 << gi;
            const float* sp = p.in[2] + (size_t)b * 15 * 512 + c; const float* up = upool + (size_t)(NP + b * 4) * 512 + c;
            for (int t = 0; t < 4; ++t) { f32x4 sum = (f32x4){0.f, 0.f, 0.f, 0.f};
                for (int s = 0; s < w; ++s) { const int e = 15 + t - s; sum += e >= 15 ? *(const f32x4*)(up + (size_t)(e - 15) * 512) : *(const f32x4*)(sp + (size_t)e * 512); }
                const f32x4 uv = *(const f32x4*)(up + (size_t)t * 512); const f32x4 dv = sum * (1.0f / (float)w) - uv;
                u32x2 o; o.x = pk2(dv[0], dv[1]); o.y = pk2(dv[2], dv[3]); *(u32x2*)(dbuf + (size_t)(NP + b * 4 + t) * 512 + c) = o; }
            for (int r = 0; r < 15; ++r) { const f32x4 v = r < 11 ? *(const f32x4*)(sp + (size_t)(r + 4) * 512) : *(const f32x4*)(up + (size_t)(r - 11) * 512);
                *(f32x4*)(p.out + O_POOLS + ((size_t)b * 15 + r) * 512 + c) = v; } }
    }
    PHASE_END(2)

    PHASE_BEGIN(3)
    {
        { const bool act = bx < 128; const int b = (bx >> 5) & 3, g = bx & 31;
          LAS float* ex = (LAS float*)lds;
          float c_r = 1.f, c_i = 0.f, hr = 0.f, hi = 0.f;
          const float* Sp = Sbuf + ((size_t)g * 2048 + b * 512 + wave * 64) * 128 + lane; bf16_t* Hp = Ap + ((size_t)g * 2048 + b * 512 + wave * 64) * 384 + lane;
          if (act) {
            const float dt = __expf(p.in[12][g]); const float zr = p.in[10][g * 64 + lane] * dt * 16.f, zi = p.in[11][g * 64 + lane] * dt * 16.f;
            float sn, cs; sincos_acc(zi, sn, cs); const float mag = __expf(zr); c_r = mag * cs; c_i = mag * sn;
            for (int c0 = 0; c0 < 64; c0 += 16) { float sr[16], si[16];
#pragma unroll
                for (int k = 0; k < 16; ++k) { sr[k] = Sp[(size_t)(c0 + k) * 128]; si[k] = Sp[(size_t)(c0 + k) * 128 + 64]; }
#pragma unroll
                for (int k = 0; k < 16; ++k) { const float n_r = c_r * hr - c_i * hi + sr[k], n_i = c_r * hi + c_i * hr + si[k]; hr = n_r; hi = n_i; } }
            ex[(wave * 64 + lane) * 2] = hr; ex[(wave * 64 + lane) * 2 + 1] = hi;
          }
          __syncthreads();
          if (act) {
            float l_r = c_r, l_i = c_i;
#pragma unroll
            for (int e = 0; e < 6; ++e) { const float t_r = l_r * l_r - l_i * l_i, t_i = 2.f * l_r * l_i; l_r = t_r; l_i = t_i; }
            hr = 0.f; hi = 0.f;
            for (int sg = 0; sg < wave; ++sg) { const float e_r = ex[(sg * 64 + lane) * 2], e_i = ex[(sg * 64 + lane) * 2 + 1];
                const float n_r = l_r * hr - l_i * hi + e_r, n_i = l_r * hi + l_i * hr + e_i; hr = n_r; hi = n_i; }
            for (int c0 = 0; c0 < 64; c0 += 16) { float sr[16], si[16];
#pragma unroll
                for (int k = 0; k < 16; ++k) { sr[k] = Sp[(size_t)(c0 + k) * 128]; si[k] = Sp[(size_t)(c0 + k) * 128 + 64]; }
#pragma unroll
                for (int k = 0; k < 16; ++k) { const unsigned w = pk2(hr, hi); Hp[(size_t)(c0 + k) * 384] = (bf16_t)(w & 0xffffu); Hp[(size_t)(c0 + k) * 384 + 64] = (bf16_t)(w >> 16);
                    const float n_r = c_r * hr - c_i * hi + sr[k], n_i = c_r * hi + c_i * hr + si[k]; hr = n_r; hi = n_i; } }
            if (wave == 7) { float* o = p.out + O_S5P + (((size_t)b * 32 + g) * 64 + lane) * 2; o[0] = hr; o[1] = hi; }
          }
        }
        __syncthreads();
        { UStd<EpiPool> U{dbuf, w_pool_t, (size_t)256 * 512, (size_t)256 * 256, 256, 128, 2, G, bx, EpiPool{ycat, p.in[9], 0, 0}};
          gemm_phase(lds, wave, 512, 256, 256, U); }
        { EpiPool E{ycat, p.in[9], 0, 0}; mini_gemm(dbuf, 512, w_pool_t, 256, 256, 512, 256, E, bx, G, wave, lane); }
    }
    PHASE_END(3)

    PHASE_BEGIN(4)
    { US5<EpiS2> U{Ap, Bt2, (size_t)98304, G, bx, EpiS2{zbuf, Ap, p.in[17], 0, 0}};
      gemm_phase(lds, wave, 384, 384, 384, U); }
    PHASE_END(4)

    PHASE_BEGIN(5)
    { UStd<EpiGlu> U{zbuf, w_glu_t, (size_t)256 * 512, (size_t)256 * 512, 0, 128, 2, G, bx, EpiGlu{ycat, zbuf, p.in[19], 0, 0}};
      gemm_phase(lds, wave, 512, 512, 512, U);
      { EpiGlu E{ycat, zbuf, p.in[19], 0, 0}; mini_gemm(zbuf, 512, w_glu_t, 512, 512, 512, 0, E, bx, G, wave, lane); } }
    PHASE_END(5)

    layer_tail<0>(p, lds, grid, xbar, bx, G, gw, NGW, wave);
            PHASE_BEGIN(11)
            { UStd<EpiQKV> U{xn, w_qkv_t, (size_t)256 * DM, (size_t)256 * DM, 0, 128, 12, G, bx, EpiQKV{Qb, p.out, 0, 0}};
              gemm_phase(lds, wave, DM, DM, DM, U);
              { EpiQKV E{Qb, p.out, 0, 0}; mini_gemm(xn, DM, w_qkv_t, DM, DM, 3072, 0, E, bx, G, wave, lane); } }
            PHASE_END(11)
            PHASE_BEGIN(12)
            {
                attn_prompt_phase(Qb, Kb, Vb, Op, lse, lds, bx, G, wave, lane);
            }
            PHASE_END(12)
            PHASE_BEGIN(13)
            {
              for (int pass = 0; pass < 2; ++pass) { const bool do_sample = (pass == 0) == ((wave & 1) == 0);
              if (do_sample) { for (int u = gw; u < 2048; u += NGW) attn_sample_unit(p, u, Qb, Kb, Vb, att, (LAS float*)(lds + wave * 8192), lane); }
              else for (int it = gt; it < NP * 128; it += NGT) { const int c8 = it & 127, row = it >> 7, h = c8 >> 3;
                const float l0 = lse[(size_t)row * 16 + h], l1 = lse[((size_t)MT + row) * 16 + h], l2 = lse[((size_t)2 * MT + row) * 16 + h];
                const float mx = fmaxf(l0, fmaxf(l1, l2)); float w0 = __builtin_amdgcn_exp2f(l0 - mx), w1 = __builtin_amdgcn_exp2f(l1 - mx), w2 = __builtin_amdgcn_exp2f(l2 - mx); const float inv = 1.f / (w0 + w1 + w2); w0 *= inv; w1 *= inv; w2 *= inv;
                const u32x4 a = *(const u32x4*)(Op + (size_t)row * 1024 + c8 * 8), b = *(const u32x4*)(Op + ((size_t)MT + row) * 1024 + c8 * 8), c = *(const u32x4*)(Op + ((size_t)2 * MT + row) * 1024 + c8 * 8);
                u32x4 o;
                o.x = pk2(w0 * bflo(a.x) + w1 * bflo(b.x) + w2 * bflo(c.x), w0 * bfhi(a.x) + w1 * bfhi(b.x) + w2 * bfhi(c.x));
                o.y = pk2(w0 * bflo(a.y) + w1 * bflo(b.y) + w2 * bflo(c.y), w0 * bfhi(a.y) + w1 * bfhi(b.y) + w2 * bfhi(c.y));
                o.z = pk2(w0 * bflo(a.z) + w1 * bflo(b.z) + w2 * bflo(c.z), w0 * bfhi(a.z) + w1 * bfhi(b.z) + w2 * bfhi(c.z));
                o.w = pk2(w0 * bflo(a.w) + w1 * bflo(b.w) + w2 * bflo(c.w), w0 * bfhi(a.w) + w1 * bfhi(b.w) + w2 * bfhi(c.w));
                *(u32x4*)(att + (size_t)row * 1024 + c8 * 8) = o; } } }
            PHASE_END(13)
            layer_tail<1>(p, lds, grid, xbar, bx, G, gw, NGW, wave);
}

constexpr int NPHASES = 19;

extern "C" void kernel_launch(void* const* d_in, const int* in_sizes, int n_in, void* d_out, int out_size, void* d_ws, size_t ws_size, hipStream_t stream) {
    static int grid = 0;
    if (grid == 0) {
        int dev = 0, cus = 0, per_cu = 0;
        hipGetDevice(&dev);
        hipDeviceGetAttribute(&cus, hipDeviceAttributeMultiprocessorCount, dev);
        hipFuncSetAttribute((const void*)mega, hipFuncAttributeMaxDynamicSharedMemorySize, LDS_BYTES);
        hipOccupancyMaxActiveBlocksPerMultiprocessor(&per_cu, (const void*)mega, 512, LDS_BYTES);
        if (per_cu < 1) per_cu = 1;
        grid = cus * 1;
        if (ws_size < WS_END) fprintf(stderr, "kernel_launch: workspace too small: %zu < %zu\n", ws_size, (size_t)WS_END);
        fprintf(stderr, "kernel_launch: cus %d per_cu %d grid %d n_in %d out %d ws %zu\n", cus, per_cu, grid, n_in, out_size, ws_size);
    }
    Params p{};
    for (int i = 0; i < 26; ++i) p.in[i] = (const float*)d_in[i];
    p.out = (float*)d_out; p.ws = (unsigned char*)d_ws; p.ph_lo = 0; p.ph_hi = NPHASES;
    void* args[] = {&p};
    hipError_t e = hipLaunchCooperativeKernel((const void*)mega, dim3(grid), dim3(512), args, LDS_BYTES, stream);
    if (e != hipSuccess) fprintf(stderr, "cooperative launch failed: %s (grid %d)\n", hipGetErrorString(e), grid);
}
```

```cpp
#include <hip/hip_runtime.h>
#include <hip/hip_cooperative_groups.h>
#include <cstdio>
#include <cstdint>
namespace cg = cooperative_groups;

#define LAS __attribute__((address_space(3)))
#define DI __device__ __forceinline__
typedef unsigned short bf16_t;
typedef short bf16x8 __attribute__((ext_vector_type(8)));
typedef short s16x4 __attribute__((ext_vector_type(4)));
typedef float f32x4 __attribute__((ext_vector_type(4)));
typedef unsigned u32x4 __attribute__((ext_vector_type(4)));
typedef unsigned u32x2 __attribute__((ext_vector_type(2)));
typedef __bf16 bf2_t __attribute__((ext_vector_type(2)));

constexpr int NP = 32768, NS = 128, NT = NP + NS, MT = 33024, DM = 1024, FF = 2816, TP = 8192;
constexpr float EPS = 1e-6f;
constexpr int LDS_BYTES = 157696 + 256;
constexpr size_t O_YP = 0, O_YS = 33554432, O_POOLP = 33685504, O_S5P = 33716224, O_KP = 33732608, O_VP = 42121216,
                 O_POOLS = 50509824, O_S5S = 50755584, O_KS = 50886656, O_VS = 51017728;
constexpr size_t MiB = 1u << 20;
constexpr size_t WS_WIN = 0, WS_WOUT = 2 * MiB, WS_WGLU = 4 * MiB, WS_WPOOL = 4 * MiB + 512 * 1024, WS_WO = 5 * MiB, WS_WQKV = 7 * MiB,
                 WS_GU0 = 13 * MiB, WS_GU1 = 24 * MiB, WS_DN0 = 35 * MiB, WS_DN1 = 41 * MiB, WS_BT1 = 47 * MiB, WS_BT2 = 51 * MiB,
                 WS_ROWSS = 57 * MiB, WS_USS = 60 * MiB, WS_LSE = 61 * MiB, WS_XN = 68 * MiB, WS_Y = 133 * MiB, WS_H = 198 * MiB,
                 WS_X = 328 * MiB;
constexpr size_t WS_AP = WS_X, WS_S = WS_X + 48 * MiB, WS_UPOOL = WS_X + 80 * MiB, WS_D = WS_X + 145 * MiB, WS_Z = WS_X + 178 * MiB,
                 WS_YCAT = WS_X + 211 * MiB;
constexpr size_t WS_HACT = WS_X;
constexpr size_t WS_Q = WS_X, WS_K = WS_X + 65 * MiB, WS_V = WS_X + 130 * MiB, WS_OP = WS_X + 195 * MiB, WS_ATT = WS_X + 389 * MiB;
constexpr size_t WS_END = WS_X + 454 * MiB;
constexpr size_t WS_CTL = 60 * MiB + 512 * 1024;

struct Params { const float* in[26]; float* out; unsigned char* ws; int ph_lo, ph_hi; };

DI unsigned pk2(float lo, float hi) { bf2_t v; v.x = (__bf16)lo; v.y = (__bf16)hi; return __builtin_bit_cast(unsigned, v); }
DI float bflo(unsigned w) { return __uint_as_float(w << 16); }
DI float bfhi(unsigned w) { return __uint_as_float(w & 0xffff0000u); }
DI float bf2f(bf16_t b) { return __uint_as_float((unsigned)b << 16); }
DI float wave_sum(float v) {
#pragma unroll
    for (int o = 1; o < 64; o <<= 1) v += __shfl_xor(v, o);
    return v;
}
DI float wave_max(float v) {
#pragma unroll
    for (int o = 1; o < 64; o <<= 1) v = fmaxf(v, __shfl_xor(v, o));
    return v;
}
DI float sigmoidf_(float x) { return __builtin_amdgcn_rcpf(1.0f + __builtin_amdgcn_exp2f(-1.4426950408889634f * x)); }
DI float gelu_tanh(float y) { const float u = 0.7978845608028654f * (y + 0.044715f * y * y * y); return y * __builtin_amdgcn_rcpf(1.0f + __builtin_amdgcn_exp2f(-2.0f * 1.4426950408889634f * u)); }
DI void sincos_acc(float a, float& s, float& c) {
    if (fabsf(a) < 0.5f) {
        const float a2 = a * a;
        s = a * (1.f - a2 * (1.f / 6.f) * (1.f - a2 * (1.f / 20.f) * (1.f - a2 * (1.f / 42.f))));
        c = 1.f - a2 * 0.5f * (1.f - a2 * (1.f / 12.f) * (1.f - a2 * (1.f / 30.f) * (1.f - a2 * (1.f / 56.f))));
    } else {
        float r = a * 0.15915494309189535f; r -= floorf(r);
        s = __builtin_amdgcn_sinf(r); c = __builtin_amdgcn_cosf(r);
    }
}
DI int lane_id() { int l; asm volatile("v_mbcnt_lo_u32_b32 %0, -1, 0\n\tv_mbcnt_hi_u32_b32 %0, -1, %0" : "=v"(l)); return l; }
#define LDS_WAIT() asm volatile("s_waitcnt lgkmcnt(0)" ::: "memory")
#define VM_WAIT() asm volatile("s_waitcnt vmcnt(0)" ::: "memory")

constexpr int BM = 256, BK = 64, HALF = 128, NXCD = 8, WGM = 8;
typedef f32x4 Acc[2][2][4][2];
DI int lds_byte(int r, int c) { const int st = (r >> 4) * 2 + (c >> 5), rr = r & 15, cc = c & 31, ob = rr * 64 + cc * 2; return st * 1024 + (ob ^ (((ob >> 9) & 1) << 5)); }
DI void stage_rc(int b, int& R, int& C) { const int st = b / 1024, sb = b % 1024, swz = sb ^ (((sb >> 9) & 1) << 5); R = (st >> 1) * 16 + swz / 64; C = (st & 1) * 32 + (swz % 64) / 2; }

DI bool unit_next(int i, int G, int c, int nM, int nN, int& pm, int& pn) {
    const int nwg = nM * nN; const long L = (long)i * G + c; if (L >= nwg) return false;
    int wgid = (int)L; { const int q = nwg / NXCD, r = nwg % NXCD, xcd = wgid % NXCD, off = wgid / NXCD; wgid = (xcd < r ? xcd * (q + 1) : r * (q + 1) + (xcd - r) * q) + off; }
    const int nig = WGM * nN, gid = wgid / nig, fm = gid * WGM, gsz = (nM - fm) < WGM ? (nM - fm) : WGM;
    pm = fm + ((wgid % nig) % gsz); pn = (wgid % nig) / gsz; return true;
}

template <class Units>
DI void gemm_phase(LAS unsigned char* lds, const int wid, const int lda, const int ldb, const int K, const Units& U) {
    typedef typename Units::Epi Epi;
    const int lane = lane_id(), tid = wid * 64 + lane, wr = wid >> 2, wc = wid & 3, fr = lane & 15, fq = lane >> 4;
    unsigned offA, offB;
    { int R, C; stage_rc(tid * 16, R, C); offA = (unsigned)(R * lda + C) * 2u;
      const int rho = R & 31, Rb = (R & ~31) + 8 * ((rho & 15) >> 2) + 4 * (rho >> 4) + (rho & 3);
      offB = (unsigned)(Rb * ldb + C) * 2u; }
    const unsigned ldsw = (unsigned)wid * 1024u;
    const unsigned hA = (unsigned)(HALF * lda * 2), hB = (unsigned)(HALF * ldb * 2), dA = (unsigned)(64 * lda * 2), dB = (unsigned)(64 * ldb * 2);
    const int aoff = lds_byte(wr * 64 + fr, fq * 8), boff = lds_byte(wc * 32 + fr, fq * 8);
#define SA(b, h) (((b) * 2 + (h)) * 16384)
#define SB(b, h) ((4 + (b) * 2 + (h)) * 16384)
#define STG(bufoff, gbase, soff, voff, dlt) do { _Pragma("unroll") for (int _i = 0; _i < 2; ++_i) { unsigned _vo = (voff); asm volatile("" : "+v"(_vo)); _vo += (unsigned)(soff) + (unsigned)_i * (dlt); \
        __builtin_amdgcn_global_load_lds((const unsigned*)((gbase) + _vo), (LAS unsigned*)(lds + (bufoff) + ldsw + _i * 8192), 16, 0, 0); } } while (0)
#define STA(b, h, base, kt) STG(SA(b, h), base, (h) * hA + (unsigned)(kt) * 128u, offA, dA)
#define STB(b, h, base, kt) STG(SB(b, h), base, (h) * hB + (unsigned)(kt) * 128u, offB, dB)
#define LDA(dst, b, h) do { _Pragma("unroll") for (int m = 0; m < 4; ++m) _Pragma("unroll") for (int k = 0; k < 2; ++k) dst[m][k] = *(const LAS bf16x8*)(lds + SA(b, h) + aoff + m * 2048 + k * 1024); } while (0)
#define LDB(dst, b, h) do { _Pragma("unroll") for (int n = 0; n < 2; ++n) _Pragma("unroll") for (int k = 0; k < 2; ++k) dst[n][k] = *(const LAS bf16x8*)(lds + SB(b, h) + boff + n * 2048 + k * 1024); } while (0)
#define MMA(ai, bj, Af, Bf) do { __builtin_amdgcn_s_setprio(1); _Pragma("unroll") for (int m = 0; m < 4; ++m) _Pragma("unroll") for (int n = 0; n < 2; ++n) _Pragma("unroll") for (int k = 0; k < 2; ++k) \
        acc[ai][bj][m][n] = __builtin_amdgcn_mfma_f32_16x16x32_bf16(Bf[n][k], Af[m][k], acc[ai][bj][m][n], 0, 0, 0); __builtin_amdgcn_s_setprio(0); } while (0)
#define WAIT_V(n) asm volatile("s_waitcnt vmcnt(" #n ")" ::: "memory")
#define WAIT_L(n) asm volatile("s_waitcnt lgkmcnt(" #n ")" ::: "memory")
#define BAR __builtin_amdgcn_s_barrier()
#define SCHED __builtin_amdgcn_sched_barrier(0)
#define ZERO_ACC() do { _Pragma("unroll") for (int a = 0; a < 2; ++a) _Pragma("unroll") for (int b = 0; b < 2; ++b) _Pragma("unroll") for (int m = 0; m < 4; ++m) _Pragma("unroll") for (int n = 0; n < 2; ++n) acc[a][b][m][n] = (f32x4){0.f, 0.f, 0.f, 0.f}; } while (0)
    const bf16_t* pa; const bf16_t* pb; Epi Ecur, Enxt;
    if (!U.get(0, pa, pb, Ecur)) return;
    const char* cA = (const char*)pa; const char* cB = (const char*)pb;
    Acc acc; ZERO_ACC();
    bf16x8 At[4][2], B0[2][2], B1[2][2];
    const int nt = K / BK;
    STB(0, 0, cB, 0); STB(0, 1, cB, 0); STA(0, 0, cA, 0); STA(0, 1, cA, 0);
    if (wr == 1) BAR;
    WAIT_V(2); BAR;
    STB(1, 0, cB, 1); STA(1, 0, cA, 1); STB(1, 1, cB, 1);
    WAIT_V(6); BAR;
    for (int ui = 0;; ++ui) {
        const bool has_next = U.get(ui + 1, pa, pb, Enxt);
        const char* nA = has_next ? (const char*)pa : cA; const char* nB = has_next ? (const char*)pb : cB;
        for (int t = 0; t < nt; t += 2) {
            const bool last = (t == nt - 2);
            const char* a2 = last ? nA : cA; const char* b2 = last ? nB : cB; const int k2 = last ? 0 : t + 2, k3 = k2 + 1;
            LDB(B0, 0, 0); LDB(B1, 0, 1); SCHED; LDA(At, 0, 0); STA(1, 1, cA, t + 1);
            WAIT_V(8); WAIT_L(0); BAR; MMA(0, 0, At, B0); MMA(0, 1, At, B1); BAR; SCHED;
            LDA(At, 0, 1); STB(0, 0, b2, k2); STB(0, 1, b2, k2); STA(0, 0, a2, k2);
            WAIT_V(8); WAIT_L(0); BAR; MMA(1, 0, At, B0); MMA(1, 1, At, B1); BAR; SCHED;
            LDB(B0, 1, 0); LDB(B1, 1, 1); SCHED; LDA(At, 1, 0); STA(0, 1, a2, k2);
            WAIT_V(8); WAIT_L(0); BAR; MMA(0, 0, At, B0); MMA(0, 1, At, B1); BAR; SCHED;
            LDA(At, 1, 1); STB(1, 0, b2, k3); STB(1, 1, b2, k3); STA(1, 0, a2, k3);
            WAIT_V(8); WAIT_L(0); BAR; MMA(1, 0, At, B0); MMA(1, 1, At, B1); BAR; SCHED;
        }
        if (wr == 0) BAR;
        Ecur(acc, wr, wc, fr, fq);
        if (!has_next) break;
        ZERO_ACC();
        cA = nA; cB = nB; Ecur = Enxt;
        if (wr == 1) BAR;
    }
    WAIT_V(0);
    BAR;
#undef ZERO_ACC
#undef SA
#undef SB
#undef STG
#undef STA
#undef STB
#undef LDA
#undef LDB
#undef MMA
#undef WAIT_V
#undef WAIT_L
#undef BAR
#undef SCHED
}

#define EPI_ROWS(...) _Pragma("unroll") for (int ai = 0; ai < 2; ++ai) _Pragma("unroll") for (int m = 0; m < 4; ++m) { const int rr = ai * 128 + wr * 64 + m * 16 + fr; __VA_ARGS__ }
#define EPI_COLS(...) _Pragma("unroll") for (int bj = 0; bj < 2; ++bj) _Pragma("unroll") for (int n = 0; n < 2; ++n) { const int cc = bj * 128 + wc * 32 + 8 * fq + 4 * n; const f32x4 v = acc[ai][bj][m][n]; __VA_ARGS__ }

struct EpiProj {
    float* upool; bf16_t* Ap; float* uss; int row0, col0;
    DI void set(int pm, int pn) { row0 = pm * 256; col0 = pn * 256; }
    DI void elem(int row, int col, const f32x4 v) const {
        if (col < 512) *(f32x4*)(upool + (size_t)row * 512 + col) = v; else *(f32x4*)(uss + (size_t)(row - NP) * 512 + (col - 512)) = v; }
    DI void operator()(const Acc& acc, int wr, int wc, int fr, int fq) const {
        if (col0 < 512) {
            EPI_ROWS(const size_t row = row0 + rr; EPI_COLS(*(f32x4*)(upool + row * 512 + col0 + cc) = v;))
        } else {
            EPI_ROWS(const int row = row0 + rr;
                EPI_COLS(const int c2 = col0 - 512 + cc; const int g = c2 >> 4, i = c2 & 15;
                    if (row < NP) { u32x2 w; w.x = pk2(v[0], v[1]); w.y = pk2(v[2], v[3]);
                        *(u32x2*)(Ap + ((size_t)g * 2048 + (row >> 4)) * 384 + 128 + (row & 15) * 16 + i) = w; }
                    else if (row < NT) { *(f32x4*)(uss + (size_t)(row - NP) * 512 + c2) = v; }))
        }
    }
};
struct EpiS1 {
    float* S; int g, row0;
    DI void set(int mt, int gg) { row0 = mt * 256; g = gg; }
    DI void operator()(const Acc& acc, int wr, int wc, int fr, int fq) const {
        EPI_ROWS(const size_t row = (size_t)g * 2048 + row0 + rr;
            _Pragma("unroll") for (int n = 0; n < 2; ++n) { const int cc = wc * 32 + 8 * fq + 4 * n; *(f32x4*)(S + row * 128 + cc) = acc[ai][0][m][n]; })
    }
};
struct EpiPool {
    bf16_t* ycat; const float* scale; int row0, col0;
    DI void set(int pm, int pn) { row0 = pm * 256; col0 = pn * 256; }
    DI void elem(int row, int col, const f32x4 v) const { const f32x4 s = *(const f32x4*)(scale + col); u32x2 w; w.x = pk2(v[0] * s[0], v[1] * s[1]); w.y = pk2(v[2] * s[2], v[3] * s[3]);
        *(u32x2*)(ycat + (size_t)row * 1024 + col) = w; }
    DI void operator()(const Acc& acc, int wr, int wc, int fr, int fq) const {
        EPI_ROWS(const size_t row = row0 + rr;
            EPI_COLS(const int col = col0 + cc; const f32x4 s = *(const f32x4*)(scale + col); u32x2 w; w.x = pk2(v[0] * s[0], v[1] * s[1]); w.y = pk2(v[2] * s[2], v[3] * s[3]);
                *(u32x2*)(ycat + row * 1024 + col) = w;))
    }
};
struct EpiS2 {
    bf16_t* z; const bf16_t* Ap; const float* dskip; int g, row0;
    DI void set(int mt, int gg) { row0 = mt * 256; g = gg; }
    DI void operator()(const Acc& acc, int wr, int wc, int fr, int fq) const {
        EPI_ROWS(const int chunk = row0 + rr; const bf16_t* ap = Ap + ((size_t)g * 2048 + chunk) * 384 + 128;
            EPI_COLS(const int r = cc >> 4, i = cc & 15; const u32x2 uw = *(const u32x2*)(ap + cc); const f32x4 d = *(const f32x4*)(dskip + g * 16 + i);
                const float y0 = v[0] + d[0] * bflo(uw.x), y1 = v[1] + d[1] * bfhi(uw.x), y2 = v[2] + d[2] * bflo(uw.y), y3 = v[3] + d[3] * bfhi(uw.y);
                u32x2 w; w.x = pk2(gelu_tanh(y0), gelu_tanh(y1)); w.y = pk2(gelu_tanh(y2), gelu_tanh(y3));
                *(u32x2*)(z + ((size_t)chunk * 16 + r) * 512 + g * 16 + i) = w;))
    }
};
struct EpiGlu {
    bf16_t* ycat; const bf16_t* z; const float* bglu; int row0, col0;
    DI void set(int pm, int pn) { row0 = pm * 256; col0 = pn * 256; }
    DI void elem(int row, int col, const f32x4 v) const { const u32x2 zw = *(const u32x2*)(z + (size_t)row * 512 + col); const f32x4 b = *(const f32x4*)(bglu + col);
        u32x2 w; w.x = pk2(bflo(zw.x) * sigmoidf_(v[0] + b[0]), bfhi(zw.x) * sigmoidf_(v[1] + b[1])); w.y = pk2(bflo(zw.y) * sigmoidf_(v[2] + b[2]), bfhi(zw.y) * sigmoidf_(v[3] + b[3]));
        *(u32x2*)(ycat + (size_t)row * 1024 + 512 + col) = w; }
    DI void operator()(const Acc& acc, int wr, int wc, int fr, int fq) const {
        EPI_ROWS(const size_t row = row0 + rr;
            EPI_COLS(const int col = col0 + cc; const u32x2 zw = *(const u32x2*)(z + row * 512 + col); const f32x4 b = *(const f32x4*)(bglu + col);
                u32x2 w; w.x = pk2(bflo(zw.x) * sigmoidf_(v[0] + b[0]), bfhi(zw.x) * sigmoidf_(v[1] + b[1]));
                w.y = pk2(bflo(zw.y) * sigmoidf_(v[2] + b[2]), bfhi(zw.y) * sigmoidf_(v[3] + b[3]));
                *(u32x2*)(ycat + row * 1024 + 512 + col) = w;))
    }
};
struct EpiY {
    bf16_t* y; int row0, col0;
    DI void set(int pm, int pn) { row0 = pm * 256; col0 = pn * 256; }
    DI void elem(int row, int col, const f32x4 v) const { u32x2 w; w.x = pk2(v[0], v[1]); w.y = pk2(v[2], v[3]); *(u32x2*)(y + (size_t)row * 1024 + col) = w; }
    DI void operator()(const Acc& acc, int wr, int wc, int fr, int fq) const {
        EPI_ROWS(const size_t row = row0 + rr;
            _Pragma("unroll") for (int bj = 0; bj < 2; ++bj) { const int cc = bj * 128 + wc * 32 + 8 * fq; const f32x4 v0 = acc[ai][bj][m][0], v1 = acc[ai][bj][m][1];
                u32x4 w; w.x = pk2(v0[0], v0[1]); w.y = pk2(v0[2], v0[3]); w.z = pk2(v1[0], v1[1]); w.w = pk2(v1[2], v1[3]); *(u32x4*)(y + row * 1024 + col0 + cc) = w; })
    }
};
struct EpiGU {
    bf16_t* hact; int row0, hb;
    DI void set(int pm, int pn) { row0 = pm * 256; hb = pn; }
    DI void elem2(int row, int col, const f32x4 a, const f32x4 u) const { u32x2 w; w.x = pk2(a[0] * sigmoidf_(a[0]) * u[0], a[1] * sigmoidf_(a[1]) * u[1]); w.y = pk2(a[2] * sigmoidf_(a[2]) * u[2], a[3] * sigmoidf_(a[3]) * u[3]);
        *(u32x2*)(hact + (size_t)row * FF + col) = w; }
    DI void operator()(const Acc& acc, int wr, int wc, int fr, int fq) const {
        EPI_ROWS(const size_t row = row0 + rr; const int cc = wc * 32 + 8 * fq; u32x4 w;
            { const f32x4 a = acc[ai][0][m][0], u = acc[ai][1][m][0]; w.x = pk2(a[0] * sigmoidf_(a[0]) * u[0], a[1] * sigmoidf_(a[1]) * u[1]); w.y = pk2(a[2] * sigmoidf_(a[2]) * u[2], a[3] * sigmoidf_(a[3]) * u[3]); }
            { const f32x4 a = acc[ai][0][m][1], u = acc[ai][1][m][1]; w.z = pk2(a[0] * sigmoidf_(a[0]) * u[0], a[1] * sigmoidf_(a[1]) * u[1]); w.w = pk2(a[2] * sigmoidf_(a[2]) * u[2], a[3] * sigmoidf_(a[3]) * u[3]); }
            *(u32x4*)(hact + row * FF + hb * 128 + cc) = w;)
    }
};
struct EpiQKV {
    bf16_t* qkv; float* out; int row0, col0;
    DI void set(int pm, int pn) { row0 = pm * 256; col0 = pn * 256; }
    DI void elem(int row, int colg, const f32x4 v) const {
        const int which = colg >> 10, col = colg & 1023; const float sc = which == 0 ? 0.125f * 1.4426950408889634f : 1.0f;
        u32x2 w; w.x = pk2(v[0] * sc, v[1] * sc); w.y = pk2(v[2] * sc, v[3] * sc);
        *(u32x2*)(qkv + (size_t)which * (65 * MiB / 2) + (size_t)row * 1024 + col) = w;
        if (which != 0) *(f32x4*)(out + (which == 1 ? O_KS : O_VS) + (size_t)(row - NP) * 1024 + col) = v; }
    DI void operator()(const Acc& acc, int wr, int wc, int fr, int fq) const {
        const int which = col0 >> 10; const int cb = col0 & 1023; const float sc = which == 0 ? 0.125f * 1.4426950408889634f : 1.0f;
        bf16_t* dst = qkv + (size_t)which * (65 * MiB / 2);
        float* op = out + (which == 1 ? O_KP : O_VP); float* os = out + (which == 1 ? O_KS : O_VS);
        EPI_ROWS(const int row = row0 + rr;
            EPI_COLS(const int col = cb + cc; u32x2 w; w.x = pk2(v[0] * sc, v[1] * sc); w.y = pk2(v[2] * sc, v[3] * sc);
                *(u32x2*)(dst + (size_t)row * 1024 + col) = w;
                if (which != 0) {
                    if (row < NP) { const int tb = row & (TP - 1); if (tb >= TP - 2048) *(f32x4*)(op + ((size_t)(row >> 13) * 2048 + (tb - (TP - 2048))) * 1024 + col) = v; }
                    else if (row < NT) *(f32x4*)(os + (size_t)(row - NP) * 1024 + col) = v;
                }))
    }
};


template <class EpiT> struct UStd {
    typedef EpiT Epi; const bf16_t* A; const bf16_t* Bt; size_t astep, bstep; int acolstep, nM, nN, G, c; EpiT proto;
    DI bool get(int i, const bf16_t*& a, const bf16_t*& b, EpiT& e) const { int pm, pn; if (!unit_next(i, G, c, nM, nN, pm, pn)) return false;
        a = A + (size_t)pm * astep + (size_t)pn * acolstep; b = Bt + (size_t)pn * bstep; e = proto; e.set(pm, pn); return true; }
};
template <class EpiT> struct US5 {
    typedef EpiT Epi; const bf16_t* A; const bf16_t* Bt; size_t bstep; int G, c; EpiT proto;
    DI bool get(int i, const bf16_t*& a, const bf16_t*& b, EpiT& e) const { const int L = c + i * G; if (L >= 256) return false; const int g = L >> 3, mt = L & 7;
        a = A + ((size_t)g * 2048 + mt * 256) * 384; b = Bt + (size_t)g * bstep; e = proto; e.set(mt, g); return true; }
};

DI f32x4 mini_acc(const bf16_t* Arow, const bf16_t* Brow, int K) {
    f32x4 acc = (f32x4){0.f, 0.f, 0.f, 0.f};
    int k0 = 0;
    for (; k0 + 512 <= K; k0 += 512) { bf16x8 a[16], b[16];
#pragma unroll
        for (int e = 0; e < 16; ++e) { a[e] = *(const bf16x8*)(Arow + k0 + 32 * e); b[e] = *(const bf16x8*)(Brow + k0 + 32 * e); }
#pragma unroll
        for (int e = 0; e < 16; ++e) acc = __builtin_amdgcn_mfma_f32_16x16x32_bf16(b[e], a[e], acc, 0, 0, 0); }
    if (k0 < K) { bf16x8 a[8], b[8];
#pragma unroll
        for (int e = 0; e < 8; ++e) { a[e] = *(const bf16x8*)(Arow + k0 + 32 * e); b[e] = *(const bf16x8*)(Brow + k0 + 32 * e); }
#pragma unroll
        for (int e = 0; e < 8; ++e) acc = __builtin_amdgcn_mfma_f32_16x16x32_bf16(b[e], a[e], acc, 0, 0, 0); }
    return acc;
}
DI void mini_acc2(const bf16_t* Arow, const bf16_t* Bg, const bf16_t* Bu, int K, f32x4& ga, f32x4& ua) {
    ga = (f32x4){0.f, 0.f, 0.f, 0.f}; ua = ga;
    for (int k0 = 0; k0 < K; k0 += 256) { bf16x8 a[8], g[8], u[8];
#pragma unroll
        for (int e = 0; e < 8; ++e) { a[e] = *(const bf16x8*)(Arow + k0 + 32 * e); g[e] = *(const bf16x8*)(Bg + k0 + 32 * e); u[e] = *(const bf16x8*)(Bu + k0 + 32 * e); }
#pragma unroll
        for (int e = 0; e < 8; ++e) { ga = __builtin_amdgcn_mfma_f32_16x16x32_bf16(g[e], a[e], ga, 0, 0, 0); ua = __builtin_amdgcn_mfma_f32_16x16x32_bf16(u[e], a[e], ua, 0, 0, 0); } }
}
template <class Epi>
DI void mini_gemm(const bf16_t* A, int lda, const bf16_t* Bt, int ldb, int K, int N, int acol_per_256, const Epi& E, int bx, int G, int wave, int lane) {
    const int fr = lane & 15, fq = lane >> 4; const int row = NP + 16 * wave + fr;
    for (int q = bx; q < N / 16; q += G) {
        const bf16_t* Arow = A + (size_t)row * lda + ((16 * q) >> 8) * acol_per_256 + 8 * fq;
        const bf16_t* Brow = Bt + (size_t)(16 * q + fr) * ldb + 8 * fq;
        const f32x4 acc = mini_acc(Arow, Brow, K);
        E.elem(row, 16 * q + 4 * fq, acc); }
}
DI void mini_gemm_gu(const bf16_t* A, const bf16_t* Bt, const EpiGU& E, int bx, int G, int wave, int lane) {
    const int fr = lane & 15, fq = lane >> 4; const int row = NP + 16 * wave + fr;
    for (int q = bx; q < FF / 16; q += G) { const int hcol = 16 * q; const int brow = (hcol >> 7) * 256 + (hcol & 127) + fr;
        const bf16_t* Arow = A + (size_t)row * DM + 8 * fq;
        f32x4 ga, ua; mini_acc2(Arow, Bt + (size_t)brow * DM + 8 * fq, Bt + (size_t)(brow + 128) * DM + 8 * fq, DM, ga, ua);
        E.elem2(row, hcol + 4 * fq, ga, ua); }
}
DI void transpose_item(const float* W, int N, int k0, int n0, bf16_t* WT, int ldt, int orow0, int ocol0, LAS float* scr, int lane) {
#pragma unroll 16
    for (int i = 0; i < 32; ++i) { const int kk = 2 * i + (lane >> 5); scr[kk * 33 + (lane & 31)] = W[(size_t)(k0 + kk) * N + n0 + (lane & 31)]; }
    LDS_WAIT();
    const int c = lane & 7;
#pragma unroll
    for (int j = 0; j < 4; ++j) { const int n = (lane >> 3) + 8 * j; const LAS float* s = scr + (8 * c) * 33 + n;
        u32x4 o; o.x = pk2(s[0 * 33], s[1 * 33]); o.y = pk2(s[2 * 33], s[3 * 33]); o.z = pk2(s[4 * 33], s[5 * 33]); o.w = pk2(s[6 * 33], s[7 * 33]);
        *(u32x4*)(WT + (size_t)(orow0 + n) * ldt + ocol0 + 8 * c) = o; }
    LDS_WAIT();
}
DI void tr_plain(const float* W, int K, int N, bf16_t* WT, int item, LAS float* scr, int lane) {
    const int nblk = N / 32, kb = item / nblk, nb = item % nblk; transpose_item(W, N, 64 * kb, 32 * nb, WT, K, 32 * nb, 64 * kb, scr, lane);
}

DI const float* in_row(const Params& p, int r) { return r < NP ? p.in[0] + (size_t)r * DM : p.in[1] + (size_t)(r - NP) * DM; }

DI void norm_row(const float* xr, const float* g, bf16_t* o, int lane) {
    f32x4 v[4]; float s = 0.f;
#pragma unroll
    for (int j = 0; j < 4; ++j) { v[j] = *(const f32x4*)(xr + 4 * lane + 256 * j); s += (v[j][0] * v[j][0] + v[j][1] * v[j][1]) + (v[j][2] * v[j][2] + v[j][3] * v[j][3]); }
    const float r = rsqrtf(wave_sum(s) * (1.f / DM) + EPS);
#pragma unroll
    for (int j = 0; j < 4; ++j) { const f32x4 gg = *(const f32x4*)(g + 4 * lane + 256 * j); u32x2 w; w.x = pk2(v[j][0] * r * gg[0], v[j][1] * r * gg[1]); w.y = pk2(v[j][2] * r * gg[2], v[j][3] * r * gg[3]);
        *(u32x2*)(o + 4 * lane + 256 * j) = w; }
}
DI void norm_row2(const float* xa, const float* xb, const float* g, bf16_t* oa, bf16_t* ob, int lane) {
    f32x4 va[4], vb[4]; float sa = 0.f, sb = 0.f;
#pragma unroll
    for (int j = 0; j < 4; ++j) { va[j] = *(const f32x4*)(xa + 4 * lane + 256 * j); vb[j] = *(const f32x4*)(xb + 4 * lane + 256 * j); }
#pragma unroll
    for (int j = 0; j < 4; ++j) { sa += (va[j][0] * va[j][0] + va[j][1] * va[j][1]) + (va[j][2] * va[j][2] + va[j][3] * va[j][3]); sb += (vb[j][0] * vb[j][0] + vb[j][1] * vb[j][1]) + (vb[j][2] * vb[j][2] + vb[j][3] * vb[j][3]); }
    const float ra = rsqrtf(wave_sum(sa) * (1.f / DM) + EPS), rb = rsqrtf(wave_sum(sb) * (1.f / DM) + EPS);
#pragma unroll
    for (int j = 0; j < 4; ++j) { const f32x4 gg = *(const f32x4*)(g + 4 * lane + 256 * j); u32x2 w;
        w.x = pk2(va[j][0] * ra * gg[0], va[j][1] * ra * gg[1]); w.y = pk2(va[j][2] * ra * gg[2], va[j][3] * ra * gg[3]); *(u32x2*)(oa + 4 * lane + 256 * j) = w;
        w.x = pk2(vb[j][0] * rb * gg[0], vb[j][1] * rb * gg[1]); w.y = pk2(vb[j][2] * rb * gg[2], vb[j][3] * rb * gg[3]); *(u32x2*)(ob + 4 * lane + 256 * j) = w; }
}
template <bool INB, bool OUTB>
DI void res_row(const void* hin_, const bf16_t* y, const float* gpost, const float* gnext, void* hout_, bf16_t* xn, int lane) {
    u32x2 yw[4]; float ss = 0.f;
#pragma unroll
    for (int j = 0; j < 4; ++j) { yw[j] = *(const u32x2*)(y + 4 * lane + 256 * j); const float a = bflo(yw[j].x), b = bfhi(yw[j].x), c = bflo(yw[j].y), d = bfhi(yw[j].y); ss += (a * a + b * b) + (c * c + d * d); }
    const float r1 = rsqrtf(wave_sum(ss) * (1.f / DM) + EPS);
    f32x4 h[4]; float s2 = 0.f;
#pragma unroll
    for (int j = 0; j < 4; ++j) { const int c = 4 * lane + 256 * j; f32x4 hv;
        if (INB) { const u32x2 hw = *(const u32x2*)((const bf16_t*)hin_ + c); hv = (f32x4){bflo(hw.x), bfhi(hw.x), bflo(hw.y), bfhi(hw.y)}; } else hv = *(const f32x4*)((const float*)hin_ + c);
        const f32x4 gp = *(const f32x4*)(gpost + c);
        h[j][0] = hv[0] + bflo(yw[j].x) * r1 * gp[0]; h[j][1] = hv[1] + bfhi(yw[j].x) * r1 * gp[1]; h[j][2] = hv[2] + bflo(yw[j].y) * r1 * gp[2]; h[j][3] = hv[3] + bfhi(yw[j].y) * r1 * gp[3];
        if (OUTB) { u32x2 w; w.x = pk2(h[j][0], h[j][1]); w.y = pk2(h[j][2], h[j][3]); *(u32x2*)((bf16_t*)hout_ + c) = w;
            h[j] = (f32x4){bflo(w.x), bfhi(w.x), bflo(w.y), bfhi(w.y)}; }
        else *(f32x4*)((float*)hout_ + c) = h[j];
        s2 += (h[j][0] * h[j][0] + h[j][1] * h[j][1]) + (h[j][2] * h[j][2] + h[j][3] * h[j][3]); }
    if (xn) {
        const float r2 = rsqrtf(wave_sum(s2) * (1.f / DM) + EPS);
#pragma unroll
        for (int j = 0; j < 4; ++j) { const int c = 4 * lane + 256 * j; const f32x4 gn = *(const f32x4*)(gnext + c); u32x2 w; w.x = pk2(h[j][0] * r2 * gn[0], h[j][1] * r2 * gn[1]); w.y = pk2(h[j][2] * r2 * gn[2], h[j][3] * r2 * gn[3]);
            *(u32x2*)(xn + c) = w; }
    }
}

template <bool INB, bool OUTB, int R>
DI void res_rows(const void* const (&hin_)[R], const bf16_t* const (&y)[R], const float* gpost, const float* gnext, void* const (&hout_)[R], bf16_t* const (&xn)[R], const bool has_xn, int lane) {
    u32x2 yw[R][4]; f32x4 hv[R][4];
#pragma unroll
    for (int q = 0; q < R; ++q)
#pragma unroll
        for (int j = 0; j < 4; ++j) { const int c = 4 * lane + 256 * j; yw[q][j] = *(const u32x2*)(y[q] + c);
            if (INB) { const u32x2 hw = *(const u32x2*)((const bf16_t*)hin_[q] + c); hv[q][j] = (f32x4){bflo(hw.x), bfhi(hw.x), bflo(hw.y), bfhi(hw.y)}; } else hv[q][j] = *(const f32x4*)((const float*)hin_[q] + c); }
    f32x4 gp[4];
#pragma unroll
    for (int j = 0; j < 4; ++j) gp[j] = *(const f32x4*)(gpost + 4 * lane + 256 * j);
#pragma unroll
    for (int q = 0; q < R; ++q) {
        float ss = 0.f;
#pragma unroll
        for (int j = 0; j < 4; ++j) { const float a = bflo(yw[q][j].x), b = bfhi(yw[q][j].x), c = bflo(yw[q][j].y), d = bfhi(yw[q][j].y); ss += (a * a + b * b) + (c * c + d * d); }
        const float r1 = rsqrtf(wave_sum(ss) * (1.f / DM) + EPS);
        float s2 = 0.f;
#pragma unroll
        for (int j = 0; j < 4; ++j) { const int c = 4 * lane + 256 * j; f32x4 h;
            h[0] = hv[q][j][0] + bflo(yw[q][j].x) * r1 * gp[j][0]; h[1] = hv[q][j][1] + bfhi(yw[q][j].x) * r1 * gp[j][1]; h[2] = hv[q][j][2] + bflo(yw[q][j].y) * r1 * gp[j][2]; h[3] = hv[q][j][3] + bfhi(yw[q][j].y) * r1 * gp[j][3];
            if (OUTB) { u32x2 w; w.x = pk2(h[0], h[1]); w.y = pk2(h[2], h[3]); *(u32x2*)((bf16_t*)hout_[q] + c) = w; h = (f32x4){bflo(w.x), bfhi(w.x), bflo(w.y), bfhi(w.y)}; }
            else *(f32x4*)((float*)hout_[q] + c) = h;
            s2 += (h[0] * h[0] + h[1] * h[1]) + (h[2] * h[2] + h[3] * h[3]); hv[q][j] = h; }
        if (has_xn) { const float r2 = rsqrtf(wave_sum(s2) * (1.f / DM) + EPS);
#pragma unroll
            for (int j = 0; j < 4; ++j) { const int c = 4 * lane + 256 * j; const f32x4 gn = *(const f32x4*)(gnext + c); u32x2 w; w.x = pk2(hv[q][j][0] * r2 * gn[0], hv[q][j][1] * r2 * gn[1]); w.y = pk2(hv[q][j][2] * r2 * gn[2], hv[q][j][3] * r2 * gn[3]);
                *(u32x2*)(xn[q] + c) = w; } }
    }
}

struct RowPass { int mode; const float* gpost; const float* gnext; const float* xp; const float* xs; bf16_t* h16; const bf16_t* y; bf16_t* xnp; float* out;
    DI void row(int r, int lane) const {
        const bf16_t* yr = y + (size_t)r * DM; bf16_t* hr = h16 + (size_t)r * DM;
        if (mode == 0) res_row<false, true>(r < NP ? xp + (size_t)r * DM : xs + (size_t)(r - NP) * DM, yr, gpost, gnext, hr, xnp + (size_t)r * DM, lane);
        else if (mode == 1) res_row<true, true>(hr, yr, gpost, gnext, hr, xnp + (size_t)r * DM, lane);
        else res_row<true, false>(hr, yr, gpost, gnext, r < NP ? out + O_YP + (size_t)r * DM : out + O_YS + (size_t)(r - NP) * DM, nullptr, lane);
    }
    DI void rows4(int r0, int lane) const {
        const void* hin[4]; const bf16_t* yr[4]; void* ho[4]; bf16_t* xo[4];
#pragma unroll
        for (int q = 0; q < 4; ++q) { const size_t o = (size_t)(r0 + q) * DM; yr[q] = y + o; xo[q] = xnp + o;
            hin[q] = mode == 0 ? (const void*)(xp + o) : (const void*)(h16 + o); ho[q] = mode == 2 ? (void*)(out + O_YP + o) : (void*)(h16 + o); }
        if (mode == 0) res_rows<false, true, 4>(hin, yr, gpost, gnext, ho, xo, true, lane);
        else if (mode == 1) res_rows<true, true, 4>(hin, yr, gpost, gnext, ho, xo, true, lane);
        else res_rows<true, false, 4>(hin, yr, gpost, gnext, ho, xo, false, lane);
    }
    DI void rows8(int r0, int lane) const {
        const void* hin[8]; const bf16_t* yr[8]; void* ho[8]; bf16_t* xo[8];
#pragma unroll
        for (int q = 0; q < 8; ++q) { const size_t o = (size_t)(r0 + q) * DM; yr[q] = y + o; xo[q] = xnp + o;
            hin[q] = mode == 0 ? (const void*)(xp + o) : (const void*)(h16 + o); ho[q] = mode == 2 ? (void*)(out + O_YP + o) : (void*)(h16 + o); }
        if (mode == 0) res_rows<false, true, 8>(hin, yr, gpost, gnext, ho, xo, true, lane);
        else if (mode == 1) res_rows<true, true, 8>(hin, yr, gpost, gnext, ho, xo, true, lane);
        else res_rows<true, false, 8>(hin, yr, gpost, gnext, ho, xo, false, lane);
    }
};

DI void s5_tables(const Params& p, int g, LAS unsigned char* lds, bf16_t* Bt1, bf16_t* Bt2, const int tid) {
    LAS float* pwr = (LAS float*)lds;
    LAS float* pwi = pwr + 17 * 64;
    LAS float* bbr = pwi + 17 * 64;
    LAS float* bbi = bbr + 1024;
    LAS float* cr = bbi + 1024;
    LAS float* ci = cr + 1024;
    LAS float* Kd = ci + 1024;
    const float dt = __expf(p.in[12][g]);
    const float* lre = p.in[10] + g * 64; const float* lim = p.in[11] + g * 64;
    for (int it = tid; it < 17 * 64; it += 512) { const int d = it >> 6, q = it & 63; const float zr = lre[q] * dt * (float)d, zi = lim[q] * dt * (float)d;
        float s, c; sincos_acc(zi, s, c); const float mag = __expf(zr); pwr[it] = mag * c; pwi[it] = mag * s; }
    for (int it = tid; it < 1024; it += 512) { const int q = it >> 4, i = it & 15;
        const float lr = lre[q], li = lim[q], zr = lr * dt, zi = li * dt;
        float s, c, sh, ch; sincos_acc(zi, s, c); sincos_acc(0.5f * zi, sh, ch);
        const float em1 = expm1f(zr); const float nr = em1 * c - 2.f * sh * sh, ni = (em1 + 1.f) * s;
        const float den = 1.f / (lr * lr + li * li); const float fr_ = (nr * lr + ni * li) * den, fi_ = (ni * lr - nr * li) * den;
        const float br = p.in[13][(size_t)g * 1024 + it], bi = p.in[14][(size_t)g * 1024 + it];
        bbr[it] = fr_ * br - fi_ * bi; bbi[it] = fr_ * bi + fi_ * br;
        cr[it] = p.in[15][(size_t)g * 1024 + it]; ci[it] = p.in[16][(size_t)g * 1024 + it]; }
    __syncthreads();
    for (int it = tid; it < 4096; it += 512) { const int d = it >> 8, i = (it >> 4) & 15, j = it & 15; float a = 0.f;
        for (int q = 0; q < 64; ++q) { const float c_r = cr[i * 64 + q], c_i = ci[i * 64 + q], p_r = pwr[d * 64 + q], p_i = pwi[d * 64 + q];
            const float xr = c_r * p_r - c_i * p_i, xi = c_r * p_i + c_i * p_r; a += xr * bbr[q * 16 + j] - xi * bbi[q * 16 + j]; }
        Kd[it] = a; }
    __syncthreads();
    for (int it = tid; it < 256 * 32; it += 512) { const int n = it >> 5, k0 = (it & 31) * 8; float v[8];
#pragma unroll
        for (int e = 0; e < 8; ++e) { const int k = k0 + e, s = k >> 4, i = k & 15; float val = 0.f;
            if (n < 128) { const int q = n & 63; const float p_r = pwr[(15 - s) * 64 + q], p_i = pwi[(15 - s) * 64 + q], b_r = bbr[q * 16 + i], b_i = bbi[q * 16 + i];
                val = n < 64 ? (p_r * b_r - p_i * b_i) : (p_r * b_i + p_i * b_r); }
            v[e] = val; }
        u32x4 o; o.x = pk2(v[0], v[1]); o.y = pk2(v[2], v[3]); o.z = pk2(v[4], v[5]); o.w = pk2(v[6], v[7]);
        *(u32x4*)(Bt1 + (size_t)n * 256 + k0) = o; }
    for (int it = tid; it < 256 * 48; it += 512) { const int n = it / 48, k0 = (it % 48) * 8; const int r = n >> 4, i = n & 15; float v[8];
#pragma unroll
        for (int e = 0; e < 8; ++e) { const int k = k0 + e; float val;
            if (k < 128) { const int q = k & 63; const float c_r = cr[i * 64 + q], c_i = ci[i * 64 + q], p_r = pwr[(r + 1) * 64 + q], p_i = pwi[(r + 1) * 64 + q];
                val = k < 64 ? (c_r * p_r - c_i * p_i) : -(c_r * p_i + c_i * p_r); }
            else { const int kk = k - 128, s = kk >> 4, j = kk & 15; val = s <= r ? Kd[(r - s) * 256 + i * 16 + j] : 0.f; }
            v[e] = val; }
        u32x4 o; o.x = pk2(v[0], v[1]); o.y = pk2(v[2], v[3]); o.z = pk2(v[4], v[5]); o.w = pk2(v[6], v[7]);
        *(u32x4*)(Bt2 + (size_t)n * 384 + k0) = o; }
    __syncthreads();
}

DI void s5_sample_unit(const Params& p, int u, const float* uss, bf16_t* z, int lane) {
    const int g = u & 31, b = u >> 5;
    const float dt = __expf(p.in[12][g]);
    const float lr = p.in[10][g * 64 + lane], li = p.in[11][g * 64 + lane], zr = lr * dt, zi = li * dt;
    float s, c, sh, ch; sincos_acc(zi, s, c); sincos_acc(0.5f * zi, sh, ch);
    const float em1 = expm1f(zr); const float nr = em1 * c - 2.f * sh * sh, ni = (em1 + 1.f) * s;
    const float lbr = nr + 1.f, lbi = ni;
    const float den = 1.f / (lr * lr + li * li); const float fr_ = (nr * lr + ni * li) * den, fi_ = (ni * lr - nr * li) * den;
    float hr = p.in[3][(((size_t)b * 32 + g) * 64 + lane) * 2], hi = p.in[3][(((size_t)b * 32 + g) * 64 + lane) * 2 + 1];
    const float* bre = p.in[13] + ((size_t)g * 64 + lane) * 16; const float* bim = p.in[14] + ((size_t)g * 64 + lane) * 16;
    const float* cre = p.in[15] + (size_t)g * 1024 + lane; const float* cim = p.in[16] + (size_t)g * 1024 + lane;
    for (int t = 0; t < 4; ++t) {
        const float* ur = uss + (size_t)(b * 4 + t) * 512 + g * 16;
        float bur = 0.f, bui = 0.f;
#pragma unroll
        for (int i = 0; i < 16; ++i) { const float uv = ur[i]; const float br = bre[i], bi = bim[i]; bur += (fr_ * br - fi_ * bi) * uv; bui += (fr_ * bi + fi_ * br) * uv; }
        const float n_r = lbr * hr - lbi * hi + bur, n_i = lbr * hi + lbi * hr + bui; hr = n_r; hi = n_i;
        float yv = 0.f;
#pragma unroll
        for (int i = 0; i < 16; ++i) { float a = cre[i * 64] * hr - cim[i * 64] * hi; a = wave_sum(a); if (lane == i) yv = a; }
        if (lane < 16) { const float y = yv + p.in[17][g * 16 + lane] * ur[lane]; z[(size_t)(NP + b * 4 + t) * 512 + g * 16 + lane] = (bf16_t)(pk2(gelu_tanh(y), 0.f) & 0xffffu); }
    }
    float* o = p.out + O_S5S + (((size_t)b * 32 + g) * 64 + lane) * 2; o[0] = hr; o[1] = hi;
}

constexpr int ATT_BUF = 69632, ATT_VOFF = 34816, ATT_OST = 2 * ATT_BUF, LDS_CTL = ATT_OST + 8 * 2304;
struct AttUnit { int pat, b, h, dil, l0; size_t rowbase; };
DI AttUnit att_decode(int bu) { AttUnit u; const int tile = bu & 63; u.h = (bu >> 6) & 15; u.b = (bu >> 10) & 3; u.pat = bu >> 12; const int dsh = u.pat * 2; u.dil = 1 << dsh;
    const int rho = tile & (u.dil - 1); u.l0 = (tile >> dsh) * 128; u.rowbase = (size_t)u.b * TP + rho; return u; }
DI void att_stage(const AttUnit& u, const bf16_t* Kb, const bf16_t* Vb, LAS unsigned char* buf, int wave, int lane) {
    const int lmax = (TP >> (2 * u.pat)) - 1;
    for (int n = wave; n < 34; n += 8) { const int r0 = n * 8; const int row = r0 + (lane >> 3); const int c = (lane & 7) ^ (row & 7);
        int lk = u.l0 - 128 + row; lk = lk < 0 ? 0 : (lk > lmax ? lmax : lk); const size_t off = (u.rowbase + (size_t)u.dil * lk) * 1024 + u.h * 64 + c * 8;
        __builtin_amdgcn_global_load_lds((const unsigned*)(Kb + off), (LAS unsigned*)(buf + r0 * 128), 16, 0, 0);
        __builtin_amdgcn_global_load_lds((const unsigned*)(Vb + off), (LAS unsigned*)(buf + ATT_VOFF + r0 * 128), 16, 0, 0); }
}
DI void att_loadq(const AttUnit& u, const bf16_t* Q, int wave, int lane, bf16x8 (&qf)[2]) {
    const int i = lane & 15, g = lane >> 4; const bf16_t* q = Q + (u.rowbase + (size_t)u.dil * (u.l0 + 16 * wave + i)) * 1024 + u.h * 64 + 8 * g;
    qf[0] = *(const bf16x8*)q; qf[1] = *(const bf16x8*)(q + 32);
}
DI void att_compute(const AttUnit& u, const bf16x8 (&qf)[2], LAS unsigned char* buf, LAS unsigned char* ost, bf16_t* Op, float* lse, int wave, int lane) {
    const int i = lane & 15, g = lane >> 4;
    const int Lw = u.l0 + 16 * wave;
    unsigned koff[2][2], voff[4];
#pragma unroll
    for (int kbl = 0; kbl < 2; ++kbl)
#pragma unroll
        for (int s = 0; s < 2; ++s) koff[kbl][s] = (unsigned)((16 * wave + 16 * kbl + i) * 128 + (((4 * s + g) ^ (i & 7)) * 16));
    { const int q = i >> 2, pp = i & 3, r = 4 * g + q;
#pragma unroll
      for (int db = 0; db < 4; ++db) voff[db] = (unsigned)((16 * wave + r) * 128 + (((2 * db + (pp >> 1)) ^ (r & 7)) * 16) + 8 * (pp & 1)); }
    f32x4 st[5][2];
#pragma unroll
    for (int ks = 0; ks < 5; ++ks)
#pragma unroll
        for (int kbl = 0; kbl < 2; ++kbl) {
            if (ks == 4 && kbl == 1) { st[ks][kbl] = (f32x4){0.f, 0.f, 0.f, 0.f}; continue; }
            const bf16x8 k0 = *(const LAS bf16x8*)(buf + ks * 4096 + koff[kbl][0]), k1 = *(const LAS bf16x8*)(buf + ks * 4096 + koff[kbl][1]);
            f32x4 a = (f32x4){0.f, 0.f, 0.f, 0.f};
            a = __builtin_amdgcn_mfma_f32_16x16x32_bf16(k0, qf[0], a, 0, 0, 0);
            a = __builtin_amdgcn_mfma_f32_16x16x32_bf16(k1, qf[1], a, 0, 0, 0); st[ks][kbl] = a; }
#pragma unroll
    for (int r = 0; r < 4; ++r) { if (i > 4 * g + r) st[0][0][r] = -INFINITY; if (4 * g + r > i) st[4][0][r] = -INFINITY; }
    if (Lw < 128) {
#pragma unroll
        for (int ks = 0; ks < 4; ++ks)
#pragma unroll
            for (int kbl = 0; kbl < 2; ++kbl)
#pragma unroll
                for (int r = 0; r < 4; ++r) if (Lw - 128 + 32 * ks + 16 * kbl + 4 * g + r < 0) st[ks][kbl][r] = -INFINITY; }
    float mx = -INFINITY;
#pragma unroll
    for (int ks = 0; ks < 5; ++ks)
#pragma unroll
        for (int kbl = 0; kbl < 2; ++kbl) { if (ks == 4 && kbl == 1) continue;
#pragma unroll
            for (int r = 0; r < 4; ++r) mx = fmaxf(mx, st[ks][kbl][r]); }
    mx = fmaxf(mx, __shfl_xor(mx, 16)); mx = fmaxf(mx, __shfl_xor(mx, 32));
    float ps = 0.f; bf16x8 pf[5];
#pragma unroll
    for (int ks = 0; ks < 5; ++ks) {
#pragma unroll
        for (int kbl = 0; kbl < 2; ++kbl) { if (ks == 4 && kbl == 1) continue;
#pragma unroll
            for (int r = 0; r < 4; ++r) { const float pv = __builtin_amdgcn_exp2f(st[ks][kbl][r] - mx); st[ks][kbl][r] = pv; ps += pv; } }
        u32x4 pw; pw.x = pk2(st[ks][0][0], st[ks][0][1]); pw.y = pk2(st[ks][0][2], st[ks][0][3]); pw.z = pk2(st[ks][1][0], st[ks][1][1]); pw.w = pk2(st[ks][1][2], st[ks][1][3]);
        pf[ks] = __builtin_bit_cast(bf16x8, pw); }
    ps += __shfl_xor(ps, 16); ps += __shfl_xor(ps, 32);
    f32x4 o[4];
#pragma unroll
    for (int db = 0; db < 4; ++db) o[db] = (f32x4){0.f, 0.f, 0.f, 0.f};
    const unsigned vb = (unsigned)(size_t)buf + (unsigned)ATT_VOFF;
#pragma unroll
    for (int ks = 0; ks < 5; ++ks) {
        s16x4 lo[4], hi[4]; const unsigned va = vb + ks * 4096;
        asm volatile("ds_read_b64_tr_b16 %0, %8\n\tds_read_b64_tr_b16 %1, %9\n\tds_read_b64_tr_b16 %2, %10\n\tds_read_b64_tr_b16 %3, %11\n\t"
                     "ds_read_b64_tr_b16 %4, %8 offset:2048\n\tds_read_b64_tr_b16 %5, %9 offset:2048\n\tds_read_b64_tr_b16 %6, %10 offset:2048\n\tds_read_b64_tr_b16 %7, %11 offset:2048\n\t"
                     "s_waitcnt lgkmcnt(0)"
                     : "=&v"(lo[0]), "=&v"(lo[1]), "=&v"(lo[2]), "=&v"(lo[3]), "=&v"(hi[0]), "=&v"(hi[1]), "=&v"(hi[2]), "=&v"(hi[3])
                     : "v"(va + voff[0]), "v"(va + voff[1]), "v"(va + voff[2]), "v"(va + voff[3]) : "memory");
#pragma unroll
        for (int db = 0; db < 4; ++db) { const bf16x8 vf = __builtin_shufflevector(lo[db], hi[db], 0, 1, 2, 3, 4, 5, 6, 7);
            o[db] = __builtin_amdgcn_mfma_f32_16x16x32_bf16(vf, pf[ks], o[db], 0, 0, 0); }
    }
    const float inv = 1.f / ps;
#pragma unroll
    for (int db = 0; db < 4; ++db) { const f32x4 v = o[db] * inv; u32x2 w; w.x = pk2(v[0], v[1]); w.y = pk2(v[2], v[3]); *(LAS u32x2*)(ost + i * 144 + (16 * db + 4 * g) * 2) = w; }
    const size_t orow0 = (size_t)u.pat * MT + u.rowbase;
    if (g == 0) lse[(orow0 + (size_t)u.dil * (Lw + i)) * 16 + u.h] = mx + __builtin_amdgcn_logf(ps);
    LDS_WAIT();
#pragma unroll
    for (int n = 0; n < 2; ++n) { const int c = lane + 64 * n, rr = c >> 3, ch = c & 7; const u32x4 v = *(const LAS u32x4*)(ost + rr * 144 + ch * 16);
        *(u32x4*)(Op + (orow0 + (size_t)u.dil * (Lw + rr)) * 1024 + u.h * 64 + ch * 8) = v; }
    LDS_WAIT();
}
DI void attn_prompt_phase(const bf16_t* Q, const bf16_t* Kb, const bf16_t* Vb, bf16_t* Op, float* lse, LAS unsigned char* lds, int bx, int G, int wave, int lane) {
    constexpr int NU = 3 * 4096;
    int bu = bx; if (bu >= NU) return;
    AttUnit u = att_decode(bu); bf16x8 qn[2];
    att_stage(u, Kb, Vb, lds, wave, lane); att_loadq(u, Q, wave, lane, qn);
    int par = 0;
    for (;;) {
        asm volatile("s_waitcnt vmcnt(0)" ::: "memory");
        __syncthreads();
        bf16x8 qf[2]; qf[0] = qn[0]; qf[1] = qn[1];
        const AttUnit cur = u; const int nb = bu + G; const bool more = nb < NU;
        if (more) { u = att_decode(nb); att_stage(u, Kb, Vb, lds + (par ^ 1) * ATT_BUF, wave, lane); att_loadq(u, Q, wave, lane, qn); }
        att_compute(cur, qf, lds + par * ATT_BUF, lds + ATT_OST + wave * 2304, Op, lse, wave, lane);
        if (!more) break;
        bu = nb; par ^= 1;
    }
    __syncthreads();
}

DI void attn_sample_unit(const Params& p, int u, const bf16_t* Q, const bf16_t* Kb, const bf16_t* Vb, bf16_t* att, LAS float* sl, int lane) {
    const int h = u & 15, t = (u >> 4) & 3, b = u >> 6;
    const size_t qrow = (size_t)NP + b * 4 + t;
    const float* ck = p.in[4]; const float* cv = p.in[5];
    sl[lane] = bf2f(Q[qrow * 1024 + h * 64 + lane]);
    LDS_WAIT();
    float mx = -INFINITY;
#pragma unroll 1
    for (int e = 0; e < 9; ++e) { const int pat = e / 3, r = e - 3 * pat; const int dil = 1 << (2 * pat);
        const int j = lane + 64 * r; const bool valid = j <= 128; const int idx = 2048 + t - dil * (valid ? j : 0);
        float dot = 0.f;
        if (idx >= 2048) { const bf16_t* kp = Kb + ((size_t)NP + b * 4 + (idx - 2048)) * 1024 + h * 64;
#pragma unroll
            for (int d8 = 0; d8 < 8; ++d8) { const u32x4 kw = *(const u32x4*)(kp + 8 * d8); const f32x4 q0 = *(const LAS f32x4*)(sl + 8 * d8), q1 = *(const LAS f32x4*)(sl + 8 * d8 + 4);
                dot += (bflo(kw.x) * q0[0] + bfhi(kw.x) * q0[1]) + (bflo(kw.y) * q0[2] + bfhi(kw.y) * q0[3]) + (bflo(kw.z) * q1[0] + bfhi(kw.z) * q1[1]) + (bflo(kw.w) * q1[2] + bfhi(kw.w) * q1[3]); } }
        else { const float* kp = ck + (((size_t)b * 2048 + idx) * 16 + h) * 64;
#pragma unroll
            for (int d4 = 0; d4 < 16; ++d4) { const f32x4 kv = *(const f32x4*)(kp + 4 * d4); const f32x4 qv = *(const LAS f32x4*)(sl + 4 * d4); dot += (kv[0] * qv[0] + kv[1] * qv[1]) + (kv[2] * qv[2] + kv[3] * qv[3]); } }
        if (valid) { sl[64 + pat * 192 + j] = dot; mx = fmaxf(mx, dot); } }
    mx = wave_max(mx);
    LDS_WAIT();
    float ls = 0.f;
#pragma unroll 1
    for (int e = 0; e < 9; ++e) { const int pat = e / 3, r = e - 3 * pat; const int j = lane + 64 * r;
        if (j <= 128) { const float pv = __builtin_amdgcn_exp2f(sl[64 + pat * 192 + j] - mx); sl[64 + pat * 192 + j] = pv; ls += pv; } }
    ls = wave_sum(ls);
    LDS_WAIT();
    { const int kg = lane >> 4, d4 = lane & 15; f32x4 acc = (f32x4){0.f, 0.f, 0.f, 0.f};
#pragma unroll 1
      for (int pat = 0; pat < 3; ++pat) { const int dil = 1 << (2 * pat);
#pragma unroll
        for (int jj = 0; jj < 33; ++jj) { const int j = kg + 4 * jj; int idx = 2048 + t - dil * j; const bool use = (j <= 128) && (idx < 2048);
            idx = idx < 0 ? 0 : (idx > 2047 ? 2047 : idx); const float pv = use ? sl[64 + pat * 192 + (j > 128 ? 128 : j)] : 0.f;
            const f32x4 vv = *(const f32x4*)(cv + (((size_t)b * 2048 + idx) * 16 + h) * 64 + 4 * d4);
            acc += vv * pv; }
        if (kg == 0) { for (int j = 0; dil * j <= t; ++j) { const int idx = 2048 + t - dil * j; const float pv = sl[64 + pat * 192 + j];
            const u32x2 w = *(const u32x2*)(Vb + ((size_t)NP + b * 4 + (idx - 2048)) * 1024 + h * 64 + 4 * d4);
            acc += (f32x4){bflo(w.x), bfhi(w.x), bflo(w.y), bfhi(w.y)} * pv; } } }
#pragma unroll
      for (int e = 0; e < 4; ++e) { float a = acc[e]; a += __shfl_xor(a, 16); a += __shfl_xor(a, 32); acc[e] = a; }
      const float inv = 1.f / ls;
      if (kg == 0) { u32x2 w; w.x = pk2(acc[0] * inv, acc[1] * inv); w.y = pk2(acc[2] * inv, acc[3] * inv); *(u32x2*)(att + qrow * 1024 + h * 64 + 4 * d4) = w; } }
    LDS_WAIT();
}


#define XB_TMO      128
#define XB_XCNT(j)  (256  + 64 * (j))
#define XB_XSUB(j)  (1280 + 64 * (j))
#define XB_XGEN(j)  (2304 + 64 * (j))
#define XB_TOP      3328
#define XB_TOPGEN   3392
#define XCD_BAR_WORDS 3456
#define XB_SPIN_CAP (1u << 22)
DI unsigned xb_ld(unsigned* p)              { return __hip_atomic_load(p, __ATOMIC_RELAXED, __HIP_MEMORY_SCOPE_AGENT); }
DI unsigned xb_add(unsigned* p, unsigned v) { return __hip_atomic_fetch_add(p, v, __ATOMIC_RELAXED, __HIP_MEMORY_SCOPE_AGENT); }
DI unsigned xb_xcc_id() { return (unsigned)__builtin_amdgcn_s_getreg((3 << 11) | 20) & 0xFu; }
#define XB_SPIN(cond, bar) do { unsigned _sp = 0; while (cond) { __builtin_amdgcn_s_sleep(1); \
    if ((++_sp & 255u) == 0u) { if (xb_ld(&(bar)[XB_TMO])) break; if (_sp > XB_SPIN_CAP) { atomicAdd(&(bar)[XB_TMO], 1u); break; } } } } while (0)
struct XcdBarrier { unsigned* bar; unsigned x; volatile LAS unsigned* st; bool w0; };
DI XcdBarrier xcd_barrier_post(unsigned* bar, volatile LAS unsigned* st, const bool w0) {
    XcdBarrier b; b.bar = bar; b.x = xb_xcc_id(); b.st = st; b.w0 = w0;
    if (w0 && lane_id() == 0) (void)xb_add(&bar[XB_XCNT(b.x)], 1u);
    return b;
}
DI void xcd_barrier_complete(unsigned* bar, unsigned x, unsigned& nloc, unsigned& nx) {
    const unsigned G = gridDim.x * gridDim.y * gridDim.z;
    unsigned sum, cnt, mine, sp = 0u;
    for (;;) {
        sum = 0u; cnt = 0u; mine = 0u;
#pragma unroll
        for (unsigned j = 0; j < 16; ++j) { const unsigned c = xb_ld(&bar[XB_XCNT(j)]); sum += c; cnt += (c > 0u) ? 1u : 0u; mine = (j == x) ? c : mine; }
        if (sum == G) break;
        __builtin_amdgcn_s_sleep(1);
        if ((++sp & 255u) == 0u) { if (xb_ld(&bar[XB_TMO])) break; if (sp > XB_SPIN_CAP) { atomicAdd(&bar[XB_TMO], 1u); break; } }
    }
    nloc = mine > 0u ? mine : 1u; nx = cnt > 0u ? cnt : 1u;
}
DI void xcd_barrier(const XcdBarrier& b) {
    asm volatile("s_waitcnt vmcnt(0)" ::: "memory");
    __syncthreads();
    if (b.w0 && lane_id() == 0) {
        unsigned* bar = b.bar;
        __builtin_amdgcn_s_waitcnt(0);
        unsigned nloc = b.st[0], nx = b.st[1];
        if (nloc == 0u) { xcd_barrier_complete(bar, b.x, nloc, nx); b.st[0] = nloc; b.st[1] = nx; }
        const unsigned old = xb_add(&bar[XB_XSUB(b.x)], 1u);
        const unsigned gen = old / nloc;
        if (old + 1u == (gen + 1u) * nloc) {
            __builtin_amdgcn_fence(__ATOMIC_RELEASE, "agent");
            asm volatile("s_waitcnt vmcnt(0)" ::: "memory");
            const unsigned og = xb_add(&bar[XB_TOP], 1u);
            const unsigned tg = og / nx;
            if (og + 1u == (tg + 1u) * nx) xb_add(&bar[XB_TOPGEN], 1u);
            else XB_SPIN(xb_ld(&bar[XB_TOPGEN]) == tg, bar);
            __builtin_amdgcn_fence(__ATOMIC_ACQUIRE, "agent");
            xb_add(&bar[XB_XGEN(b.x)], 1u);
            asm volatile("s_waitcnt vmcnt(0)" ::: "memory");
        } else {
            XB_SPIN(xb_ld(&bar[XB_XGEN(b.x)]) == gen, bar);
            __builtin_amdgcn_fence(__ATOMIC_ACQUIRE, "agent");
            asm volatile("s_waitcnt vmcnt(0)" ::: "memory");
        }
    }
    __syncthreads();
}

#define w_in_t ((bf16_t*)(ws + WS_WIN))
#define w_out_t ((bf16_t*)(ws + WS_WOUT))
#define w_glu_t ((bf16_t*)(ws + WS_WGLU))
#define w_pool_t ((bf16_t*)(ws + WS_WPOOL))
#define w_o_t ((bf16_t*)(ws + WS_WO))
#define w_qkv_t ((bf16_t*)(ws + WS_WQKV))
#define Bt1 ((bf16_t*)(ws + WS_BT1))
#define Bt2 ((bf16_t*)(ws + WS_BT2))
#define rowss ((float*)(ws + WS_ROWSS))
#define uss ((float*)(ws + WS_USS))
#define lse ((float*)(ws + WS_LSE))
#define xn ((bf16_t*)(ws + WS_XN))
#define ybuf ((bf16_t*)(ws + WS_Y))
#define hbuf16 ((bf16_t*)(ws + WS_H))
#define Ap ((bf16_t*)(ws + WS_AP))
#define Sbuf ((float*)(ws + WS_S))
#define upool ((float*)(ws + WS_UPOOL))
#define dbuf ((bf16_t*)(ws + WS_D))
#define zbuf ((bf16_t*)(ws + WS_Z))
#define ycat ((bf16_t*)(ws + WS_YCAT))
#define hact ((bf16_t*)(ws + WS_HACT))
#define Qb ((bf16_t*)(ws + WS_Q))
#define Kb ((bf16_t*)(ws + WS_K))
#define Vb ((bf16_t*)(ws + WS_V))
#define Op ((bf16_t*)(ws + WS_OP))
#define att ((bf16_t*)(ws + WS_ATT))
#define gains (p.in[6])
#ifndef PHMASK
#define PHMASK 0xFFFFFFFFu
#endif
#ifndef DUPMASK
#define DUPMASK 0u
#endif
#define PHASE_BEGIN(k) if (((PHMASK >> (k)) & 1u) && p.ph_lo <= (k) && (k) < p.ph_hi) { for (int _rep = 0; _rep < 1 + (int)((DUPMASK >> (k)) & 1u); ++_rep) { if (_rep) __syncthreads(); const int lane = lane_id(); const int tid = wave * 64 + lane; const int gt = bx * 512 + tid; (void)gt;
#define PHASE_END(k) } } if (p.ph_lo <= (k) && (k) + 1 < p.ph_hi) { if ((k) == 0) { grid.sync(); xbar = xcd_barrier_post((unsigned*)(p.ws + WS_CTL), (volatile LAS unsigned*)(lds + 157696), wave == 0); } else xcd_barrier(xbar); }

template <int layer>
DI void layer_tail(const Params& p, LAS unsigned char* lds, cg::grid_group& grid, XcdBarrier& xbar, const int bx, const int G, const int gw, const int NGW, const int wave) {
    unsigned char* ws = p.ws;
    constexpr int pb = 6 + layer * 8;
    const float* gl = gains + (size_t)layer * 4 * DM;
        PHASE_BEGIN(pb)
        { const bf16_t* A = layer == 0 ? ycat : att; const bf16_t* W = layer == 0 ? w_out_t : w_o_t;
          { UStd<EpiY> U{A, W, (size_t)256 * DM, (size_t)256 * DM, 0, 128, 4, G, bx, EpiY{ybuf, 0, 0}};
            gemm_phase(lds, wave, DM, DM, DM, U); }
          { EpiY E{ybuf, 0, 0}; mini_gemm(A, DM, W, DM, DM, 1024, 0, E, bx, G, wave, lane); } }
        PHASE_END(pb)
        PHASE_BEGIN(pb + 1)
        { const RowPass rp{layer == 0 ? 0 : 1, gl + DM, gl + 2 * DM, p.in[0], p.in[1], hbuf16, ybuf, xn, p.out};
          for (int q = gw; q < NP / 4; q += NGW) rp.rows4(q * 4, lane);
          for (int r = NP + (NGW - 1 - gw); r < NT; r += NGW) rp.row(r, lane); }
        PHASE_END(pb + 1)
        PHASE_BEGIN(pb + 2)
        { const bf16_t* W = (const bf16_t*)(ws + (layer ? WS_GU1 : WS_GU0));
          { UStd<EpiGU> U{xn, W, (size_t)256 * DM, (size_t)256 * DM, 0, 128, 22, G, bx, EpiGU{hact, 0, 0}};
            gemm_phase(lds, wave, DM, DM, DM, U); }
          { EpiGU E{hact, 0, 0}; mini_gemm_gu(xn, W, E, bx, G, wave, lane); } }
        PHASE_END(pb + 2)
        PHASE_BEGIN(pb + 3)
        { const bf16_t* W = (const bf16_t*)(ws + (layer ? WS_DN1 : WS_DN0));
          { UStd<EpiY> U{hact, W, (size_t)256 * FF, (size_t)256 * FF, 0, 128, 4, G, bx, EpiY{ybuf, 0, 0}};
            gemm_phase(lds, wave, FF, FF, FF, U); }
          { EpiY E{ybuf, 0, 0}; mini_gemm(hact, FF, W, FF, FF, 1024, 0, E, bx, G, wave, lane); } }
        PHASE_END(pb + 3)
        PHASE_BEGIN(pb + 4)
        { const RowPass rp{layer == 0 ? 1 : 2, gl + 3 * DM, gains + 4 * DM, p.in[0], p.in[1], hbuf16, ybuf, xn, p.out};
          for (int q = gw; q < NP / 4; q += NGW) rp.rows4(q * 4, lane);
          for (int r = NP + (NGW - 1 - gw); r < NT; r += NGW) rp.row(r, lane); }
        PHASE_END(pb + 4)
    }

__global__ void __launch_bounds__(512, 2) mega(Params p) {
    extern __shared__ __attribute__((aligned(16))) unsigned char lds_raw[];
    LAS unsigned char* lds = (LAS unsigned char*)lds_raw;
    cg::grid_group grid = cg::this_grid();
    const int wave = __builtin_amdgcn_readfirstlane((int)threadIdx.x >> 6);
    const int G = gridDim.x, bx = blockIdx.x;
    const int gw = bx * 8 + wave, NGW = G * 8;
    const int NGT = G * 512;
    unsigned char* ws = p.ws;
    XcdBarrier xbar; xbar.bar = (unsigned*)(ws + WS_CTL); xbar.x = 0; xbar.st = (volatile LAS unsigned*)(lds + 157696); xbar.w0 = wave == 0;
    { const int tid = wave * 64 + lane_id();
      if (tid < 64) ((LAS unsigned*)(lds + 157696))[tid] = 0u;
      if (bx == 0) { for (int i = tid; i < 4096; i += 512) ((unsigned*)(ws + WS_CTL))[i] = 0u; } }
    __syncthreads();

    PHASE_BEGIN(0)
    {
        if (bx < 32) { s5_tables(p, bx, lds, Bt1 + (size_t)bx * 65536, Bt2 + (size_t)bx * 98304, tid); }
        LAS float* scr = (LAS float*)(lds + wave * 16384);
        constexpr int I_IN = 512, I_OUT = 512, I_GLU = 128, I_POOL = 32, I_O = 512, I_QKV = 1536, I_G = 1408, I_D = 1408;
        constexpr int NITEMS = I_IN + I_OUT + I_GLU + I_POOL + I_O + I_QKV + 4 * I_G + 2 * I_D;
        for (int it = gw; it < NITEMS; it += NGW) {
            int r = it;
            if (r < I_IN) { tr_plain(p.in[7], 1024, 1024, w_in_t, r, scr, lane); continue; } r -= I_IN;
            if (r < I_OUT) { tr_plain(p.in[20], 1024, 1024, w_out_t, r, scr, lane); continue; } r -= I_OUT;
            if (r < I_GLU) { tr_plain(p.in[18], 512, 512, w_glu_t, r, scr, lane); continue; } r -= I_GLU;
            if (r < I_POOL) { const int gg = r >> 3, q = r & 7, kb = q >> 2, nb = q & 3;
                transpose_item(p.in[8] + (size_t)gg * 16384, 128, 64 * kb, 32 * nb, w_pool_t, 256, gg * 128 + 32 * nb, (gg & 1) * 128 + 64 * kb, scr, lane); continue; } r -= I_POOL;
            if (r < I_O) { tr_plain(p.in[22], 1024, 1024, w_o_t, r, scr, lane); continue; } r -= I_O;
            if (r < I_QKV) { tr_plain(p.in[21], 1024, 3072, w_qkv_t, r, scr, lane); continue; } r -= I_QKV;
            if (r < 4 * I_G) { const int which = r / I_G, q = r % I_G; const int layer = which >> 1, up = which & 1;
                const float* W = p.in[up ? 24 : 23] + (size_t)layer * 1024 * FF; bf16_t* WT = (bf16_t*)(ws + (layer ? WS_GU1 : WS_GU0));
                const int nblk = FF / 32, kb = q / nblk, nb = q % nblk, n0 = 32 * nb;
                transpose_item(W, FF, 64 * kb, n0, WT, 1024, (n0 >> 7) * 256 + up * 128 + (n0 & 127), 64 * kb, scr, lane); continue; } r -= 4 * I_G;
            { const int layer = r / I_D, q = r % I_D; tr_plain(p.in[25] + (size_t)layer * FF * 1024, FF, 1024, (bf16_t*)(ws + (layer ? WS_DN1 : WS_DN0)), q, scr, lane); }
        }
        for (int it = gt; it < 512 * 16; it += NGT) { const int n = it >> 4, c8 = it & 15; const int gg = n >> 7;
            *(u32x4*)(w_pool_t + (size_t)n * 256 + ((gg & 1) ^ 1) * 128 + c8 * 8) = (u32x4){0u, 0u, 0u, 0u}; }
        if (bx >= 32 || G <= 32) { const int gwn = G > 32 ? (bx - 32) * 8 + wave : gw, ngwn = G > 32 ? (G - 32) * 8 : NGW;
          for (int r = gwn; r < NT; r += 2 * ngwn) { const int r2 = r + ngwn; const bool two = r2 < NT;
            norm_row2(in_row(p, r), in_row(p, two ? r2 : r), gains, xn + (size_t)r * DM, xn + (size_t)(two ? r2 : r) * DM, lane); } }
    }
    PHASE_END(0)

    PHASE_BEGIN(1)
    { UStd<EpiProj> U{xn, w_in_t, (size_t)256 * DM, (size_t)256 * DM, 0, 128, 4, G, bx, EpiProj{upool, Ap, uss, 0, 0}};
      gemm_phase(lds, wave, DM, DM, DM, U);
      { EpiProj E{upool, Ap, uss, 0, 0}; mini_gemm(xn, DM, w_in_t, DM, DM, 1024, 0, E, bx, G, wave, lane); } }
    PHASE_END(1)

    PHASE_BEGIN(2)
    {
        { US5<EpiS1> U{Ap + 128, Bt1, (size_t)65536, G, bx, EpiS1{Sbuf, 0, 0}};
          gemm_phase(lds, wave, 384, 256, 256, U); }
        for (int u = gw; u < 1024; u += NGW) s5_sample_unit(p, u, uss, zbuf, lane);
        for (int it = gt; it < (NP / 16) * 128; it += NGT) { const int cq = it & 127, run = it >> 7; const int c = cq * 4, gi = c >> 7, w = 2 << gi;
            const int t0 = run * 16, tb0 = t0 & (TP - 1); const float* up = upool + (size_t)t0 * 512 + c;
            f32x4 e[31];
#pragma unroll
            for (int k = 0; k < 31; ++k) { const int rel = k - 15; e[k] = (rel >= 1 - w && tb0 + rel >= 0) ? *(const f32x4*)(up + (ptrdiff_t)rel * 512) : (f32x4){0.f, 0.f, 0.f, 0.f}; }
            f32x4 sum = (f32x4){0.f, 0.f, 0.f, 0.f};
#pragma unroll
            for (int k = 0; k < 15; ++k) sum += e[k];
#pragma unroll
            for (int k = 0; k < 16; ++k) { const f32x4 uv = e[15 + k]; sum += uv; const int tb = tb0 + k; const int cnt = tb + 1 < w ? tb + 1 : w;
                const f32x4 dv = sum * (1.0f / (float)cnt) - uv; u32x2 o; o.x = pk2(dv[0], dv[1]); o.y = pk2(dv[2], dv[3]); *(u32x2*)(dbuf + (size_t)(t0 + k) * 512 + c) = o;
                f32x4 out_ = (f32x4){0.f, 0.f, 0.f, 0.f};
                if (w == 2) out_ = e[15 + k - 1]; else if (w == 4) out_ = e[15 + k - 3]; else if (w == 8) out_ = e[15 + k - 7]; else out_ = e[15 + k - 15];
                sum -= out_;
                if (tb >= TP - 15) *(f32x4*)(p.out + O_POOLP + ((size_t)(t0 >> 13) * 15 + (tb - (TP - 15))) * 512 + c) = uv; } }
        for (int it = gt; it < 32 * 128; it += NGT) { const int cq = it & 127, b = it >> 7; const int c = cq * 4, gi = c >> 7, w = 2 << gi;
            const float* sp = p.in[2] + (size_t)b * 15 * 512 + c; const float* up = upool + (size_t)(NP + b * 4) * 512 + c;
            for (int t = 0; t < 4; ++t) { f32x4 sum = (f32x4){0.f, 0.f, 0.f, 0.f};
                for (int s = 0; s < w; ++s) { const int e = 15 + t - s; sum += e >= 15 ? *(const f32x4*)(up + (size_t)(e - 15) * 512) : *(const f32x4*)(sp + (size_t)e * 512); }
                const f32x4 uv = *(const f32x4*)(up + (size_t)t * 512); const f32x4 dv = sum * (1.0f / (float)w) - uv;
                u32x2 o; o.x = pk2(dv[0], dv[1]); o.y = pk2(dv[2], dv[3]); *(u32x2*)(dbuf + (size_t)(NP + b * 4 + t) * 512 + c) = o; }
            for (int r = 0; r < 15; ++r) { const f32x4 v = r < 11 ? *(const f32x4*)(sp + (size_t)(r + 4) * 512) : *(const f32x4*)(up + (size_t)(r - 11) * 512);
                *(f32x4*)(p.out + O_POOLS + ((size_t)b * 15 + r) * 512 + c) = v; } }
    }
    PHASE_END(2)

    PHASE_BEGIN(3)
    {
        { const bool act = bx < 128; const int b = (bx >> 5) & 3, g = bx & 31;
          LAS float* ex = (LAS float*)lds;
          float c_r = 1.f, c_i = 0.f, hr = 0.f, hi = 0.f;
          const float* Sp = Sbuf + ((size_t)g * 2048 + b * 512 + wave * 64) * 128 + lane; bf16_t* Hp = Ap + ((size_t)g * 2048 + b * 512 + wave * 64) * 384 + lane;
          if (act) {
            const float dt = __expf(p.in[12][g]); const float zr = p.in[10][g * 64 + lane] * dt * 16.f, zi = p.in[11][g * 64 + lane] * dt * 16.f;
            float sn, cs; sincos_acc(zi, sn, cs); const float mag = __expf(zr); c_r = mag * cs; c_i = mag * sn;
            for (int c0 = 0; c0 < 64; c0 += 16) { float sr[16], si[16];
#pragma unroll
                for (int k = 0; k < 16; ++k) { sr[k] = Sp[(size_t)(c0 + k) * 128]; si[k] = Sp[(size_t)(c0 + k) * 128 + 64]; }
#pragma unroll
                for (int k = 0; k < 16; ++k) { const float n_r = c_r * hr - c_i * hi + sr[k], n_i = c_r * hi + c_i * hr + si[k]; hr = n_r; hi = n_i; } }
            ex[(wave * 64 + lane) * 2] = hr; ex[(wave * 64 + lane) * 2 + 1] = hi;
          }
          __syncthreads();
          if (act) {
            float l_r = c_r, l_i = c_i;
#pragma unroll
            for (int e = 0; e < 6; ++e) { const float t_r = l_r * l_r - l_i * l_i, t_i = 2.f * l_r * l_i; l_r = t_r; l_i = t_i; }
            hr = 0.f; hi = 0.f;
            for (int sg = 0; sg < wave; ++sg) { const float e_r = ex[(sg * 64 + lane) * 2], e_i = ex[(sg * 64 + lane) * 2 + 1];
                const float n_r = l_r * hr - l_i * hi + e_r, n_i = l_r * hi + l_i * hr + e_i; hr = n_r; hi = n_i; }
            for (int c0 = 0; c0 < 64; c0 += 16) { float sr[16], si[16];
#pragma unroll
                for (int k = 0; k < 16; ++k) { sr[k] = Sp[(size_t)(c0 + k) * 128]; si[k] = Sp[(size_t)(c0 + k) * 128 + 64]; }
#pragma unroll
                for (int k = 0; k < 16; ++k) { const unsigned w = pk2(hr, hi); Hp[(size_t)(c0 + k) * 384] = (bf16_t)(w & 0xffffu); Hp[(size_t)(c0 + k) * 384 + 64] = (bf16_t)(w >> 16);
                    const float n_r = c_r * hr - c_i * hi + sr[k], n_i = c_r * hi + c_i * hr + si[k]; hr = n_r; hi = n_i; } }
            if (wave == 7) { float* o = p.out + O_S5P + (((size_t)b * 32 + g) * 64 + lane) * 2; o[0] = hr; o[1] = hi; }
          }
        }
        __syncthreads();
        { UStd<EpiPool> U{dbuf, w_pool_t, (size_t)256 * 512, (size_t)256 * 256, 256, 128, 2, G, bx, EpiPool{ycat, p.in[9], 0, 0}};
          gemm_phase(lds, wave, 512, 256, 256, U); }
        { EpiPool E{ycat, p.in[9], 0, 0}; mini_gemm(dbuf, 512, w_pool_t, 256, 256, 512, 256, E, bx, G, wave, lane); }
    }
    PHASE_END(3)

    PHASE_BEGIN(4)
    { US5<EpiS2> U{Ap, Bt2, (size_t)98304, G, bx, EpiS2{zbuf, Ap, p.in[17], 0, 0}};
      gemm_phase(lds, wave, 384, 384, 384, U); }
    PHASE_END(4)

    PHASE_BEGIN(5)
    { UStd<EpiGlu> U{zbuf, w_glu_t, (size_t)256 * 512, (size_t)256 * 512, 0, 128, 2, G, bx, EpiGlu{ycat, zbuf, p.in[19], 0, 0}};
      gemm_phase(lds, wave, 512, 512, 512, U);
      { EpiGlu E{ycat, zbuf, p.in[19], 0, 0}; mini_gemm(zbuf, 512, w_glu_t, 512, 512, 512, 0, E, bx, G, wave, lane); } }
    PHASE_END(5)

    layer_tail<0>(p, lds, grid, xbar, bx, G, gw, NGW, wave);
            PHASE_BEGIN(11)
            { UStd<EpiQKV> U{xn, w_qkv_t, (size_t)256 * DM, (size_t)256 * DM, 0, 128, 12, G, bx, EpiQKV{Qb, p.out, 0, 0}};
              gemm_phase(lds, wave, DM, DM, DM, U);
              { EpiQKV E{Qb, p.out, 0, 0}; mini_gemm(xn, DM, w_qkv_t, DM, DM, 3072, 0, E, bx, G, wave, lane); } }
            PHASE_END(11)
            PHASE_BEGIN(12)
            {
                attn_prompt_phase(Qb, Kb, Vb, Op, lse, lds, bx, G, wave, lane);
            }
            PHASE_END(12)
            PHASE_BEGIN(13)
            {
              for (int pass = 0; pass < 2; ++pass) { const bool do_sample = (pass == 0) == ((wave & 1) == 0);
              if (do_sample) { for (int u = gw; u < 2048; u += NGW) attn_sample_unit(p, u, Qb, Kb, Vb, att, (LAS float*)(lds + wave * 8192), lane); }
              else for (int it = gt; it < NP * 128; it += NGT) { const int c8 = it & 127, row = it >> 7, h = c8 >> 3;
                const float l0 = lse[(size_t)row * 16 + h], l1 = lse[((size_t)MT + row) * 16 + h], l2 = lse[((size_t)2 * MT + row) * 16 + h];
                const float mx = fmaxf(l0, fmaxf(l1, l2)); float w0 = __builtin_amdgcn_exp2f(l0 - mx), w1 = __builtin_amdgcn_exp2f(l1 - mx), w2 = __builtin_amdgcn_exp2f(l2 - mx); const float inv = 1.f / (w0 + w1 + w2); w0 *= inv; w1 *= inv; w2 *= inv;
                const u32x4 a = *(const u32x4*)(Op + (size_t)row * 1024 + c8 * 8), b = *(const u32x4*)(Op + ((size_t)MT + row) * 1024 + c8 * 8), c = *(const u32x4*)(Op + ((size_t)2 * MT + row) * 1024 + c8 * 8);
                u32x4 o;
                o.x = pk2(w0 * bflo(a.x) + w1 * bflo(b.x) + w2 * bflo(c.x), w0 * bfhi(a.x) + w1 * bfhi(b.x) + w2 * bfhi(c.x));
                o.y = pk2(w0 * bflo(a.y) + w1 * bflo(b.y) + w2 * bflo(c.y), w0 * bfhi(a.y) + w1 * bfhi(b.y) + w2 * bfhi(c.y));
                o.z = pk2(w0 * bflo(a.z) + w1 * bflo(b.z) + w2 * bflo(c.z), w0 * bfhi(a.z) + w1 * bfhi(b.z) + w2 * bfhi(c.z));
                o.w = pk2(w0 * bflo(a.w) + w1 * bflo(b.w) + w2 * bflo(c.w), w0 * bfhi(a.w) + w1 * bfhi(b.w) + w2 * bfhi(c.w));
                *(u32x4*)(att + (size_t)row * 1024 + c8 * 8) = o; } } }
            PHASE_END(13)
            layer_tail<1>(p, lds, grid, xbar, bx, G, gw, NGW, wave);
}

constexpr int NPHASES = 19;

extern "C" void kernel_launch(void* const* d_in, const int* in_sizes, int n_in, void* d_out, int out_size, void* d_ws, size_t ws_size, hipStream_t stream) {
    static int grid = 0;
    if (grid == 0) {
        int dev = 0, cus = 0, per_cu = 0;
        hipGetDevice(&dev);
        hipDeviceGetAttribute(&cus, hipDeviceAttributeMultiprocessorCount, dev);
        hipFuncSetAttribute((const void*)mega, hipFuncAttributeMaxDynamicSharedMemorySize, LDS_BYTES);
        hipOccupancyMaxActiveBlocksPerMultiprocessor(&per_cu, (const void*)mega, 512, LDS_BYTES);
        if (per_cu < 1) per_cu = 1;
        grid = cus * 1;
        if (ws_size < WS_END) fprintf(stderr, "kernel_launch: workspace too small: %zu < %zu\n", ws_size, (size_t)WS_END);
        fprintf(stderr, "kernel_launch: cus %d per_cu %d grid %d n_in %d out %d ws %zu\n", cus, per_cu, grid, n_in, out_size, ws_size);
    }
    Params p{};
    for (int i = 0; i < 26; ++i) p.in[i] = (const float*)d_in[i];
    p.out = (float*)d_out; p.ws = (unsigned char*)d_ws; p.ph_lo = 0; p.ph_hi = NPHASES;
    void* args[] = {&p};
    hipError_t e = hipLaunchCooperativeKernel((const void*)mega, dim3(grid), dim3(512), args, LDS_BYTES, stream);
    if (e != hipSuccess) fprintf(stderr, "cooperative launch failed: %s (grid %d)\n", hipGetErrorString(e), grid);
}
```

```cpp
#include <hip/hip_runtime.h>
#include <hip/hip_cooperative_groups.h>
#include <cstdio>
#include <cstdint>
namespace cg = cooperative_groups;

#define LAS __attribute__((address_space(3)))
#define DI __device__ __forceinline__
typedef unsigned short bf16_t;
typedef short bf16x8 __attribute__((ext_vector_type(8)));
typedef short s16x4 __attribute__((ext_vector_type(4)));
typedef float f32x4 __attribute__((ext_vector_type(4)));
typedef unsigned u32x4 __attribute__((ext_vector_type(4)));
typedef unsigned u32x2 __attribute__((ext_vector_type(2)));
typedef __bf16 bf2_t __attribute__((ext_vector_type(2)));

constexpr int NP = 32768, NS = 128, NT = NP + NS, MT = 33024, DM = 1024, FF = 2816, TP = 8192;
constexpr float EPS = 1e-6f;
constexpr int LDS_BYTES = 157696 + 256;
constexpr size_t O_YP = 0, O_YS = 33554432, O_POOLP = 33685504, O_S5P = 33716224, O_KP = 33732608, O_VP = 42121216,
                 O_POOLS = 50509824, O_S5S = 50755584, O_KS = 50886656, O_VS = 51017728;
constexpr size_t MiB = 1u << 20;
constexpr size_t WS_WIN = 0, WS_WOUT = 2 * MiB, WS_WGLU = 4 * MiB, WS_WPOOL = 4 * MiB + 512 * 1024, WS_WO = 5 * MiB, WS_WQKV = 7 * MiB,
                 WS_GU0 = 13 * MiB, WS_GU1 = 24 * MiB, WS_DN0 = 35 * MiB, WS_DN1 = 41 * MiB, WS_BT1 = 47 * MiB, WS_BT2 = 51 * MiB,
                 WS_ROWSS = 57 * MiB, WS_USS = 60 * MiB, WS_LSE = 61 * MiB, WS_XN = 68 * MiB, WS_Y = 133 * MiB, WS_H = 198 * MiB,
                 WS_X = 328 * MiB;
constexpr size_t WS_AP = WS_X, WS_S = WS_X + 48 * MiB, WS_UPOOL = WS_X + 80 * MiB, WS_D = WS_X + 145 * MiB, WS_Z = WS_X + 178 * MiB,
                 WS_YCAT = WS_X + 211 * MiB;
constexpr size_t WS_HACT = WS_X;
constexpr size_t WS_Q = WS_X, WS_K = WS_X + 65 * MiB, WS_V = WS_X + 130 * MiB, WS_OP = WS_X + 195 * MiB, WS_ATT = WS_X + 389 * MiB;
constexpr size_t WS_END = WS_X + 454 * MiB;
constexpr size_t WS_CTL = 60 * MiB + 512 * 1024;

struct Params { const float* in[26]; float* out; unsigned char* ws; int ph_lo, ph_hi; };

DI unsigned pk2(float lo, float hi) { bf2_t v; v.x = (__bf16)lo; v.y = (__bf16)hi; return __builtin_bit_cast(unsigned, v); }
DI float bflo(unsigned w) { return __uint_as_float(w << 16); }
DI float bfhi(unsigned w) { return __uint_as_float(w & 0xffff0000u); }
DI float bf2f(bf16_t b) { return __uint_as_float((unsigned)b << 16); }
DI float wave_sum(float v) {
#pragma unroll
    for (int o = 1; o < 64; o <<= 1) v += __shfl_xor(v, o);
    return v;
}
DI float wave_max(float v) {
#pragma unroll
    for (int o = 1; o < 64; o <<= 1) v = fmaxf(v, __shfl_xor(v, o));
    return v;
}
DI float sigmoidf_(float x) { return __builtin_amdgcn_rcpf(1.0f + __builtin_amdgcn_exp2f(-1.4426950408889634f * x)); }
DI float gelu_tanh(float y) { const float u = 0.7978845608028654f * (y + 0.044715f * y * y * y); return y * __builtin_amdgcn_rcpf(1.0f + __builtin_amdgcn_exp2f(-2.0f * 1.4426950408889634f * u)); }
DI void sincos_acc(float a, float& s, float& c) {
    if (fabsf(a) < 0.5f) {
        const float a2 = a * a;
        s = a * (1.f - a2 * (1.f / 6.f) * (1.f - a2 * (1.f / 20.f) * (1.f - a2 * (1.f / 42.f))));
        c = 1.f - a2 * 0.5f * (1.f - a2 * (1.f / 12.f) * (1.f - a2 * (1.f / 30.f) * (1.f - a2 * (1.f / 56.f))));
    } else {
        float r = a * 0.15915494309189535f; r -= floorf(r);
        s = __builtin_amdgcn_sinf(r); c = __builtin_amdgcn_cosf(r);
    }
}
DI int lane_id() { int l; asm volatile("v_mbcnt_lo_u32_b32 %0, -1, 0\n\tv_mbcnt_hi_u32_b32 %0, -1, %0" : "=v"(l)); return l; }
#define LDS_WAIT() asm volatile("s_waitcnt lgkmcnt(0)" ::: "memory")
#define VM_WAIT() asm volatile("s_waitcnt vmcnt(0)" ::: "memory")

constexpr int BM = 256, BK = 64, HALF = 128, NXCD = 8, WGM = 8;
typedef f32x4 Acc[2][2][4][2];
DI int lds_byte(int r, int c) { const int st = (r >> 4) * 2 + (c >> 5), rr = r & 15, cc = c & 31, ob = rr * 64 + cc * 2; return st * 1024 + (ob ^ (((ob >> 9) & 1) << 5)); }
DI void stage_rc(int b, int& R, int& C) { const int st = b / 1024, sb = b % 1024, swz = sb ^ (((sb >> 9) & 1) << 5); R = (st >> 1) * 16 + swz / 64; C = (st & 1) * 32 + (swz % 64) / 2; }

DI bool unit_next(int i, int G, int c, int nM, int nN, int& pm, int& pn) {
    const int nwg = nM * nN; const long L = (long)i * G + c; if (L >= nwg) return false;
    int wgid = (int)L; { const int q = nwg / NXCD, r = nwg % NXCD, xcd = wgid % NXCD, off = wgid / NXCD; wgid = (xcd < r ? xcd * (q + 1) : r * (q + 1) + (xcd - r) * q) + off; }
    const int nig = WGM * nN, gid = wgid / nig, fm = gid * WGM, gsz = (nM - fm) < WGM ? (nM - fm) : WGM;
    pm = fm + ((wgid % nig) % gsz); pn = (wgid % nig) / gsz; return true;
}

template <class Units>
DI void gemm_phase(LAS unsigned char* lds, const int wid, const int lda, const int ldb, const int K, const Units& U) {
    typedef typename Units::Epi Epi;
    const int lane = lane_id(), tid = wid * 64 + lane, wr = wid >> 2, wc = wid & 3, fr = lane & 15, fq = lane >> 4;
    unsigned offA, offB;
    { int R, C; stage_rc(tid * 16, R, C); offA = (unsigned)(R * lda + C) * 2u;
      const int rho = R & 31, Rb = (R & ~31) + 8 * ((rho & 15) >> 2) + 4 * (rho >> 4) + (rho & 3);
      offB = (unsigned)(Rb * ldb + C) * 2u; }
    const unsigned ldsw = (unsigned)wid * 1024u;
    const unsigned hA = (unsigned)(HALF * lda * 2), hB = (unsigned)(HALF * ldb * 2), dA = (unsigned)(64 * lda * 2), dB = (unsigned)(64 * ldb * 2);
    const int aoff = lds_byte(wr * 64 + fr, fq * 8), boff = lds_byte(wc * 32 + fr, fq * 8);
#define SA(b, h) (((b) * 2 + (h)) * 16384)
#define SB(b, h) ((4 + (b) * 2 + (h)) * 16384)
#define STG(bufoff, gbase, soff, voff, dlt) do { _Pragma("unroll") for (int _i = 0; _i < 2; ++_i) { unsigned _vo = (voff); asm volatile("" : "+v"(_vo)); _vo += (unsigned)(soff) + (unsigned)_i * (dlt); \
        __builtin_amdgcn_global_load_lds((const unsigned*)((gbase) + _vo), (LAS unsigned*)(lds + (bufoff) + ldsw + _i * 8192), 16, 0, 0); } } while (0)
#define STA(b, h, base, kt) STG(SA(b, h), base, (h) * hA + (unsigned)(kt) * 128u, offA, dA)
#define STB(b, h, base, kt) STG(SB(b, h), base, (h) * hB + (unsigned)(kt) * 128u, offB, dB)
#define LDA(dst, b, h) do { _Pragma("unroll") for (int m = 0; m < 4; ++m) _Pragma("unroll") for (int k = 0; k < 2; ++k) dst[m][k] = *(const LAS bf16x8*)(lds + SA(b, h) + aoff + m * 2048 + k * 1024); } while (0)
#define LDB(dst, b, h) do { _Pragma("unroll") for (int n = 0; n < 2; ++n) _Pragma("unroll") for (int k = 0; k < 2; ++k) dst[n][k] = *(const LAS bf16x8*)(lds + SB(b, h) + boff + n * 2048 + k * 1024); } while (0)
#define MMA(ai, bj, Af, Bf) do { __builtin_amdgcn_s_setprio(1); _Pragma("unroll") for (int m = 0; m < 4; ++m) _Pragma("unroll") for (int n = 0; n < 2; ++n) _Pragma("unroll") for (int k = 0; k < 2; ++k) \
        acc[ai][bj][m][n] = __builtin_amdgcn_mfma_f32_16x16x32_bf16(Bf[n][k], Af[m][k], acc[ai][bj][m][n], 0, 0, 0); __builtin_amdgcn_s_setprio(0); } while (0)
#define WAIT_V(n) asm volatile("s_waitcnt vmcnt(" #n ")" ::: "memory")
#define WAIT_L(n) asm volatile("s_waitcnt lgkmcnt(" #n ")" ::: "memory")
#define BAR __builtin_amdgcn_s_barrier()
#define SCHED __builtin_amdgcn_sched_barrier(0)
#define ZERO_ACC() do { _Pragma("unroll") for (int a = 0; a < 2; ++a) _Pragma("unroll") for (int b = 0; b < 2; ++b) _Pragma("unroll") for (int m = 0; m < 4; ++m) _Pragma("unroll") for (int n = 0; n < 2; ++n) acc[a][b][m][n] = (f32x4){0.f, 0.f, 0.f, 0.f}; } while (0)
    const bf16_t* pa; const bf16_t* pb; Epi Ecur, Enxt;
    if (!U.get(0, pa, pb, Ecur)) return;
    const char* cA = (const char*)pa; const char* cB = (const char*)pb;
    Acc acc; ZERO_ACC();
    bf16x8 At[4][2], B0[2][2], B1[2][2];
    const int nt = K / BK;
    STB(0, 0, cB, 0); STB(0, 1, cB, 0); STA(0, 0, cA, 0); STA(0, 1, cA, 0);
    if (wr == 1) BAR;
    WAIT_V(2); BAR;
    STB(1, 0, cB, 1); STA(1, 0, cA, 1); STB(1, 1, cB, 1);
    WAIT_V(6); BAR;
    for (int ui = 0;; ++ui) {
        const bool has_next = U.get(ui + 1, pa, pb, Enxt);
        const char* nA = has_next ? (const char*)pa : cA; const char* nB = has_next ? (const char*)pb : cB;
        for (int t = 0; t < nt; t += 2) {
            const bool last = (t == nt - 2);
            const char* a2 = last ? nA : cA; const char* b2 = last ? nB : cB; const int k2 = last ? 0 : t + 2, k3 = k2 + 1;
            LDB(B0, 0, 0); LDB(B1, 0, 1); SCHED; LDA(At, 0, 0); STA(1, 1, cA, t + 1);
            WAIT_V(8); WAIT_L(0); BAR; MMA(0, 0, At, B0); MMA(0, 1, At, B1); BAR; SCHED;
            LDA(At, 0, 1); STB(0, 0, b2, k2); STB(0, 1, b2, k2); STA(0, 0, a2, k2);
            WAIT_V(8); WAIT_L(0); BAR; MMA(1, 0, At, B0); MMA(1, 1, At, B1); BAR; SCHED;
            LDB(B0, 1, 0); LDB(B1, 1, 1); SCHED; LDA(At, 1, 0); STA(0, 1, a2, k2);
            WAIT_V(8); WAIT_L(0); BAR; MMA(0, 0, At, B0); MMA(0, 1, At, B1); BAR; SCHED;
            LDA(At, 1, 1); STB(1, 0, b2, k3); STB(1, 1, b2, k3); STA(1, 0, a2, k3);
            WAIT_V(8); WAIT_L(0); BAR; MMA(1, 0, At, B0); MMA(1, 1, At, B1); BAR; SCHED;
        }
        if (wr == 0) BAR;
        Ecur(acc, wr, wc, fr, fq);
        if (!has_next) break;
        ZERO_ACC();
        cA = nA; cB = nB; Ecur = Enxt;
        if (wr == 1) BAR;
    }
    WAIT_V(0);
    BAR;
#undef ZERO_ACC
#undef SA
#undef SB
#undef STG
#undef STA
#undef STB
#undef LDA
#undef LDB
#undef MMA
#undef WAIT_V
#undef WAIT_L
#undef BAR
#undef SCHED
}

#define EPI_ROWS(...) _Pragma("unroll") for (int ai = 0; ai < 2; ++ai) _Pragma("unroll") for (int m = 0; m < 4; ++m) { const int rr = ai * 128 + wr * 64 + m * 16 + fr; __VA_ARGS__ }
#define EPI_COLS8(...) _Pragma("unroll") for (int bj = 0; bj < 2; ++bj) { const int cc = bj * 128 + wc * 32 + 8 * fq; const f32x4 v0 = acc[ai][bj][m][0], v1 = acc[ai][bj][m][1]; __VA_ARGS__ }
#define EPI_COLS(...) _Pragma("unroll") for (int bj = 0; bj < 2; ++bj) _Pragma("unroll") for (int n = 0; n < 2; ++n) { const int cc = bj * 128 + wc * 32 + 8 * fq + 4 * n; const f32x4 v = acc[ai][bj][m][n]; __VA_ARGS__ }

struct EpiProj {
    float* upool; bf16_t* Ap; float* uss; int row0, col0;
    DI void set(int pm, int pn) { row0 = pm * 256; col0 = pn * 256; }
    DI void elem(int row, int col, const f32x4 v) const {
        if (col < 512) *(f32x4*)(upool + (size_t)row * 512 + col) = v; else *(f32x4*)(uss + (size_t)(row - NP) * 512 + (col - 512)) = v; }
    DI void operator()(const Acc& acc, int wr, int wc, int fr, int fq) const {
        if (col0 < 512) {
            EPI_ROWS(const size_t row = row0 + rr; EPI_COLS(*(f32x4*)(upool + row * 512 + col0 + cc) = v;))
        } else {
            EPI_ROWS(const int row = row0 + rr;
                EPI_COLS8(const int c2 = col0 - 512 + cc; const int g = c2 >> 4, i = c2 & 15;
                    if (row < NP) { u32x4 w; w.x = pk2(v0[0], v0[1]); w.y = pk2(v0[2], v0[3]); w.z = pk2(v1[0], v1[1]); w.w = pk2(v1[2], v1[3]);
                        *(u32x4*)(Ap + ((size_t)g * 2048 + (row >> 4)) * 384 + 128 + (row & 15) * 16 + i) = w; }
                    else if (row < NT) { *(f32x4*)(uss + (size_t)(row - NP) * 512 + c2) = v0; *(f32x4*)(uss + (size_t)(row - NP) * 512 + c2 + 4) = v1; }))
        }
    }
};
struct EpiS1 {
    float* S; int g, row0;
    DI void set(int mt, int gg) { row0 = mt * 256; g = gg; }
    DI void operator()(const Acc& acc, int wr, int wc, int fr, int fq) const {
        EPI_ROWS(const size_t row = (size_t)g * 2048 + row0 + rr;
            _Pragma("unroll") for (int n = 0; n < 2; ++n) { const int cc = wc * 32 + 8 * fq + 4 * n; *(f32x4*)(S + row * 128 + cc) = acc[ai][0][m][n]; })
    }
};
struct EpiPool {
    bf16_t* ycat; const float* scale; int row0, col0;
    DI void set(int pm, int pn) { row0 = pm * 256; col0 = pn * 256; }
    DI void elem(int row, int col, const f32x4 v) const { const f32x4 s = *(const f32x4*)(scale + col); u32x2 w; w.x = pk2(v[0] * s[0], v[1] * s[1]); w.y = pk2(v[2] * s[2], v[3] * s[3]);
        *(u32x2*)(ycat + (size_t)row * 1024 + col) = w; }
    DI void operator()(const Acc& acc, int wr, int wc, int fr, int fq) const {
        EPI_ROWS(const size_t row = row0 + rr;
            EPI_COLS8(const int col = col0 + cc; const f32x4 s0 = *(const f32x4*)(scale + col), s1 = *(const f32x4*)(scale + col + 4); u32x4 w;
                w.x = pk2(v0[0] * s0[0], v0[1] * s0[1]); w.y = pk2(v0[2] * s0[2], v0[3] * s0[3]); w.z = pk2(v1[0] * s1[0], v1[1] * s1[1]); w.w = pk2(v1[2] * s1[2], v1[3] * s1[3]);
                *(u32x4*)(ycat + row * 1024 + col) = w;))
    }
};
struct EpiS2 {
    bf16_t* z; const bf16_t* Ap; const float* dskip; int g, row0;
    DI void set(int mt, int gg) { row0 = mt * 256; g = gg; }
    DI void operator()(const Acc& acc, int wr, int wc, int fr, int fq) const {
        EPI_ROWS(const int chunk = row0 + rr; const bf16_t* ap = Ap + ((size_t)g * 2048 + chunk) * 384 + 128;
            EPI_COLS8(const int r = cc >> 4, i = cc & 15; const u32x4 uw = *(const u32x4*)(ap + cc); const f32x4 d0 = *(const f32x4*)(dskip + g * 16 + i), d1 = *(const f32x4*)(dskip + g * 16 + i + 4);
                const float y0 = v0[0] + d0[0] * bflo(uw.x), y1 = v0[1] + d0[1] * bfhi(uw.x), y2 = v0[2] + d0[2] * bflo(uw.y), y3 = v0[3] + d0[3] * bfhi(uw.y);
                const float y4 = v1[0] + d1[0] * bflo(uw.z), y5 = v1[1] + d1[1] * bfhi(uw.z), y6 = v1[2] + d1[2] * bflo(uw.w), y7 = v1[3] + d1[3] * bfhi(uw.w);
                u32x4 w; w.x = pk2(gelu_tanh(y0), gelu_tanh(y1)); w.y = pk2(gelu_tanh(y2), gelu_tanh(y3)); w.z = pk2(gelu_tanh(y4), gelu_tanh(y5)); w.w = pk2(gelu_tanh(y6), gelu_tanh(y7));
                *(u32x4*)(z + ((size_t)chunk * 16 + r) * 512 + g * 16 + i) = w;))
    }
};
struct EpiGlu {
    bf16_t* ycat; const bf16_t* z; const float* bglu; int row0, col0;
    DI void set(int pm, int pn) { row0 = pm * 256; col0 = pn * 256; }
    DI void elem(int row, int col, const f32x4 v) const { const u32x2 zw = *(const u32x2*)(z + (size_t)row * 512 + col); const f32x4 b = *(const f32x4*)(bglu + col);
        u32x2 w; w.x = pk2(bflo(zw.x) * sigmoidf_(v[0] + b[0]), bfhi(zw.x) * sigmoidf_(v[1] + b[1])); w.y = pk2(bflo(zw.y) * sigmoidf_(v[2] + b[2]), bfhi(zw.y) * sigmoidf_(v[3] + b[3]));
        *(u32x2*)(ycat + (size_t)row * 1024 + 512 + col) = w; }
    DI void operator()(const Acc& acc, int wr, int wc, int fr, int fq) const {
        EPI_ROWS(const size_t row = row0 + rr;
            EPI_COLS8(const int col = col0 + cc; const u32x4 zw = *(const u32x4*)(z + row * 512 + col); const f32x4 b0 = *(const f32x4*)(bglu + col), b1 = *(const f32x4*)(bglu + col + 4);
                u32x4 w; w.x = pk2(bflo(zw.x) * sigmoidf_(v0[0] + b0[0]), bfhi(zw.x) * sigmoidf_(v0[1] + b0[1]));
                w.y = pk2(bflo(zw.y) * sigmoidf_(v0[2] + b0[2]), bfhi(zw.y) * sigmoidf_(v0[3] + b0[3]));
                w.z = pk2(bflo(zw.z) * sigmoidf_(v1[0] + b1[0]), bfhi(zw.z) * sigmoidf_(v1[1] + b1[1]));
                w.w = pk2(bflo(zw.w) * sigmoidf_(v1[2] + b1[2]), bfhi(zw.w) * sigmoidf_(v1[3] + b1[3]));
                *(u32x4*)(ycat + row * 1024 + 512 + col) = w;))
    }
};
struct EpiY {
    bf16_t* y; int row0, col0;
    DI void set(int pm, int pn) { row0 = pm * 256; col0 = pn * 256; }
    DI void elem(int row, int col, const f32x4 v) const { u32x2 w; w.x = pk2(v[0], v[1]); w.y = pk2(v[2], v[3]); *(u32x2*)(y + (size_t)row * 1024 + col) = w; }
    DI void operator()(const Acc& acc, int wr, int wc, int fr, int fq) const {
        EPI_ROWS(const size_t row = row0 + rr;
            _Pragma("unroll") for (int bj = 0; bj < 2; ++bj) { const int cc = bj * 128 + wc * 32 + 8 * fq; const f32x4 v0 = acc[ai][bj][m][0], v1 = acc[ai][bj][m][1];
                u32x4 w; w.x = pk2(v0[0], v0[1]); w.y = pk2(v0[2], v0[3]); w.z = pk2(v1[0], v1[1]); w.w = pk2(v1[2], v1[3]); *(u32x4*)(y + row * 1024 + col0 + cc) = w; })
    }
};
struct EpiGU {
    bf16_t* hact; int row0, hb;
    DI void set(int pm, int pn) { row0 = pm * 256; hb = pn; }
    DI void elem2(int row, int col, const f32x4 a, const f32x4 u) const { u32x2 w; w.x = pk2(a[0] * sigmoidf_(a[0]) * u[0], a[1] * sigmoidf_(a[1]) * u[1]); w.y = pk2(a[2] * sigmoidf_(a[2]) * u[2], a[3] * sigmoidf_(a[3]) * u[3]);
        *(u32x2*)(hact + (size_t)row * FF + col) = w; }
    DI void operator()(const Acc& acc, int wr, int wc, int fr, int fq) const {
        EPI_ROWS(const size_t row = row0 + rr; const int cc = wc * 32 + 8 * fq; u32x4 w;
            { const f32x4 a = acc[ai][0][m][0], u = acc[ai][1][m][0]; w.x = pk2(a[0] * sigmoidf_(a[0]) * u[0], a[1] * sigmoidf_(a[1]) * u[1]); w.y = pk2(a[2] * sigmoidf_(a[2]) * u[2], a[3] * sigmoidf_(a[3]) * u[3]); }
            { const f32x4 a = acc[ai][0][m][1], u = acc[ai][1][m][1]; w.z = pk2(a[0] * sigmoidf_(a[0]) * u[0], a[1] * sigmoidf_(a[1]) * u[1]); w.w = pk2(a[2] * sigmoidf_(a[2]) * u[2], a[3] * sigmoidf_(a[3]) * u[3]); }
            *(u32x4*)(hact + row * FF + hb * 128 + cc) = w;)
    }
};
struct EpiQKV {
    bf16_t* qkv; float* out; int row0, col0;
    DI void set(int pm, int pn) { row0 = pm * 256; col0 = pn * 256; }
    DI void elem(int row, int colg, const f32x4 v) const {
        const int which = colg >> 10, col = colg & 1023; const float sc = which == 0 ? 0.125f * 1.4426950408889634f : 1.0f;
        u32x2 w; w.x = pk2(v[0] * sc, v[1] * sc); w.y = pk2(v[2] * sc, v[3] * sc);
        *(u32x2*)(qkv + (size_t)which * (65 * MiB / 2) + (size_t)row * 1024 + col) = w;
        if (which != 0) *(f32x4*)(out + (which == 1 ? O_KS : O_VS) + (size_t)(row - NP) * 1024 + col) = v; }
    DI void operator()(const Acc& acc, int wr, int wc, int fr, int fq) const {
        const int which = col0 >> 10; const int cb = col0 & 1023; const float sc = which == 0 ? 0.125f * 1.4426950408889634f : 1.0f;
        bf16_t* dst = qkv + (size_t)which * (65 * MiB / 2);
        float* op = out + (which == 1 ? O_KP : O_VP); float* os = out + (which == 1 ? O_KS : O_VS);
        EPI_ROWS(const int row = row0 + rr;
            EPI_COLS8(const int col = cb + cc; u32x4 w; w.x = pk2(v0[0] * sc, v0[1] * sc); w.y = pk2(v0[2] * sc, v0[3] * sc); w.z = pk2(v1[0] * sc, v1[1] * sc); w.w = pk2(v1[2] * sc, v1[3] * sc);
                *(u32x4*)(dst + (size_t)row * 1024 + col) = w;
                if (which != 0) {
                    if (row < NP) { const int tb = row & (TP - 1); if (tb >= TP - 2048) { float* o = op + ((size_t)(row >> 13) * 2048 + (tb - (TP - 2048))) * 1024 + col; *(f32x4*)o = v0; *(f32x4*)(o + 4) = v1; } }
                    else if (row < NT) { float* o = os + (size_t)(row - NP) * 1024 + col; *(f32x4*)o = v0; *(f32x4*)(o + 4) = v1; }
                }))
    }
};


template <class EpiT> struct UStd {
    typedef EpiT Epi; const bf16_t* A; const bf16_t* Bt; size_t astep, bstep; int acolstep, nM, nN, G, c; EpiT proto;
    DI bool get(int i, const bf16_t*& a, const bf16_t*& b, EpiT& e) const { int pm, pn; if (!unit_next(i, G, c, nM, nN, pm, pn)) return false;
        a = A + (size_t)pm * astep + (size_t)pn * acolstep; b = Bt + (size_t)pn * bstep; e = proto; e.set(pm, pn); return true; }
};
template <class EpiT> struct US5 {
    typedef EpiT Epi; const bf16_t* A; const bf16_t* Bt; size_t bstep; int G, c; EpiT proto;
    DI bool get(int i, const bf16_t*& a, const bf16_t*& b, EpiT& e) const { const int L = c + i * G; if (L >= 256) return false; const int g = L >> 3, mt = L & 7;
        a = A + ((size_t)g * 2048 + mt * 256) * 384; b = Bt + (size_t)g * bstep; e = proto; e.set(mt, g); return true; }
};

DI f32x4 mini_acc(const bf16_t* Arow, const bf16_t* Brow, int K) {
    f32x4 acc = (f32x4){0.f, 0.f, 0.f, 0.f};
    int k0 = 0;
    for (; k0 + 512 <= K; k0 += 512) { bf16x8 a[16], b[16];
#pragma unroll
        for (int e = 0; e < 16; ++e) { a[e] = *(const bf16x8*)(Arow + k0 + 32 * e); b[e] = *(const bf16x8*)(Brow + k0 + 32 * e); }
#pragma unroll
        for (int e = 0; e < 16; ++e) acc = __builtin_amdgcn_mfma_f32_16x16x32_bf16(b[e], a[e], acc, 0, 0, 0); }
    if (k0 < K) { bf16x8 a[8], b[8];
#pragma unroll
        for (int e = 0; e < 8; ++e) { a[e] = *(const bf16x8*)(Arow + k0 + 32 * e); b[e] = *(const bf16x8*)(Brow + k0 + 32 * e); }
#pragma unroll
        for (int e = 0; e < 8; ++e) acc = __builtin_amdgcn_mfma_f32_16x16x32_bf16(b[e], a[e], acc, 0, 0, 0); }
    return acc;
}
DI void mini_acc2(const bf16_t* Arow, const bf16_t* Bg, const bf16_t* Bu, int K, f32x4& ga, f32x4& ua) {
    ga = (f32x4){0.f, 0.f, 0.f, 0.f}; ua = ga;
    for (int k0 = 0; k0 < K; k0 += 256) { bf16x8 a[8], g[8], u[8];
#pragma unroll
        for (int e = 0; e < 8; ++e) { a[e] = *(const bf16x8*)(Arow + k0 + 32 * e); g[e] = *(const bf16x8*)(Bg + k0 + 32 * e); u[e] = *(const bf16x8*)(Bu + k0 + 32 * e); }
#pragma unroll
        for (int e = 0; e < 8; ++e) { ga = __builtin_amdgcn_mfma_f32_16x16x32_bf16(g[e], a[e], ga, 0, 0, 0); ua = __builtin_amdgcn_mfma_f32_16x16x32_bf16(u[e], a[e], ua, 0, 0, 0); } }
}
template <class Epi>
DI void mini_gemm(const bf16_t* A, int lda, const bf16_t* Bt, int ldb, int K, int N, int acol_per_256, const Epi& E, int bx, int G, int wave, int lane) {
    const int fr = lane & 15, fq = lane >> 4; const int row = NP + 16 * wave + fr;
    for (int q = bx; q < N / 16; q += G) {
        const bf16_t* Arow = A + (size_t)row * lda + ((16 * q) >> 8) * acol_per_256 + 8 * fq;
        const bf16_t* Brow = Bt + (size_t)(16 * q + fr) * ldb + 8 * fq;
        const f32x4 acc = mini_acc(Arow, Brow, K);
        E.elem(row, 16 * q + 4 * fq, acc); }
}
DI void mini_gemm_gu(const bf16_t* A, const bf16_t* Bt, const EpiGU& E, int bx, int G, int wave, int lane) {
    const int fr = lane & 15, fq = lane >> 4; const int row = NP + 16 * wave + fr;
    for (int q = bx; q < FF / 16; q += G) { const int hcol = 16 * q; const int brow = (hcol >> 7) * 256 + (hcol & 127) + fr;
        const bf16_t* Arow = A + (size_t)row * DM + 8 * fq;
        f32x4 ga, ua; mini_acc2(Arow, Bt + (size_t)brow * DM + 8 * fq, Bt + (size_t)(brow + 128) * DM + 8 * fq, DM, ga, ua);
        E.elem2(row, hcol + 4 * fq, ga, ua); }
}
DI void transpose_item(const float* W, int N, int k0, int n0, bf16_t* WT, int ldt, int orow0, int ocol0, LAS float* scr, int lane) {
#pragma unroll 16
    for (int i = 0; i < 32; ++i) { const int kk = 2 * i + (lane >> 5); scr[kk * 33 + (lane & 31)] = W[(size_t)(k0 + kk) * N + n0 + (lane & 31)]; }
    LDS_WAIT();
    const int c = lane & 7;
#pragma unroll
    for (int j = 0; j < 4; ++j) { const int n = (lane >> 3) + 8 * j; const LAS float* s = scr + (8 * c) * 33 + n;
        u32x4 o; o.x = pk2(s[0 * 33], s[1 * 33]); o.y = pk2(s[2 * 33], s[3 * 33]); o.z = pk2(s[4 * 33], s[5 * 33]); o.w = pk2(s[6 * 33], s[7 * 33]);
        *(u32x4*)(WT + (size_t)(orow0 + n) * ldt + ocol0 + 8 * c) = o; }
    LDS_WAIT();
}
DI void tr_plain(const float* W, int K, int N, bf16_t* WT, int item, LAS float* scr, int lane) {
    const int nblk = N / 32, kb = item / nblk, nb = item % nblk; transpose_item(W, N, 64 * kb, 32 * nb, WT, K, 32 * nb, 64 * kb, scr, lane);
}

DI const float* in_row(const Params& p, int r) { return r < NP ? p.in[0] + (size_t)r * DM : p.in[1] + (size_t)(r - NP) * DM; }

DI void norm_row(const float* xr, const float* g, bf16_t* o, int lane) {
    f32x4 v[4]; float s = 0.f;
#pragma unroll
    for (int j = 0; j < 4; ++j) { v[j] = *(const f32x4*)(xr + 4 * lane + 256 * j); s += (v[j][0] * v[j][0] + v[j][1] * v[j][1]) + (v[j][2] * v[j][2] + v[j][3] * v[j][3]); }
    const float r = rsqrtf(wave_sum(s) * (1.f / DM) + EPS);
#pragma unroll
    for (int j = 0; j < 4; ++j) { const f32x4 gg = *(const f32x4*)(g + 4 * lane + 256 * j); u32x2 w; w.x = pk2(v[j][0] * r * gg[0], v[j][1] * r * gg[1]); w.y = pk2(v[j][2] * r * gg[2], v[j][3] * r * gg[3]);
        *(u32x2*)(o + 4 * lane + 256 * j) = w; }
}
DI void norm_row2(const float* xa, const float* xb, const float* g, bf16_t* oa, bf16_t* ob, int lane) {
    f32x4 va[4], vb[4]; float sa = 0.f, sb = 0.f;
#pragma unroll
    for (int j = 0; j < 4; ++j) { va[j] = *(const f32x4*)(xa + 4 * lane + 256 * j); vb[j] = *(const f32x4*)(xb + 4 * lane + 256 * j); }
#pragma unroll
    for (int j = 0; j < 4; ++j) { sa += (va[j][0] * va[j][0] + va[j][1] * va[j][1]) + (va[j][2] * va[j][2] + va[j][3] * va[j][3]); sb += (vb[j][0] * vb[j][0] + vb[j][1] * vb[j][1]) + (vb[j][2] * vb[j][2] + vb[j][3] * vb[j][3]); }
    const float ra = rsqrtf(wave_sum(sa) * (1.f / DM) + EPS), rb = rsqrtf(wave_sum(sb) * (1.f / DM) + EPS);
#pragma unroll
    for (int j = 0; j < 4; ++j) { const f32x4 gg = *(const f32x4*)(g + 4 * lane + 256 * j); u32x2 w;
        w.x = pk2(va[j][0] * ra * gg[0], va[j][1] * ra * gg[1]); w.y = pk2(va[j][2] * ra * gg[2], va[j][3] * ra * gg[3]); *(u32x2*)(oa + 4 * lane + 256 * j) = w;
        w.x = pk2(vb[j][0] * rb * gg[0], vb[j][1] * rb * gg[1]); w.y = pk2(vb[j][2] * rb * gg[2], vb[j][3] * rb * gg[3]); *(u32x2*)(ob + 4 * lane + 256 * j) = w; }
}
template <bool INB, bool OUTB>
DI void res_row(const void* hin_, const bf16_t* y, const float* gpost, const float* gnext, void* hout_, bf16_t* xn, int lane) {
    u32x2 yw[4]; float ss = 0.f;
#pragma unroll
    for (int j = 0; j < 4; ++j) { yw[j] = *(const u32x2*)(y + 4 * lane + 256 * j); const float a = bflo(yw[j].x), b = bfhi(yw[j].x), c = bflo(yw[j].y), d = bfhi(yw[j].y); ss += (a * a + b * b) + (c * c + d * d); }
    const float r1 = rsqrtf(wave_sum(ss) * (1.f / DM) + EPS);
    f32x4 h[4]; float s2 = 0.f;
#pragma unroll
    for (int j = 0; j < 4; ++j) { const int c = 4 * lane + 256 * j; f32x4 hv;
        if (INB) { const u32x2 hw = *(const u32x2*)((const bf16_t*)hin_ + c); hv = (f32x4){bflo(hw.x), bfhi(hw.x), bflo(hw.y), bfhi(hw.y)}; } else hv = *(const f32x4*)((const float*)hin_ + c);
        const f32x4 gp = *(const f32x4*)(gpost + c);
        h[j][0] = hv[0] + bflo(yw[j].x) * r1 * gp[0]; h[j][1] = hv[1] + bfhi(yw[j].x) * r1 * gp[1]; h[j][2] = hv[2] + bflo(yw[j].y) * r1 * gp[2]; h[j][3] = hv[3] + bfhi(yw[j].y) * r1 * gp[3];
        if (OUTB) { u32x2 w; w.x = pk2(h[j][0], h[j][1]); w.y = pk2(h[j][2], h[j][3]); *(u32x2*)((bf16_t*)hout_ + c) = w;
            h[j] = (f32x4){bflo(w.x), bfhi(w.x), bflo(w.y), bfhi(w.y)}; }
        else *(f32x4*)((float*)hout_ + c) = h[j];
        s2 += (h[j][0] * h[j][0] + h[j][1] * h[j][1]) + (h[j][2] * h[j][2] + h[j][3] * h[j][3]); }
    if (xn) {
        const float r2 = rsqrtf(wave_sum(s2) * (1.f / DM) + EPS);
#pragma unroll
        for (int j = 0; j < 4; ++j) { const int c = 4 * lane + 256 * j; const f32x4 gn = *(const f32x4*)(gnext + c); u32x2 w; w.x = pk2(h[j][0] * r2 * gn[0], h[j][1] * r2 * gn[1]); w.y = pk2(h[j][2] * r2 * gn[2], h[j][3] * r2 * gn[3]);
            *(u32x2*)(xn + c) = w; }
    }
}

template <bool INB, bool OUTB, int R>
DI void res_rows(const void* const (&hin_)[R], const bf16_t* const (&y)[R], const float* gpost, const float* gnext, void* const (&hout_)[R], bf16_t* const (&xn)[R], const bool has_xn, int lane) {
    u32x2 yw[R][4]; f32x4 hv[R][4];
#pragma unroll
    for (int q = 0; q < R; ++q)
#pragma unroll
        for (int j = 0; j < 4; ++j) { const int c = 4 * lane + 256 * j; yw[q][j] = *(const u32x2*)(y[q] + c);
            if (INB) { const u32x2 hw = *(const u32x2*)((const bf16_t*)hin_[q] + c); hv[q][j] = (f32x4){bflo(hw.x), bfhi(hw.x), bflo(hw.y), bfhi(hw.y)}; } else hv[q][j] = *(const f32x4*)((const float*)hin_[q] + c); }
    f32x4 gp[4];
#pragma unroll
    for (int j = 0; j < 4; ++j) gp[j] = *(const f32x4*)(gpost + 4 * lane + 256 * j);
#pragma unroll
    for (int q = 0; q < R; ++q) {
        float ss = 0.f;
#pragma unroll
        for (int j = 0; j < 4; ++j) { const float a = bflo(yw[q][j].x), b = bfhi(yw[q][j].x), c = bflo(yw[q][j].y), d = bfhi(yw[q][j].y); ss += (a * a + b * b) + (c * c + d * d); }
        const float r1 = rsqrtf(wave_sum(ss) * (1.f / DM) + EPS);
        float s2 = 0.f;
#pragma unroll
        for (int j = 0; j < 4; ++j) { const int c = 4 * lane + 256 * j; f32x4 h;
            h[0] = hv[q][j][0] + bflo(yw[q][j].x) * r1 * gp[j][0]; h[1] = hv[q][j][1] + bfhi(yw[q][j].x) * r1 * gp[j][1]; h[2] = hv[q][j][2] + bflo(yw[q][j].y) * r1 * gp[j][2]; h[3] = hv[q][j][3] + bfhi(yw[q][j].y) * r1 * gp[j][3];
            if (OUTB) { u32x2 w; w.x = pk2(h[0], h[1]); w.y = pk2(h[2], h[3]); *(u32x2*)((bf16_t*)hout_[q] + c) = w; h = (f32x4){bflo(w.x), bfhi(w.x), bflo(w.y), bfhi(w.y)}; }
            else *(f32x4*)((float*)hout_[q] + c) = h;
            s2 += (h[0] * h[0] + h[1] * h[1]) + (h[2] * h[2] + h[3] * h[3]); hv[q][j] = h; }
        if (has_xn) { const float r2 = rsqrtf(wave_sum(s2) * (1.f / DM) + EPS);
#pragma unroll
            for (int j = 0; j < 4; ++j) { const int c = 4 * lane + 256 * j; const f32x4 gn = *(const f32x4*)(gnext + c); u32x2 w; w.x = pk2(hv[q][j][0] * r2 * gn[0], hv[q][j][1] * r2 * gn[1]); w.y = pk2(hv[q][j][2] * r2 * gn[2], hv[q][j][3] * r2 * gn[3]);
                *(u32x2*)(xn[q] + c) = w; } }
    }
}

struct RowPass { int mode; const float* gpost; const float* gnext; const float* xp; const float* xs; bf16_t* h16; const bf16_t* y; bf16_t* xnp; float* out;
    DI void row(int r, int lane) const {
        const bf16_t* yr = y + (size_t)r * DM; bf16_t* hr = h16 + (size_t)r * DM;
        if (mode == 0) res_row<false, true>(r < NP ? xp + (size_t)r * DM : xs + (size_t)(r - NP) * DM, yr, gpost, gnext, hr, xnp + (size_t)r * DM, lane);
        else if (mode == 1) res_row<true, true>(hr, yr, gpost, gnext, hr, xnp + (size_t)r * DM, lane);
        else res_row<true, false>(hr, yr, gpost, gnext, r < NP ? out + O_YP + (size_t)r * DM : out + O_YS + (size_t)(r - NP) * DM, nullptr, lane);
    }
    DI void rows4(int r0, int lane) const {
        const void* hin[4]; const bf16_t* yr[4]; void* ho[4]; bf16_t* xo[4];
#pragma unroll
        for (int q = 0; q < 4; ++q) { const size_t o = (size_t)(r0 + q) * DM; yr[q] = y + o; xo[q] = xnp + o;
            hin[q] = mode == 0 ? (const void*)(xp + o) : (const void*)(h16 + o); ho[q] = mode == 2 ? (void*)(out + O_YP + o) : (void*)(h16 + o); }
        if (mode == 0) res_rows<false, true, 4>(hin, yr, gpost, gnext, ho, xo, true, lane);
        else if (mode == 1) res_rows<true, true, 4>(hin, yr, gpost, gnext, ho, xo, true, lane);
        else res_rows<true, false, 4>(hin, yr, gpost, gnext, ho, xo, false, lane);
    }
    DI void rows8(int r0, int lane) const {
        const void* hin[8]; const bf16_t* yr[8]; void* ho[8]; bf16_t* xo[8];
#pragma unroll
        for (int q = 0; q < 8; ++q) { const size_t o = (size_t)(r0 + q) * DM; yr[q] = y + o; xo[q] = xnp + o;
            hin[q] = mode == 0 ? (const void*)(xp + o) : (const void*)(h16 + o); ho[q] = mode == 2 ? (void*)(out + O_YP + o) : (void*)(h16 + o); }
        if (mode == 0) res_rows<false, true, 8>(hin, yr, gpost, gnext, ho, xo, true, lane);
        else if (mode == 1) res_rows<true, true, 8>(hin, yr, gpost, gnext, ho, xo, true, lane);
        else res_rows<true, false, 8>(hin, yr, gpost, gnext, ho, xo, false, lane);
    }
};

DI void s5_tables(const Params& p, int g, LAS unsigned char* lds, bf16_t* Bt1, bf16_t* Bt2, const int tid) {
    LAS float* pwr = (LAS float*)lds;
    LAS float* pwi = pwr + 17 * 64;
    LAS float* bbr = pwi + 17 * 64;
    LAS float* bbi = bbr + 1024;
    LAS float* cr = bbi + 1024;
    LAS float* ci = cr + 1024;
    LAS float* Kd = ci + 1024;
    const float dt = __expf(p.in[12][g]);
    const float* lre = p.in[10] + g * 64; const float* lim = p.in[11] + g * 64;
    for (int it = tid; it < 17 * 64; it += 512) { const int d = it >> 6, q = it & 63; const float zr = lre[q] * dt * (float)d, zi = lim[q] * dt * (float)d;
        float s, c; sincos_acc(zi, s, c); const float mag = __expf(zr); pwr[it] = mag * c; pwi[it] = mag * s; }
    for (int it = tid; it < 1024; it += 512) { const int q = it >> 4, i = it & 15;
        const float lr = lre[q], li = lim[q], zr = lr * dt, zi = li * dt;
        float s, c, sh, ch; sincos_acc(zi, s, c); sincos_acc(0.5f * zi, sh, ch);
        const float em1 = expm1f(zr); const float nr = em1 * c - 2.f * sh * sh, ni = (em1 + 1.f) * s;
        const float den = 1.f / (lr * lr + li * li); const float fr_ = (nr * lr + ni * li) * den, fi_ = (ni * lr - nr * li) * den;
        const float br = p.in[13][(size_t)g * 1024 + it], bi = p.in[14][(size_t)g * 1024 + it];
        bbr[it] = fr_ * br - fi_ * bi; bbi[it] = fr_ * bi + fi_ * br;
        cr[it] = p.in[15][(size_t)g * 1024 + it]; ci[it] = p.in[16][(size_t)g * 1024 + it]; }
    __syncthreads();
    for (int it = tid; it < 4096; it += 512) { const int d = it >> 8, i = (it >> 4) & 15, j = it & 15; float a = 0.f;
        for (int q = 0; q < 64; ++q) { const float c_r = cr[i * 64 + q], c_i = ci[i * 64 + q], p_r = pwr[d * 64 + q], p_i = pwi[d * 64 + q];
            const float xr = c_r * p_r - c_i * p_i, xi = c_r * p_i + c_i * p_r; a += xr * bbr[q * 16 + j] - xi * bbi[q * 16 + j]; }
        Kd[it] = a; }
    __syncthreads();
    for (int it = tid; it < 256 * 32; it += 512) { const int n = it >> 5, k0 = (it & 31) * 8; float v[8];
#pragma unroll
        for (int e = 0; e < 8; ++e) { const int k = k0 + e, s = k >> 4, i = k & 15; float val = 0.f;
            if (n < 128) { const int q = n & 63; const float p_r = pwr[(15 - s) * 64 + q], p_i = pwi[(15 - s) * 64 + q], b_r = bbr[q * 16 + i], b_i = bbi[q * 16 + i];
                val = n < 64 ? (p_r * b_r - p_i * b_i) : (p_r * b_i + p_i * b_r); }
            v[e] = val; }
        u32x4 o; o.x = pk2(v[0], v[1]); o.y = pk2(v[2], v[3]); o.z = pk2(v[4], v[5]); o.w = pk2(v[6], v[7]);
        *(u32x4*)(Bt1 + (size_t)n * 256 + k0) = o; }
    for (int it = tid; it < 256 * 48; it += 512) { const int n = it / 48, k0 = (it % 48) * 8; const int r = n >> 4, i = n & 15; float v[8];
#pragma unroll
        for (int e = 0; e < 8; ++e) { const int k = k0 + e; float val;
            if (k < 128) { const int q = k & 63; const float c_r = cr[i * 64 + q], c_i = ci[i * 64 + q], p_r = pwr[(r + 1) * 64 + q], p_i = pwi[(r + 1) * 64 + q];
                val = k < 64 ? (c_r * p_r - c_i * p_i) : -(c_r * p_i + c_i * p_r); }
            else { const int kk = k - 128, s = kk >> 4, j = kk & 15; val = s <= r ? Kd[(r - s) * 256 + i * 16 + j] : 0.f; }
            v[e] = val; }
        u32x4 o; o.x = pk2(v[0], v[1]); o.y = pk2(v[2], v[3]); o.z = pk2(v[4], v[5]); o.w = pk2(v[6], v[7]);
        *(u32x4*)(Bt2 + (size_t)n * 384 + k0) = o; }
    __syncthreads();
}

DI void s5_sample_unit(const Params& p, int u, const float* uss, bf16_t* z, int lane) {
    const int g = u & 31, b = u >> 5;
    const float dt = __expf(p.in[12][g]);
    const float lr = p.in[10][g * 64 + lane], li = p.in[11][g * 64 + lane], zr = lr * dt, zi = li * dt;
    float s, c, sh, ch; sincos_acc(zi, s, c); sincos_acc(0.5f * zi, sh, ch);
    const float em1 = expm1f(zr); const float nr = em1 * c - 2.f * sh * sh, ni = (em1 + 1.f) * s;
    const float lbr = nr + 1.f, lbi = ni;
    const float den = 1.f / (lr * lr + li * li); const float fr_ = (nr * lr + ni * li) * den, fi_ = (ni * lr - nr * li) * den;
    float hr = p.in[3][(((size_t)b * 32 + g) * 64 + lane) * 2], hi = p.in[3][(((size_t)b * 32 + g) * 64 + lane) * 2 + 1];
    const float* bre = p.in[13] + ((size_t)g * 64 + lane) * 16; const float* bim = p.in[14] + ((size_t)g * 64 + lane) * 16;
    const float* cre = p.in[15] + (size_t)g * 1024 + lane; const float* cim = p.in[16] + (size_t)g * 1024 + lane;
    for (int t = 0; t < 4; ++t) {
        const float* ur = uss + (size_t)(b * 4 + t) * 512 + g * 16;
        float bur = 0.f, bui = 0.f;
#pragma unroll
        for (int i = 0; i < 16; ++i) { const float uv = ur[i]; const float br = bre[i], bi = bim[i]; bur += (fr_ * br - fi_ * bi) * uv; bui += (fr_ * bi + fi_ * br) * uv; }
        const float n_r = lbr * hr - lbi * hi + bur, n_i = lbr * hi + lbi * hr + bui; hr = n_r; hi = n_i;
        float yv = 0.f;
#pragma unroll
        for (int i = 0; i < 16; ++i) { float a = cre[i * 64] * hr - cim[i * 64] * hi; a = wave_sum(a); if (lane == i) yv = a; }
        if (lane < 16) { const float y = yv + p.in[17][g * 16 + lane] * ur[lane]; z[(size_t)(NP + b * 4 + t) * 512 + g * 16 + lane] = (bf16_t)(pk2(gelu_tanh(y), 0.f) & 0xffffu); }
    }
    float* o = p.out + O_S5S + (((size_t)b * 32 + g) * 64 + lane) * 2; o[0] = hr; o[1] = hi;
}

constexpr int ATT_BUF = 69632, ATT_VOFF = 34816, ATT_OST = 2 * ATT_BUF, LDS_CTL = ATT_OST + 8 * 2304;
struct AttUnit { int pat, b, h, dil, l0; size_t rowbase; };
DI AttUnit att_decode(int bu) { AttUnit u; const int tile = bu & 63; u.h = (bu >> 6) & 15; u.b = (bu >> 10) & 3; u.pat = bu >> 12; const int dsh = u.pat * 2; u.dil = 1 << dsh;
    const int rho = tile & (u.dil - 1); u.l0 = (tile >> dsh) * 128; u.rowbase = (size_t)u.b * TP + rho; return u; }
DI void att_stage(const AttUnit& u, const bf16_t* Kb, const bf16_t* Vb, LAS unsigned char* buf, int wave, int lane) {
    const int lmax = (TP >> (2 * u.pat)) - 1;
    for (int n = wave; n < 34; n += 8) { const int r0 = n * 8; const int row = r0 + (lane >> 3); const int c = (lane & 7) ^ (row & 7);
        int lk = u.l0 - 128 + row; lk = lk < 0 ? 0 : (lk > lmax ? lmax : lk); const size_t off = (u.rowbase + (size_t)u.dil * lk) * 1024 + u.h * 64 + c * 8;
        __builtin_amdgcn_global_load_lds((const unsigned*)(Kb + off), (LAS unsigned*)(buf + r0 * 128), 16, 0, 0);
        __builtin_amdgcn_global_load_lds((const unsigned*)(Vb + off), (LAS unsigned*)(buf + ATT_VOFF + r0 * 128), 16, 0, 0); }
}
DI void att_loadq(const AttUnit& u, const bf16_t* Q, int wave, int lane, bf16x8 (&qf)[2]) {
    const int i = lane & 15, g = lane >> 4; const bf16_t* q = Q + (u.rowbase + (size_t)u.dil * (u.l0 + 16 * wave + i)) * 1024 + u.h * 64 + 8 * g;
    qf[0] = *(const bf16x8*)q; qf[1] = *(const bf16x8*)(q + 32);
}
DI void att_compute(const AttUnit& u, const bf16x8 (&qf)[2], LAS unsigned char* buf, LAS unsigned char* ost, bf16_t* Op, float* lse, int wave, int lane) {
    const int i = lane & 15, g = lane >> 4;
    const int Lw = u.l0 + 16 * wave;
    unsigned koff[2][2], voff[4];
#pragma unroll
    for (int kbl = 0; kbl < 2; ++kbl)
#pragma unroll
        for (int s = 0; s < 2; ++s) koff[kbl][s] = (unsigned)((16 * wave + 16 * kbl + i) * 128 + (((4 * s + g) ^ (i & 7)) * 16));
    { const int q = i >> 2, pp = i & 3, r = 4 * g + q;
#pragma unroll
      for (int db = 0; db < 4; ++db) voff[db] = (unsigned)((16 * wave + r) * 128 + (((2 * db + (pp >> 1)) ^ (r & 7)) * 16) + 8 * (pp & 1)); }
    f32x4 st[5][2];
#pragma unroll
    for (int ks = 0; ks < 5; ++ks)
#pragma unroll
        for (int kbl = 0; kbl < 2; ++kbl) {
            if (ks == 4 && kbl == 1) { st[ks][kbl] = (f32x4){0.f, 0.f, 0.f, 0.f}; continue; }
            const bf16x8 k0 = *(const LAS bf16x8*)(buf + ks * 4096 + koff[kbl][0]), k1 = *(const LAS bf16x8*)(buf + ks * 4096 + koff[kbl][1]);
            f32x4 a = (f32x4){0.f, 0.f, 0.f, 0.f};
            a = __builtin_amdgcn_mfma_f32_16x16x32_bf16(k0, qf[0], a, 0, 0, 0);
            a = __builtin_amdgcn_mfma_f32_16x16x32_bf16(k1, qf[1], a, 0, 0, 0); st[ks][kbl] = a; }
#pragma unroll
    for (int r = 0; r < 4; ++r) { if (i > 4 * g + r) st[0][0][r] = -INFINITY; if (4 * g + r > i) st[4][0][r] = -INFINITY; }
    if (Lw < 128) {
#pragma unroll
        for (int ks = 0; ks < 4; ++ks)
#pragma unroll
            for (int kbl = 0; kbl < 2; ++kbl)
#pragma unroll
                for (int r = 0; r < 4; ++r) if (Lw - 128 + 32 * ks + 16 * kbl + 4 * g + r < 0) st[ks][kbl][r] = -INFINITY; }
    float mx = -INFINITY;
#pragma unroll
    for (int ks = 0; ks < 5; ++ks)
#pragma unroll
        for (int kbl = 0; kbl < 2; ++kbl) { if (ks == 4 && kbl == 1) continue;
#pragma unroll
            for (int r = 0; r < 4; ++r) mx = fmaxf(mx, st[ks][kbl][r]); }
    mx = fmaxf(mx, __shfl_xor(mx, 16)); mx = fmaxf(mx, __shfl_xor(mx, 32));
    float ps = 0.f; bf16x8 pf[5];
#pragma unroll
    for (int ks = 0; ks < 5; ++ks) {
#pragma unroll
        for (int kbl = 0; kbl < 2; ++kbl) { if (ks == 4 && kbl == 1) continue;
#pragma unroll
            for (int r = 0; r < 4; ++r) { const float pv = __builtin_amdgcn_exp2f(st[ks][kbl][r] - mx); st[ks][kbl][r] = pv; ps += pv; } }
        u32x4 pw; pw.x = pk2(st[ks][0][0], st[ks][0][1]); pw.y = pk2(st[ks][0][2], st[ks][0][3]); pw.z = pk2(st[ks][1][0], st[ks][1][1]); pw.w = pk2(st[ks][1][2], st[ks][1][3]);
        pf[ks] = __builtin_bit_cast(bf16x8, pw); }
    ps += __shfl_xor(ps, 16); ps += __shfl_xor(ps, 32);
    f32x4 o[4];
#pragma unroll
    for (int db = 0; db < 4; ++db) o[db] = (f32x4){0.f, 0.f, 0.f, 0.f};
    const unsigned vb = (unsigned)(size_t)buf + (unsigned)ATT_VOFF;
#pragma unroll
    for (int ks = 0; ks < 5; ++ks) {
        s16x4 lo[4], hi[4]; const unsigned va = vb + ks * 4096;
        asm volatile("ds_read_b64_tr_b16 %0, %8\n\tds_read_b64_tr_b16 %1, %9\n\tds_read_b64_tr_b16 %2, %10\n\tds_read_b64_tr_b16 %3, %11\n\t"
                     "ds_read_b64_tr_b16 %4, %8 offset:2048\n\tds_read_b64_tr_b16 %5, %9 offset:2048\n\tds_read_b64_tr_b16 %6, %10 offset:2048\n\tds_read_b64_tr_b16 %7, %11 offset:2048\n\t"
                     "s_waitcnt lgkmcnt(0)"
                     : "=&v"(lo[0]), "=&v"(lo[1]), "=&v"(lo[2]), "=&v"(lo[3]), "=&v"(hi[0]), "=&v"(hi[1]), "=&v"(hi[2]), "=&v"(hi[3])
                     : "v"(va + voff[0]), "v"(va + voff[1]), "v"(va + voff[2]), "v"(va + voff[3]) : "memory");
#pragma unroll
        for (int db = 0; db < 4; ++db) { const bf16x8 vf = __builtin_shufflevector(lo[db], hi[db], 0, 1, 2, 3, 4, 5, 6, 7);
            o[db] = __builtin_amdgcn_mfma_f32_16x16x32_bf16(vf, pf[ks], o[db], 0, 0, 0); }
    }
    const float inv = 1.f / ps;
#pragma unroll
    for (int db = 0; db < 4; ++db) { const f32x4 v = o[db] * inv; u32x2 w; w.x = pk2(v[0], v[1]); w.y = pk2(v[2], v[3]); *(LAS u32x2*)(ost + i * 144 + (16 * db + 4 * g) * 2) = w; }
    const size_t orow0 = (size_t)u.pat * MT + u.rowbase;
    if (g == 0) lse[(orow0 + (size_t)u.dil * (Lw + i)) * 16 + u.h] = mx + __builtin_amdgcn_logf(ps);
    LDS_WAIT();
#pragma unroll
    for (int n = 0; n < 2; ++n) { const int c = lane + 64 * n, rr = c >> 3, ch = c & 7; const u32x4 v = *(const LAS u32x4*)(ost + rr * 144 + ch * 16);
        *(u32x4*)(Op + (orow0 + (size_t)u.dil * (Lw + rr)) * 1024 + u.h * 64 + ch * 8) = v; }
    LDS_WAIT();
}
DI void attn_prompt_phase(const bf16_t* Q, const bf16_t* Kb, const bf16_t* Vb, bf16_t* Op, float* lse, LAS unsigned char* lds, int bx, int G, int wave, int lane) {
    constexpr int NU = 3 * 4096;
    int bu = bx; if (bu >= NU) return;
    AttUnit u = att_decode(bu); bf16x8 qn[2];
    att_stage(u, Kb, Vb, lds, wave, lane); att_loadq(u, Q, wave, lane, qn);
    int par = 0;
    for (;;) {
        asm volatile("s_waitcnt vmcnt(0)" ::: "memory");
        __syncthreads();
        bf16x8 qf[2]; qf[0] = qn[0]; qf[1] = qn[1];
        const AttUnit cur = u; const int nb = bu + G; const bool more = nb < NU;
        if (more) { u = att_decode(nb); att_stage(u, Kb, Vb, lds + (par ^ 1) * ATT_BUF, wave, lane); att_loadq(u, Q, wave, lane, qn); }
        att_compute(cur, qf, lds + par * ATT_BUF, lds + ATT_OST + wave * 2304, Op, lse, wave, lane);
        if (!more) break;
        bu = nb; par ^= 1;
    }
    __syncthreads();
}

DI void attn_sample_unit(const Params& p, int u, const bf16_t* Q, const bf16_t* Kb, const bf16_t* Vb, bf16_t* att, LAS float* sl, int lane) {
    const int h = u & 15, t = (u >> 4) & 3, b = u >> 6;
    const size_t qrow = (size_t)NP + b * 4 + t;
    const float* ck = p.in[4]; const float* cv = p.in[5];
    sl[lane] = bf2f(Q[qrow * 1024 + h * 64 + lane]);
    LDS_WAIT();
    float mx = -INFINITY;
#pragma unroll 1
    for (int e = 0; e < 9; ++e) { const int pat = e / 3, r = e - 3 * pat; const int dil = 1 << (2 * pat);
        const int j = lane + 64 * r; const bool valid = j <= 128; const int idx = 2048 + t - dil * (valid ? j : 0);
        float dot = 0.f;
        if (idx >= 2048) { const bf16_t* kp = Kb + ((size_t)NP + b * 4 + (idx - 2048)) * 1024 + h * 64;
#pragma unroll
            for (int d8 = 0; d8 < 8; ++d8) { const u32x4 kw = *(const u32x4*)(kp + 8 * d8); const f32x4 q0 = *(const LAS f32x4*)(sl + 8 * d8), q1 = *(const LAS f32x4*)(sl + 8 * d8 + 4);
                dot += (bflo(kw.x) * q0[0] + bfhi(kw.x) * q0[1]) + (bflo(kw.y) * q0[2] + bfhi(kw.y) * q0[3]) + (bflo(kw.z) * q1[0] + bfhi(kw.z) * q1[1]) + (bflo(kw.w) * q1[2] + bfhi(kw.w) * q1[3]); } }
        else { const float* kp = ck + (((size_t)b * 2048 + idx) * 16 + h) * 64;
#pragma unroll
            for (int d4 = 0; d4 < 16; ++d4) { const f32x4 kv = *(const f32x4*)(kp + 4 * d4); const f32x4 qv = *(const LAS f32x4*)(sl + 4 * d4); dot += (kv[0] * qv[0] + kv[1] * qv[1]) + (kv[2] * qv[2] + kv[3] * qv[3]); } }
        if (valid) { sl[64 + pat * 192 + j] = dot; mx = fmaxf(mx, dot); } }
    mx = wave_max(mx);
    LDS_WAIT();
    float ls = 0.f;
#pragma unroll 1
    for (int e = 0; e < 9; ++e) { const int pat = e / 3, r = e - 3 * pat; const int j = lane + 64 * r;
        if (j <= 128) { const float pv = __builtin_amdgcn_exp2f(sl[64 + pat * 192 + j] - mx); sl[64 + pat * 192 + j] = pv; ls += pv; } }
    ls = wave_sum(ls);
    LDS_WAIT();
    { const int kg = lane >> 4, d4 = lane & 15; f32x4 acc = (f32x4){0.f, 0.f, 0.f, 0.f};
#pragma unroll 1
      for (int pat = 0; pat < 3; ++pat) { const int dil = 1 << (2 * pat);
#pragma unroll
        for (int jj = 0; jj < 33; ++jj) { const int j = kg + 4 * jj; int idx = 2048 + t - dil * j; const bool use = (j <= 128) && (idx < 2048);
            idx = idx < 0 ? 0 : (idx > 2047 ? 2047 : idx); const float pv = use ? sl[64 + pat * 192 + (j > 128 ? 128 : j)] : 0.f;
            const f32x4 vv = *(const f32x4*)(cv + (((size_t)b * 2048 + idx) * 16 + h) * 64 + 4 * d4);
            acc += vv * pv; }
        if (kg == 0) { for (int j = 0; dil * j <= t; ++j) { const int idx = 2048 + t - dil * j; const float pv = sl[64 + pat * 192 + j];
            const u32x2 w = *(const u32x2*)(Vb + ((size_t)NP + b * 4 + (idx - 2048)) * 1024 + h * 64 + 4 * d4);
            acc += (f32x4){bflo(w.x), bfhi(w.x), bflo(w.y), bfhi(w.y)} * pv; } } }
#pragma unroll
      for (int e = 0; e < 4; ++e) { float a = acc[e]; a += __shfl_xor(a, 16); a += __shfl_xor(a, 32); acc[e] = a; }
      const float inv = 1.f / ls;
      if (kg == 0) { u32x2 w; w.x = pk2(acc[0] * inv, acc[1] * inv); w.y = pk2(acc[2] * inv, acc[3] * inv); *(u32x2*)(att + qrow * 1024 + h * 64 + 4 * d4) = w; } }
    LDS_WAIT();
}


#define XB_TMO      128
#define XB_XCNT(j)  (256  + 64 * (j))
#define XB_XSUB(j)  (1280 + 64 * (j))
#define XB_XGEN(j)  (2304 + 64 * (j))
#define XB_TOP      3328
#define XB_TOPGEN   3392
#define XCD_BAR_WORDS 3456
#define XB_SPIN_CAP (1u << 22)
DI unsigned xb_ld(unsigned* p)              { return __hip_atomic_load(p, __ATOMIC_RELAXED, __HIP_MEMORY_SCOPE_AGENT); }
DI unsigned xb_add(unsigned* p, unsigned v) { return __hip_atomic_fetch_add(p, v, __ATOMIC_RELAXED, __HIP_MEMORY_SCOPE_AGENT); }
DI unsigned xb_xcc_id() { return (unsigned)__builtin_amdgcn_s_getreg((3 << 11) | 20) & 0xFu; }
#define XB_SPIN(cond, bar) do { unsigned _sp = 0; while (cond) { __builtin_amdgcn_s_sleep(1); \
    if ((++_sp & 255u) == 0u) { if (xb_ld(&(bar)[XB_TMO])) break; if (_sp > XB_SPIN_CAP) { atomicAdd(&(bar)[XB_TMO], 1u); break; } } } } while (0)
struct XcdBarrier { unsigned* bar; unsigned x; volatile LAS unsigned* st; bool w0; };
DI XcdBarrier xcd_barrier_post(unsigned* bar, volatile LAS unsigned* st, const bool w0) {
    XcdBarrier b; b.bar = bar; b.x = xb_xcc_id(); b.st = st; b.w0 = w0;
    if (w0 && lane_id() == 0) (void)xb_add(&bar[XB_XCNT(b.x)], 1u);
    return b;
}
DI void xcd_barrier_complete(unsigned* bar, unsigned x, unsigned& nloc, unsigned& nx) {
    const unsigned G = gridDim.x * gridDim.y * gridDim.z;
    unsigned sum, cnt, mine, sp = 0u;
    for (;;) {
        sum = 0u; cnt = 0u; mine = 0u;
#pragma unroll
        for (unsigned j = 0; j < 16; ++j) { const unsigned c = xb_ld(&bar[XB_XCNT(j)]); sum += c; cnt += (c > 0u) ? 1u : 0u; mine = (j == x) ? c : mine; }
        if (sum == G) break;
        __builtin_amdgcn_s_sleep(1);
        if ((++sp & 255u) == 0u) { if (xb_ld(&bar[XB_TMO])) break; if (sp > XB_SPIN_CAP) { atomicAdd(&bar[XB_TMO], 1u); break; } }
    }
    nloc = mine > 0u ? mine : 1u; nx = cnt > 0u ? cnt : 1u;
}
DI void xcd_barrier(const XcdBarrier& b) {
    asm volatile("s_waitcnt vmcnt(0)" ::: "memory");
    __syncthreads();
    if (b.w0 && lane_id() == 0) {
        unsigned* bar = b.bar;
        __builtin_amdgcn_s_waitcnt(0);
        unsigned nloc = b.st[0], nx = b.st[1];
        if (nloc == 0u) { xcd_barrier_complete(bar, b.x, nloc, nx); b.st[0] = nloc; b.st[1] = nx; }
        const unsigned old = xb_add(&bar[XB_XSUB(b.x)], 1u);
        const unsigned gen = old / nloc;
        if (old + 1u == (gen + 1u) * nloc) {
            __builtin_amdgcn_fence(__ATOMIC_RELEASE, "agent");
            asm volatile("s_waitcnt vmcnt(0)" ::: "memory");
            const unsigned og = xb_add(&bar[XB_TOP], 1u);
            const unsigned tg = og / nx;
            if (og + 1u == (tg + 1u) * nx) xb_add(&bar[XB_TOPGEN], 1u);
            else XB_SPIN(xb_ld(&bar[XB_TOPGEN]) == tg, bar);
            __builtin_amdgcn_fence(__ATOMIC_ACQUIRE, "agent");
            xb_add(&bar[XB_XGEN(b.x)], 1u);
            asm volatile("s_waitcnt vmcnt(0)" ::: "memory");
        } else {
            XB_SPIN(xb_ld(&bar[XB_XGEN(b.x)]) == gen, bar);
            __builtin_amdgcn_fence(__ATOMIC_ACQUIRE, "agent");
            asm volatile("s_waitcnt vmcnt(0)" ::: "memory");
        }
    }
    __syncthreads();
}

#define w_in_t ((bf16_t*)(ws + WS_WIN))
#define w_out_t ((bf16_t*)(ws + WS_WOUT))
#define w_glu_t ((bf16_t*)(ws + WS_WGLU))
#define w_pool_t ((bf16_t*)(ws + WS_WPOOL))
#define w_o_t ((bf16_t*)(ws + WS_WO))
#define w_qkv_t ((bf16_t*)(ws + WS_WQKV))
#define Bt1 ((bf16_t*)(ws + WS_BT1))
#define Bt2 ((bf16_t*)(ws + WS_BT2))
#define rowss ((float*)(ws + WS_ROWSS))
#define uss ((float*)(ws + WS_USS))
#define lse ((float*)(ws + WS_LSE))
#define xn ((bf16_t*)(ws + WS_XN))
#define ybuf ((bf16_t*)(ws + WS_Y))
#define hbuf16 ((bf16_t*)(ws + WS_H))
#define Ap ((bf16_t*)(ws + WS_AP))
#define Sbuf ((float*)(ws + WS_S))
#define upool ((float*)(ws + WS_UPOOL))
#define dbuf ((bf16_t*)(ws + WS_D))
#define zbuf ((bf16_t*)(ws + WS_Z))
#define ycat ((bf16_t*)(ws + WS_YCAT))
#define hact ((bf16_t*)(ws + WS_HACT))
#define Qb ((bf16_t*)(ws + WS_Q))
#define Kb ((bf16_t*)(ws + WS_K))
#define Vb ((bf16_t*)(ws + WS_V))
#define Op ((bf16_t*)(ws + WS_OP))
#define att ((bf16_t*)(ws + WS_ATT))
#define gains (p.in[6])
#ifndef PHMASK
#define PHMASK 0xFFFFFFFFu
#endif
#ifndef DUPMASK
#define DUPMASK 0u
#endif
#define PHASE_BEGIN(k) if (((PHMASK >> (k)) & 1u) && p.ph_lo <= (k) && (k) < p.ph_hi) { for (int _rep = 0; _rep < 1 + (int)((DUPMASK >> (k)) & 1u); ++_rep) { if (_rep) __syncthreads(); const int lane = lane_id(); const int tid = wave * 64 + lane; const int gt = bx * 512 + tid; (void)gt;
#define PHASE_END(k) } } if (p.ph_lo <= (k) && (k) + 1 < p.ph_hi) { if ((k) == 0) { grid.sync(); xbar = xcd_barrier_post((unsigned*)(p.ws + WS_CTL), (volatile LAS unsigned*)(lds + 157696), wave == 0); } else xcd_barrier(xbar); }

template <int layer>
DI void layer_tail(const Params& p, LAS unsigned char* lds, cg::grid_group& grid, XcdBarrier& xbar, const int bx, const int G, const int gw, const int NGW, const int wave) {
    unsigned char* ws = p.ws;
    constexpr int pb = 6 + layer * 8;
    const float* gl = gains + (size_t)layer * 4 * DM;
        PHASE_BEGIN(pb)
        { const bf16_t* A = layer == 0 ? ycat : att; const bf16_t* W = layer == 0 ? w_out_t : w_o_t;
          { UStd<EpiY> U{A, W, (size_t)256 * DM, (size_t)256 * DM, 0, 128, 4, G, bx, EpiY{ybuf, 0, 0}};
            gemm_phase(lds, wave, DM, DM, DM, U); }
          { EpiY E{ybuf, 0, 0}; mini_gemm(A, DM, W, DM, DM, 1024, 0, E, bx, G, wave, lane); } }
        PHASE_END(pb)
        PHASE_BEGIN(pb + 1)
        { const RowPass rp{layer == 0 ? 0 : 1, gl + DM, gl + 2 * DM, p.in[0], p.in[1], hbuf16, ybuf, xn, p.out};
          for (int q = gw; q < NP / 4; q += NGW) rp.rows4(q * 4, lane);
          for (int r = NP + (NGW - 1 - gw); r < NT; r += NGW) rp.row(r, lane); }
        PHASE_END(pb + 1)
        PHASE_BEGIN(pb + 2)
        { const bf16_t* W = (const bf16_t*)(ws + (layer ? WS_GU1 : WS_GU0));
          { UStd<EpiGU> U{xn, W, (size_t)256 * DM, (size_t)256 * DM, 0, 128, 22, G, bx, EpiGU{hact, 0, 0}};
            gemm_phase(lds, wave, DM, DM, DM, U); }
          { EpiGU E{hact, 0, 0}; mini_gemm_gu(xn, W, E, bx, G, wave, lane); } }
        PHASE_END(pb + 2)
        PHASE_BEGIN(pb + 3)
        { const bf16_t* W = (const bf16_t*)(ws + (layer ? WS_DN1 : WS_DN0));
          { UStd<EpiY> U{hact, W, (size_t)256 * FF, (size_t)256 * FF, 0, 128, 4, G, bx, EpiY{ybuf, 0, 0}};
            gemm_phase(lds, wave, FF, FF, FF, U); }
          { EpiY E{ybuf, 0, 0}; mini_gemm(hact, FF, W, FF, FF, 1024, 0, E, bx, G, wave, lane); } }
        PHASE_END(pb + 3)
        PHASE_BEGIN(pb + 4)
        { const RowPass rp{layer == 0 ? 1 : 2, gl + 3 * DM, gains + 4 * DM, p.in[0], p.in[1], hbuf16, ybuf, xn, p.out};
          for (int q = gw; q < NP / 4; q += NGW) rp.rows4(q * 4, lane);
          for (int r = NP + (NGW - 1 - gw); r < NT; r += NGW) rp.row(r, lane); }
        PHASE_END(pb + 4)
    }

__global__ void __launch_bounds__(512, 2) mega(Params p) {
    extern __shared__ __attribute__((aligned(16))) unsigned char lds_raw[];
    LAS unsigned char* lds = (LAS unsigned char*)lds_raw;
    cg::grid_group grid = cg::this_grid();
    const int wave = __builtin_amdgcn_readfirstlane((int)threadIdx.x >> 6);
    const int G = gridDim.x, bx = blockIdx.x;
    const int gw = bx * 8 + wave, NGW = G * 8;
    const int NGT = G * 512;
    unsigned char* ws = p.ws;
    XcdBarrier xbar; xbar.bar = (unsigned*)(ws + WS_CTL); xbar.x = 0; xbar.st = (volatile LAS unsigned*)(lds + 157696); xbar.w0 = wave == 0;
    { const int tid = wave * 64 + lane_id();
      if (tid < 64) ((LAS unsigned*)(lds + 157696))[tid] = 0u;
      if (bx == 0) { for (int i = tid; i < 4096; i += 512) ((unsigned*)(ws + WS_CTL))[i] = 0u; } }
    __syncthreads();

    PHASE_BEGIN(0)
    {
        if (bx < 32) { s5_tables(p, bx, lds, Bt1 + (size_t)bx * 65536, Bt2 + (size_t)bx * 98304, tid); }
        LAS float* scr = (LAS float*)(lds + wave * 16384);
        constexpr int I_IN = 512, I_OUT = 512, I_GLU = 128, I_POOL = 32, I_O = 512, I_QKV = 1536, I_G = 1408, I_D = 1408;
        constexpr int NITEMS = I_IN + I_OUT + I_GLU + I_POOL + I_O + I_QKV + 4 * I_G + 2 * I_D;
        for (int it = gw; it < NITEMS; it += NGW) {
            int r = it;
            if (r < I_IN) { tr_plain(p.in[7], 1024, 1024, w_in_t, r, scr, lane); continue; } r -= I_IN;
            if (r < I_OUT) { tr_plain(p.in[20], 1024, 1024, w_out_t, r, scr, lane); continue; } r -= I_OUT;
            if (r < I_GLU) { tr_plain(p.in[18], 512, 512, w_glu_t, r, scr, lane); continue; } r -= I_GLU;
            if (r < I_POOL) { const int gg = r >> 3, q = r & 7, kb = q >> 2, nb = q & 3;
                transpose_item(p.in[8] + (size_t)gg * 16384, 128, 64 * kb, 32 * nb, w_pool_t, 256, gg * 128 + 32 * nb, (gg & 1) * 128 + 64 * kb, scr, lane); continue; } r -= I_POOL;
            if (r < I_O) { tr_plain(p.in[22], 1024, 1024, w_o_t, r, scr, lane); continue; } r -= I_O;
            if (r < I_QKV) { tr_plain(p.in[21], 1024, 3072, w_qkv_t, r, scr, lane); continue; } r -= I_QKV;
            if (r < 4 * I_G) { const int which = r / I_G, q = r % I_G; const int layer = which >> 1, up = which & 1;
                const float* W = p.in[up ? 24 : 23] + (size_t)layer * 1024 * FF; bf16_t* WT = (bf16_t*)(ws + (layer ? WS_GU1 : WS_GU0));
                const int nblk = FF / 32, kb = q / nblk, nb = q % nblk, n0 = 32 * nb;
                transpose_item(W, FF, 64 * kb, n0, WT, 1024, (n0 >> 7) * 256 + up * 128 + (n0 & 127), 64 * kb, scr, lane); continue; } r -= 4 * I_G;
            { const int layer = r / I_D, q = r % I_D; tr_plain(p.in[25] + (size_t)layer * FF * 1024, FF, 1024, (bf16_t*)(ws + (layer ? WS_DN1 : WS_DN0)), q, scr, lane); }
        }
        for (int it = gt; it < 512 * 16; it += NGT) { const int n = it >> 4, c8 = it & 15; const int gg = n >> 7;
            *(u32x4*)(w_pool_t + (size_t)n * 256 + ((gg & 1) ^ 1) * 128 + c8 * 8) = (u32x4){0u, 0u, 0u, 0u}; }
        if (bx >= 32 || G <= 32) { const int gwn = G > 32 ? (bx - 32) * 8 + wave : gw, ngwn = G > 32 ? (G - 32) * 8 : NGW;
          for (int r = gwn; r < NT; r += 2 * ngwn) { const int r2 = r + ngwn; const bool two = r2 < NT;
            norm_row2(in_row(p, r), in_row(p, two ? r2 : r), gains, xn + (size_t)r * DM, xn + (size_t)(two ? r2 : r) * DM, lane); } }
    }
    PHASE_END(0)

    PHASE_BEGIN(1)
    { UStd<EpiProj> U{xn, w_in_t, (size_t)256 * DM, (size_t)256 * DM, 0, 128, 4, G, bx, EpiProj{upool, Ap, uss, 0, 0}};
      gemm_phase(lds, wave, DM, DM, DM, U);
      { EpiProj E{upool, Ap, uss, 0, 0}; mini_gemm(xn, DM, w_in_t, DM, DM, 1024, 0, E, bx, G, wave, lane); } }
    PHASE_END(1)

    PHASE_BEGIN(2)
    {
        { US5<EpiS1> U{Ap + 128, Bt1, (size_t)65536, G, bx, EpiS1{Sbuf, 0, 0}};
          gemm_phase(lds, wave, 384, 256, 256, U); }
        for (int u = gw; u < 1024; u += NGW) s5_sample_unit(p, u, uss, zbuf, lane);
        for (int it = gt; it < (NP / 16) * 128; it += NGT) { const int cq = it & 127, run = it >> 7; const int c = cq * 4, gi = c >> 7, w = 2 << gi;
            const int t0 = run * 16, tb0 = t0 & (TP - 1); const float* up = upool + (size_t)t0 * 512 + c;
            f32x4 e[31];
#pragma unroll
            for (int k = 0; k < 31; ++k) { const int rel = k - 15; e[k] = (rel >= 1 - w && tb0 + rel >= 0) ? *(const f32x4*)(up + (ptrdiff_t)rel * 512) : (f32x4){0.f, 0.f, 0.f, 0.f}; }
            f32x4 sum = (f32x4){0.f, 0.f, 0.f, 0.f};
#pragma unroll
            for (int k = 0; k < 15; ++k) sum += e[k];
#pragma unroll
            for (int k = 0; k < 16; ++k) { const f32x4 uv = e[15 + k]; sum += uv; const int tb = tb0 + k; const int cnt = tb + 1 < w ? tb + 1 : w;
                const f32x4 dv = sum * (1.0f / (float)cnt) - uv; u32x2 o; o.x = pk2(dv[0], dv[1]); o.y = pk2(dv[2], dv[3]); *(u32x2*)(dbuf + (size_t)(t0 + k) * 512 + c) = o;
                f32x4 out_ = (f32x4){0.f, 0.f, 0.f, 0.f};
                if (w == 2) out_ = e[15 + k - 1]; else if (w == 4) out_ = e[15 + k - 3]; else if (w == 8) out_ = e[15 + k - 7]; else out_ = e[15 + k - 15];
                sum -= out_;
                if (tb >= TP - 15) *(f32x4*)(p.out + O_POOLP + ((size_t)(t0 >> 13) * 15 + (tb - (TP - 15))) * 512 + c) = uv; } }
        for (int it = gt; it < 32 * 128; it += NGT) { const int cq = it & 127, b = it >> 7; const int c = cq * 4, gi = c >> 7, w = 2 << gi;
            const float* sp = p.in[2] + (size_t)b * 15 * 512 + c; const float* up = upool + (size_t)(NP + b * 4) * 512 + c;
            for (int t = 0; t < 4; ++t) { f32x4 sum = (f32x4){0.f, 0.f, 0.f, 0.f};
                for (int s = 0; s < w; ++s) { const int e = 15 + t - s; sum += e >= 15 ? *(const f32x4*)(up + (size_t)(e - 15) * 512) : *(const f32x4*)(sp + (size_t)e * 512); }
                const f32x4 uv = *(const f32x4*)(up + (size_t)t * 512); const f32x4 dv = sum * (1.0f / (float)w) - uv;
                u32x2 o; o.x = pk2(dv[0], dv[1]); o.y = pk2(dv[2], dv[3]); *(u32x2*)(dbuf + (size_t)(NP + b * 4 + t) * 512 + c) = o; }
            for (int r = 0; r < 15; ++r) { const f32x4 v = r < 11 ? *(const f32x4*)(sp + (size_t)(r + 4) * 512) : *(const f32x4*)(up + (size_t)(r - 11) * 512);
                *(f32x4*)(p.out + O_POOLS + ((size_t)b * 15 + r) * 512 + c) = v; } }
    }
    PHASE_END(2)

    PHASE_BEGIN(3)
    {
        { const bool act = bx < 128; const int b = (bx >> 5) & 3, g = bx & 31;
          LAS float* ex = (LAS float*)lds;
          float c_r = 1.f, c_i = 0.f, hr = 0.f, hi = 0.f;
          const float* Sp = Sbuf + ((size_t)g * 2048 + b * 512 + wave * 64) * 128 + lane; bf16_t* Hp = Ap + ((size_t)g * 2048 + b * 512 + wave * 64) * 384 + lane;
          if (act) {
            const float dt = __expf(p.in[12][g]); const float zr = p.in[10][g * 64 + lane] * dt * 16.f, zi = p.in[11][g * 64 + lane] * dt * 16.f;
            float sn, cs; sincos_acc(zi, sn, cs); const float mag = __expf(zr); c_r = mag * cs; c_i = mag * sn;
            for (int c0 = 0; c0 < 64; c0 += 16) { float sr[16], si[16];
#pragma unroll
                for (int k = 0; k < 16; ++k) { sr[k] = Sp[(size_t)(c0 + k) * 128]; si[k] = Sp[(size_t)(c0 + k) * 128 + 64]; }
#pragma unroll
                for (int k = 0; k < 16; ++k) { const float n_r = c_r * hr - c_i * hi + sr[k], n_i = c_r * hi + c_i * hr + si[k]; hr = n_r; hi = n_i; } }
            ex[(wave * 64 + lane) * 2] = hr; ex[(wave * 64 + lane) * 2 + 1] = hi;
          }
          __syncthreads();
          if (act) {
            float l_r = c_r, l_i = c_i;
#pragma unroll
            for (int e = 0; e < 6; ++e) { const float t_r = l_r * l_r - l_i * l_i, t_i = 2.f * l_r * l_i; l_r = t_r; l_i = t_i; }
            hr = 0.f; hi = 0.f;
            for (int sg = 0; sg < wave; ++sg) { const float e_r = ex[(sg * 64 + lane) * 2], e_i = ex[(sg * 64 + lane) * 2 + 1];
                const float n_r = l_r * hr - l_i * hi + e_r, n_i = l_r * hi + l_i * hr + e_i; hr = n_r; hi = n_i; }
            for (int c0 = 0; c0 < 64; c0 += 16) { float sr[16], si[16];
#pragma unroll
                for (int k = 0; k < 16; ++k) { sr[k] = Sp[(size_t)(c0 + k) * 128]; si[k] = Sp[(size_t)(c0 + k) * 128 + 64]; }
#pragma unroll
                for (int k = 0; k < 16; ++k) { const unsigned w = pk2(hr, hi); Hp[(size_t)(c0 + k) * 384] = (bf16_t)(w & 0xffffu); Hp[(size_t)(c0 + k) * 384 + 64] = (bf16_t)(w >> 16);
                    const float n_r = c_r * hr - c_i * hi + sr[k], n_i = c_r * hi + c_i * hr + si[k]; hr = n_r; hi = n_i; } }
            if (wave == 7) { float* o = p.out + O_S5P + (((size_t)b * 32 + g) * 64 + lane) * 2; o[0] = hr; o[1] = hi; }
          }
        }
        __syncthreads();
        { UStd<EpiPool> U{dbuf, w_pool_t, (size_t)256 * 512, (size_t)256 * 256, 256, 128, 2, G, bx, EpiPool{ycat, p.in[9], 0, 0}};
          gemm_phase(lds, wave, 512, 256, 256, U); }
        { EpiPool E{ycat, p.in[9], 0, 0}; mini_gemm(dbuf, 512, w_pool_t, 256, 256, 512, 256, E, bx, G, wave, lane); }
    }
    PHASE_END(3)

    PHASE_BEGIN(4)
    { US5<EpiS2> U{Ap, Bt2, (size_t)98304, G, bx, EpiS2{zbuf, Ap, p.in[17], 0, 0}};
      gemm_phase(lds, wave, 384, 384, 384, U); }
    PHASE_END(4)

    PHASE_BEGIN(5)
    { UStd<EpiGlu> U{zbuf, w_glu_t, (size_t)256 * 512, (size_t)256 * 512, 0, 128, 2, G, bx, EpiGlu{ycat, zbuf, p.in[19], 0, 0}};
      gemm_phase(lds, wave, 512, 512, 512, U);
      { EpiGlu E{ycat, zbuf, p.in[19], 0, 0}; mini_gemm(zbuf, 512, w_glu_t, 512, 512, 512, 0, E, bx, G, wave, lane); } }
    PHASE_END(5)

    layer_tail<0>(p, lds, grid, xbar, bx, G, gw, NGW, wave);
            PHASE_BEGIN(11)
            { UStd<EpiQKV> U{xn, w_qkv_t, (size_t)256 * DM, (size_t)256 * DM, 0, 128, 12, G, bx, EpiQKV{Qb, p.out, 0, 0}};
              gemm_phase(lds, wave, DM, DM, DM, U);
              { EpiQKV E{Qb, p.out, 0, 0}; mini_gemm(xn, DM, w_qkv_t, DM, DM, 3072, 0, E, bx, G, wave, lane); } }
            PHASE_END(11)
            PHASE_BEGIN(12)
            {
                attn_prompt_phase(Qb, Kb, Vb, Op, lse, lds, bx, G, wave, lane);
            }
            PHASE_END(12)
            PHASE_BEGIN(13)
            {
              for (int pass = 0; pass < 2; ++pass) { const bool do_sample = (pass == 0) == ((wave & 1) == 0);
              if (do_sample) { for (int u = gw; u < 2048; u += NGW) attn_sample_unit(p, u, Qb, Kb, Vb, att, (LAS float*)(lds + wave * 8192), lane); }
              else for (int it = gt; it < NP * 128; it += NGT) { const int c8 = it & 127, row = it >> 7, h = c8 >> 3;
                const float l0 = lse[(size_t)row * 16 + h], l1 = lse[((size_t)MT + row) * 16 + h], l2 = lse[((size_t)2 * MT + row) * 16 + h];
                const float mx = fmaxf(l0, fmaxf(l1, l2)); float w0 = __builtin_amdgcn_exp2f(l0 - mx), w1 = __builtin_amdgcn_exp2f(l1 - mx), w2 = __builtin_amdgcn_exp2f(l2 - mx); const float inv = 1.f / (w0 + w1 + w2); w0 *= inv; w1 *= inv; w2 *= inv;
                const u32x4 a = *(const u32x4*)(Op + (size_t)row * 1024 + c8 * 8), b = *(const u32x4*)(Op + ((size_t)MT + row) * 1024 + c8 * 8), c = *(const u32x4*)(Op + ((size_t)2 * MT + row) * 1024 + c8 * 8);
                u32x4 o;
                o.x = pk2(w0 * bflo(a.x) + w1 * bflo(b.x) + w2 * bflo(c.x), w0 * bfhi(a.x) + w1 * bfhi(b.x) + w2 * bfhi(c.x));
                o.y = pk2(w0 * bflo(a.y) + w1 * bflo(b.y) + w2 * bflo(c.y), w0 * bfhi(a.y) + w1 * bfhi(b.y) + w2 * bfhi(c.y));
                o.z = pk2(w0 * bflo(a.z) + w1 * bflo(b.z) + w2 * bflo(c.z), w0 * bfhi(a.z) + w1 * bfhi(b.z) + w2 * bfhi(c.z));
                o.w = pk2(w0 * bflo(a.w) + w1 * bflo(b.w) + w2 * bflo(c.w), w0 * bfhi(a.w) + w1 * bfhi(b.w) + w2 * bfhi(c.w));
                *(u32x4*)(att + (size_t)row * 1024 + c8 * 8) = o; } } }
            PHASE_END(13)
            layer_tail<1>(p, lds, grid, xbar, bx, G, gw, NGW, wave);
}

constexpr int NPHASES = 19;

extern "C" void kernel_launch(void* const* d_in, const int* in_sizes, int n_in, void* d_out, int out_size, void* d_ws, size_t ws_size, hipStream_t stream) {
    static int grid = 0;
    if (grid == 0) {
        int dev = 0, cus = 0, per_cu = 0;
        hipGetDevice(&dev);
        hipDeviceGetAttribute(&cus, hipDeviceAttributeMultiprocessorCount, dev);
        hipFuncSetAttribute((const void*)mega, hipFuncAttributeMaxDynamicSharedMemorySize, LDS_BYTES);
        hipOccupancyMaxActiveBlocksPerMultiprocessor(&per_cu, (const void*)mega, 512, LDS_BYTES);
        if (per_cu < 1) per_cu = 1;
        grid = cus * 1;
        if (ws_size < WS_END) fprintf(stderr, "kernel_launch: workspace too small: %zu < %zu\n", ws_size, (size_t)WS_END);
        fprintf(stderr, "kernel_launch: cus %d per_cu %d grid %d n_in %d out %d ws %zu\n", cus, per_cu, grid, n_in, out_size, ws_size);
    }
    Params p{};
    for (int i = 0; i < 26; ++i) p.in[i] = (const float*)d_in[i];
    p.out = (float*)d_out; p.ws = (unsigned char*)d_ws; p.ph_lo = 0; p.ph_hi = NPHASES;
    void* args[] = {&p};
    hipError_t e = hipLaunchCooperativeKernel((const void*)mega, dim3(grid), dim3(512), args, LDS_BYTES, stream);
    if (e != hipSuccess) fprintf(stderr, "cooperative launch failed: %s (grid %d)\n", hipGetErrorString(e), grid);
}
```

```cpp
#include <hip/hip_runtime.h>
#include <hip/hip_cooperative_groups.h>
#include <cstdio>
#include <cstdint>
namespace cg = cooperative_groups;

#define LAS __attribute__((address_space(3)))
#define DI __device__ __forceinline__
typedef unsigned short bf16_t;
typedef short bf16x8 __attribute__((ext_vector_type(8)));
typedef short s16x4 __attribute__((ext_vector_type(4)));
typedef float f32x4 __attribute__((ext_vector_type(4)));
typedef unsigned u32x4 __attribute__((ext_vector_type(4)));
typedef unsigned u32x2 __attribute__((ext_vector_type(2)));
typedef __bf16 bf2_t __attribute__((ext_vector_type(2)));

constexpr int NP = 32768, NS = 128, NT = NP + NS, MT = 33024, DM = 1024, FF = 2816, TP = 8192;
constexpr float EPS = 1e-6f;
constexpr int LDS_BYTES = 157696 + 256;
constexpr size_t O_YP = 0, O_YS = 33554432, O_POOLP = 33685504, O_S5P = 33716224, O_KP = 33732608, O_VP = 42121216,
                 O_POOLS = 50509824, O_S5S = 50755584, O_KS = 50886656, O_VS = 51017728;
constexpr size_t MiB = 1u << 20;
constexpr size_t WS_WIN = 0, WS_WOUT = 2 * MiB, WS_WGLU = 4 * MiB, WS_WPOOL = 4 * MiB + 512 * 1024, WS_WO = 5 * MiB, WS_WQKV = 7 * MiB,
                 WS_GU0 = 13 * MiB, WS_GU1 = 24 * MiB, WS_DN0 = 35 * MiB, WS_DN1 = 41 * MiB, WS_BT1 = 47 * MiB, WS_BT2 = 51 * MiB,
                 WS_ROWSS = 57 * MiB, WS_USS = 60 * MiB, WS_LSE = 61 * MiB, WS_XN = 68 * MiB, WS_Y = 133 * MiB, WS_H = 198 * MiB,
                 WS_X = 328 * MiB;
constexpr size_t WS_AP = WS_X, WS_S = WS_X + 48 * MiB, WS_UPOOL = WS_X + 80 * MiB, WS_D = WS_X + 145 * MiB, WS_Z = WS_X + 178 * MiB,
                 WS_YCAT = WS_X + 211 * MiB;
constexpr size_t WS_HACT = WS_X;
constexpr size_t WS_Q = WS_X, WS_K = WS_X + 65 * MiB, WS_V = WS_X + 130 * MiB, WS_OP = WS_X + 195 * MiB, WS_ATT = WS_X + 389 * MiB;
constexpr size_t WS_END = WS_X + 454 * MiB;
constexpr size_t WS_CTL = 60 * MiB + 512 * 1024;

struct Params { const float* in[26]; float* out; unsigned char* ws; int ph_lo, ph_hi; };

DI unsigned pk2(float lo, float hi) { bf2_t v; v.x = (__bf16)lo; v.y = (__bf16)hi; return __builtin_bit_cast(unsigned, v); }
DI float bflo(unsigned w) { return __uint_as_float(w << 16); }
DI float bfhi(unsigned w) { return __uint_as_float(w & 0xffff0000u); }
DI float bf2f(bf16_t b) { return __uint_as_float((unsigned)b << 16); }
DI float wave_sum(float v) {
#pragma unroll
    for (int o = 1; o < 64; o <<= 1) v += __shfl_xor(v, o);
    return v;
}
DI float wave_max(float v) {
#pragma unroll
    for (int o = 1; o < 64; o <<= 1) v = fmaxf(v, __shfl_xor(v, o));
    return v;
}
DI float sigmoidf_(float x) { return __builtin_amdgcn_rcpf(1.0f + __builtin_amdgcn_exp2f(-1.4426950408889634f * x)); }
DI float gelu_tanh(float y) { const float u = 0.7978845608028654f * (y + 0.044715f * y * y * y); return y * __builtin_amdgcn_rcpf(1.0f + __builtin_amdgcn_exp2f(-2.0f * 1.4426950408889634f * u)); }
DI void sincos_acc(float a, float& s, float& c) {
    if (fabsf(a) < 0.5f) {
        const float a2 = a * a;
        s = a * (1.f - a2 * (1.f / 6.f) * (1.f - a2 * (1.f / 20.f) * (1.f - a2 * (1.f / 42.f))));
        c = 1.f - a2 * 0.5f * (1.f - a2 * (1.f / 12.f) * (1.f - a2 * (1.f / 30.f) * (1.f - a2 * (1.f / 56.f))));
    } else {
        float r = a * 0.15915494309189535f; r -= floorf(r);
        s = __builtin_amdgcn_sinf(r); c = __builtin_amdgcn_cosf(r);
    }
}
DI int lane_id() { int l; asm volatile("v_mbcnt_lo_u32_b32 %0, -1, 0\n\tv_mbcnt_hi_u32_b32 %0, -1, %0" : "=v"(l)); return l; }
#define LDS_WAIT() asm volatile("s_waitcnt lgkmcnt(0)" ::: "memory")
#define VM_WAIT() asm volatile("s_waitcnt vmcnt(0)" ::: "memory")

constexpr int BM = 256, BK = 64, HALF = 128, NXCD = 8, WGM = 8;
typedef f32x4 Acc[2][2][4][2];
DI int lds_byte(int r, int c) { const int st = (r >> 4) * 2 + (c >> 5), rr = r & 15, cc = c & 31, ob = rr * 64 + cc * 2; return st * 1024 + (ob ^ (((ob >> 9) & 1) << 5)); }
DI void stage_rc(int b, int& R, int& C) { const int st = b / 1024, sb = b % 1024, swz = sb ^ (((sb >> 9) & 1) << 5); R = (st >> 1) * 16 + swz / 64; C = (st & 1) * 32 + (swz % 64) / 2; }

DI bool unit_next(int i, int G, int c, int nM, int nN, int& pm, int& pn) {
    const int nwg = nM * nN; const long L = (long)i * G + c; if (L >= nwg) return false;
    int wgid = (int)L; { const int q = nwg / NXCD, r = nwg % NXCD, xcd = wgid % NXCD, off = wgid / NXCD; wgid = (xcd < r ? xcd * (q + 1) : r * (q + 1) + (xcd - r) * q) + off; }
    const int nig = WGM * nN, gid = wgid / nig, fm = gid * WGM, gsz = (nM - fm) < WGM ? (nM - fm) : WGM;
    pm = fm + ((wgid % nig) % gsz); pn = (wgid % nig) / gsz; return true;
}

template <class Units>
DI void gemm_phase(LAS unsigned char* lds, const int wid, const int lda, const int ldb, const int K, const Units& U) {
    typedef typename Units::Epi Epi;
    const int lane = lane_id(), tid = wid * 64 + lane, wr = wid >> 2, wc = wid & 3, fr = lane & 15, fq = lane >> 4;
    unsigned offA, offB;
    { int R, C; stage_rc(tid * 16, R, C); offA = (unsigned)(R * lda + C) * 2u;
      const int rho = R & 31, Rb = (R & ~31) + 8 * ((rho & 15) >> 2) + 4 * (rho >> 4) + (rho & 3);
      offB = (unsigned)(Rb * ldb + C) * 2u; }
    const unsigned ldsw = (unsigned)wid * 1024u;
    const unsigned hA = (unsigned)(HALF * lda * 2), hB = (unsigned)(HALF * ldb * 2), dA = (unsigned)(64 * lda * 2), dB = (unsigned)(64 * ldb * 2);
    const int aoff = lds_byte(wr * 64 + fr, fq * 8), boff = lds_byte(wc * 32 + fr, fq * 8);
#define SA(b, h) (((b) * 2 + (h)) * 16384)
#define SB(b, h) ((4 + (b) * 2 + (h)) * 16384)
#define STG(bufoff, gbase, soff, voff, dlt) do { _Pragma("unroll") for (int _i = 0; _i < 2; ++_i) { unsigned _vo = (voff); asm volatile("" : "+v"(_vo)); _vo += (unsigned)(soff) + (unsigned)_i * (dlt); \
        __builtin_amdgcn_global_load_lds((const unsigned*)((gbase) + _vo), (LAS unsigned*)(lds + (bufoff) + ldsw + _i * 8192), 16, 0, 0); } } while (0)
#define STA(b, h, base, kt) STG(SA(b, h), base, (h) * hA + (unsigned)(kt) * 128u, offA, dA)
#define STB(b, h, base, kt) STG(SB(b, h), base, (h) * hB + (unsigned)(kt) * 128u, offB, dB)
#define LDA(dst, b, h) do { _Pragma("unroll") for (int m = 0; m < 4; ++m) _Pragma("unroll") for (int k = 0; k < 2; ++k) dst[m][k] = *(const LAS bf16x8*)(lds + SA(b, h) + aoff + m * 2048 + k * 1024); } while (0)
#define LDB(dst, b, h) do { _Pragma("unroll") for (int n = 0; n < 2; ++n) _Pragma("unroll") for (int k = 0; k < 2; ++k) dst[n][k] = *(const LAS bf16x8*)(lds + SB(b, h) + boff + n * 2048 + k * 1024); } while (0)
#define MMA(ai, bj, Af, Bf) do { __builtin_amdgcn_s_setprio(1); _Pragma("unroll") for (int m = 0; m < 4; ++m) _Pragma("unroll") for (int n = 0; n < 2; ++n) _Pragma("unroll") for (int k = 0; k < 2; ++k) \
        acc[ai][bj][m][n] = __builtin_amdgcn_mfma_f32_16x16x32_bf16(Bf[n][k], Af[m][k], acc[ai][bj][m][n], 0, 0, 0); __builtin_amdgcn_s_setprio(0); } while (0)
#define WAIT_V(n) asm volatile("s_waitcnt vmcnt(" #n ")" ::: "memory")
#define WAIT_L(n) asm volatile("s_waitcnt lgkmcnt(" #n ")" ::: "memory")
#define BAR __builtin_amdgcn_s_barrier()
#define SCHED __builtin_amdgcn_sched_barrier(0)
#define ZERO_ACC() do { _Pragma("unroll") for (int a = 0; a < 2; ++a) _Pragma("unroll") for (int b = 0; b < 2; ++b) _Pragma("unroll") for (int m = 0; m < 4; ++m) _Pragma("unroll") for (int n = 0; n < 2; ++n) acc[a][b][m][n] = (f32x4){0.f, 0.f, 0.f, 0.f}; } while (0)
    const bf16_t* pa; const bf16_t* pb; Epi Ecur, Enxt;
    if (!U.get(0, pa, pb, Ecur)) return;
    const char* cA = (const char*)pa; const char* cB = (const char*)pb;
    Acc acc; ZERO_ACC();
    bf16x8 At[4][2], B0[2][2], B1[2][2];
    const int nt = K / BK;
    STB(0, 0, cB, 0); STB(0, 1, cB, 0); STA(0, 0, cA, 0); STA(0, 1, cA, 0);
    if (wr == 1) BAR;
    WAIT_V(2); BAR;
    STB(1, 0, cB, 1); STA(1, 0, cA, 1); STB(1, 1, cB, 1);
    WAIT_V(6); BAR;
    for (int ui = 0;; ++ui) {
        const bool has_next = U.get(ui + 1, pa, pb, Enxt);
        const char* nA = has_next ? (const char*)pa : cA; const char* nB = has_next ? (const char*)pb : cB;
        for (int t = 0; t < nt; t += 2) {
            const bool last = (t == nt - 2);
            const char* a2 = last ? nA : cA; const char* b2 = last ? nB : cB; const int k2 = last ? 0 : t + 2, k3 = k2 + 1;
            LDB(B0, 0, 0); LDB(B1, 0, 1); SCHED; LDA(At, 0, 0); STA(1, 1, cA, t + 1);
            WAIT_V(8); WAIT_L(0); BAR; MMA(0, 0, At, B0); MMA(0, 1, At, B1); BAR; SCHED;
            LDA(At, 0, 1); STB(0, 0, b2, k2); STB(0, 1, b2, k2); STA(0, 0, a2, k2);
            WAIT_V(8); WAIT_L(0); BAR; MMA(1, 0, At, B0); MMA(1, 1, At, B1); BAR; SCHED;
            LDB(B0, 1, 0); LDB(B1, 1, 1); SCHED; LDA(At, 1, 0); STA(0, 1, a2, k2);
            WAIT_V(8); WAIT_L(0); BAR; MMA(0, 0, At, B0); MMA(0, 1, At, B1); BAR; SCHED;
            LDA(At, 1, 1); STB(1, 0, b2, k3); STB(1, 1, b2, k3); STA(1, 0, a2, k3);
            WAIT_V(8); WAIT_L(0); BAR; MMA(1, 0, At, B0); MMA(1, 1, At, B1); BAR; SCHED;
        }
        if (wr == 0) BAR;
        Ecur(acc, wr, wc, fr, fq);
        if (!has_next) break;
        ZERO_ACC();
        cA = nA; cB = nB; Ecur = Enxt;
        if (wr == 1) BAR;
    }
    WAIT_V(0);
    BAR;
#undef ZERO_ACC
#undef SA
#undef SB
#undef STG
#undef STA
#undef STB
#undef LDA
#undef LDB
#undef MMA
#undef WAIT_V
#undef WAIT_L
#undef BAR
#undef SCHED
}

#define EPI_ROWS(...) _Pragma("unroll") for (int ai = 0; ai < 2; ++ai) _Pragma("unroll") for (int m = 0; m < 4; ++m) { const int rr = ai * 128 + wr * 64 + m * 16 + fr; __VA_ARGS__ }
#define EPI_COLS8(...) _Pragma("unroll") for (int bj = 0; bj < 2; ++bj) { const int cc = bj * 128 + wc * 32 + 8 * fq; const f32x4 v0 = acc[ai][bj][m][0], v1 = acc[ai][bj][m][1]; __VA_ARGS__ }
#define EPI_COLS(...) _Pragma("unroll") for (int bj = 0; bj < 2; ++bj) _Pragma("unroll") for (int n = 0; n < 2; ++n) { const int cc = bj * 128 + wc * 32 + 8 * fq + 4 * n; const f32x4 v = acc[ai][bj][m][n]; __VA_ARGS__ }

struct EpiProj {
    float* upool; bf16_t* Ap; float* uss; int row0, col0;
    DI void set(int pm, int pn) { row0 = pm * 256; col0 = pn * 256; }
    DI void elem(int row, int col, const f32x4 v) const {
        if (col < 512) *(f32x4*)(upool + (size_t)row * 512 + col) = v; else *(f32x4*)(uss + (size_t)(row - NP) * 512 + (col - 512)) = v; }
    DI void operator()(const Acc& acc, int wr, int wc, int fr, int fq) const {
        if (col0 < 512) {
            EPI_ROWS(const size_t row = row0 + rr; EPI_COLS(*(f32x4*)(upool + row * 512 + col0 + cc) = v;))
        } else {
            EPI_ROWS(const int row = row0 + rr;
                EPI_COLS8(const int c2 = col0 - 512 + cc; const int g = c2 >> 4, i = c2 & 15;
                    if (row < NP) { u32x4 w; w.x = pk2(v0[0], v0[1]); w.y = pk2(v0[2], v0[3]); w.z = pk2(v1[0], v1[1]); w.w = pk2(v1[2], v1[3]);
                        *(u32x4*)(Ap + ((size_t)g * 2048 + (row >> 4)) * 384 + 128 + (row & 15) * 16 + i) = w; }
                    else if (row < NT) { *(f32x4*)(uss + (size_t)(row - NP) * 512 + c2) = v0; *(f32x4*)(uss + (size_t)(row - NP) * 512 + c2 + 4) = v1; }))
        }
    }
};
struct EpiS1 {
    float* S; int g, row0;
    DI void set(int mt, int gg) { row0 = mt * 256; g = gg; }
    DI void operator()(const Acc& acc, int wr, int wc, int fr, int fq) const {
        EPI_ROWS(const size_t row = (size_t)g * 2048 + row0 + rr;
            _Pragma("unroll") for (int n = 0; n < 2; ++n) { const int cc = wc * 32 + 8 * fq + 4 * n; *(f32x4*)(S + row * 128 + cc) = acc[ai][0][m][n]; })
    }
};
struct EpiPool {
    bf16_t* ycat; const float* scale; int row0, col0;
    DI void set(int pm, int pn) { row0 = pm * 256; col0 = pn * 256; }
    DI void elem(int row, int col, const f32x4 v) const { const f32x4 s = *(const f32x4*)(scale + col); u32x2 w; w.x = pk2(v[0] * s[0], v[1] * s[1]); w.y = pk2(v[2] * s[2], v[3] * s[3]);
        *(u32x2*)(ycat + (size_t)row * 1024 + col) = w; }
    DI void operator()(const Acc& acc, int wr, int wc, int fr, int fq) const {
        EPI_ROWS(const size_t row = row0 + rr;
            EPI_COLS8(const int col = col0 + cc; const f32x4 s0 = *(const f32x4*)(scale + col), s1 = *(const f32x4*)(scale + col + 4); u32x4 w;
                w.x = pk2(v0[0] * s0[0], v0[1] * s0[1]); w.y = pk2(v0[2] * s0[2], v0[3] * s0[3]); w.z = pk2(v1[0] * s1[0], v1[1] * s1[1]); w.w = pk2(v1[2] * s1[2], v1[3] * s1[3]);
                *(u32x4*)(ycat + row * 1024 + col) = w;))
    }
};
struct EpiS2 {
    bf16_t* z; const bf16_t* Ap; const float* dskip; int g, row0;
    DI void set(int mt, int gg) { row0 = mt * 256; g = gg; }
    DI void operator()(const Acc& acc, int wr, int wc, int fr, int fq) const {
        EPI_ROWS(const int chunk = row0 + rr; const bf16_t* ap = Ap + ((size_t)g * 2048 + chunk) * 384 + 128;
            EPI_COLS8(const int r = cc >> 4, i = cc & 15; const u32x4 uw = *(const u32x4*)(ap + cc); const f32x4 d0 = *(const f32x4*)(dskip + g * 16 + i), d1 = *(const f32x4*)(dskip + g * 16 + i + 4);
                const float y0 = v0[0] + d0[0] * bflo(uw.x), y1 = v0[1] + d0[1] * bfhi(uw.x), y2 = v0[2] + d0[2] * bflo(uw.y), y3 = v0[3] + d0[3] * bfhi(uw.y);
                const float y4 = v1[0] + d1[0] * bflo(uw.z), y5 = v1[1] + d1[1] * bfhi(uw.z), y6 = v1[2] + d1[2] * bflo(uw.w), y7 = v1[3] + d1[3] * bfhi(uw.w);
                u32x4 w; w.x = pk2(gelu_tanh(y0), gelu_tanh(y1)); w.y = pk2(gelu_tanh(y2), gelu_tanh(y3)); w.z = pk2(gelu_tanh(y4), gelu_tanh(y5)); w.w = pk2(gelu_tanh(y6), gelu_tanh(y7));
                *(u32x4*)(z + ((size_t)chunk * 16 + r) * 512 + g * 16 + i) = w;))
    }
};
struct EpiGlu {
    bf16_t* ycat; const bf16_t* z; const float* bglu; int row0, col0;
    DI void set(int pm, int pn) { row0 = pm * 256; col0 = pn * 256; }
    DI void elem(int row, int col, const f32x4 v) const { const u32x2 zw = *(const u32x2*)(z + (size_t)row * 512 + col); const f32x4 b = *(const f32x4*)(bglu + col);
        u32x2 w; w.x = pk2(bflo(zw.x) * sigmoidf_(v[0] + b[0]), bfhi(zw.x) * sigmoidf_(v[1] + b[1])); w.y = pk2(bflo(zw.y) * sigmoidf_(v[2] + b[2]), bfhi(zw.y) * sigmoidf_(v[3] + b[3]));
        *(u32x2*)(ycat + (size_t)row * 1024 + 512 + col) = w; }
    DI void operator()(const Acc& acc, int wr, int wc, int fr, int fq) const {
        EPI_ROWS(const size_t row = row0 + rr;
            EPI_COLS8(const int col = col0 + cc; const u32x4 zw = *(const u32x4*)(z + row * 512 + col); const f32x4 b0 = *(const f32x4*)(bglu + col), b1 = *(const f32x4*)(bglu + col + 4);
                u32x4 w; w.x = pk2(bflo(zw.x) * sigmoidf_(v0[0] + b0[0]), bfhi(zw.x) * sigmoidf_(v0[1] + b0[1]));
                w.y = pk2(bflo(zw.y) * sigmoidf_(v0[2] + b0[2]), bfhi(zw.y) * sigmoidf_(v0[3] + b0[3]));
                w.z = pk2(bflo(zw.z) * sigmoidf_(v1[0] + b1[0]), bfhi(zw.z) * sigmoidf_(v1[1] + b1[1]));
                w.w = pk2(bflo(zw.w) * sigmoidf_(v1[2] + b1[2]), bfhi(zw.w) * sigmoidf_(v1[3] + b1[3]));
                *(u32x4*)(ycat + row * 1024 + 512 + col) = w;))
    }
};
struct EpiY {
    bf16_t* y; int row0, col0;
    DI void set(int pm, int pn) { row0 = pm * 256; col0 = pn * 256; }
    DI void elem(int row, int col, const f32x4 v) const { u32x2 w; w.x = pk2(v[0], v[1]); w.y = pk2(v[2], v[3]); *(u32x2*)(y + (size_t)row * 1024 + col) = w; }
    DI void operator()(const Acc& acc, int wr, int wc, int fr, int fq) const {
        EPI_ROWS(const size_t row = row0 + rr;
            _Pragma("unroll") for (int bj = 0; bj < 2; ++bj) { const int cc = bj * 128 + wc * 32 + 8 * fq; const f32x4 v0 = acc[ai][bj][m][0], v1 = acc[ai][bj][m][1];
                u32x4 w; w.x = pk2(v0[0], v0[1]); w.y = pk2(v0[2], v0[3]); w.z = pk2(v1[0], v1[1]); w.w = pk2(v1[2], v1[3]); *(u32x4*)(y + row * 1024 + col0 + cc) = w; })
    }
};
struct EpiGU {
    bf16_t* hact; int row0, hb;
    DI void set(int pm, int pn) { row0 = pm * 256; hb = pn; }
    DI void elem2(int row, int col, const f32x4 a, const f32x4 u) const { u32x2 w; w.x = pk2(a[0] * sigmoidf_(a[0]) * u[0], a[1] * sigmoidf_(a[1]) * u[1]); w.y = pk2(a[2] * sigmoidf_(a[2]) * u[2], a[3] * sigmoidf_(a[3]) * u[3]);
        *(u32x2*)(hact + (size_t)row * FF + col) = w; }
    DI void operator()(const Acc& acc, int wr, int wc, int fr, int fq) const {
        EPI_ROWS(const size_t row = row0 + rr; const int cc = wc * 32 + 8 * fq; u32x4 w;
            { const f32x4 a = acc[ai][0][m][0], u = acc[ai][1][m][0]; w.x = pk2(a[0] * sigmoidf_(a[0]) * u[0], a[1] * sigmoidf_(a[1]) * u[1]); w.y = pk2(a[2] * sigmoidf_(a[2]) * u[2], a[3] * sigmoidf_(a[3]) * u[3]); }
            { const f32x4 a = acc[ai][0][m][1], u = acc[ai][1][m][1]; w.z = pk2(a[0] * sigmoidf_(a[0]) * u[0], a[1] * sigmoidf_(a[1]) * u[1]); w.w = pk2(a[2] * sigmoidf_(a[2]) * u[2], a[3] * sigmoidf_(a[3]) * u[3]); }
            *(u32x4*)(hact + row * FF + hb * 128 + cc) = w;)
    }
};
struct EpiQKV {
    bf16_t* qkv; float* out; int row0, col0;
    DI void set(int pm, int pn) { row0 = pm * 256; col0 = pn * 256; }
    DI void elem(int row, int colg, const f32x4 v) const {
        const int which = colg >> 10, col = colg & 1023; const float sc = which == 0 ? 0.125f * 1.4426950408889634f : 1.0f;
        u32x2 w; w.x = pk2(v[0] * sc, v[1] * sc); w.y = pk2(v[2] * sc, v[3] * sc);
        *(u32x2*)(qkv + (size_t)which * (65 * MiB / 2) + (size_t)row * 1024 + col) = w;
        if (which != 0) *(f32x4*)(out + (which == 1 ? O_KS : O_VS) + (size_t)(row - NP) * 1024 + col) = v; }
    DI void operator()(const Acc& acc, int wr, int wc, int fr, int fq) const {
        const int which = col0 >> 10; const int cb = col0 & 1023; const float sc = which == 0 ? 0.125f * 1.4426950408889634f : 1.0f;
        bf16_t* dst = qkv + (size_t)which * (65 * MiB / 2);
        float* op = out + (which == 1 ? O_KP : O_VP); float* os = out + (which == 1 ? O_KS : O_VS);
        EPI_ROWS(const int row = row0 + rr;
            EPI_COLS8(const int col = cb + cc; u32x4 w; w.x = pk2(v0[0] * sc, v0[1] * sc); w.y = pk2(v0[2] * sc, v0[3] * sc); w.z = pk2(v1[0] * sc, v1[1] * sc); w.w = pk2(v1[2] * sc, v1[3] * sc);
                *(u32x4*)(dst + (size_t)row * 1024 + col) = w;
                if (which != 0) {
                    if (row < NP) { const int tb = row & (TP - 1); if (tb >= TP - 2048) { float* o = op + ((size_t)(row >> 13) * 2048 + (tb - (TP - 2048))) * 1024 + col; *(f32x4*)o = v0; *(f32x4*)(o + 4) = v1; } }
                    else if (row < NT) { float* o = os + (size_t)(row - NP) * 1024 + col; *(f32x4*)o = v0; *(f32x4*)(o + 4) = v1; }
                }))
    }
};


template <class EpiT> struct UStd {
    typedef EpiT Epi; const bf16_t* A; const bf16_t* Bt; size_t astep, bstep; int acolstep, nM, nN, G, c; EpiT proto;
    DI bool get(int i, const bf16_t*& a, const bf16_t*& b, EpiT& e) const { int pm, pn; if (!unit_next(i, G, c, nM, nN, pm, pn)) return false;
        a = A + (size_t)pm * astep + (size_t)pn * acolstep; b = Bt + (size_t)pn * bstep; e = proto; e.set(pm, pn); return true; }
};
template <class EpiT> struct US5 {
    typedef EpiT Epi; const bf16_t* A; const bf16_t* Bt; size_t bstep; int G, c; EpiT proto;
    DI bool get(int i, const bf16_t*& a, const bf16_t*& b, EpiT& e) const { const int L = c + i * G; if (L >= 256) return false; const int g = L >> 3, mt = L & 7;
        a = A + ((size_t)g * 2048 + mt * 256) * 384; b = Bt + (size_t)g * bstep; e = proto; e.set(mt, g); return true; }
};

DI f32x4 mini_acc(const bf16_t* Arow, const bf16_t* Brow, int K) {
    f32x4 acc = (f32x4){0.f, 0.f, 0.f, 0.f};
    int k0 = 0;
    for (; k0 + 512 <= K; k0 += 512) { bf16x8 a[16], b[16];
#pragma unroll
        for (int e = 0; e < 16; ++e) { a[e] = *(const bf16x8*)(Arow + k0 + 32 * e); b[e] = *(const bf16x8*)(Brow + k0 + 32 * e); }
#pragma unroll
        for (int e = 0; e < 16; ++e) acc = __builtin_amdgcn_mfma_f32_16x16x32_bf16(b[e], a[e], acc, 0, 0, 0); }
    if (k0 < K) { bf16x8 a[8], b[8];
#pragma unroll
        for (int e = 0; e < 8; ++e) { a[e] = *(const bf16x8*)(Arow + k0 + 32 * e); b[e] = *(const bf16x8*)(Brow + k0 + 32 * e); }
#pragma unroll
        for (int e = 0; e < 8; ++e) acc = __builtin_amdgcn_mfma_f32_16x16x32_bf16(b[e], a[e], acc, 0, 0, 0); }
    return acc;
}
DI void mini_acc2(const bf16_t* Arow, const bf16_t* Bg, const bf16_t* Bu, int K, f32x4& ga, f32x4& ua) {
    ga = (f32x4){0.f, 0.f, 0.f, 0.f}; ua = ga;
    for (int k0 = 0; k0 < K; k0 += 256) { bf16x8 a[8], g[8], u[8];
#pragma unroll
        for (int e = 0; e < 8; ++e) { a[e] = *(const bf16x8*)(Arow + k0 + 32 * e); g[e] = *(const bf16x8*)(Bg + k0 + 32 * e); u[e] = *(const bf16x8*)(Bu + k0 + 32 * e); }
#pragma unroll
        for (int e = 0; e < 8; ++e) { ga = __builtin_amdgcn_mfma_f32_16x16x32_bf16(g[e], a[e], ga, 0, 0, 0); ua = __builtin_amdgcn_mfma_f32_16x16x32_bf16(u[e], a[e], ua, 0, 0, 0); } }
}
template <class Epi>
DI void mini_gemm(const bf16_t* A, int lda, const bf16_t* Bt, int ldb, int K, int N, int acol_per_256, const Epi& E, int bx, int G, int wave, int lane) {
    const int fr = lane & 15, fq = lane >> 4; const int row = NP + 16 * wave + fr;
    for (int q = bx; q < N / 16; q += G) {
        const bf16_t* Arow = A + (size_t)row * lda + ((16 * q) >> 8) * acol_per_256 + 8 * fq;
        const bf16_t* Brow = Bt + (size_t)(16 * q + fr) * ldb + 8 * fq;
        const f32x4 acc = mini_acc(Arow, Brow, K);
        E.elem(row, 16 * q + 4 * fq, acc); }
}
DI void mini_gemm_gu(const bf16_t* A, const bf16_t* Bt, const EpiGU& E, int bx, int G, int wave, int lane) {
    const int fr = lane & 15, fq = lane >> 4; const int row = NP + 16 * wave + fr;
    for (int q = bx; q < FF / 16; q += G) { const int hcol = 16 * q; const int brow = (hcol >> 7) * 256 + (hcol & 127) + fr;
        const bf16_t* Arow = A + (size_t)row * DM + 8 * fq;
        f32x4 ga, ua; mini_acc2(Arow, Bt + (size_t)brow * DM + 8 * fq, Bt + (size_t)(brow + 128) * DM + 8 * fq, DM, ga, ua);
        E.elem2(row, hcol + 4 * fq, ga, ua); }
}
DI void transpose_item(const float* W, int N, int k0, int n0, bf16_t* WT, int ldt, int orow0, int ocol0, LAS float* scr, int lane) {
#pragma unroll 16
    for (int i = 0; i < 32; ++i) { const int kk = 2 * i + (lane >> 5); scr[kk * 33 + (lane & 31)] = W[(size_t)(k0 + kk) * N + n0 + (lane & 31)]; }
    LDS_WAIT();
    const int c = lane & 7;
#pragma unroll
    for (int j = 0; j < 4; ++j) { const int n = (lane >> 3) + 8 * j; const LAS float* s = scr + (8 * c) * 33 + n;
        u32x4 o; o.x = pk2(s[0 * 33], s[1 * 33]); o.y = pk2(s[2 * 33], s[3 * 33]); o.z = pk2(s[4 * 33], s[5 * 33]); o.w = pk2(s[6 * 33], s[7 * 33]);
        *(u32x4*)(WT + (size_t)(orow0 + n) * ldt + ocol0 + 8 * c) = o; }
    LDS_WAIT();
}
DI void tr_plain(const float* W, int K, int N, bf16_t* WT, int item, LAS float* scr, int lane) {
    const int nblk = N / 32, kb = item / nblk, nb = item % nblk; transpose_item(W, N, 64 * kb, 32 * nb, WT, K, 32 * nb, 64 * kb, scr, lane);
}

DI const float* in_row(const Params& p, int r) { return r < NP ? p.in[0] + (size_t)r * DM : p.in[1] + (size_t)(r - NP) * DM; }

DI void norm_row(const float* xr, const float* g, bf16_t* o, int lane) {
    f32x4 v[4]; float s = 0.f;
#pragma unroll
    for (int j = 0; j < 4; ++j) { v[j] = *(const f32x4*)(xr + 4 * lane + 256 * j); s += (v[j][0] * v[j][0] + v[j][1] * v[j][1]) + (v[j][2] * v[j][2] + v[j][3] * v[j][3]); }
    const float r = rsqrtf(wave_sum(s) * (1.f / DM) + EPS);
#pragma unroll
    for (int j = 0; j < 4; ++j) { const f32x4 gg = *(const f32x4*)(g + 4 * lane + 256 * j); u32x2 w; w.x = pk2(v[j][0] * r * gg[0], v[j][1] * r * gg[1]); w.y = pk2(v[j][2] * r * gg[2], v[j][3] * r * gg[3]);
        *(u32x2*)(o + 4 * lane + 256 * j) = w; }
}
DI void norm_row2(const float* xa, const float* xb, const float* g, bf16_t* oa, bf16_t* ob, int lane) {
    f32x4 va[4], vb[4]; float sa = 0.f, sb = 0.f;
#pragma unroll
    for (int j = 0; j < 4; ++j) { va[j] = *(const f32x4*)(xa + 4 * lane + 256 * j); vb[j] = *(const f32x4*)(xb + 4 * lane + 256 * j); }
#pragma unroll
    for (int j = 0; j < 4; ++j) { sa += (va[j][0] * va[j][0] + va[j][1] * va[j][1]) + (va[j][2] * va[j][2] + va[j][3] * va[j][3]); sb += (vb[j][0] * vb[j][0] + vb[j][1] * vb[j][1]) + (vb[j][2] * vb[j][2] + vb[j][3] * vb[j][3]); }
    const float ra = rsqrtf(wave_sum(sa) * (1.f / DM) + EPS), rb = rsqrtf(wave_sum(sb) * (1.f / DM) + EPS);
#pragma unroll
    for (int j = 0; j < 4; ++j) { const f32x4 gg = *(const f32x4*)(g + 4 * lane + 256 * j); u32x2 w;
        w.x = pk2(va[j][0] * ra * gg[0], va[j][1] * ra * gg[1]); w.y = pk2(va[j][2] * ra * gg[2], va[j][3] * ra * gg[3]); *(u32x2*)(oa + 4 * lane + 256 * j) = w;
        w.x = pk2(vb[j][0] * rb * gg[0], vb[j][1] * rb * gg[1]); w.y = pk2(vb[j][2] * rb * gg[2], vb[j][3] * rb * gg[3]); *(u32x2*)(ob + 4 * lane + 256 * j) = w; }
}
template <bool INB, bool OUTB>
DI void res_row(const void* hin_, const bf16_t* y, const float* gpost, const float* gnext, void* hout_, bf16_t* xn, int lane) {
    u32x2 yw[4]; float ss = 0.f;
#pragma unroll
    for (int j = 0; j < 4; ++j) { yw[j] = *(const u32x2*)(y + 4 * lane + 256 * j); const float a = bflo(yw[j].x), b = bfhi(yw[j].x), c = bflo(yw[j].y), d = bfhi(yw[j].y); ss += (a * a + b * b) + (c * c + d * d); }
    const float r1 = rsqrtf(wave_sum(ss) * (1.f / DM) + EPS);
    f32x4 h[4]; float s2 = 0.f;
#pragma unroll
    for (int j = 0; j < 4; ++j) { const int c = 4 * lane + 256 * j; f32x4 hv;
        if (INB) { const u32x2 hw = *(const u32x2*)((const bf16_t*)hin_ + c); hv = (f32x4){bflo(hw.x), bfhi(hw.x), bflo(hw.y), bfhi(hw.y)}; } else hv = *(const f32x4*)((const float*)hin_ + c);
        const f32x4 gp = *(const f32x4*)(gpost + c);
        h[j][0] = hv[0] + bflo(yw[j].x) * r1 * gp[0]; h[j][1] = hv[1] + bfhi(yw[j].x) * r1 * gp[1]; h[j][2] = hv[2] + bflo(yw[j].y) * r1 * gp[2]; h[j][3] = hv[3] + bfhi(yw[j].y) * r1 * gp[3];
        if (OUTB) { u32x2 w; w.x = pk2(h[j][0], h[j][1]); w.y = pk2(h[j][2], h[j][3]); *(u32x2*)((bf16_t*)hout_ + c) = w;
            h[j] = (f32x4){bflo(w.x), bfhi(w.x), bflo(w.y), bfhi(w.y)}; }
        else *(f32x4*)((float*)hout_ + c) = h[j];
        s2 += (h[j][0] * h[j][0] + h[j][1] * h[j][1]) + (h[j][2] * h[j][2] + h[j][3] * h[j][3]); }
    if (xn) {
        const float r2 = rsqrtf(wave_sum(s2) * (1.f / DM) + EPS);
#pragma unroll
        for (int j = 0; j < 4; ++j) { const int c = 4 * lane + 256 * j; const f32x4 gn = *(const f32x4*)(gnext + c); u32x2 w; w.x = pk2(h[j][0] * r2 * gn[0], h[j][1] * r2 * gn[1]); w.y = pk2(h[j][2] * r2 * gn[2], h[j][3] * r2 * gn[3]);
            *(u32x2*)(xn + c) = w; }
    }
}

template <bool INB, bool OUTB, int R>
DI void res_rows(const void* const (&hin_)[R], const bf16_t* const (&y)[R], const float* gpost, const float* gnext, void* const (&hout_)[R], bf16_t* const (&xn)[R], const bool has_xn, int lane) {
    u32x4 yw[R][2]; f32x4 hv[R][2][2];
#pragma unroll
    for (int q = 0; q < R; ++q)
#pragma unroll
        for (int j = 0; j < 2; ++j) { const int c = 8 * lane + 512 * j; yw[q][j] = *(const u32x4*)(y[q] + c);
            if (INB) { const u32x4 hw = *(const u32x4*)((const bf16_t*)hin_[q] + c); hv[q][j][0] = (f32x4){bflo(hw.x), bfhi(hw.x), bflo(hw.y), bfhi(hw.y)}; hv[q][j][1] = (f32x4){bflo(hw.z), bfhi(hw.z), bflo(hw.w), bfhi(hw.w)}; }
            else { hv[q][j][0] = *(const f32x4*)((const float*)hin_[q] + c); hv[q][j][1] = *(const f32x4*)((const float*)hin_[q] + c + 4); } }
    f32x4 gp[2][2];
#pragma unroll
    for (int j = 0; j < 2; ++j) { gp[j][0] = *(const f32x4*)(gpost + 8 * lane + 512 * j); gp[j][1] = *(const f32x4*)(gpost + 8 * lane + 512 * j + 4); }
#pragma unroll
    for (int q = 0; q < R; ++q) {
        f32x4 yv[2][2]; float ss = 0.f;
#pragma unroll
        for (int j = 0; j < 2; ++j) { yv[j][0] = (f32x4){bflo(yw[q][j].x), bfhi(yw[q][j].x), bflo(yw[q][j].y), bfhi(yw[q][j].y)}; yv[j][1] = (f32x4){bflo(yw[q][j].z), bfhi(yw[q][j].z), bflo(yw[q][j].w), bfhi(yw[q][j].w)};
#pragma unroll
            for (int e = 0; e < 2; ++e) ss += (yv[j][e][0] * yv[j][e][0] + yv[j][e][1] * yv[j][e][1]) + (yv[j][e][2] * yv[j][e][2] + yv[j][e][3] * yv[j][e][3]); }
        const float r1 = rsqrtf(wave_sum(ss) * (1.f / DM) + EPS);
        float s2 = 0.f;
#pragma unroll
        for (int j = 0; j < 2; ++j) { const int c = 8 * lane + 512 * j; f32x4 h0 = hv[q][j][0] + yv[j][0] * r1 * gp[j][0], h1 = hv[q][j][1] + yv[j][1] * r1 * gp[j][1];
            if (OUTB) { u32x4 w; w.x = pk2(h0[0], h0[1]); w.y = pk2(h0[2], h0[3]); w.z = pk2(h1[0], h1[1]); w.w = pk2(h1[2], h1[3]); *(u32x4*)((bf16_t*)hout_[q] + c) = w;
                h0 = (f32x4){bflo(w.x), bfhi(w.x), bflo(w.y), bfhi(w.y)}; h1 = (f32x4){bflo(w.z), bfhi(w.z), bflo(w.w), bfhi(w.w)}; }
            else { *(f32x4*)((float*)hout_[q] + c) = h0; *(f32x4*)((float*)hout_[q] + c + 4) = h1; }
            s2 += (h0[0] * h0[0] + h0[1] * h0[1]) + (h0[2] * h0[2] + h0[3] * h0[3]) + (h1[0] * h1[0] + h1[1] * h1[1]) + (h1[2] * h1[2] + h1[3] * h1[3]);
            hv[q][j][0] = h0; hv[q][j][1] = h1; }
        if (has_xn) { const float r2 = rsqrtf(wave_sum(s2) * (1.f / DM) + EPS);
#pragma unroll
            for (int j = 0; j < 2; ++j) { const int c = 8 * lane + 512 * j; const f32x4 g0 = *(const f32x4*)(gnext + c), g1 = *(const f32x4*)(gnext + c + 4); const f32x4 a = hv[q][j][0] * r2 * g0, bb = hv[q][j][1] * r2 * g1;
                u32x4 w; w.x = pk2(a[0], a[1]); w.y = pk2(a[2], a[3]); w.z = pk2(bb[0], bb[1]); w.w = pk2(bb[2], bb[3]); *(u32x4*)(xn[q] + c) = w; } }
    }
}

struct RowPass { int mode; const float* gpost; const float* gnext; const float* xp; const float* xs; bf16_t* h16; const bf16_t* y; bf16_t* xnp; float* out;
    DI void row(int r, int lane) const {
        const bf16_t* yr = y + (size_t)r * DM; bf16_t* hr = h16 + (size_t)r * DM;
        if (mode == 0) res_row<false, true>(r < NP ? xp + (size_t)r * DM : xs + (size_t)(r - NP) * DM, yr, gpost, gnext, hr, xnp + (size_t)r * DM, lane);
        else if (mode == 1) res_row<true, true>(hr, yr, gpost, gnext, hr, xnp + (size_t)r * DM, lane);
        else res_row<true, false>(hr, yr, gpost, gnext, r < NP ? out + O_YP + (size_t)r * DM : out + O_YS + (size_t)(r - NP) * DM, nullptr, lane);
    }
    DI void rows4(int r0, int lane) const {
        const void* hin[4]; const bf16_t* yr[4]; void* ho[4]; bf16_t* xo[4];
#pragma unroll
        for (int q = 0; q < 4; ++q) { const size_t o = (size_t)(r0 + q) * DM; yr[q] = y + o; xo[q] = xnp + o;
            hin[q] = mode == 0 ? (const void*)(xp + o) : (const void*)(h16 + o); ho[q] = mode == 2 ? (void*)(out + O_YP + o) : (void*)(h16 + o); }
        if (mode == 0) res_rows<false, true, 4>(hin, yr, gpost, gnext, ho, xo, true, lane);
        else if (mode == 1) res_rows<true, true, 4>(hin, yr, gpost, gnext, ho, xo, true, lane);
        else res_rows<true, false, 4>(hin, yr, gpost, gnext, ho, xo, false, lane);
    }
    DI void rows8(int r0, int lane) const {
        const void* hin[8]; const bf16_t* yr[8]; void* ho[8]; bf16_t* xo[8];
#pragma unroll
        for (int q = 0; q < 8; ++q) { const size_t o = (size_t)(r0 + q) * DM; yr[q] = y + o; xo[q] = xnp + o;
            hin[q] = mode == 0 ? (const void*)(xp + o) : (const void*)(h16 + o); ho[q] = mode == 2 ? (void*)(out + O_YP + o) : (void*)(h16 + o); }
        if (mode == 0) res_rows<false, true, 8>(hin, yr, gpost, gnext, ho, xo, true, lane);
        else if (mode == 1) res_rows<true, true, 8>(hin, yr, gpost, gnext, ho, xo, true, lane);
        else res_rows<true, false, 8>(hin, yr, gpost, gnext, ho, xo, false, lane);
    }
};

DI void s5_tables(const Params& p, int g, LAS unsigned char* lds, bf16_t* Bt1, bf16_t* Bt2, const int tid) {
    LAS float* pwr = (LAS float*)lds;
    LAS float* pwi = pwr + 17 * 64;
    LAS float* bbr = pwi + 17 * 64;
    LAS float* bbi = bbr + 1024;
    LAS float* cr = bbi + 1024;
    LAS float* ci = cr + 1024;
    LAS float* Kd = ci + 1024;
    const float dt = __expf(p.in[12][g]);
    const float* lre = p.in[10] + g * 64; const float* lim = p.in[11] + g * 64;
    for (int it = tid; it < 17 * 64; it += 512) { const int d = it >> 6, q = it & 63; const float zr = lre[q] * dt * (float)d, zi = lim[q] * dt * (float)d;
        float s, c; sincos_acc(zi, s, c); const float mag = __expf(zr); pwr[it] = mag * c; pwi[it] = mag * s; }
    for (int it = tid; it < 1024; it += 512) { const int q = it >> 4, i = it & 15;
        const float lr = lre[q], li = lim[q], zr = lr * dt, zi = li * dt;
        float s, c, sh, ch; sincos_acc(zi, s, c); sincos_acc(0.5f * zi, sh, ch);
        const float em1 = expm1f(zr); const float nr = em1 * c - 2.f * sh * sh, ni = (em1 + 1.f) * s;
        const float den = 1.f / (lr * lr + li * li); const float fr_ = (nr * lr + ni * li) * den, fi_ = (ni * lr - nr * li) * den;
        const float br = p.in[13][(size_t)g * 1024 + it], bi = p.in[14][(size_t)g * 1024 + it];
        bbr[it] = fr_ * br - fi_ * bi; bbi[it] = fr_ * bi + fi_ * br;
        cr[it] = p.in[15][(size_t)g * 1024 + it]; ci[it] = p.in[16][(size_t)g * 1024 + it]; }
    __syncthreads();
    for (int it = tid; it < 4096; it += 512) { const int d = it >> 8, i = (it >> 4) & 15, j = it & 15; float a = 0.f;
        for (int q = 0; q < 64; ++q) { const float c_r = cr[i * 64 + q], c_i = ci[i * 64 + q], p_r = pwr[d * 64 + q], p_i = pwi[d * 64 + q];
            const float xr = c_r * p_r - c_i * p_i, xi = c_r * p_i + c_i * p_r; a += xr * bbr[q * 16 + j] - xi * bbi[q * 16 + j]; }
        Kd[it] = a; }
    __syncthreads();
    for (int it = tid; it < 256 * 32; it += 512) { const int n = it >> 5, k0 = (it & 31) * 8; float v[8];
#pragma unroll
        for (int e = 0; e < 8; ++e) { const int k = k0 + e, s = k >> 4, i = k & 15; float val = 0.f;
            if (n < 128) { const int q = n & 63; const float p_r = pwr[(15 - s) * 64 + q], p_i = pwi[(15 - s) * 64 + q], b_r = bbr[q * 16 + i], b_i = bbi[q * 16 + i];
                val = n < 64 ? (p_r * b_r - p_i * b_i) : (p_r * b_i + p_i * b_r); }
            v[e] = val; }
        u32x4 o; o.x = pk2(v[0], v[1]); o.y = pk2(v[2], v[3]); o.z = pk2(v[4], v[5]); o.w = pk2(v[6], v[7]);
        *(u32x4*)(Bt1 + (size_t)n * 256 + k0) = o; }
    for (int it = tid; it < 256 * 48; it += 512) { const int n = it / 48, k0 = (it % 48) * 8; const int r = n >> 4, i = n & 15; float v[8];
#pragma unroll
        for (int e = 0; e < 8; ++e) { const int k = k0 + e; float val;
            if (k < 128) { const int q = k & 63; const float c_r = cr[i * 64 + q], c_i = ci[i * 64 + q], p_r = pwr[(r + 1) * 64 + q], p_i = pwi[(r + 1) * 64 + q];
                val = k < 64 ? (c_r * p_r - c_i * p_i) : -(c_r * p_i + c_i * p_r); }
            else { const int kk = k - 128, s = kk >> 4, j = kk & 15; val = s <= r ? Kd[(r - s) * 256 + i * 16 + j] : 0.f; }
            v[e] = val; }
        u32x4 o; o.x = pk2(v[0], v[1]); o.y = pk2(v[2], v[3]); o.z = pk2(v[4], v[5]); o.w = pk2(v[6], v[7]);
        *(u32x4*)(Bt2 + (size_t)n * 384 + k0) = o; }
    __syncthreads();
}

DI void s5_sample_unit(const Params& p, int u, const float* uss, bf16_t* z, int lane) {
    const int g = u & 31, b = u >> 5;
    const float dt = __expf(p.in[12][g]);
    const float lr = p.in[10][g * 64 + lane], li = p.in[11][g * 64 + lane], zr = lr * dt, zi = li * dt;
    float s, c, sh, ch; sincos_acc(zi, s, c); sincos_acc(0.5f * zi, sh, ch);
    const float em1 = expm1f(zr); const float nr = em1 * c - 2.f * sh * sh, ni = (em1 + 1.f) * s;
    const float lbr = nr + 1.f, lbi = ni;
    const float den = 1.f / (lr * lr + li * li); const float fr_ = (nr * lr + ni * li) * den, fi_ = (ni * lr - nr * li) * den;
    float hr = p.in[3][(((size_t)b * 32 + g) * 64 + lane) * 2], hi = p.in[3][(((size_t)b * 32 + g) * 64 + lane) * 2 + 1];
    const float* bre = p.in[13] + ((size_t)g * 64 + lane) * 16; const float* bim = p.in[14] + ((size_t)g * 64 + lane) * 16;
    const float* cre = p.in[15] + (size_t)g * 1024 + lane; const float* cim = p.in[16] + (size_t)g * 1024 + lane;
    for (int t = 0; t < 4; ++t) {
        const float* ur = uss + (size_t)(b * 4 + t) * 512 + g * 16;
        float bur = 0.f, bui = 0.f;
#pragma unroll
        for (int i = 0; i < 16; ++i) { const float uv = ur[i]; const float br = bre[i], bi = bim[i]; bur += (fr_ * br - fi_ * bi) * uv; bui += (fr_ * bi + fi_ * br) * uv; }
        const float n_r = lbr * hr - lbi * hi + bur, n_i = lbr * hi + lbi * hr + bui; hr = n_r; hi = n_i;
        float yv = 0.f;
#pragma unroll
        for (int i = 0; i < 16; ++i) { float a = cre[i * 64] * hr - cim[i * 64] * hi; a = wave_sum(a); if (lane == i) yv = a; }
        if (lane < 16) { const float y = yv + p.in[17][g * 16 + lane] * ur[lane]; z[(size_t)(NP + b * 4 + t) * 512 + g * 16 + lane] = (bf16_t)(pk2(gelu_tanh(y), 0.f) & 0xffffu); }
    }
    float* o = p.out + O_S5S + (((size_t)b * 32 + g) * 64 + lane) * 2; o[0] = hr; o[1] = hi;
}

constexpr int ATT_BUF = 69632, ATT_VOFF = 34816, ATT_OST = 2 * ATT_BUF, LDS_CTL = ATT_OST + 8 * 2304;
struct AttUnit { int pat, b, h, dil, l0; size_t rowbase; };
DI AttUnit att_decode(int bu) { AttUnit u; const int tile = bu & 63; u.h = (bu >> 6) & 15; u.b = (bu >> 10) & 3; u.pat = bu >> 12; const int dsh = u.pat * 2; u.dil = 1 << dsh;
    const int rho = tile & (u.dil - 1); u.l0 = (tile >> dsh) * 128; u.rowbase = (size_t)u.b * TP + rho; return u; }
DI void att_stage(const AttUnit& u, const bf16_t* Kb, const bf16_t* Vb, LAS unsigned char* buf, int wave, int lane) {
    const int lmax = (TP >> (2 * u.pat)) - 1;
    for (int n = wave; n < 34; n += 8) { const int r0 = n * 8; const int row = r0 + (lane >> 3); const int c = (lane & 7) ^ (row & 7);
        int lk = u.l0 - 128 + row; lk = lk < 0 ? 0 : (lk > lmax ? lmax : lk); const size_t off = (u.rowbase + (size_t)u.dil * lk) * 1024 + u.h * 64 + c * 8;
        __builtin_amdgcn_global_load_lds((const unsigned*)(Kb + off), (LAS unsigned*)(buf + r0 * 128), 16, 0, 0);
        __builtin_amdgcn_global_load_lds((const unsigned*)(Vb + off), (LAS unsigned*)(buf + ATT_VOFF + r0 * 128), 16, 0, 0); }
}
DI void att_loadq(const AttUnit& u, const bf16_t* Q, int wave, int lane, bf16x8 (&qf)[2]) {
    const int i = lane & 15, g = lane >> 4; const bf16_t* q = Q + (u.rowbase + (size_t)u.dil * (u.l0 + 16 * wave + i)) * 1024 + u.h * 64 + 8 * g;
    qf[0] = *(const bf16x8*)q; qf[1] = *(const bf16x8*)(q + 32);
}
DI void att_compute(const AttUnit& u, const bf16x8 (&qf)[2], LAS unsigned char* buf, LAS unsigned char* ost, bf16_t* Op, float* lse, int wave, int lane) {
    const int i = lane & 15, g = lane >> 4;
    const int Lw = u.l0 + 16 * wave;
    unsigned koff[2][2], voff[4];
#pragma unroll
    for (int kbl = 0; kbl < 2; ++kbl)
#pragma unroll
        for (int s = 0; s < 2; ++s) koff[kbl][s] = (unsigned)((16 * wave + 16 * kbl + i) * 128 + (((4 * s + g) ^ (i & 7)) * 16));
    { const int q = i >> 2, pp = i & 3, r = 4 * g + q;
#pragma unroll
      for (int db = 0; db < 4; ++db) voff[db] = (unsigned)((16 * wave + r) * 128 + (((2 * db + (pp >> 1)) ^ (r & 7)) * 16) + 8 * (pp & 1)); }
    f32x4 st[5][2];
#pragma unroll
    for (int ks = 0; ks < 5; ++ks)
#pragma unroll
        for (int kbl = 0; kbl < 2; ++kbl) {
            if (ks == 4 && kbl == 1) { st[ks][kbl] = (f32x4){0.f, 0.f, 0.f, 0.f}; continue; }
            const bf16x8 k0 = *(const LAS bf16x8*)(buf + ks * 4096 + koff[kbl][0]), k1 = *(const LAS bf16x8*)(buf + ks * 4096 + koff[kbl][1]);
            f32x4 a = (f32x4){0.f, 0.f, 0.f, 0.f};
            a = __builtin_amdgcn_mfma_f32_16x16x32_bf16(k0, qf[0], a, 0, 0, 0);
            a = __builtin_amdgcn_mfma_f32_16x16x32_bf16(k1, qf[1], a, 0, 0, 0); st[ks][kbl] = a; }
#pragma unroll
    for (int r = 0; r < 4; ++r) { if (i > 4 * g + r) st[0][0][r] = -INFINITY; if (4 * g + r > i) st[4][0][r] = -INFINITY; }
    if (Lw < 128) {
#pragma unroll
        for (int ks = 0; ks < 4; ++ks)
#pragma unroll
            for (int kbl = 0; kbl < 2; ++kbl)
#pragma unroll
                for (int r = 0; r < 4; ++r) if (Lw - 128 + 32 * ks + 16 * kbl + 4 * g + r < 0) st[ks][kbl][r] = -INFINITY; }
    float mx = -INFINITY;
#pragma unroll
    for (int ks = 0; ks < 5; ++ks)
#pragma unroll
        for (int kbl = 0; kbl < 2; ++kbl) { if (ks == 4 && kbl == 1) continue;
#pragma unroll
            for (int r = 0; r < 4; ++r) mx = fmaxf(mx, st[ks][kbl][r]); }
    mx = fmaxf(mx, __shfl_xor(mx, 16)); mx = fmaxf(mx, __shfl_xor(mx, 32));
    float ps = 0.f; bf16x8 pf[5];
#pragma unroll
    for (int ks = 0; ks < 5; ++ks) {
#pragma unroll
        for (int kbl = 0; kbl < 2; ++kbl) { if (ks == 4 && kbl == 1) continue;
#pragma unroll
            for (int r = 0; r < 4; ++r) { const float pv = __builtin_amdgcn_exp2f(st[ks][kbl][r] - mx); st[ks][kbl][r] = pv; ps += pv; } }
        u32x4 pw; pw.x = pk2(st[ks][0][0], st[ks][0][1]); pw.y = pk2(st[ks][0][2], st[ks][0][3]); pw.z = pk2(st[ks][1][0], st[ks][1][1]); pw.w = pk2(st[ks][1][2], st[ks][1][3]);
        pf[ks] = __builtin_bit_cast(bf16x8, pw); }
    ps += __shfl_xor(ps, 16); ps += __shfl_xor(ps, 32);
    f32x4 o[4];
#pragma unroll
    for (int db = 0; db < 4; ++db) o[db] = (f32x4){0.f, 0.f, 0.f, 0.f};
    const unsigned vb = (unsigned)(size_t)buf + (unsigned)ATT_VOFF;
#pragma unroll
    for (int ks = 0; ks < 5; ++ks) {
        s16x4 lo[4], hi[4]; const unsigned va = vb + ks * 4096;
        asm volatile("ds_read_b64_tr_b16 %0, %8\n\tds_read_b64_tr_b16 %1, %9\n\tds_read_b64_tr_b16 %2, %10\n\tds_read_b64_tr_b16 %3, %11\n\t"
                     "ds_read_b64_tr_b16 %4, %8 offset:2048\n\tds_read_b64_tr_b16 %5, %9 offset:2048\n\tds_read_b64_tr_b16 %6, %10 offset:2048\n\tds_read_b64_tr_b16 %7, %11 offset:2048\n\t"
                     "s_waitcnt lgkmcnt(0)"
                     : "=&v"(lo[0]), "=&v"(lo[1]), "=&v"(lo[2]), "=&v"(lo[3]), "=&v"(hi[0]), "=&v"(hi[1]), "=&v"(hi[2]), "=&v"(hi[3])
                     : "v"(va + voff[0]), "v"(va + voff[1]), "v"(va + voff[2]), "v"(va + voff[3]) : "memory");
#pragma unroll
        for (int db = 0; db < 4; ++db) { const bf16x8 vf = __builtin_shufflevector(lo[db], hi[db], 0, 1, 2, 3, 4, 5, 6, 7);
            o[db] = __builtin_amdgcn_mfma_f32_16x16x32_bf16(vf, pf[ks], o[db], 0, 0, 0); }
    }
    const float inv = 1.f / ps;
#pragma unroll
    for (int db = 0; db < 4; ++db) { const f32x4 v = o[db] * inv; u32x2 w; w.x = pk2(v[0], v[1]); w.y = pk2(v[2], v[3]); *(LAS u32x2*)(ost + i * 144 + (16 * db + 4 * g) * 2) = w; }
    const size_t orow0 = (size_t)u.pat * MT + u.rowbase;
    if (g == 0) lse[(orow0 + (size_t)u.dil * (Lw + i)) * 16 + u.h] = mx + __builtin_amdgcn_logf(ps);
    LDS_WAIT();
#pragma unroll
    for (int n = 0; n < 2; ++n) { const int c = lane + 64 * n, rr = c >> 3, ch = c & 7; const u32x4 v = *(const LAS u32x4*)(ost + rr * 144 + ch * 16);
        *(u32x4*)(Op + (orow0 + (size_t)u.dil * (Lw + rr)) * 1024 + u.h * 64 + ch * 8) = v; }
    LDS_WAIT();
}
DI void attn_prompt_phase(const bf16_t* Q, const bf16_t* Kb, const bf16_t* Vb, bf16_t* Op, float* lse, LAS unsigned char* lds, int bx, int G, int wave, int lane) {
    constexpr int NU = 3 * 4096;
    int bu = bx; if (bu >= NU) return;
    AttUnit u = att_decode(bu); bf16x8 qn[2];
    att_stage(u, Kb, Vb, lds, wave, lane); att_loadq(u, Q, wave, lane, qn);
    int par = 0;
    for (;;) {
        asm volatile("s_waitcnt vmcnt(0)" ::: "memory");
        __syncthreads();
        bf16x8 qf[2]; qf[0] = qn[0]; qf[1] = qn[1];
        const AttUnit cur = u; const int nb = bu + G; const bool more = nb < NU;
        if (more) { u = att_decode(nb); att_stage(u, Kb, Vb, lds + (par ^ 1) * ATT_BUF, wave, lane); att_loadq(u, Q, wave, lane, qn); }
        att_compute(cur, qf, lds + par * ATT_BUF, lds + ATT_OST + wave * 2304, Op, lse, wave, lane);
        if (!more) break;
        bu = nb; par ^= 1;
    }
    __syncthreads();
}

DI void attn_sample_unit(const Params& p, int u, const bf16_t* Q, const bf16_t* Kb, const bf16_t* Vb, bf16_t* att, LAS float* sl, int lane) {
    const int h = u & 15, t = (u >> 4) & 3, b = u >> 6;
    const size_t qrow = (size_t)NP + b * 4 + t;
    const float* ck = p.in[4]; const float* cv = p.in[5];
    sl[lane] = bf2f(Q[qrow * 1024 + h * 64 + lane]);
    LDS_WAIT();
    float mx = -INFINITY;
#pragma unroll 1
    for (int e = 0; e < 9; ++e) { const int pat = e / 3, r = e - 3 * pat; const int dil = 1 << (2 * pat);
        const int j = lane + 64 * r; const bool valid = j <= 128; const int idx = 2048 + t - dil * (valid ? j : 0);
        float dot = 0.f;
        if (idx >= 2048) { const bf16_t* kp = Kb + ((size_t)NP + b * 4 + (idx - 2048)) * 1024 + h * 64;
#pragma unroll
            for (int d8 = 0; d8 < 8; ++d8) { const u32x4 kw = *(const u32x4*)(kp + 8 * d8); const f32x4 q0 = *(const LAS f32x4*)(sl + 8 * d8), q1 = *(const LAS f32x4*)(sl + 8 * d8 + 4);
                dot += (bflo(kw.x) * q0[0] + bfhi(kw.x) * q0[1]) + (bflo(kw.y) * q0[2] + bfhi(kw.y) * q0[3]) + (bflo(kw.z) * q1[0] + bfhi(kw.z) * q1[1]) + (bflo(kw.w) * q1[2] + bfhi(kw.w) * q1[3]); } }
        else { const float* kp = ck + (((size_t)b * 2048 + idx) * 16 + h) * 64;
#pragma unroll
            for (int d4 = 0; d4 < 16; ++d4) { const f32x4 kv = *(const f32x4*)(kp + 4 * d4); const f32x4 qv = *(const LAS f32x4*)(sl + 4 * d4); dot += (kv[0] * qv[0] + kv[1] * qv[1]) + (kv[2] * qv[2] + kv[3] * qv[3]); } }
        if (valid) { sl[64 + pat * 192 + j] = dot; mx = fmaxf(mx, dot); } }
    mx = wave_max(mx);
    LDS_WAIT();
    float ls = 0.f;
#pragma unroll 1
    for (int e = 0; e < 9; ++e) { const int pat = e / 3, r = e - 3 * pat; const int j = lane + 64 * r;
        if (j <= 128) { const float pv = __builtin_amdgcn_exp2f(sl[64 + pat * 192 + j] - mx); sl[64 + pat * 192 + j] = pv; ls += pv; } }
    ls = wave_sum(ls);
    LDS_WAIT();
    { const int kg = lane >> 4, d4 = lane & 15; f32x4 acc = (f32x4){0.f, 0.f, 0.f, 0.f};
#pragma unroll 1
      for (int pat = 0; pat < 3; ++pat) { const int dil = 1 << (2 * pat);
#pragma unroll
        for (int jj = 0; jj < 33; ++jj) { const int j = kg + 4 * jj; int idx = 2048 + t - dil * j; const bool use = (j <= 128) && (idx < 2048);
            idx = idx < 0 ? 0 : (idx > 2047 ? 2047 : idx); const float pv = use ? sl[64 + pat * 192 + (j > 128 ? 128 : j)] : 0.f;
            const f32x4 vv = *(const f32x4*)(cv + (((size_t)b * 2048 + idx) * 16 + h) * 64 + 4 * d4);
            acc += vv * pv; }
        if (kg == 0) { for (int j = 0; dil * j <= t; ++j) { const int idx = 2048 + t - dil * j; const float pv = sl[64 + pat * 192 + j];
            const u32x2 w = *(const u32x2*)(Vb + ((size_t)NP + b * 4 + (idx - 2048)) * 1024 + h * 64 + 4 * d4);
            acc += (f32x4){bflo(w.x), bfhi(w.x), bflo(w.y), bfhi(w.y)} * pv; } } }
#pragma unroll
      for (int e = 0; e < 4; ++e) { float a = acc[e]; a += __shfl_xor(a, 16); a += __shfl_xor(a, 32); acc[e] = a; }
      const float inv = 1.f / ls;
      if (kg == 0) { u32x2 w; w.x = pk2(acc[0] * inv, acc[1] * inv); w.y = pk2(acc[2] * inv, acc[3] * inv); *(u32x2*)(att + qrow * 1024 + h * 64 + 4 * d4) = w; } }
    LDS_WAIT();
}


#define XB_TMO      128
#define XB_XCNT(j)  (256  + 64 * (j))
#define XB_XSUB(j)  (1280 + 64 * (j))
#define XB_XGEN(j)  (2304 + 64 * (j))
#define XB_TOP      3328
#define XB_TOPGEN   3392
#define XCD_BAR_WORDS 3456
#define XB_SPIN_CAP (1u << 22)
DI unsigned xb_ld(unsigned* p)              { return __hip_atomic_load(p, __ATOMIC_RELAXED, __HIP_MEMORY_SCOPE_AGENT); }
DI unsigned xb_add(unsigned* p, unsigned v) { return __hip_atomic_fetch_add(p, v, __ATOMIC_RELAXED, __HIP_MEMORY_SCOPE_AGENT); }
DI unsigned xb_xcc_id() { return (unsigned)__builtin_amdgcn_s_getreg((3 << 11) | 20) & 0xFu; }
#define XB_SPIN(cond, bar) do { unsigned _sp = 0; while (cond) { __builtin_amdgcn_s_sleep(1); \
    if ((++_sp & 255u) == 0u) { if (xb_ld(&(bar)[XB_TMO])) break; if (_sp > XB_SPIN_CAP) { atomicAdd(&(bar)[XB_TMO], 1u); break; } } } } while (0)
struct XcdBarrier { unsigned* bar; unsigned x; volatile LAS unsigned* st; bool w0; };
DI XcdBarrier xcd_barrier_post(unsigned* bar, volatile LAS unsigned* st, const bool w0) {
    XcdBarrier b; b.bar = bar; b.x = xb_xcc_id(); b.st = st; b.w0 = w0;
    if (w0 && lane_id() == 0) (void)xb_add(&bar[XB_XCNT(b.x)], 1u);
    return b;
}
DI void xcd_barrier_complete(unsigned* bar, unsigned x, unsigned& nloc, unsigned& nx) {
    const unsigned G = gridDim.x * gridDim.y * gridDim.z;
    unsigned sum, cnt, mine, sp = 0u;
    for (;;) {
        sum = 0u; cnt = 0u; mine = 0u;
#pragma unroll
        for (unsigned j = 0; j < 16; ++j) { const unsigned c = xb_ld(&bar[XB_XCNT(j)]); sum += c; cnt += (c > 0u) ? 1u : 0u; mine = (j == x) ? c : mine; }
        if (sum == G) break;
        __builtin_amdgcn_s_sleep(1);
        if ((++sp & 255u) == 0u) { if (xb_ld(&bar[XB_TMO])) break; if (sp > XB_SPIN_CAP) { atomicAdd(&bar[XB_TMO], 1u); break; } }
    }
    nloc = mine > 0u ? mine : 1u; nx = cnt > 0u ? cnt : 1u;
}
DI void xcd_barrier(const XcdBarrier& b) {
    asm volatile("s_waitcnt vmcnt(0)" ::: "memory");
    __syncthreads();
    if (b.w0 && lane_id() == 0) {
        unsigned* bar = b.bar;
        __builtin_amdgcn_s_waitcnt(0);
        unsigned nloc = b.st[0], nx = b.st[1];
        if (nloc == 0u) { xcd_barrier_complete(bar, b.x, nloc, nx); b.st[0] = nloc; b.st[1] = nx; }
        const unsigned old = xb_add(&bar[XB_XSUB(b.x)], 1u);
        const unsigned gen = old / nloc;
        if (old + 1u == (gen + 1u) * nloc) {
            __builtin_amdgcn_fence(__ATOMIC_RELEASE, "agent");
            asm volatile("s_waitcnt vmcnt(0)" ::: "memory");
            const unsigned og = xb_add(&bar[XB_TOP], 1u);
            const unsigned tg = og / nx;
            if (og + 1u == (tg + 1u) * nx) xb_add(&bar[XB_TOPGEN], 1u);
            else XB_SPIN(xb_ld(&bar[XB_TOPGEN]) == tg, bar);
            __builtin_amdgcn_fence(__ATOMIC_ACQUIRE, "agent");
            xb_add(&bar[XB_XGEN(b.x)], 1u);
            asm volatile("s_waitcnt vmcnt(0)" ::: "memory");
        } else {
            XB_SPIN(xb_ld(&bar[XB_XGEN(b.x)]) == gen, bar);
            __builtin_amdgcn_fence(__ATOMIC_ACQUIRE, "agent");
            asm volatile("s_waitcnt vmcnt(0)" ::: "memory");
        }
    }
    __syncthreads();
}

#define w_in_t ((bf16_t*)(ws + WS_WIN))
#define w_out_t ((bf16_t*)(ws + WS_WOUT))
#define w_glu_t ((bf16_t*)(ws + WS_WGLU))
#define w_pool_t ((bf16_t*)(ws + WS_WPOOL))
#define w_o_t ((bf16_t*)(ws + WS_WO))
#define w_qkv_t ((bf16_t*)(ws + WS_WQKV))
#define Bt1 ((bf16_t*)(ws + WS_BT1))
#define Bt2 ((bf16_t*)(ws + WS_BT2))
#define rowss ((float*)(ws + WS_ROWSS))
#define uss ((float*)(ws + WS_USS))
#define lse ((float*)(ws + WS_LSE))
#define xn ((bf16_t*)(ws + WS_XN))
#define ybuf ((bf16_t*)(ws + WS_Y))
#define hbuf16 ((bf16_t*)(ws + WS_H))
#define Ap ((bf16_t*)(ws + WS_AP))
#define Sbuf ((float*)(ws + WS_S))
#define upool ((float*)(ws + WS_UPOOL))
#define dbuf ((bf16_t*)(ws + WS_D))
#define zbuf ((bf16_t*)(ws + WS_Z))
#define ycat ((bf16_t*)(ws + WS_YCAT))
#define hact ((bf16_t*)(ws + WS_HACT))
#define Qb ((bf16_t*)(ws + WS_Q))
#define Kb ((bf16_t*)(ws + WS_K))
#define Vb ((bf16_t*)(ws + WS_V))
#define Op ((bf16_t*)(ws + WS_OP))
#define att ((bf16_t*)(ws + WS_ATT))
#define gains (p.in[6])
#ifndef PHMASK
#define PHMASK 0xFFFFFFFFu
#endif
#ifndef DUPMASK
#define DUPMASK 0u
#endif
#define PHASE_BEGIN(k) if (((PHMASK >> (k)) & 1u) && p.ph_lo <= (k) && (k) < p.ph_hi) { for (int _rep = 0; _rep < 1 + (int)((DUPMASK >> (k)) & 1u); ++_rep) { if (_rep) __syncthreads(); const int lane = lane_id(); const int tid = wave * 64 + lane; const int gt = bx * 512 + tid; (void)gt;
#define PHASE_END(k) } } if (p.ph_lo <= (k) && (k) + 1 < p.ph_hi) { if ((k) == 0) { grid.sync(); xbar = xcd_barrier_post((unsigned*)(p.ws + WS_CTL), (volatile LAS unsigned*)(lds + 157696), wave == 0); } else xcd_barrier(xbar); }

template <int layer>
DI void layer_tail(const Params& p, LAS unsigned char* lds, cg::grid_group& grid, XcdBarrier& xbar, const int bx, const int G, const int gw, const int NGW, const int wave) {
    unsigned char* ws = p.ws;
    constexpr int pb = 6 + layer * 8;
    const float* gl = gains + (size_t)layer * 4 * DM;
        PHASE_BEGIN(pb)
        { const bf16_t* A = layer == 0 ? ycat : att; const bf16_t* W = layer == 0 ? w_out_t : w_o_t;
          { UStd<EpiY> U{A, W, (size_t)256 * DM, (size_t)256 * DM, 0, 128, 4, G, bx, EpiY{ybuf, 0, 0}};
            gemm_phase(lds, wave, DM, DM, DM, U); }
          { EpiY E{ybuf, 0, 0}; mini_gemm(A, DM, W, DM, DM, 1024, 0, E, bx, G, wave, lane); } }
        PHASE_END(pb)
        PHASE_BEGIN(pb + 1)
        { const RowPass rp{layer == 0 ? 0 : 1, gl + DM, gl + 2 * DM, p.in[0], p.in[1], hbuf16, ybuf, xn, p.out};
          for (int q = gw; q < NP / 4; q += NGW) rp.rows4(q * 4, lane);
          for (int r = NP + (NGW - 1 - gw); r < NT; r += NGW) rp.row(r, lane); }
        PHASE_END(pb + 1)
        PHASE_BEGIN(pb + 2)
        { const bf16_t* W = (const bf16_t*)(ws + (layer ? WS_GU1 : WS_GU0));
          { UStd<EpiGU> U{xn, W, (size_t)256 * DM, (size_t)256 * DM, 0, 128, 22, G, bx, EpiGU{hact, 0, 0}};
            gemm_phase(lds, wave, DM, DM, DM, U); }
          { EpiGU E{hact, 0, 0}; mini_gemm_gu(xn, W, E, bx, G, wave, lane); } }
        PHASE_END(pb + 2)
        PHASE_BEGIN(pb + 3)
        { const bf16_t* W = (const bf16_t*)(ws + (layer ? WS_DN1 : WS_DN0));
          { UStd<EpiY> U{hact, W, (size_t)256 * FF, (size_t)256 * FF, 0, 128, 4, G, bx, EpiY{ybuf, 0, 0}};
            gemm_phase(lds, wave, FF, FF, FF, U); }
          { EpiY E{ybuf, 0, 0}; mini_gemm(hact, FF, W, FF, FF, 1024, 0, E, bx, G, wave, lane); } }
        PHASE_END(pb + 3)
        PHASE_BEGIN(pb + 4)
        { const RowPass rp{layer == 0 ? 1 : 2, gl + 3 * DM, gains + 4 * DM, p.in[0], p.in[1], hbuf16, ybuf, xn, p.out};
          for (int q = gw; q < NP / 4; q += NGW) rp.rows4(q * 4, lane);
          for (int r = NP + (NGW - 1 - gw); r < NT; r += NGW) rp.row(r, lane); }
        PHASE_END(pb + 4)
    }

__global__ void __launch_bounds__(512, 2) mega(Params p) {
    extern __shared__ __attribute__((aligned(16))) unsigned char lds_raw[];
    LAS unsigned char* lds = (LAS unsigned char*)lds_raw;
    cg::grid_group grid = cg::this_grid();
    const int wave = __builtin_amdgcn_readfirstlane((int)threadIdx.x >> 6);
    const int G = gridDim.x, bx = blockIdx.x;
    const int gw = bx * 8 + wave, NGW = G * 8;
    const int NGT = G * 512;
    unsigned char* ws = p.ws;
    XcdBarrier xbar; xbar.bar = (unsigned*)(ws + WS_CTL); xbar.x = 0; xbar.st = (volatile LAS unsigned*)(lds + 157696); xbar.w0 = wave == 0;
    { const int tid = wave * 64 + lane_id();
      if (tid < 64) ((LAS unsigned*)(lds + 157696))[tid] = 0u;
      if (bx == 0) { for (int i = tid; i < 4096; i += 512) ((unsigned*)(ws + WS_CTL))[i] = 0u; } }
    __syncthreads();

    PHASE_BEGIN(0)
    {
        if (bx < 32) { s5_tables(p, bx, lds, Bt1 + (size_t)bx * 65536, Bt2 + (size_t)bx * 98304, tid); }
        LAS float* scr = (LAS float*)(lds + wave * 16384);
        constexpr int I_IN = 512, I_OUT = 512, I_GLU = 128, I_POOL = 32, I_O = 512, I_QKV = 1536, I_G = 1408, I_D = 1408;
        constexpr int NITEMS = I_IN + I_OUT + I_GLU + I_POOL + I_O + I_QKV + 4 * I_G + 2 * I_D;
        for (int it = gw; it < NITEMS; it += NGW) {
            int r = it;
            if (r < I_IN) { tr_plain(p.in[7], 1024, 1024, w_in_t, r, scr, lane); continue; } r -= I_IN;
            if (r < I_OUT) { tr_plain(p.in[20], 1024, 1024, w_out_t, r, scr, lane); continue; } r -= I_OUT;
            if (r < I_GLU) { tr_plain(p.in[18], 512, 512, w_glu_t, r, scr, lane); continue; } r -= I_GLU;
            if (r < I_POOL) { const int gg = r >> 3, q = r & 7, kb = q >> 2, nb = q & 3;
                transpose_item(p.in[8] + (size_t)gg * 16384, 128, 64 * kb, 32 * nb, w_pool_t, 256, gg * 128 + 32 * nb, (gg & 1) * 128 + 64 * kb, scr, lane); continue; } r -= I_POOL;
            if (r < I_O) { tr_plain(p.in[22], 1024, 1024, w_o_t, r, scr, lane); continue; } r -= I_O;
            if (r < I_QKV) { tr_plain(p.in[21], 1024, 3072, w_qkv_t, r, scr, lane); continue; } r -= I_QKV;
            if (r < 4 * I_G) { const int which = r / I_G, q = r % I_G; const int layer = which >> 1, up = which & 1;
                const float* W = p.in[up ? 24 : 23] + (size_t)layer * 1024 * FF; bf16_t* WT = (bf16_t*)(ws + (layer ? WS_GU1 : WS_GU0));
                const int nblk = FF / 32, kb = q / nblk, nb = q % nblk, n0 = 32 * nb;
                transpose_item(W, FF, 64 * kb, n0, WT, 1024, (n0 >> 7) * 256 + up * 128 + (n0 & 127), 64 * kb, scr, lane); continue; } r -= 4 * I_G;
            { const int layer = r / I_D, q = r % I_D; tr_plain(p.in[25] + (size_t)layer * FF * 1024, FF, 1024, (bf16_t*)(ws + (layer ? WS_DN1 : WS_DN0)), q, scr, lane); }
        }
        for (int it = gt; it < 512 * 16; it += NGT) { const int n = it >> 4, c8 = it & 15; const int gg = n >> 7;
            *(u32x4*)(w_pool_t + (size_t)n * 256 + ((gg & 1) ^ 1) * 128 + c8 * 8) = (u32x4){0u, 0u, 0u, 0u}; }
        if (bx >= 32 || G <= 32) { const int gwn = G > 32 ? (bx - 32) * 8 + wave : gw, ngwn = G > 32 ? (G - 32) * 8 : NGW;
          for (int r = gwn; r < NT; r += 2 * ngwn) { const int r2 = r + ngwn; const bool two = r2 < NT;
            norm_row2(in_row(p, r), in_row(p, two ? r2 : r), gains, xn + (size_t)r * DM, xn + (size_t)(two ? r2 : r) * DM, lane); } }
    }
    PHASE_END(0)

    PHASE_BEGIN(1)
    { UStd<EpiProj> U{xn, w_in_t, (size_t)256 * DM, (size_t)256 * DM, 0, 128, 4, G, bx, EpiProj{upool, Ap, uss, 0, 0}};
      gemm_phase(lds, wave, DM, DM, DM, U);
      { EpiProj E{upool, Ap, uss, 0, 0}; mini_gemm(xn, DM, w_in_t, DM, DM, 1024, 0, E, bx, G, wave, lane); } }
    PHASE_END(1)

    PHASE_BEGIN(2)
    {
        { US5<EpiS1> U{Ap + 128, Bt1, (size_t)65536, G, bx, EpiS1{Sbuf, 0, 0}};
          gemm_phase(lds, wave, 384, 256, 256, U); }
        for (int u = gw; u < 1024; u += NGW) s5_sample_unit(p, u, uss, zbuf, lane);
        for (int it = gt; it < (NP / 16) * 128; it += NGT) { const int cq = it & 127, run = it >> 7; const int c = cq * 4, gi = c >> 7, w = 2 << gi;
            const int t0 = run * 16, tb0 = t0 & (TP - 1); const float* up = upool + (size_t)t0 * 512 + c;
            f32x4 e[31];
#pragma unroll
            for (int k = 0; k < 31; ++k) { const int rel = k - 15; e[k] = (rel >= 1 - w && tb0 + rel >= 0) ? *(const f32x4*)(up + (ptrdiff_t)rel * 512) : (f32x4){0.f, 0.f, 0.f, 0.f}; }
            f32x4 sum = (f32x4){0.f, 0.f, 0.f, 0.f};
#pragma unroll
            for (int k = 0; k < 15; ++k) sum += e[k];
#pragma unroll
            for (int k = 0; k < 16; ++k) { const f32x4 uv = e[15 + k]; sum += uv; const int tb = tb0 + k; const int cnt = tb + 1 < w ? tb + 1 : w;
                const f32x4 dv = sum * (1.0f / (float)cnt) - uv; u32x2 o; o.x = pk2(dv[0], dv[1]); o.y = pk2(dv[2], dv[3]); *(u32x2*)(dbuf + (size_t)(t0 + k) * 512 + c) = o;
                f32x4 out_ = (f32x4){0.f, 0.f, 0.f, 0.f};
                if (w == 2) out_ = e[15 + k - 1]; else if (w == 4) out_ = e[15 + k - 3]; else if (w == 8) out_ = e[15 + k - 7]; else out_ = e[15 + k - 15];
                sum -= out_;
                if (tb >= TP - 15) *(f32x4*)(p.out + O_POOLP + ((size_t)(t0 >> 13) * 15 + (tb - (TP - 15))) * 512 + c) = uv; } }
        for (int it = gt; it < 32 * 128; it += NGT) { const int cq = it & 127, b = it >> 7; const int c = cq * 4, gi = c >> 7, w = 2 << gi;
            const float* sp = p.in[2] + (size_t)b * 15 * 512 + c; const float* up = upool + (size_t)(NP + b * 4) * 512 + c;
            for (int t = 0; t < 4; ++t) { f32x4 sum = (f32x4){0.f, 0.f, 0.f, 0.f};
                for (int s = 0; s < w; ++s) { const int e = 15 + t - s; sum += e >= 15 ? *(const f32x4*)(up + (size_t)(e - 15) * 512) : *(const f32x4*)(sp + (size_t)e * 512); }
                const f32x4 uv = *(const f32x4*)(up + (size_t)t * 512); const f32x4 dv = sum * (1.0f / (float)w) - uv;
                u32x2 o; o.x = pk2(dv[0], dv[1]); o.y = pk2(dv[2], dv[3]); *(u32x2*)(dbuf + (size_t)(NP + b * 4 + t) * 512 + c) = o; }
            for (int r = 0; r < 15; ++r) { const f32x4 v = r < 11 ? *(const f32x4*)(sp + (size_t)(r + 4) * 512) : *(const f32x4*)(up + (size_t)(r - 11) * 512);
                *(f32x4*)(p.out + O_POOLS + ((size_t)b * 15 + r) * 512 + c) = v; } }
    }
    PHASE_END(2)

    PHASE_BEGIN(3)
    {
        { const bool act = bx < 128; const int b = (bx >> 5) & 3, g = bx & 31;
          LAS float* ex = (LAS float*)lds;
          float c_r = 1.f, c_i = 0.f, hr = 0.f, hi = 0.f;
          const float* Sp = Sbuf + ((size_t)g * 2048 + b * 512 + wave * 64) * 128 + lane; bf16_t* Hp = Ap + ((size_t)g * 2048 + b * 512 + wave * 64) * 384 + lane;
          if (act) {
            const float dt = __expf(p.in[12][g]); const float zr = p.in[10][g * 64 + lane] * dt * 16.f, zi = p.in[11][g * 64 + lane] * dt * 16.f;
            float sn, cs; sincos_acc(zi, sn, cs); const float mag = __expf(zr); c_r = mag * cs; c_i = mag * sn;
            for (int c0 = 0; c0 < 64; c0 += 16) { float sr[16], si[16];
#pragma unroll
                for (int k = 0; k < 16; ++k) { sr[k] = Sp[(size_t)(c0 + k) * 128]; si[k] = Sp[(size_t)(c0 + k) * 128 + 64]; }
#pragma unroll
                for (int k = 0; k < 16; ++k) { const float n_r = c_r * hr - c_i * hi + sr[k], n_i = c_r * hi + c_i * hr + si[k]; hr = n_r; hi = n_i; } }
            ex[(wave * 64 + lane) * 2] = hr; ex[(wave * 64 + lane) * 2 + 1] = hi;
          }
          __syncthreads();
          if (act) {
            float l_r = c_r, l_i = c_i;
#pragma unroll
            for (int e = 0; e < 6; ++e) { const float t_r = l_r * l_r - l_i * l_i, t_i = 2.f * l_r * l_i; l_r = t_r; l_i = t_i; }
            hr = 0.f; hi = 0.f;
            for (int sg = 0; sg < wave; ++sg) { const float e_r = ex[(sg * 64 + lane) * 2], e_i = ex[(sg * 64 + lane) * 2 + 1];
                const float n_r = l_r * hr - l_i * hi + e_r, n_i = l_r * hi + l_i * hr + e_i; hr = n_r; hi = n_i; }
            for (int c0 = 0; c0 < 64; c0 += 16) { float sr[16], si[16];
#pragma unroll
                for (int k = 0; k < 16; ++k) { sr[k] = Sp[(size_t)(c0 + k) * 128]; si[k] = Sp[(size_t)(c0 + k) * 128 + 64]; }
#pragma unroll
                for (int k = 0; k < 16; ++k) { const unsigned w = pk2(hr, hi); Hp[(size_t)(c0 + k) * 384] = (bf16_t)(w & 0xffffu); Hp[(size_t)(c0 + k) * 384 + 64] = (bf16_t)(w >> 16);
                    const float n_r = c_r * hr - c_i * hi + sr[k], n_i = c_r * hi + c_i * hr + si[k]; hr = n_r; hi = n_i; } }
            if (wave == 7) { float* o = p.out + O_S5P + (((size_t)b * 32 + g) * 64 + lane) * 2; o[0] = hr; o[1] = hi; }
          }
        }
        __syncthreads();
        { UStd<EpiPool> U{dbuf, w_pool_t, (size_t)256 * 512, (size_t)256 * 256, 256, 128, 2, G, bx, EpiPool{ycat, p.in[9], 0, 0}};
          gemm_phase(lds, wave, 512, 256, 256, U); }
        { EpiPool E{ycat, p.in[9], 0, 0}; mini_gemm(dbuf, 512, w_pool_t, 256, 256, 512, 256, E, bx, G, wave, lane); }
    }
    PHASE_END(3)

    PHASE_BEGIN(4)
    { US5<EpiS2> U{Ap, Bt2, (size_t)98304, G, bx, EpiS2{zbuf, Ap, p.in[17], 0, 0}};
      gemm_phase(lds, wave, 384, 384, 384, U); }
    PHASE_END(4)

    PHASE_BEGIN(5)
    { UStd<EpiGlu> U{zbuf, w_glu_t, (size_t)256 * 512, (size_t)256 * 512, 0, 128, 2, G, bx, EpiGlu{ycat, zbuf, p.in[19], 0, 0}};
      gemm_phase(lds, wave, 512, 512, 512, U);
      { EpiGlu E{ycat, zbuf, p.in[19], 0, 0}; mini_gemm(zbuf, 512, w_glu_t, 512, 512, 512, 0, E, bx, G, wave, lane); } }
    PHASE_END(5)

    layer_tail<0>(p, lds, grid, xbar, bx, G, gw, NGW, wave);
            PHASE_BEGIN(11)
            { UStd<EpiQKV> U{xn, w_qkv_t, (size_t)256 * DM, (size_t)256 * DM, 0, 128, 12, G, bx, EpiQKV{Qb, p.out, 0, 0}};
              gemm_phase(lds, wave, DM, DM, DM, U);
              { EpiQKV E{Qb, p.out, 0, 0}; mini_gemm(xn, DM, w_qkv_t, DM, DM, 3072, 0, E, bx, G, wave, lane); } }
            PHASE_END(11)
            PHASE_BEGIN(12)
            {
                attn_prompt_phase(Qb, Kb, Vb, Op, lse, lds, bx, G, wave, lane);
            }
            PHASE_END(12)
            PHASE_BEGIN(13)
            {
              for (int pass = 0; pass < 2; ++pass) { const bool do_sample = (pass == 0) == ((wave & 1) == 0);
              if (do_sample) { for (int u = gw; u < 2048; u += NGW) attn_sample_unit(p, u, Qb, Kb, Vb, att, (LAS float*)(lds + wave * 8192), lane); }
              else for (int it = gt; it < NP * 128; it += NGT) { const int c8 = it & 127, row = it >> 7, h = c8 >> 3;
                const float l0 = lse[(size_t)row * 16 + h], l1 = lse[((size_t)MT + row) * 16 + h], l2 = lse[((size_t)2 * MT + row) * 16 + h];
                const float mx = fmaxf(l0, fmaxf(l1, l2)); float w0 = __builtin_amdgcn_exp2f(l0 - mx), w1 = __builtin_amdgcn_exp2f(l1 - mx), w2 = __builtin_amdgcn_exp2f(l2 - mx); const float inv = 1.f / (w0 + w1 + w2); w0 *= inv; w1 *= inv; w2 *= inv;
                const u32x4 a = *(const u32x4*)(Op + (size_t)row * 1024 + c8 * 8), b = *(const u32x4*)(Op + ((size_t)MT + row) * 1024 + c8 * 8), c = *(const u32x4*)(Op + ((size_t)2 * MT + row) * 1024 + c8 * 8);
                u32x4 o;
                o.x = pk2(w0 * bflo(a.x) + w1 * bflo(b.x) + w2 * bflo(c.x), w0 * bfhi(a.x) + w1 * bfhi(b.x) + w2 * bfhi(c.x));
                o.y = pk2(w0 * bflo(a.y) + w1 * bflo(b.y) + w2 * bflo(c.y), w0 * bfhi(a.y) + w1 * bfhi(b.y) + w2 * bfhi(c.y));
                o.z = pk2(w0 * bflo(a.z) + w1 * bflo(b.z) + w2 * bflo(c.z), w0 * bfhi(a.z) + w1 * bfhi(b.z) + w2 * bfhi(c.z));
                o.w = pk2(w0 * bflo(a.w) + w1 * bflo(b.w) + w2 * bflo(c.w), w0 * bfhi(a.w) + w1 * bfhi(b.w) + w2 * bfhi(c.w));
                *(u32x4*)(att + (size_t)row * 1024 + c8 * 8) = o; } } }
            PHASE_END(13)
            layer_tail<1>(p, lds, grid, xbar, bx, G, gw, NGW, wave);
}

constexpr int NPHASES = 19;

extern "C" void kernel_launch(void* const* d_in, const int* in_sizes, int n_in, void* d_out, int out_size, void* d_ws, size_t ws_size, hipStream_t stream) {
    static int grid = 0;
    if (grid == 0) {
        int dev = 0, cus = 0, per_cu = 0;
        hipGetDevice(&dev);
        hipDeviceGetAttribute(&cus, hipDeviceAttributeMultiprocessorCount, dev);
        hipFuncSetAttribute((const void*)mega, hipFuncAttributeMaxDynamicSharedMemorySize, LDS_BYTES);
        hipOccupancyMaxActiveBlocksPerMultiprocessor(&per_cu, (const void*)mega, 512, LDS_BYTES);
        if (per_cu < 1) per_cu = 1;
        grid = cus * 1;
        if (ws_size < WS_END) fprintf(stderr, "kernel_launch: workspace too small: %zu < %zu\n", ws_size, (size_t)WS_END);
        fprintf(stderr, "kernel_launch: cus %d per_cu %d grid %d n_in %d out %d ws %zu\n", cus, per_cu, grid, n_in, out_size, ws_size);
    }
    Params p{};
    for (int i = 0; i < 26; ++i) p.in[i] = (const float*)d_in[i];
    p.out = (float*)d_out; p.ws = (unsigned char*)d_ws; p.ph_lo = 0; p.ph_hi = NPHASES;
    void* args[] = {&p};
    hipError_t e = hipLaunchCooperativeKernel((const void*)mega, dim3(grid), dim3(512), args, LDS_BYTES, stream);
    if (e != hipSuccess) fprintf(stderr, "cooperative launch failed: %s (grid %d)\n", hipGetErrorString(e), grid);
}
```

```cpp
#include <hip/hip_runtime.h>
#include <hip/hip_cooperative_groups.h>
#include <cstdio>
#include <cstdint>
namespace cg = cooperative_groups;

#define LAS __attribute__((address_space(3)))
#define DI __device__ __forceinline__
typedef unsigned short bf16_t;
typedef short bf16x8 __attribute__((ext_vector_type(8)));
typedef short s16x4 __attribute__((ext_vector_type(4)));
typedef float f32x4 __attribute__((ext_vector_type(4)));
typedef unsigned u32x4 __attribute__((ext_vector_type(4)));
typedef unsigned u32x2 __attribute__((ext_vector_type(2)));
typedef __bf16 bf2_t __attribute__((ext_vector_type(2)));

constexpr int NP = 32768, NS = 128, NT = NP + NS, MT = 33024, DM = 1024, FF = 2816, TP = 8192;
constexpr float EPS = 1e-6f;
constexpr int LDS_BYTES = 157696 + 256;
constexpr size_t O_YP = 0, O_YS = 33554432, O_POOLP = 33685504, O_S5P = 33716224, O_KP = 33732608, O_VP = 42121216,
                 O_POOLS = 50509824, O_S5S = 50755584, O_KS = 50886656, O_VS = 51017728;
constexpr size_t MiB = 1u << 20;
constexpr size_t WS_WIN = 0, WS_WOUT = 2 * MiB, WS_WGLU = 4 * MiB, WS_WPOOL = 4 * MiB + 512 * 1024, WS_WO = 5 * MiB, WS_WQKV = 7 * MiB,
                 WS_GU0 = 13 * MiB, WS_GU1 = 24 * MiB, WS_DN0 = 35 * MiB, WS_DN1 = 41 * MiB, WS_BT1 = 47 * MiB, WS_BT2 = 51 * MiB,
                 WS_ROWSS = 57 * MiB, WS_USS = 60 * MiB, WS_LSE = 61 * MiB, WS_XN = 68 * MiB, WS_Y = 133 * MiB, WS_H = 198 * MiB,
                 WS_X = 328 * MiB;
constexpr size_t WS_AP = WS_X, WS_S = WS_X + 48 * MiB, WS_UPOOL = WS_X + 80 * MiB, WS_D = WS_X + 145 * MiB, WS_Z = WS_X + 178 * MiB,
                 WS_YCAT = WS_X + 211 * MiB;
constexpr size_t WS_HACT = WS_X;
constexpr size_t WS_Q = WS_X, WS_K = WS_X + 65 * MiB, WS_V = WS_X + 130 * MiB, WS_OP = WS_X + 195 * MiB, WS_ATT = WS_X + 389 * MiB;
constexpr size_t WS_END = WS_X + 454 * MiB;
constexpr size_t WS_CTL = 60 * MiB + 512 * 1024;

struct Params { const float* in[26]; float* out; unsigned char* ws; int ph_lo, ph_hi; };

DI unsigned pk2(float lo, float hi) { bf2_t v; v.x = (__bf16)lo; v.y = (__bf16)hi; return __builtin_bit_cast(unsigned, v); }
DI float bflo(unsigned w) { return __uint_as_float(w << 16); }
DI float bfhi(unsigned w) { return __uint_as_float(w & 0xffff0000u); }
DI float bf2f(bf16_t b) { return __uint_as_float((unsigned)b << 16); }
DI float wave_sum(float v) {
#pragma unroll
    for (int o = 1; o < 64; o <<= 1) v += __shfl_xor(v, o);
    return v;
}
DI float wave_max(float v) {
#pragma unroll
    for (int o = 1; o < 64; o <<= 1) v = fmaxf(v, __shfl_xor(v, o));
    return v;
}
DI float sigmoidf_(float x) { return __builtin_amdgcn_rcpf(1.0f + __builtin_amdgcn_exp2f(-1.4426950408889634f * x)); }
DI float gelu_tanh(float y) { const float u = 0.7978845608028654f * (y + 0.044715f * y * y * y); return y * __builtin_amdgcn_rcpf(1.0f + __builtin_amdgcn_exp2f(-2.0f * 1.4426950408889634f * u)); }
DI void sincos_acc(float a, float& s, float& c) {
    if (fabsf(a) < 0.5f) {
        const float a2 = a * a;
        s = a * (1.f - a2 * (1.f / 6.f) * (1.f - a2 * (1.f / 20.f) * (1.f - a2 * (1.f / 42.f))));
        c = 1.f - a2 * 0.5f * (1.f - a2 * (1.f / 12.f) * (1.f - a2 * (1.f / 30.f) * (1.f - a2 * (1.f / 56.f))));
    } else {
        float r = a * 0.15915494309189535f; r -= floorf(r);
        s = __builtin_amdgcn_sinf(r); c = __builtin_amdgcn_cosf(r);
    }
}
DI int lane_id() { int l; asm volatile("v_mbcnt_lo_u32_b32 %0, -1, 0\n\tv_mbcnt_hi_u32_b32 %0, -1, %0" : "=v"(l)); return l; }
#define LDS_WAIT() asm volatile("s_waitcnt lgkmcnt(0)" ::: "memory")
#define VM_WAIT() asm volatile("s_waitcnt vmcnt(0)" ::: "memory")

constexpr int BM = 256, BK = 64, HALF = 128, NXCD = 8, WGM = 8;
typedef f32x4 Acc[2][2][4][2];
DI int lds_byte(int r, int c) { const int st = (r >> 4) * 2 + (c >> 5), rr = r & 15, cc = c & 31, ob = rr * 64 + cc * 2; return st * 1024 + (ob ^ (((ob >> 9) & 1) << 5)); }
DI void stage_rc(int b, int& R, int& C) { const int st = b / 1024, sb = b % 1024, swz = sb ^ (((sb >> 9) & 1) << 5); R = (st >> 1) * 16 + swz / 64; C = (st & 1) * 32 + (swz % 64) / 2; }

DI bool unit_next(int i, int G, int c, int nM, int nN, int& pm, int& pn) {
    const int nwg = nM * nN; const long L = (long)i * G + c; if (L >= nwg) return false;
    int wgid = (int)L; { const int q = nwg / NXCD, r = nwg % NXCD, xcd = wgid % NXCD, off = wgid / NXCD; wgid = (xcd < r ? xcd * (q + 1) : r * (q + 1) + (xcd - r) * q) + off; }
    const int nig = WGM * nN, gid = wgid / nig, fm = gid * WGM, gsz = (nM - fm) < WGM ? (nM - fm) : WGM;
    pm = fm + ((wgid % nig) % gsz); pn = (wgid % nig) / gsz; return true;
}

template <class Units>
DI void gemm_phase(LAS unsigned char* lds, const int wid, const int lda, const int ldb, const int K, const Units& U) {
    typedef typename Units::Epi Epi;
    const int lane = lane_id(), tid = wid * 64 + lane, wr = wid >> 2, wc = wid & 3, fr = lane & 15, fq = lane >> 4;
    unsigned offA, offB;
    { int R, C; stage_rc(tid * 16, R, C); offA = (unsigned)(R * lda + C) * 2u;
      const int rho = R & 31, Rb = (R & ~31) + 8 * ((rho & 15) >> 2) + 4 * (rho >> 4) + (rho & 3);
      offB = (unsigned)(Rb * ldb + C) * 2u; }
    const unsigned ldsw = (unsigned)wid * 1024u;
    const unsigned hA = (unsigned)(HALF * lda * 2), hB = (unsigned)(HALF * ldb * 2), dA = (unsigned)(64 * lda * 2), dB = (unsigned)(64 * ldb * 2);
    const int aoff = lds_byte(wr * 64 + fr, fq * 8), boff = lds_byte(wc * 32 + fr, fq * 8);
#define SA(b, h) (((b) * 2 + (h)) * 16384)
#define SB(b, h) ((4 + (b) * 2 + (h)) * 16384)
#define STG(bufoff, gbase, soff, voff, dlt) do { _Pragma("unroll") for (int _i = 0; _i < 2; ++_i) { unsigned _vo = (voff); asm volatile("" : "+v"(_vo)); _vo += (unsigned)(soff) + (unsigned)_i * (dlt); \
        __builtin_amdgcn_global_load_lds((const unsigned*)((gbase) + _vo), (LAS unsigned*)(lds + (bufoff) + ldsw + _i * 8192), 16, 0, 0); } } while (0)
#define STA(b, h, base, kt) STG(SA(b, h), base, (h) * hA + (unsigned)(kt) * 128u, offA, dA)
#define STB(b, h, base, kt) STG(SB(b, h), base, (h) * hB + (unsigned)(kt) * 128u, offB, dB)
#define LDA(dst, b, h) do { _Pragma("unroll") for (int m = 0; m < 4; ++m) _Pragma("unroll") for (int k = 0; k < 2; ++k) dst[m][k] = *(const LAS bf16x8*)(lds + SA(b, h) + aoff + m * 2048 + k * 1024); } while (0)
#define LDB(dst, b, h) do { _Pragma("unroll") for (int n = 0; n < 2; ++n) _Pragma("unroll") for (int k = 0; k < 2; ++k) dst[n][k] = *(const LAS bf16x8*)(lds + SB(b, h) + boff + n * 2048 + k * 1024); } while (0)
#define MMA(ai, bj, Af, Bf) do { __builtin_amdgcn_s_setprio(1); _Pragma("unroll") for (int m = 0; m < 4; ++m) _Pragma("unroll") for (int n = 0; n < 2; ++n) _Pragma("unroll") for (int k = 0; k < 2; ++k) \
        acc[ai][bj][m][n] = __builtin_amdgcn_mfma_f32_16x16x32_bf16(Bf[n][k], Af[m][k], acc[ai][bj][m][n], 0, 0, 0); __builtin_amdgcn_s_setprio(0); } while (0)
#define WAIT_V(n) asm volatile("s_waitcnt vmcnt(" #n ")" ::: "memory")
#define WAIT_L(n) asm volatile("s_waitcnt lgkmcnt(" #n ")" ::: "memory")
#define BAR __builtin_amdgcn_s_barrier()
#define SCHED __builtin_amdgcn_sched_barrier(0)
#define ZERO_ACC() do { _Pragma("unroll") for (int a = 0; a < 2; ++a) _Pragma("unroll") for (int b = 0; b < 2; ++b) _Pragma("unroll") for (int m = 0; m < 4; ++m) _Pragma("unroll") for (int n = 0; n < 2; ++n) acc[a][b][m][n] = (f32x4){0.f, 0.f, 0.f, 0.f}; } while (0)
    const bf16_t* pa; const bf16_t* pb; Epi Ecur, Enxt;
    if (!U.get(0, pa, pb, Ecur)) return;
    const char* cA = (const char*)pa; const char* cB = (const char*)pb;
    Acc acc; ZERO_ACC();
    bf16x8 At[4][2], B0[2][2], B1[2][2];
    const int nt = K / BK;
    STB(0, 0, cB, 0); STB(0, 1, cB, 0); STA(0, 0, cA, 0); STA(0, 1, cA, 0);
    if (wr == 1) BAR;
    WAIT_V(2); BAR;
    STB(1, 0, cB, 1); STA(1, 0, cA, 1); STB(1, 1, cB, 1);
    WAIT_V(6); BAR;
    for (int ui = 0;; ++ui) {
        const bool has_next = U.get(ui + 1, pa, pb, Enxt);
        const char* nA = has_next ? (const char*)pa : cA; const char* nB = has_next ? (const char*)pb : cB;
        for (int t = 0; t < nt; t += 2) {
            const bool last = (t == nt - 2);
            const char* a2 = last ? nA : cA; const char* b2 = last ? nB : cB; const int k2 = last ? 0 : t + 2, k3 = k2 + 1;
            LDB(B0, 0, 0); LDB(B1, 0, 1); SCHED; LDA(At, 0, 0); STA(1, 1, cA, t + 1);
            WAIT_V(8); WAIT_L(0); BAR; MMA(0, 0, At, B0); MMA(0, 1, At, B1); BAR; SCHED;
            LDA(At, 0, 1); STB(0, 0, b2, k2); STB(0, 1, b2, k2); STA(0, 0, a2, k2);
            WAIT_V(8); WAIT_L(0); BAR; MMA(1, 0, At, B0); MMA(1, 1, At, B1); BAR; SCHED;
            LDB(B0, 1, 0); LDB(B1, 1, 1); SCHED; LDA(At, 1, 0); STA(0, 1, a2, k2);
            WAIT_V(8); WAIT_L(0); BAR; MMA(0, 0, At, B0); MMA(0, 1, At, B1); BAR; SCHED;
            LDA(At, 1, 1); STB(1, 0, b2, k3); STB(1, 1, b2, k3); STA(1, 0, a2, k3);
            WAIT_V(8); WAIT_L(0); BAR; MMA(1, 0, At, B0); MMA(1, 1, At, B1); BAR; SCHED;
        }
        if (wr == 0) BAR;
        Ecur(acc, wr, wc, fr, fq);
        if (!has_next) break;
        ZERO_ACC();
        cA = nA; cB = nB; Ecur = Enxt;
        if (wr == 1) BAR;
    }
    WAIT_V(0);
    BAR;
#undef ZERO_ACC
#undef SA
#undef SB
#undef STG
#undef STA
#undef STB
#undef LDA
#undef LDB
#undef MMA
#undef WAIT_V
#undef WAIT_L
#undef BAR
#undef SCHED
}

#define EPI_ROWS(...) _Pragma("unroll") for (int ai = 0; ai < 2; ++ai) _Pragma("unroll") for (int m = 0; m < 4; ++m) { const int rr = ai * 128 + wr * 64 + m * 16 + fr; __VA_ARGS__ }
#define EPI_COLS8(...) _Pragma("unroll") for (int bj = 0; bj < 2; ++bj) { const int cc = bj * 128 + wc * 32 + 8 * fq; const f32x4 v0 = acc[ai][bj][m][0], v1 = acc[ai][bj][m][1]; __VA_ARGS__ }
#define EPI_COLS(...) _Pragma("unroll") for (int bj = 0; bj < 2; ++bj) _Pragma("unroll") for (int n = 0; n < 2; ++n) { const int cc = bj * 128 + wc * 32 + 8 * fq + 4 * n; const f32x4 v = acc[ai][bj][m][n]; __VA_ARGS__ }

struct EpiProj {
    float* upool; bf16_t* Ap; float* uss; int row0, col0;
    DI void set(int pm, int pn) { row0 = pm * 256; col0 = pn * 256; }
    DI void elem(int row, int col, const f32x4 v) const {
        if (col < 512) *(f32x4*)(upool + (size_t)row * 512 + col) = v; else *(f32x4*)(uss + (size_t)(row - NP) * 512 + (col - 512)) = v; }
    DI void operator()(const Acc& acc, int wr, int wc, int fr, int fq) const {
        if (col0 < 512) {
            EPI_ROWS(const size_t row = row0 + rr; EPI_COLS(*(f32x4*)(upool + row * 512 + col0 + cc) = v;))
        } else {
            EPI_ROWS(const int row = row0 + rr;
                EPI_COLS8(const int c2 = col0 - 512 + cc; const int g = c2 >> 4, i = c2 & 15;
                    if (row < NP) { u32x4 w; w.x = pk2(v0[0], v0[1]); w.y = pk2(v0[2], v0[3]); w.z = pk2(v1[0], v1[1]); w.w = pk2(v1[2], v1[3]);
                        *(u32x4*)(Ap + ((size_t)g * 2048 + (row >> 4)) * 384 + 128 + (row & 15) * 16 + i) = w; }
                    else if (row < NT) { *(f32x4*)(uss + (size_t)(row - NP) * 512 + c2) = v0; *(f32x4*)(uss + (size_t)(row - NP) * 512 + c2 + 4) = v1; }))
        }
    }
};
struct EpiS1 {
    float* S; int g, row0;
    DI void set(int mt, int gg) { row0 = mt * 256; g = gg; }
    DI void operator()(const Acc& acc, int wr, int wc, int fr, int fq) const {
        EPI_ROWS(const size_t row = (size_t)g * 2048 + row0 + rr;
            _Pragma("unroll") for (int n = 0; n < 2; ++n) { const int cc = wc * 32 + 8 * fq + 4 * n; *(f32x4*)(S + row * 128 + cc) = acc[ai][0][m][n]; })
    }
};
struct EpiPool {
    bf16_t* ycat; const float* scale; int row0, col0;
    DI void set(int pm, int pn) { row0 = pm * 256; col0 = pn * 256; }
    DI void elem(int row, int col, const f32x4 v) const { const f32x4 s = *(const f32x4*)(scale + col); u32x2 w; w.x = pk2(v[0] * s[0], v[1] * s[1]); w.y = pk2(v[2] * s[2], v[3] * s[3]);
        *(u32x2*)(ycat + (size_t)row * 1024 + col) = w; }
    DI void operator()(const Acc& acc, int wr, int wc, int fr, int fq) const {
        EPI_ROWS(const size_t row = row0 + rr;
            EPI_COLS8(const int col = col0 + cc; const f32x4 s0 = *(const f32x4*)(scale + col), s1 = *(const f32x4*)(scale + col + 4); u32x4 w;
                w.x = pk2(v0[0] * s0[0], v0[1] * s0[1]); w.y = pk2(v0[2] * s0[2], v0[3] * s0[3]); w.z = pk2(v1[0] * s1[0], v1[1] * s1[1]); w.w = pk2(v1[2] * s1[2], v1[3] * s1[3]);
                *(u32x4*)(ycat + row * 1024 + col) = w;))
    }
};
struct EpiS2 {
    bf16_t* z; const bf16_t* Ap; const float* dskip; int g, row0;
    DI void set(int mt, int gg) { row0 = mt * 256; g = gg; }
    DI void operator()(const Acc& acc, int wr, int wc, int fr, int fq) const {
        EPI_ROWS(const int chunk = row0 + rr; const bf16_t* ap = Ap + ((size_t)g * 2048 + chunk) * 384 + 128;
            EPI_COLS8(const int r = cc >> 4, i = cc & 15; const u32x4 uw = *(const u32x4*)(ap + cc); const f32x4 d0 = *(const f32x4*)(dskip + g * 16 + i), d1 = *(const f32x4*)(dskip + g * 16 + i + 4);
                const float y0 = v0[0] + d0[0] * bflo(uw.x), y1 = v0[1] + d0[1] * bfhi(uw.x), y2 = v0[2] + d0[2] * bflo(uw.y), y3 = v0[3] + d0[3] * bfhi(uw.y);
                const float y4 = v1[0] + d1[0] * bflo(uw.z), y5 = v1[1] + d1[1] * bfhi(uw.z), y6 = v1[2] + d1[2] * bflo(uw.w), y7 = v1[3] + d1[3] * bfhi(uw.w);
                u32x4 w; w.x = pk2(gelu_tanh(y0), gelu_tanh(y1)); w.y = pk2(gelu_tanh(y2), gelu_tanh(y3)); w.z = pk2(gelu_tanh(y4), gelu_tanh(y5)); w.w = pk2(gelu_tanh(y6), gelu_tanh(y7));
                *(u32x4*)(z + ((size_t)chunk * 16 + r) * 512 + g * 16 + i) = w;))
    }
};
struct EpiGlu {
    bf16_t* ycat; const bf16_t* z; const float* bglu; int row0, col0;
    DI void set(int pm, int pn) { row0 = pm * 256; col0 = pn * 256; }
    DI void elem(int row, int col, const f32x4 v) const { const u32x2 zw = *(const u32x2*)(z + (size_t)row * 512 + col); const f32x4 b = *(const f32x4*)(bglu + col);
        u32x2 w; w.x = pk2(bflo(zw.x) * sigmoidf_(v[0] + b[0]), bfhi(zw.x) * sigmoidf_(v[1] + b[1])); w.y = pk2(bflo(zw.y) * sigmoidf_(v[2] + b[2]), bfhi(zw.y) * sigmoidf_(v[3] + b[3]));
        *(u32x2*)(ycat + (size_t)row * 1024 + 512 + col) = w; }
    DI void operator()(const Acc& acc, int wr, int wc, int fr, int fq) const {
        EPI_ROWS(const size_t row = row0 + rr;
            EPI_COLS8(const int col = col0 + cc; const u32x4 zw = *(const u32x4*)(z + row * 512 + col); const f32x4 b0 = *(const f32x4*)(bglu + col), b1 = *(const f32x4*)(bglu + col + 4);
                u32x4 w; w.x = pk2(bflo(zw.x) * sigmoidf_(v0[0] + b0[0]), bfhi(zw.x) * sigmoidf_(v0[1] + b0[1]));
                w.y = pk2(bflo(zw.y) * sigmoidf_(v0[2] + b0[2]), bfhi(zw.y) * sigmoidf_(v0[3] + b0[3]));
                w.z = pk2(bflo(zw.z) * sigmoidf_(v1[0] + b1[0]), bfhi(zw.z) * sigmoidf_(v1[1] + b1[1]));
                w.w = pk2(bflo(zw.w) * sigmoidf_(v1[2] + b1[2]), bfhi(zw.w) * sigmoidf_(v1[3] + b1[3]));
                *(u32x4*)(ycat + row * 1024 + 512 + col) = w;))
    }
};
struct EpiY {
    bf16_t* y; int row0, col0;
    DI void set(int pm, int pn) { row0 = pm * 256; col0 = pn * 256; }
    DI void elem(int row, int col, const f32x4 v) const { u32x2 w; w.x = pk2(v[0], v[1]); w.y = pk2(v[2], v[3]); *(u32x2*)(y + (size_t)row * 1024 + col) = w; }
    DI void operator()(const Acc& acc, int wr, int wc, int fr, int fq) const {
        EPI_ROWS(const size_t row = row0 + rr;
            _Pragma("unroll") for (int bj = 0; bj < 2; ++bj) { const int cc = bj * 128 + wc * 32 + 8 * fq; const f32x4 v0 = acc[ai][bj][m][0], v1 = acc[ai][bj][m][1];
                u32x4 w; w.x = pk2(v0[0], v0[1]); w.y = pk2(v0[2], v0[3]); w.z = pk2(v1[0], v1[1]); w.w = pk2(v1[2], v1[3]); *(u32x4*)(y + row * 1024 + col0 + cc) = w; })
    }
};
struct EpiGU {
    bf16_t* hact; int row0, hb;
    DI void set(int pm, int pn) { row0 = pm * 256; hb = pn; }
    DI void elem2(int row, int col, const f32x4 a, const f32x4 u) const { u32x2 w; w.x = pk2(a[0] * sigmoidf_(a[0]) * u[0], a[1] * sigmoidf_(a[1]) * u[1]); w.y = pk2(a[2] * sigmoidf_(a[2]) * u[2], a[3] * sigmoidf_(a[3]) * u[3]);
        *(u32x2*)(hact + (size_t)row * FF + col) = w; }
    DI void operator()(const Acc& acc, int wr, int wc, int fr, int fq) const {
        EPI_ROWS(const size_t row = row0 + rr; const int cc = wc * 32 + 8 * fq; u32x4 w;
            { const f32x4 a = acc[ai][0][m][0], u = acc[ai][1][m][0]; w.x = pk2(a[0] * sigmoidf_(a[0]) * u[0], a[1] * sigmoidf_(a[1]) * u[1]); w.y = pk2(a[2] * sigmoidf_(a[2]) * u[2], a[3] * sigmoidf_(a[3]) * u[3]); }
            { const f32x4 a = acc[ai][0][m][1], u = acc[ai][1][m][1]; w.z = pk2(a[0] * sigmoidf_(a[0]) * u[0], a[1] * sigmoidf_(a[1]) * u[1]); w.w = pk2(a[2] * sigmoidf_(a[2]) * u[2], a[3] * sigmoidf_(a[3]) * u[3]); }
            *(u32x4*)(hact + row * FF + hb * 128 + cc) = w;)
    }
};
struct EpiQKV {
    bf16_t* qkv; float* out; int row0, col0;
    DI void set(int pm, int pn) { row0 = pm * 256; col0 = pn * 256; }
    DI void elem(int row, int colg, const f32x4 v) const {
        const int which = colg >> 10, col = colg & 1023; const float sc = which == 0 ? 0.125f * 1.4426950408889634f : 1.0f;
        u32x2 w; w.x = pk2(v[0] * sc, v[1] * sc); w.y = pk2(v[2] * sc, v[3] * sc);
        *(u32x2*)(qkv + (size_t)which * (65 * MiB / 2) + (size_t)row * 1024 + col) = w;
        if (which != 0) *(f32x4*)(out + (which == 1 ? O_KS : O_VS) + (size_t)(row - NP) * 1024 + col) = v; }
    DI void operator()(const Acc& acc, int wr, int wc, int fr, int fq) const {
        const int which = col0 >> 10; const int cb = col0 & 1023; const float sc = which == 0 ? 0.125f * 1.4426950408889634f : 1.0f;
        bf16_t* dst = qkv + (size_t)which * (65 * MiB / 2);
        float* op = out + (which == 1 ? O_KP : O_VP); float* os = out + (which == 1 ? O_KS : O_VS);
        EPI_ROWS(const int row = row0 + rr;
            EPI_COLS8(const int col = cb + cc; u32x4 w; w.x = pk2(v0[0] * sc, v0[1] * sc); w.y = pk2(v0[2] * sc, v0[3] * sc); w.z = pk2(v1[0] * sc, v1[1] * sc); w.w = pk2(v1[2] * sc, v1[3] * sc);
                *(u32x4*)(dst + (size_t)row * 1024 + col) = w;
                if (which != 0) {
                    if (row < NP) { const int tb = row & (TP - 1); if (tb >= TP - 2048) { float* o = op + ((size_t)(row >> 13) * 2048 + (tb - (TP - 2048))) * 1024 + col; *(f32x4*)o = v0; *(f32x4*)(o + 4) = v1; } }
                    else if (row < NT) { float* o = os + (size_t)(row - NP) * 1024 + col; *(f32x4*)o = v0; *(f32x4*)(o + 4) = v1; }
                }))
    }
};


template <class EpiT> struct UStd {
    typedef EpiT Epi; const bf16_t* A; const bf16_t* Bt; size_t astep, bstep; int acolstep, nM, nN, G, c; EpiT proto;
    DI bool get(int i, const bf16_t*& a, const bf16_t*& b, EpiT& e) const { int pm, pn; if (!unit_next(i, G, c, nM, nN, pm, pn)) return false;
        a = A + (size_t)pm * astep + (size_t)pn * acolstep; b = Bt + (size_t)pn * bstep; e = proto; e.set(pm, pn); return true; }
};
template <class EpiT> struct US5 {
    typedef EpiT Epi; const bf16_t* A; const bf16_t* Bt; size_t bstep; int G, c; EpiT proto;
    DI bool get(int i, const bf16_t*& a, const bf16_t*& b, EpiT& e) const { const int L = c + i * G; if (L >= 256) return false; const int g = L >> 3, mt = L & 7;
        a = A + ((size_t)g * 2048 + mt * 256) * 384; b = Bt + (size_t)g * bstep; e = proto; e.set(mt, g); return true; }
};

DI f32x4 mini_acc(const bf16_t* Arow, const bf16_t* Brow, int K) {
    f32x4 acc = (f32x4){0.f, 0.f, 0.f, 0.f};
    int k0 = 0;
    for (; k0 + 512 <= K; k0 += 512) { bf16x8 a[16], b[16];
#pragma unroll
        for (int e = 0; e < 16; ++e) { a[e] = *(const bf16x8*)(Arow + k0 + 32 * e); b[e] = *(const bf16x8*)(Brow + k0 + 32 * e); }
#pragma unroll
        for (int e = 0; e < 16; ++e) acc = __builtin_amdgcn_mfma_f32_16x16x32_bf16(b[e], a[e], acc, 0, 0, 0); }
    if (k0 < K) { bf16x8 a[8], b[8];
#pragma unroll
        for (int e = 0; e < 8; ++e) { a[e] = *(const bf16x8*)(Arow + k0 + 32 * e); b[e] = *(const bf16x8*)(Brow + k0 + 32 * e); }
#pragma unroll
        for (int e = 0; e < 8; ++e) acc = __builtin_amdgcn_mfma_f32_16x16x32_bf16(b[e], a[e], acc, 0, 0, 0); }
    return acc;
}
DI void mini_acc2(const bf16_t* Arow, const bf16_t* Bg, const bf16_t* Bu, int K, f32x4& ga, f32x4& ua) {
    ga = (f32x4){0.f, 0.f, 0.f, 0.f}; ua = ga;
    for (int k0 = 0; k0 < K; k0 += 256) { bf16x8 a[8], g[8], u[8];
#pragma unroll
        for (int e = 0; e < 8; ++e) { a[e] = *(const bf16x8*)(Arow + k0 + 32 * e); g[e] = *(const bf16x8*)(Bg + k0 + 32 * e); u[e] = *(const bf16x8*)(Bu + k0 + 32 * e); }
#pragma unroll
        for (int e = 0; e < 8; ++e) { ga = __builtin_amdgcn_mfma_f32_16x16x32_bf16(g[e], a[e], ga, 0, 0, 0); ua = __builtin_amdgcn_mfma_f32_16x16x32_bf16(u[e], a[e], ua, 0, 0, 0); } }
}
template <class Epi>
DI void mini_gemm(const bf16_t* A, int lda, const bf16_t* Bt, int ldb, int K, int N, int acol_per_256, const Epi& E, int bx, int G, int wave, int lane) {
    const int fr = lane & 15, fq = lane >> 4; const int row = NP + 16 * wave + fr;
    for (int q = bx; q < N / 16; q += G) {
        const bf16_t* Arow = A + (size_t)row * lda + ((16 * q) >> 8) * acol_per_256 + 8 * fq;
        const bf16_t* Brow = Bt + (size_t)(16 * q + fr) * ldb + 8 * fq;
        const f32x4 acc = mini_acc(Arow, Brow, K);
        E.elem(row, 16 * q + 4 * fq, acc); }
}
DI void mini_gemm_gu(const bf16_t* A, const bf16_t* Bt, const EpiGU& E, int bx, int G, int wave, int lane) {
    const int fr = lane & 15, fq = lane >> 4; const int row = NP + 16 * wave + fr;
    for (int q = bx; q < FF / 16; q += G) { const int hcol = 16 * q; const int brow = (hcol >> 7) * 256 + (hcol & 127) + fr;
        const bf16_t* Arow = A + (size_t)row * DM + 8 * fq;
        f32x4 ga, ua; mini_acc2(Arow, Bt + (size_t)brow * DM + 8 * fq, Bt + (size_t)(brow + 128) * DM + 8 * fq, DM, ga, ua);
        E.elem2(row, hcol + 4 * fq, ga, ua); }
}
DI void transpose_item(const float* W, int N, int k0, int n0, bf16_t* WT, int ldt, int orow0, int ocol0, LAS float* scr, int lane) {
#pragma unroll 16
    for (int i = 0; i < 32; ++i) { const int kk = 2 * i + (lane >> 5); scr[kk * 33 + (lane & 31)] = W[(size_t)(k0 + kk) * N + n0 + (lane & 31)]; }
    LDS_WAIT();
    const int c = lane & 7;
#pragma unroll
    for (int j = 0; j < 4; ++j) { const int n = (lane >> 3) + 8 * j; const LAS float* s = scr + (8 * c) * 33 + n;
        u32x4 o; o.x = pk2(s[0 * 33], s[1 * 33]); o.y = pk2(s[2 * 33], s[3 * 33]); o.z = pk2(s[4 * 33], s[5 * 33]); o.w = pk2(s[6 * 33], s[7 * 33]);
        *(u32x4*)(WT + (size_t)(orow0 + n) * ldt + ocol0 + 8 * c) = o; }
    LDS_WAIT();
}
DI void tr_plain(const float* W, int K, int N, bf16_t* WT, int item, LAS float* scr, int lane) {
    const int nblk = N / 32, kb = item / nblk, nb = item % nblk; transpose_item(W, N, 64 * kb, 32 * nb, WT, K, 32 * nb, 64 * kb, scr, lane);
}

DI const float* in_row(const Params& p, int r) { return r < NP ? p.in[0] + (size_t)r * DM : p.in[1] + (size_t)(r - NP) * DM; }

DI void norm_row(const float* xr, const float* g, bf16_t* o, int lane) {
    f32x4 v[4]; float s = 0.f;
#pragma unroll
    for (int j = 0; j < 4; ++j) { v[j] = *(const f32x4*)(xr + 4 * lane + 256 * j); s += (v[j][0] * v[j][0] + v[j][1] * v[j][1]) + (v[j][2] * v[j][2] + v[j][3] * v[j][3]); }
    const float r = rsqrtf(wave_sum(s) * (1.f / DM) + EPS);
#pragma unroll
    for (int j = 0; j < 4; ++j) { const f32x4 gg = *(const f32x4*)(g + 4 * lane + 256 * j); u32x2 w; w.x = pk2(v[j][0] * r * gg[0], v[j][1] * r * gg[1]); w.y = pk2(v[j][2] * r * gg[2], v[j][3] * r * gg[3]);
        *(u32x2*)(o + 4 * lane + 256 * j) = w; }
}
DI void norm_row2(const float* xa, const float* xb, const float* g, bf16_t* oa, bf16_t* ob, int lane) {
    f32x4 va[4], vb[4]; float sa = 0.f, sb = 0.f;
#pragma unroll
    for (int j = 0; j < 4; ++j) { va[j] = *(const f32x4*)(xa + 4 * lane + 256 * j); vb[j] = *(const f32x4*)(xb + 4 * lane + 256 * j); }
#pragma unroll
    for (int j = 0; j < 4; ++j) { sa += (va[j][0] * va[j][0] + va[j][1] * va[j][1]) + (va[j][2] * va[j][2] + va[j][3] * va[j][3]); sb += (vb[j][0] * vb[j][0] + vb[j][1] * vb[j][1]) + (vb[j][2] * vb[j][2] + vb[j][3] * vb[j][3]); }
    const float ra = rsqrtf(wave_sum(sa) * (1.f / DM) + EPS), rb = rsqrtf(wave_sum(sb) * (1.f / DM) + EPS);
#pragma unroll
    for (int j = 0; j < 4; ++j) { const f32x4 gg = *(const f32x4*)(g + 4 * lane + 256 * j); u32x2 w;
        w.x = pk2(va[j][0] * ra * gg[0], va[j][1] * ra * gg[1]); w.y = pk2(va[j][2] * ra * gg[2], va[j][3] * ra * gg[3]); *(u32x2*)(oa + 4 * lane + 256 * j) = w;
        w.x = pk2(vb[j][0] * rb * gg[0], vb[j][1] * rb * gg[1]); w.y = pk2(vb[j][2] * rb * gg[2], vb[j][3] * rb * gg[3]); *(u32x2*)(ob + 4 * lane + 256 * j) = w; }
}
template <bool INB, bool OUTB>
DI void res_row(const void* hin_, const bf16_t* y, const float* gpost, const float* gnext, void* hout_, bf16_t* xn, int lane) {
    u32x2 yw[4]; float ss = 0.f;
#pragma unroll
    for (int j = 0; j < 4; ++j) { yw[j] = *(const u32x2*)(y + 4 * lane + 256 * j); const float a = bflo(yw[j].x), b = bfhi(yw[j].x), c = bflo(yw[j].y), d = bfhi(yw[j].y); ss += (a * a + b * b) + (c * c + d * d); }
    const float r1 = rsqrtf(wave_sum(ss) * (1.f / DM) + EPS);
    f32x4 h[4]; float s2 = 0.f;
#pragma unroll
    for (int j = 0; j < 4; ++j) { const int c = 4 * lane + 256 * j; f32x4 hv;
        if (INB) { const u32x2 hw = *(const u32x2*)((const bf16_t*)hin_ + c); hv = (f32x4){bflo(hw.x), bfhi(hw.x), bflo(hw.y), bfhi(hw.y)}; } else hv = *(const f32x4*)((const float*)hin_ + c);
        const f32x4 gp = *(const f32x4*)(gpost + c);
        h[j][0] = hv[0] + bflo(yw[j].x) * r1 * gp[0]; h[j][1] = hv[1] + bfhi(yw[j].x) * r1 * gp[1]; h[j][2] = hv[2] + bflo(yw[j].y) * r1 * gp[2]; h[j][3] = hv[3] + bfhi(yw[j].y) * r1 * gp[3];
        if (OUTB) { u32x2 w; w.x = pk2(h[j][0], h[j][1]); w.y = pk2(h[j][2], h[j][3]); *(u32x2*)((bf16_t*)hout_ + c) = w;
            h[j] = (f32x4){bflo(w.x), bfhi(w.x), bflo(w.y), bfhi(w.y)}; }
        else *(f32x4*)((float*)hout_ + c) = h[j];
        s2 += (h[j][0] * h[j][0] + h[j][1] * h[j][1]) + (h[j][2] * h[j][2] + h[j][3] * h[j][3]); }
    if (xn) {
        const float r2 = rsqrtf(wave_sum(s2) * (1.f / DM) + EPS);
#pragma unroll
        for (int j = 0; j < 4; ++j) { const int c = 4 * lane + 256 * j; const f32x4 gn = *(const f32x4*)(gnext + c); u32x2 w; w.x = pk2(h[j][0] * r2 * gn[0], h[j][1] * r2 * gn[1]); w.y = pk2(h[j][2] * r2 * gn[2], h[j][3] * r2 * gn[3]);
            *(u32x2*)(xn + c) = w; }
    }
}

template <bool INB, bool OUTB, int R>
DI void res_rows(const void* const (&hin_)[R], const bf16_t* const (&y)[R], const float* gpost, const float* gnext, void* const (&hout_)[R], bf16_t* const (&xn)[R], const bool has_xn, int lane) {
    u32x4 yw[R][2]; f32x4 hv[R][2][2];
#pragma unroll
    for (int q = 0; q < R; ++q)
#pragma unroll
        for (int j = 0; j < 2; ++j) { const int c = 8 * lane + 512 * j; yw[q][j] = *(const u32x4*)(y[q] + c);
            if (INB) { const u32x4 hw = *(const u32x4*)((const bf16_t*)hin_[q] + c); hv[q][j][0] = (f32x4){bflo(hw.x), bfhi(hw.x), bflo(hw.y), bfhi(hw.y)}; hv[q][j][1] = (f32x4){bflo(hw.z), bfhi(hw.z), bflo(hw.w), bfhi(hw.w)}; }
            else { hv[q][j][0] = *(const f32x4*)((const float*)hin_[q] + c); hv[q][j][1] = *(const f32x4*)((const float*)hin_[q] + c + 4); } }
    f32x4 gp[2][2];
#pragma unroll
    for (int j = 0; j < 2; ++j) { gp[j][0] = *(const f32x4*)(gpost + 8 * lane + 512 * j); gp[j][1] = *(const f32x4*)(gpost + 8 * lane + 512 * j + 4); }
#pragma unroll
    for (int q = 0; q < R; ++q) {
        f32x4 yv[2][2]; float ss = 0.f;
#pragma unroll
        for (int j = 0; j < 2; ++j) { yv[j][0] = (f32x4){bflo(yw[q][j].x), bfhi(yw[q][j].x), bflo(yw[q][j].y), bfhi(yw[q][j].y)}; yv[j][1] = (f32x4){bflo(yw[q][j].z), bfhi(yw[q][j].z), bflo(yw[q][j].w), bfhi(yw[q][j].w)};
#pragma unroll
            for (int e = 0; e < 2; ++e) ss += (yv[j][e][0] * yv[j][e][0] + yv[j][e][1] * yv[j][e][1]) + (yv[j][e][2] * yv[j][e][2] + yv[j][e][3] * yv[j][e][3]); }
        const float r1 = rsqrtf(wave_sum(ss) * (1.f / DM) + EPS);
        float s2 = 0.f;
#pragma unroll
        for (int j = 0; j < 2; ++j) { const int c = 8 * lane + 512 * j; f32x4 h0 = hv[q][j][0] + yv[j][0] * r1 * gp[j][0], h1 = hv[q][j][1] + yv[j][1] * r1 * gp[j][1];
            if (OUTB) { u32x4 w; w.x = pk2(h0[0], h0[1]); w.y = pk2(h0[2], h0[3]); w.z = pk2(h1[0], h1[1]); w.w = pk2(h1[2], h1[3]); *(u32x4*)((bf16_t*)hout_[q] + c) = w;
                h0 = (f32x4){bflo(w.x), bfhi(w.x), bflo(w.y), bfhi(w.y)}; h1 = (f32x4){bflo(w.z), bfhi(w.z), bflo(w.w), bfhi(w.w)}; }
            else { *(f32x4*)((float*)hout_[q] + c) = h0; *(f32x4*)((float*)hout_[q] + c + 4) = h1; }
            s2 += (h0[0] * h0[0] + h0[1] * h0[1]) + (h0[2] * h0[2] + h0[3] * h0[3]) + (h1[0] * h1[0] + h1[1] * h1[1]) + (h1[2] * h1[2] + h1[3] * h1[3]);
            hv[q][j][0] = h0; hv[q][j][1] = h1; }
        if (has_xn) { const float r2 = rsqrtf(wave_sum(s2) * (1.f / DM) + EPS);
#pragma unroll
            for (int j = 0; j < 2; ++j) { const int c = 8 * lane + 512 * j; const f32x4 g0 = *(const f32x4*)(gnext + c), g1 = *(const f32x4*)(gnext + c + 4); const f32x4 a = hv[q][j][0] * r2 * g0, bb = hv[q][j][1] * r2 * g1;
                u32x4 w; w.x = pk2(a[0], a[1]); w.y = pk2(a[2], a[3]); w.z = pk2(bb[0], bb[1]); w.w = pk2(bb[2], bb[3]); *(u32x4*)(xn[q] + c) = w; } }
    }
}

struct RowPass { int mode; const float* gpost; const float* gnext; const float* xp; const float* xs; bf16_t* h16; const bf16_t* y; bf16_t* xnp; float* out;
    DI void row(int r, int lane) const {
        const bf16_t* yr = y + (size_t)r * DM; bf16_t* hr = h16 + (size_t)r * DM;
        if (mode == 0) res_row<false, true>(r < NP ? xp + (size_t)r * DM : xs + (size_t)(r - NP) * DM, yr, gpost, gnext, hr, xnp + (size_t)r * DM, lane);
        else if (mode == 1) res_row<true, true>(hr, yr, gpost, gnext, hr, xnp + (size_t)r * DM, lane);
        else res_row<true, false>(hr, yr, gpost, gnext, r < NP ? out + O_YP + (size_t)r * DM : out + O_YS + (size_t)(r - NP) * DM, nullptr, lane);
    }
    DI void rows4(int r0, int lane) const {
        const void* hin[4]; const bf16_t* yr[4]; void* ho[4]; bf16_t* xo[4];
#pragma unroll
        for (int q = 0; q < 4; ++q) { const size_t o = (size_t)(r0 + q) * DM; yr[q] = y + o; xo[q] = xnp + o;
            hin[q] = mode == 0 ? (const void*)(xp + o) : (const void*)(h16 + o); ho[q] = mode == 2 ? (void*)(out + O_YP + o) : (void*)(h16 + o); }
        if (mode == 0) res_rows<false, true, 4>(hin, yr, gpost, gnext, ho, xo, true, lane);
        else if (mode == 1) res_rows<true, true, 4>(hin, yr, gpost, gnext, ho, xo, true, lane);
        else res_rows<true, false, 4>(hin, yr, gpost, gnext, ho, xo, false, lane);
    }
    DI void rows8(int r0, int lane) const {
        const void* hin[8]; const bf16_t* yr[8]; void* ho[8]; bf16_t* xo[8];
#pragma unroll
        for (int q = 0; q < 8; ++q) { const size_t o = (size_t)(r0 + q) * DM; yr[q] = y + o; xo[q] = xnp + o;
            hin[q] = mode == 0 ? (const void*)(xp + o) : (const void*)(h16 + o); ho[q] = mode == 2 ? (void*)(out + O_YP + o) : (void*)(h16 + o); }
        if (mode == 0) res_rows<false, true, 8>(hin, yr, gpost, gnext, ho, xo, true, lane);
        else if (mode == 1) res_rows<true, true, 8>(hin, yr, gpost, gnext, ho, xo, true, lane);
        else res_rows<true, false, 8>(hin, yr, gpost, gnext, ho, xo, false, lane);
    }
};

DI void s5_tables(const Params& p, int g, LAS unsigned char* lds, bf16_t* Bt1, bf16_t* Bt2, const int tid) {
    LAS float* pwr = (LAS float*)lds;
    LAS float* pwi = pwr + 17 * 64;
    LAS float* bbr = pwi + 17 * 64;
    LAS float* bbi = bbr + 1024;
    LAS float* cr = bbi + 1024;
    LAS float* ci = cr + 1024;
    LAS float* Kd = ci + 1024;
    const float dt = __expf(p.in[12][g]);
    const float* lre = p.in[10] + g * 64; const float* lim = p.in[11] + g * 64;
    for (int it = tid; it < 17 * 64; it += 512) { const int d = it >> 6, q = it & 63; const float zr = lre[q] * dt * (float)d, zi = lim[q] * dt * (float)d;
        float s, c; sincos_acc(zi, s, c); const float mag = __expf(zr); pwr[it] = mag * c; pwi[it] = mag * s; }
    for (int it = tid; it < 1024; it += 512) { const int q = it >> 4, i = it & 15;
        const float lr = lre[q], li = lim[q], zr = lr * dt, zi = li * dt;
        float s, c, sh, ch; sincos_acc(zi, s, c); sincos_acc(0.5f * zi, sh, ch);
        const float em1 = expm1f(zr); const float nr = em1 * c - 2.f * sh * sh, ni = (em1 + 1.f) * s;
        const float den = 1.f / (lr * lr + li * li); const float fr_ = (nr * lr + ni * li) * den, fi_ = (ni * lr - nr * li) * den;
        const float br = p.in[13][(size_t)g * 1024 + it], bi = p.in[14][(size_t)g * 1024 + it];
        bbr[it] = fr_ * br - fi_ * bi; bbi[it] = fr_ * bi + fi_ * br;
        cr[it] = p.in[15][(size_t)g * 1024 + it]; ci[it] = p.in[16][(size_t)g * 1024 + it]; }
    __syncthreads();
    for (int it = tid; it < 4096; it += 512) { const int d = it >> 8, i = (it >> 4) & 15, j = it & 15; float a = 0.f;
        for (int q = 0; q < 64; ++q) { const float c_r = cr[i * 64 + q], c_i = ci[i * 64 + q], p_r = pwr[d * 64 + q], p_i = pwi[d * 64 + q];
            const float xr = c_r * p_r - c_i * p_i, xi = c_r * p_i + c_i * p_r; a += xr * bbr[q * 16 + j] - xi * bbi[q * 16 + j]; }
        Kd[it] = a; }
    __syncthreads();
    for (int it = tid; it < 256 * 32; it += 512) { const int n = it >> 5, k0 = (it & 31) * 8; float v[8];
#pragma unroll
        for (int e = 0; e < 8; ++e) { const int k = k0 + e, s = k >> 4, i = k & 15; float val = 0.f;
            if (n < 128) { const int q = n & 63; const float p_r = pwr[(15 - s) * 64 + q], p_i = pwi[(15 - s) * 64 + q], b_r = bbr[q * 16 + i], b_i = bbi[q * 16 + i];
                val = n < 64 ? (p_r * b_r - p_i * b_i) : (p_r * b_i + p_i * b_r); }
            v[e] = val; }
        u32x4 o; o.x = pk2(v[0], v[1]); o.y = pk2(v[2], v[3]); o.z = pk2(v[4], v[5]); o.w = pk2(v[6], v[7]);
        *(u32x4*)(Bt1 + (size_t)n * 256 + k0) = o; }
    for (int it = tid; it < 256 * 48; it += 512) { const int n = it / 48, k0 = (it % 48) * 8; const int r = n >> 4, i = n & 15; float v[8];
#pragma unroll
        for (int e = 0; e < 8; ++e) { const int k = k0 + e; float val;
            if (k < 128) { const int q = k & 63; const float c_r = cr[i * 64 + q], c_i = ci[i * 64 + q], p_r = pwr[(r + 1) * 64 + q], p_i = pwi[(r + 1) * 64 + q];
                val = k < 64 ? (c_r * p_r - c_i * p_i) : -(c_r * p_i + c_i * p_r); }
            else { const int kk = k - 128, s = kk >> 4, j = kk & 15; val = s <= r ? Kd[(r - s) * 256 + i * 16 + j] : 0.f; }
            v[e] = val; }
        u32x4 o; o.x = pk2(v[0], v[1]); o.y = pk2(v[2], v[3]); o.z = pk2(v[4], v[5]); o.w = pk2(v[6], v[7]);
        *(u32x4*)(Bt2 + (size_t)n * 384 + k0) = o; }
    __syncthreads();
}

DI void s5_sample_unit(const Params& p, int u, const float* uss, bf16_t* z, int lane) {
    const int g = u & 31, b = u >> 5;
    const float dt = __expf(p.in[12][g]);
    const float lr = p.in[10][g * 64 + lane], li = p.in[11][g * 64 + lane], zr = lr * dt, zi = li * dt;
    float s, c, sh, ch; sincos_acc(zi, s, c); sincos_acc(0.5f * zi, sh, ch);
    const float em1 = expm1f(zr); const float nr = em1 * c - 2.f * sh * sh, ni = (em1 + 1.f) * s;
    const float lbr = nr + 1.f, lbi = ni;
    const float den = 1.f / (lr * lr + li * li); const float fr_ = (nr * lr + ni * li) * den, fi_ = (ni * lr - nr * li) * den;
    float hr = p.in[3][(((size_t)b * 32 + g) * 64 + lane) * 2], hi = p.in[3][(((size_t)b * 32 + g) * 64 + lane) * 2 + 1];
    const float* bre = p.in[13] + ((size_t)g * 64 + lane) * 16; const float* bim = p.in[14] + ((size_t)g * 64 + lane) * 16;
    const float* cre = p.in[15] + (size_t)g * 1024 + lane; const float* cim = p.in[16] + (size_t)g * 1024 + lane;
    for (int t = 0; t < 4; ++t) {
        const float* ur = uss + (size_t)(b * 4 + t) * 512 + g * 16;
        float bur = 0.f, bui = 0.f;
#pragma unroll
        for (int i = 0; i < 16; ++i) { const float uv = ur[i]; const float br = bre[i], bi = bim[i]; bur += (fr_ * br - fi_ * bi) * uv; bui += (fr_ * bi + fi_ * br) * uv; }
        const float n_r = lbr * hr - lbi * hi + bur, n_i = lbr * hi + lbi * hr + bui; hr = n_r; hi = n_i;
        float yv = 0.f;
#pragma unroll
        for (int i = 0; i < 16; ++i) { float a = cre[i * 64] * hr - cim[i * 64] * hi; a = wave_sum(a); if (lane == i) yv = a; }
        if (lane < 16) { const float y = yv + p.in[17][g * 16 + lane] * ur[lane]; z[(size_t)(NP + b * 4 + t) * 512 + g * 16 + lane] = (bf16_t)(pk2(gelu_tanh(y), 0.f) & 0xffffu); }
    }
    float* o = p.out + O_S5S + (((size_t)b * 32 + g) * 64 + lane) * 2; o[0] = hr; o[1] = hi;
}

constexpr int ATT_BUF = 69632, ATT_VOFF = 34816, ATT_OST = 2 * ATT_BUF, LDS_CTL = ATT_OST + 8 * 2304;
struct AttUnit { int pat, b, h, dil, l0; size_t rowbase; };
DI AttUnit att_decode(int bu) { AttUnit u; const int tile = bu & 63; u.h = (bu >> 6) & 15; u.b = (bu >> 10) & 3; u.pat = bu >> 12; const int dsh = u.pat * 2; u.dil = 1 << dsh;
    const int rho = tile & (u.dil - 1); u.l0 = (tile >> dsh) * 128; u.rowbase = (size_t)u.b * TP + rho; return u; }
DI void att_stage(const AttUnit& u, const bf16_t* Kb, const bf16_t* Vb, LAS unsigned char* buf, int wave, int lane) {
    const int lmax = (TP >> (2 * u.pat)) - 1;
    for (int n = wave; n < 34; n += 8) { const int r0 = n * 8; const int row = r0 + (lane >> 3); const int c = (lane & 7) ^ (row & 7);
        int lk = u.l0 - 128 + row; lk = lk < 0 ? 0 : (lk > lmax ? lmax : lk); const size_t off = (u.rowbase + (size_t)u.dil * lk) * 1024 + u.h * 64 + c * 8;
        __builtin_amdgcn_global_load_lds((const unsigned*)(Kb + off), (LAS unsigned*)(buf + r0 * 128), 16, 0, 0);
        __builtin_amdgcn_global_load_lds((const unsigned*)(Vb + off), (LAS unsigned*)(buf + ATT_VOFF + r0 * 128), 16, 0, 0); }
}
DI void att_loadq(const AttUnit& u, const bf16_t* Q, int wave, int lane, bf16x8 (&qf)[2]) {
    const int i = lane & 15, g = lane >> 4; const bf16_t* q = Q + (u.rowbase + (size_t)u.dil * (u.l0 + 16 * wave + i)) * 1024 + u.h * 64 + 8 * g;
    qf[0] = *(const bf16x8*)q; qf[1] = *(const bf16x8*)(q + 32);
}
DI void att_compute(const AttUnit& u, const bf16x8 (&qf)[2], LAS unsigned char* buf, LAS unsigned char* ost, bf16_t* Op, float* lse, bf16_t* attp, int wave, int lane) {
    const int i = lane & 15, g = lane >> 4;
    const int Lw = u.l0 + 16 * wave;
    unsigned koff[2][2], voff[4];
#pragma unroll
    for (int kbl = 0; kbl < 2; ++kbl)
#pragma unroll
        for (int s = 0; s < 2; ++s) koff[kbl][s] = (unsigned)((16 * wave + 16 * kbl + i) * 128 + (((4 * s + g) ^ (i & 7)) * 16));
    { const int q = i >> 2, pp = i & 3, r = 4 * g + q;
#pragma unroll
      for (int db = 0; db < 4; ++db) voff[db] = (unsigned)((16 * wave + r) * 128 + (((2 * db + (pp >> 1)) ^ (r & 7)) * 16) + 8 * (pp & 1)); }
    u32x4 pa[2], pb[2]; float pl0[2], pl1[2];
    if (u.pat == 2) {
#pragma unroll
        for (int n = 0; n < 2; ++n) { const int c = lane + 64 * n, rr = c >> 3, ch = c & 7; const size_t trow = u.rowbase + (size_t)u.dil * (Lw + rr);
            pl0[n] = lse[trow * 16 + u.h]; pl1[n] = lse[((size_t)MT + trow) * 16 + u.h];
            pa[n] = *(const u32x4*)(Op + trow * 1024 + u.h * 64 + ch * 8); pb[n] = *(const u32x4*)(Op + ((size_t)MT + trow) * 1024 + u.h * 64 + ch * 8); }
    } else { pa[0] = pa[1] = pb[0] = pb[1] = (u32x4){0u, 0u, 0u, 0u}; pl0[0] = pl0[1] = pl1[0] = pl1[1] = 0.f; }
    f32x4 st[5][2];
#pragma unroll
    for (int ks = 0; ks < 5; ++ks)
#pragma unroll
        for (int kbl = 0; kbl < 2; ++kbl) {
            if (ks == 4 && kbl == 1) { st[ks][kbl] = (f32x4){0.f, 0.f, 0.f, 0.f}; continue; }
            const bf16x8 k0 = *(const LAS bf16x8*)(buf + ks * 4096 + koff[kbl][0]), k1 = *(const LAS bf16x8*)(buf + ks * 4096 + koff[kbl][1]);
            f32x4 a = (f32x4){0.f, 0.f, 0.f, 0.f};
            a = __builtin_amdgcn_mfma_f32_16x16x32_bf16(k0, qf[0], a, 0, 0, 0);
            a = __builtin_amdgcn_mfma_f32_16x16x32_bf16(k1, qf[1], a, 0, 0, 0); st[ks][kbl] = a; }
#pragma unroll
    for (int r = 0; r < 4; ++r) { if (i > 4 * g + r) st[0][0][r] = -INFINITY; if (4 * g + r > i) st[4][0][r] = -INFINITY; }
    if (Lw < 128) {
#pragma unroll
        for (int ks = 0; ks < 4; ++ks)
#pragma unroll
            for (int kbl = 0; kbl < 2; ++kbl)
#pragma unroll
                for (int r = 0; r < 4; ++r) if (Lw - 128 + 32 * ks + 16 * kbl + 4 * g + r < 0) st[ks][kbl][r] = -INFINITY; }
    float mx = -INFINITY;
#pragma unroll
    for (int ks = 0; ks < 5; ++ks)
#pragma unroll
        for (int kbl = 0; kbl < 2; ++kbl) { if (ks == 4 && kbl == 1) continue;
#pragma unroll
            for (int r = 0; r < 4; ++r) mx = fmaxf(mx, st[ks][kbl][r]); }
    mx = fmaxf(mx, __shfl_xor(mx, 16)); mx = fmaxf(mx, __shfl_xor(mx, 32));
    float ps = 0.f; bf16x8 pf[5];
#pragma unroll
    for (int ks = 0; ks < 5; ++ks) {
#pragma unroll
        for (int kbl = 0; kbl < 2; ++kbl) { if (ks == 4 && kbl == 1) continue;
#pragma unroll
            for (int r = 0; r < 4; ++r) { const float pv = __builtin_amdgcn_exp2f(st[ks][kbl][r] - mx); st[ks][kbl][r] = pv; ps += pv; } }
        u32x4 pw; pw.x = pk2(st[ks][0][0], st[ks][0][1]); pw.y = pk2(st[ks][0][2], st[ks][0][3]); pw.z = pk2(st[ks][1][0], st[ks][1][1]); pw.w = pk2(st[ks][1][2], st[ks][1][3]);
        pf[ks] = __builtin_bit_cast(bf16x8, pw); }
    ps += __shfl_xor(ps, 16); ps += __shfl_xor(ps, 32);
    f32x4 o[4];
#pragma unroll
    for (int db = 0; db < 4; ++db) o[db] = (f32x4){0.f, 0.f, 0.f, 0.f};
    const unsigned vb = (unsigned)(size_t)buf + (unsigned)ATT_VOFF;
#pragma unroll
    for (int ks = 0; ks < 5; ++ks) {
        s16x4 lo[4], hi[4]; const unsigned va = vb + ks * 4096;
        asm volatile("ds_read_b64_tr_b16 %0, %8\n\tds_read_b64_tr_b16 %1, %9\n\tds_read_b64_tr_b16 %2, %10\n\tds_read_b64_tr_b16 %3, %11\n\t"
                     "ds_read_b64_tr_b16 %4, %8 offset:2048\n\tds_read_b64_tr_b16 %5, %9 offset:2048\n\tds_read_b64_tr_b16 %6, %10 offset:2048\n\tds_read_b64_tr_b16 %7, %11 offset:2048\n\t"
                     "s_waitcnt lgkmcnt(0)"
                     : "=&v"(lo[0]), "=&v"(lo[1]), "=&v"(lo[2]), "=&v"(lo[3]), "=&v"(hi[0]), "=&v"(hi[1]), "=&v"(hi[2]), "=&v"(hi[3])
                     : "v"(va + voff[0]), "v"(va + voff[1]), "v"(va + voff[2]), "v"(va + voff[3]) : "memory");
#pragma unroll
        for (int db = 0; db < 4; ++db) { const bf16x8 vf = __builtin_shufflevector(lo[db], hi[db], 0, 1, 2, 3, 4, 5, 6, 7);
            o[db] = __builtin_amdgcn_mfma_f32_16x16x32_bf16(vf, pf[ks], o[db], 0, 0, 0); }
    }
    const float inv = 1.f / ps;
#pragma unroll
    for (int db = 0; db < 4; ++db) { const f32x4 v = o[db] * inv; u32x2 w; w.x = pk2(v[0], v[1]); w.y = pk2(v[2], v[3]); *(LAS u32x2*)(ost + i * 144 + (16 * db + 4 * g) * 2) = w; }
    if (u.pat == 2) {
        if (g == 0) *(LAS float*)(ost + i * 144 + 128) = mx + __builtin_amdgcn_logf(ps);
        LDS_WAIT();
#pragma unroll
        for (int n = 0; n < 2; ++n) { const int c = lane + 64 * n, rr = c >> 3, ch = c & 7; const size_t trow = u.rowbase + (size_t)u.dil * (Lw + rr);
            const u32x4 v = *(const LAS u32x4*)(ost + rr * 144 + ch * 16); const float l2 = *(const LAS float*)(ost + rr * 144 + 128);
            const float l0 = pl0[n], l1 = pl1[n]; const u32x4 a = pa[n], b = pb[n];
            const float mxl = fmaxf(l0, fmaxf(l1, l2)); float w0 = __builtin_amdgcn_exp2f(l0 - mxl), w1 = __builtin_amdgcn_exp2f(l1 - mxl), w2 = __builtin_amdgcn_exp2f(l2 - mxl);
            const float winv = __builtin_amdgcn_rcpf(w0 + w1 + w2); w0 *= winv; w1 *= winv; w2 *= winv;
            u32x4 r;
            r.x = pk2(w0 * bflo(a.x) + w1 * bflo(b.x) + w2 * bflo(v.x), w0 * bfhi(a.x) + w1 * bfhi(b.x) + w2 * bfhi(v.x));
            r.y = pk2(w0 * bflo(a.y) + w1 * bflo(b.y) + w2 * bflo(v.y), w0 * bfhi(a.y) + w1 * bfhi(b.y) + w2 * bfhi(v.y));
            r.z = pk2(w0 * bflo(a.z) + w1 * bflo(b.z) + w2 * bflo(v.z), w0 * bfhi(a.z) + w1 * bfhi(b.z) + w2 * bfhi(v.z));
            r.w = pk2(w0 * bflo(a.w) + w1 * bflo(b.w) + w2 * bflo(v.w), w0 * bfhi(a.w) + w1 * bfhi(b.w) + w2 * bfhi(v.w));
            *(u32x4*)(attp + trow * 1024 + u.h * 64 + ch * 8) = r; }
        LDS_WAIT();
    } else {
    const size_t orow0 = (size_t)u.pat * MT + u.rowbase;
    if (g == 0) lse[(orow0 + (size_t)u.dil * (Lw + i)) * 16 + u.h] = mx + __builtin_amdgcn_logf(ps);
    LDS_WAIT();
#pragma unroll
    for (int n = 0; n < 2; ++n) { const int c = lane + 64 * n, rr = c >> 3, ch = c & 7; const u32x4 v = *(const LAS u32x4*)(ost + rr * 144 + ch * 16);
        *(u32x4*)(Op + (orow0 + (size_t)u.dil * (Lw + rr)) * 1024 + u.h * 64 + ch * 8) = v; }
    LDS_WAIT();
    }
}
struct XcdBarrier; DI void xcd_barrier(const XcdBarrier& b);
DI void attn_prompt_phase(const bf16_t* Q, const bf16_t* Kb, const bf16_t* Vb, bf16_t* Op, float* lse, bf16_t* attp, const XcdBarrier& xbar, LAS unsigned char* lds, int bx, int G, int wave, int lane) {
    constexpr int NU = 3 * 4096;
    int bu = bx; if (bu >= NU) return;
    AttUnit u = att_decode(bu); bf16x8 qn[2];
    att_stage(u, Kb, Vb, lds, wave, lane); att_loadq(u, Q, wave, lane, qn);
    int par = 0;
    for (;;) {
        asm volatile("s_waitcnt vmcnt(0)" ::: "memory");
        __syncthreads();
        bf16x8 qf[2]; qf[0] = qn[0]; qf[1] = qn[1];
        const AttUnit cur = u; const int nb = bu + G; const bool more = nb < NU;
        if (more) { u = att_decode(nb); att_stage(u, Kb, Vb, lds + (par ^ 1) * ATT_BUF, wave, lane); att_loadq(u, Q, wave, lane, qn); }
        att_compute(cur, qf, lds + par * ATT_BUF, lds + ATT_OST + wave * 2304, Op, lse, attp, wave, lane);
        if (!more) break;
        if (cur.pat == 1 && u.pat == 2) xcd_barrier(xbar);
        bu = nb; par ^= 1;
    }
    __syncthreads();
}

DI void attn_sample_unit(const Params& p, int u, const bf16_t* Q, const bf16_t* Kb, const bf16_t* Vb, bf16_t* att, LAS float* sl, int lane) {
    const int h = u & 15, t = (u >> 4) & 3, b = u >> 6;
    const size_t qrow = (size_t)NP + b * 4 + t;
    const float* ck = p.in[4]; const float* cv = p.in[5];
    sl[lane] = bf2f(Q[qrow * 1024 + h * 64 + lane]);
    LDS_WAIT();
    float mx = -INFINITY;
#pragma unroll 1
    for (int e = 0; e < 9; ++e) { const int pat = e / 3, r = e - 3 * pat; const int dil = 1 << (2 * pat);
        const int j = lane + 64 * r; const bool valid = j <= 128; const int idx = 2048 + t - dil * (valid ? j : 0);
        float dot = 0.f;
        if (idx >= 2048) { const bf16_t* kp = Kb + ((size_t)NP + b * 4 + (idx - 2048)) * 1024 + h * 64;
#pragma unroll
            for (int d8 = 0; d8 < 8; ++d8) { const u32x4 kw = *(const u32x4*)(kp + 8 * d8); const f32x4 q0 = *(const LAS f32x4*)(sl + 8 * d8), q1 = *(const LAS f32x4*)(sl + 8 * d8 + 4);
                dot += (bflo(kw.x) * q0[0] + bfhi(kw.x) * q0[1]) + (bflo(kw.y) * q0[2] + bfhi(kw.y) * q0[3]) + (bflo(kw.z) * q1[0] + bfhi(kw.z) * q1[1]) + (bflo(kw.w) * q1[2] + bfhi(kw.w) * q1[3]); } }
        else { const float* kp = ck + (((size_t)b * 2048 + idx) * 16 + h) * 64;
#pragma unroll
            for (int d4 = 0; d4 < 16; ++d4) { const f32x4 kv = *(const f32x4*)(kp + 4 * d4); const f32x4 qv = *(const LAS f32x4*)(sl + 4 * d4); dot += (kv[0] * qv[0] + kv[1] * qv[1]) + (kv[2] * qv[2] + kv[3] * qv[3]); } }
        if (valid) { sl[64 + pat * 192 + j] = dot; mx = fmaxf(mx, dot); } }
    mx = wave_max(mx);
    LDS_WAIT();
    float ls = 0.f;
#pragma unroll 1
    for (int e = 0; e < 9; ++e) { const int pat = e / 3, r = e - 3 * pat; const int j = lane + 64 * r;
        if (j <= 128) { const float pv = __builtin_amdgcn_exp2f(sl[64 + pat * 192 + j] - mx); sl[64 + pat * 192 + j] = pv; ls += pv; } }
    ls = wave_sum(ls);
    LDS_WAIT();
    { const int kg = lane >> 4, d4 = lane & 15; f32x4 acc = (f32x4){0.f, 0.f, 0.f, 0.f};
#pragma unroll 1
      for (int pat = 0; pat < 3; ++pat) { const int dil = 1 << (2 * pat);
#pragma unroll
        for (int jj = 0; jj < 33; ++jj) { const int j = kg + 4 * jj; int idx = 2048 + t - dil * j; const bool use = (j <= 128) && (idx < 2048);
            idx = idx < 0 ? 0 : (idx > 2047 ? 2047 : idx); const float pv = use ? sl[64 + pat * 192 + (j > 128 ? 128 : j)] : 0.f;
            const f32x4 vv = *(const f32x4*)(cv + (((size_t)b * 2048 + idx) * 16 + h) * 64 + 4 * d4);
            acc += vv * pv; }
        if (kg == 0) { for (int j = 0; dil * j <= t; ++j) { const int idx = 2048 + t - dil * j; const float pv = sl[64 + pat * 192 + j];
            const u32x2 w = *(const u32x2*)(Vb + ((size_t)NP + b * 4 + (idx - 2048)) * 1024 + h * 64 + 4 * d4);
            acc += (f32x4){bflo(w.x), bfhi(w.x), bflo(w.y), bfhi(w.y)} * pv; } } }
#pragma unroll
      for (int e = 0; e < 4; ++e) { float a = acc[e]; a += __shfl_xor(a, 16); a += __shfl_xor(a, 32); acc[e] = a; }
      const float inv = 1.f / ls;
      if (kg == 0) { u32x2 w; w.x = pk2(acc[0] * inv, acc[1] * inv); w.y = pk2(acc[2] * inv, acc[3] * inv); *(u32x2*)(att + qrow * 1024 + h * 64 + 4 * d4) = w; } }
    LDS_WAIT();
}


#define XB_TMO      128
#define XB_XCNT(j)  (256  + 64 * (j))
#define XB_XSUB(j)  (1280 + 64 * (j))
#define XB_XGEN(j)  (2304 + 64 * (j))
#define XB_TOP      3328
#define XB_TOPGEN   3392
#define XCD_BAR_WORDS 3456
#define XB_SPIN_CAP (1u << 22)
DI unsigned xb_ld(unsigned* p)              { return __hip_atomic_load(p, __ATOMIC_RELAXED, __HIP_MEMORY_SCOPE_AGENT); }
DI unsigned xb_add(unsigned* p, unsigned v) { return __hip_atomic_fetch_add(p, v, __ATOMIC_RELAXED, __HIP_MEMORY_SCOPE_AGENT); }
DI unsigned xb_xcc_id() { return (unsigned)__builtin_amdgcn_s_getreg((3 << 11) | 20) & 0xFu; }
#define XB_SPIN(cond, bar) do { unsigned _sp = 0; while (cond) { __builtin_amdgcn_s_sleep(1); \
    if ((++_sp & 255u) == 0u) { if (xb_ld(&(bar)[XB_TMO])) break; if (_sp > XB_SPIN_CAP) { atomicAdd(&(bar)[XB_TMO], 1u); break; } } } } while (0)
struct XcdBarrier { unsigned* bar; unsigned x; volatile LAS unsigned* st; bool w0; };
DI XcdBarrier xcd_barrier_post(unsigned* bar, volatile LAS unsigned* st, const bool w0) {
    XcdBarrier b; b.bar = bar; b.x = xb_xcc_id(); b.st = st; b.w0 = w0;
    if (w0 && lane_id() == 0) (void)xb_add(&bar[XB_XCNT(b.x)], 1u);
    return b;
}
DI void xcd_barrier_complete(unsigned* bar, unsigned x, unsigned& nloc, unsigned& nx) {
    const unsigned G = gridDim.x * gridDim.y * gridDim.z;
    unsigned sum, cnt, mine, sp = 0u;
    for (;;) {
        sum = 0u; cnt = 0u; mine = 0u;
#pragma unroll
        for (unsigned j = 0; j < 16; ++j) { const unsigned c = xb_ld(&bar[XB_XCNT(j)]); sum += c; cnt += (c > 0u) ? 1u : 0u; mine = (j == x) ? c : mine; }
        if (sum == G) break;
        __builtin_amdgcn_s_sleep(1);
        if ((++sp & 255u) == 0u) { if (xb_ld(&bar[XB_TMO])) break; if (sp > XB_SPIN_CAP) { atomicAdd(&bar[XB_TMO], 1u); break; } }
    }
    nloc = mine > 0u ? mine : 1u; nx = cnt > 0u ? cnt : 1u;
}
DI void xcd_barrier(const XcdBarrier& b) {
    asm volatile("s_waitcnt vmcnt(0)" ::: "memory");
    __syncthreads();
    if (b.w0 && lane_id() == 0) {
        unsigned* bar = b.bar;
        __builtin_amdgcn_s_waitcnt(0);
        unsigned nloc = b.st[0], nx = b.st[1];
        if (nloc == 0u) { xcd_barrier_complete(bar, b.x, nloc, nx); b.st[0] = nloc; b.st[1] = nx; }
        const unsigned old = xb_add(&bar[XB_XSUB(b.x)], 1u);
        const unsigned gen = old / nloc;
        if (old + 1u == (gen + 1u) * nloc) {
            __builtin_amdgcn_fence(__ATOMIC_RELEASE, "agent");
            asm volatile("s_waitcnt vmcnt(0)" ::: "memory");
            const unsigned og = xb_add(&bar[XB_TOP], 1u);
            const unsigned tg = og / nx;
            if (og + 1u == (tg + 1u) * nx) xb_add(&bar[XB_TOPGEN], 1u);
            else XB_SPIN(xb_ld(&bar[XB_TOPGEN]) == tg, bar);
            __builtin_amdgcn_fence(__ATOMIC_ACQUIRE, "agent");
            xb_add(&bar[XB_XGEN(b.x)], 1u);
            asm volatile("s_waitcnt vmcnt(0)" ::: "memory");
        } else {
            XB_SPIN(xb_ld(&bar[XB_XGEN(b.x)]) == gen, bar);
            __builtin_amdgcn_fence(__ATOMIC_ACQUIRE, "agent");
            asm volatile("s_waitcnt vmcnt(0)" ::: "memory");
        }
    }
    __syncthreads();
}

#define w_in_t ((bf16_t*)(ws + WS_WIN))
#define w_out_t ((bf16_t*)(ws + WS_WOUT))
#define w_glu_t ((bf16_t*)(ws + WS_WGLU))
#define w_pool_t ((bf16_t*)(ws + WS_WPOOL))
#define w_o_t ((bf16_t*)(ws + WS_WO))
#define w_qkv_t ((bf16_t*)(ws + WS_WQKV))
#define Bt1 ((bf16_t*)(ws + WS_BT1))
#define Bt2 ((bf16_t*)(ws + WS_BT2))
#define rowss ((float*)(ws + WS_ROWSS))
#define uss ((float*)(ws + WS_USS))
#define lse ((float*)(ws + WS_LSE))
#define xn ((bf16_t*)(ws + WS_XN))
#define ybuf ((bf16_t*)(ws + WS_Y))
#define hbuf16 ((bf16_t*)(ws + WS_H))
#define Ap ((bf16_t*)(ws + WS_AP))
#define Sbuf ((float*)(ws + WS_S))
#define upool ((float*)(ws + WS_UPOOL))
#define dbuf ((bf16_t*)(ws + WS_D))
#define zbuf ((bf16_t*)(ws + WS_Z))
#define ycat ((bf16_t*)(ws + WS_YCAT))
#define hact ((bf16_t*)(ws + WS_HACT))
#define Qb ((bf16_t*)(ws + WS_Q))
#define Kb ((bf16_t*)(ws + WS_K))
#define Vb ((bf16_t*)(ws + WS_V))
#define Op ((bf16_t*)(ws + WS_OP))
#define att ((bf16_t*)(ws + WS_ATT))
#define gains (p.in[6])
#ifndef PHMASK
#define PHMASK 0xFFFFFFFFu
#endif
#ifndef DUPMASK
#define DUPMASK 0u
#endif
#define PHASE_BEGIN(k) if (((PHMASK >> (k)) & 1u) && p.ph_lo <= (k) && (k) < p.ph_hi) { for (int _rep = 0; _rep < 1 + (int)((DUPMASK >> (k)) & 1u); ++_rep) { if (_rep) __syncthreads(); const int lane = lane_id(); const int tid = wave * 64 + lane; const int gt = bx * 512 + tid; (void)gt;
#define PHASE_END(k) } } if (p.ph_lo <= (k) && (k) + 1 < p.ph_hi) { if ((k) == 0) { grid.sync(); xbar = xcd_barrier_post((unsigned*)(p.ws + WS_CTL), (volatile LAS unsigned*)(lds + 157696), wave == 0); } else xcd_barrier(xbar); }

template <int layer>
DI void layer_tail(const Params& p, LAS unsigned char* lds, cg::grid_group& grid, XcdBarrier& xbar, const int bx, const int G, const int gw, const int NGW, const int wave) {
    unsigned char* ws = p.ws;
    constexpr int pb = 6 + layer * 8;
    const float* gl = gains + (size_t)layer * 4 * DM;
        PHASE_BEGIN(pb)
        { const bf16_t* A = layer == 0 ? ycat : att; const bf16_t* W = layer == 0 ? w_out_t : w_o_t;
          { UStd<EpiY> U{A, W, (size_t)256 * DM, (size_t)256 * DM, 0, 128, 4, G, bx, EpiY{ybuf, 0, 0}};
            gemm_phase(lds, wave, DM, DM, DM, U); }
          { EpiY E{ybuf, 0, 0}; mini_gemm(A, DM, W, DM, DM, 1024, 0, E, bx, G, wave, lane); } }
        PHASE_END(pb)
        PHASE_BEGIN(pb + 1)
        { const RowPass rp{layer == 0 ? 0 : 1, gl + DM, gl + 2 * DM, p.in[0], p.in[1], hbuf16, ybuf, xn, p.out};
          for (int q = gw; q < NP / 4; q += NGW) rp.rows4(q * 4, lane);
          for (int r = NP + (NGW - 1 - gw); r < NT; r += NGW) rp.row(r, lane); }
        PHASE_END(pb + 1)
        PHASE_BEGIN(pb + 2)
        { const bf16_t* W = (const bf16_t*)(ws + (layer ? WS_GU1 : WS_GU0));
          { UStd<EpiGU> U{xn, W, (size_t)256 * DM, (size_t)256 * DM, 0, 128, 22, G, bx, EpiGU{hact, 0, 0}};
            gemm_phase(lds, wave, DM, DM, DM, U); }
          { EpiGU E{hact, 0, 0}; mini_gemm_gu(xn, W, E, bx, G, wave, lane); } }
        PHASE_END(pb + 2)
        PHASE_BEGIN(pb + 3)
        { const bf16_t* W = (const bf16_t*)(ws + (layer ? WS_DN1 : WS_DN0));
          { UStd<EpiY> U{hact, W, (size_t)256 * FF, (size_t)256 * FF, 0, 128, 4, G, bx, EpiY{ybuf, 0, 0}};
            gemm_phase(lds, wave, FF, FF, FF, U); }
          { EpiY E{ybuf, 0, 0}; mini_gemm(hact, FF, W, FF, FF, 1024, 0, E, bx, G, wave, lane); } }
        PHASE_END(pb + 3)
        PHASE_BEGIN(pb + 4)
        { const RowPass rp{layer == 0 ? 1 : 2, gl + 3 * DM, gains + 4 * DM, p.in[0], p.in[1], hbuf16, ybuf, xn, p.out};
          for (int q = gw; q < NP / 4; q += NGW) rp.rows4(q * 4, lane);
          for (int r = NP + (NGW - 1 - gw); r < NT; r += NGW) rp.row(r, lane); }
        PHASE_END(pb + 4)
    }

__global__ void __launch_bounds__(512, 2) mega(Params p) {
    extern __shared__ __attribute__((aligned(16))) unsigned char lds_raw[];
    LAS unsigned char* lds = (LAS unsigned char*)lds_raw;
    cg::grid_group grid = cg::this_grid();
    const int wave = __builtin_amdgcn_readfirstlane((int)threadIdx.x >> 6);
    const int G = gridDim.x, bx = blockIdx.x;
    const int gw = bx * 8 + wave, NGW = G * 8;
    const int NGT = G * 512;
    unsigned char* ws = p.ws;
    XcdBarrier xbar; xbar.bar = (unsigned*)(ws + WS_CTL); xbar.x = 0; xbar.st = (volatile LAS unsigned*)(lds + 157696); xbar.w0 = wave == 0;
    { const int tid = wave * 64 + lane_id();
      if (tid < 64) ((LAS unsigned*)(lds + 157696))[tid] = 0u;
      if (bx == 0) { for (int i = tid; i < 4096; i += 512) ((unsigned*)(ws + WS_CTL))[i] = 0u; } }
    __syncthreads();

    PHASE_BEGIN(0)
    {
        if (bx < 32) { s5_tables(p, bx, lds, Bt1 + (size_t)bx * 65536, Bt2 + (size_t)bx * 98304, tid); }
        LAS float* scr = (LAS float*)(lds + wave * 16384);
        constexpr int I_IN = 512, I_OUT = 512, I_GLU = 128, I_POOL = 32, I_O = 512, I_QKV = 1536, I_G = 1408, I_D = 1408;
        constexpr int NITEMS = I_IN + I_OUT + I_GLU + I_POOL + I_O + I_QKV + 4 * I_G + 2 * I_D;
        for (int it = gw; it < NITEMS; it += NGW) {
            int r = it;
            if (r < I_IN) { tr_plain(p.in[7], 1024, 1024, w_in_t, r, scr, lane); continue; } r -= I_IN;
            if (r < I_OUT) { tr_plain(p.in[20], 1024, 1024, w_out_t, r, scr, lane); continue; } r -= I_OUT;
            if (r < I_GLU) { tr_plain(p.in[18], 512, 512, w_glu_t, r, scr, lane); continue; } r -= I_GLU;
            if (r < I_POOL) { const int gg = r >> 3, q = r & 7, kb = q >> 2, nb = q & 3;
                transpose_item(p.in[8] + (size_t)gg * 16384, 128, 64 * kb, 32 * nb, w_pool_t, 256, gg * 128 + 32 * nb, (gg & 1) * 128 + 64 * kb, scr, lane); continue; } r -= I_POOL;
            if (r < I_O) { tr_plain(p.in[22], 1024, 1024, w_o_t, r, scr, lane); continue; } r -= I_O;
            if (r < I_QKV) { tr_plain(p.in[21], 1024, 3072, w_qkv_t, r, scr, lane); continue; } r -= I_QKV;
            if (r < 4 * I_G) { const int which = r / I_G, q = r % I_G; const int layer = which >> 1, up = which & 1;
                const float* W = p.in[up ? 24 : 23] + (size_t)layer * 1024 * FF; bf16_t* WT = (bf16_t*)(ws + (layer ? WS_GU1 : WS_GU0));
                const int nblk = FF / 32, kb = q / nblk, nb = q % nblk, n0 = 32 * nb;
                transpose_item(W, FF, 64 * kb, n0, WT, 1024, (n0 >> 7) * 256 + up * 128 + (n0 & 127), 64 * kb, scr, lane); continue; } r -= 4 * I_G;
            { const int layer = r / I_D, q = r % I_D; tr_plain(p.in[25] + (size_t)layer * FF * 1024, FF, 1024, (bf16_t*)(ws + (layer ? WS_DN1 : WS_DN0)), q, scr, lane); }
        }
        for (int it = gt; it < 512 * 16; it += NGT) { const int n = it >> 4, c8 = it & 15; const int gg = n >> 7;
            *(u32x4*)(w_pool_t + (size_t)n * 256 + ((gg & 1) ^ 1) * 128 + c8 * 8) = (u32x4){0u, 0u, 0u, 0u}; }
        if (bx >= 32 || G <= 32) { const int gwn = G > 32 ? (bx - 32) * 8 + wave : gw, ngwn = G > 32 ? (G - 32) * 8 : NGW;
          for (int r = gwn; r < NT; r += 2 * ngwn) { const int r2 = r + ngwn; const bool two = r2 < NT;
            norm_row2(in_row(p, r), in_row(p, two ? r2 : r), gains, xn + (size_t)r * DM, xn + (size_t)(two ? r2 : r) * DM, lane); } }
    }
    PHASE_END(0)

    PHASE_BEGIN(1)
    { UStd<EpiProj> U{xn, w_in_t, (size_t)256 * DM, (size_t)256 * DM, 0, 128, 4, G, bx, EpiProj{upool, Ap, uss, 0, 0}};
      gemm_phase(lds, wave, DM, DM, DM, U);
      { EpiProj E{upool, Ap, uss, 0, 0}; mini_gemm(xn, DM, w_in_t, DM, DM, 1024, 0, E, bx, G, wave, lane); } }
    PHASE_END(1)

    PHASE_BEGIN(2)
    {
        { US5<EpiS1> U{Ap + 128, Bt1, (size_t)65536, G, bx, EpiS1{Sbuf, 0, 0}};
          gemm_phase(lds, wave, 384, 256, 256, U); }
        for (int u = gw; u < 1024; u += NGW) s5_sample_unit(p, u, uss, zbuf, lane);
        for (int it = gt; it < (NP / 16) * 128; it += NGT) { const int cq = it & 127, run = it >> 7; const int c = cq * 4, gi = c >> 7, w = 2 << gi;
            const int t0 = run * 16, tb0 = t0 & (TP - 1); const float* up = upool + (size_t)t0 * 512 + c;
            f32x4 e[31];
#pragma unroll
            for (int k = 0; k < 31; ++k) { const int rel = k - 15; e[k] = (rel >= 1 - w && tb0 + rel >= 0) ? *(const f32x4*)(up + (ptrdiff_t)rel * 512) : (f32x4){0.f, 0.f, 0.f, 0.f}; }
            f32x4 sum = (f32x4){0.f, 0.f, 0.f, 0.f};
#pragma unroll
            for (int k = 0; k < 15; ++k) sum += e[k];
#pragma unroll
            for (int k = 0; k < 16; ++k) { const f32x4 uv = e[15 + k]; sum += uv; const int tb = tb0 + k; const int cnt = tb + 1 < w ? tb + 1 : w;
                const f32x4 dv = sum * (1.0f / (float)cnt) - uv; u32x2 o; o.x = pk2(dv[0], dv[1]); o.y = pk2(dv[2], dv[3]); *(u32x2*)(dbuf + (size_t)(t0 + k) * 512 + c) = o;
                f32x4 out_ = (f32x4){0.f, 0.f, 0.f, 0.f};
                if (w == 2) out_ = e[15 + k - 1]; else if (w == 4) out_ = e[15 + k - 3]; else if (w == 8) out_ = e[15 + k - 7]; else out_ = e[15 + k - 15];
                sum -= out_;
                if (tb >= TP - 15) *(f32x4*)(p.out + O_POOLP + ((size_t)(t0 >> 13) * 15 + (tb - (TP - 15))) * 512 + c) = uv; } }
        for (int it = gt; it < 32 * 128; it += NGT) { const int cq = it & 127, b = it >> 7; const int c = cq * 4, gi = c >> 7, w = 2 << gi;
            const float* sp = p.in[2] + (size_t)b * 15 * 512 + c; const float* up = upool + (size_t)(NP + b * 4) * 512 + c;
            for (int t = 0; t < 4; ++t) { f32x4 sum = (f32x4){0.f, 0.f, 0.f, 0.f};
                for (int s = 0; s < w; ++s) { const int e = 15 + t - s; sum += e >= 15 ? *(const f32x4*)(up + (size_t)(e - 15) * 512) : *(const f32x4*)(sp + (size_t)e * 512); }
                const f32x4 uv = *(const f32x4*)(up + (size_t)t * 512); const f32x4 dv = sum * (1.0f / (float)w) - uv;
                u32x2 o; o.x = pk2(dv[0], dv[1]); o.y = pk2(dv[2], dv[3]); *(u32x2*)(dbuf + (size_t)(NP + b * 4 + t) * 512 + c) = o; }
            for (int r = 0; r < 15; ++r) { const f32x4 v = r < 11 ? *(const f32x4*)(sp + (size_t)(r + 4) * 512) : *(const f32x4*)(up + (size_t)(r - 11) * 512);
                *(f32x4*)(p.out + O_POOLS + ((size_t)b * 15 + r) * 512 + c) = v; } }
    }
    PHASE_END(2)

    PHASE_BEGIN(3)
    {
        { const bool act = bx < 128; const int b = (bx >> 5) & 3, g = bx & 31;
          LAS float* ex = (LAS float*)lds;
          float c_r = 1.f, c_i = 0.f, hr = 0.f, hi = 0.f;
          const float* Sp = Sbuf + ((size_t)g * 2048 + b * 512 + wave * 64) * 128 + lane; bf16_t* Hp = Ap + ((size_t)g * 2048 + b * 512 + wave * 64) * 384 + lane;
          if (act) {
            const float dt = __expf(p.in[12][g]); const float zr = p.in[10][g * 64 + lane] * dt * 16.f, zi = p.in[11][g * 64 + lane] * dt * 16.f;
            float sn, cs; sincos_acc(zi, sn, cs); const float mag = __expf(zr); c_r = mag * cs; c_i = mag * sn;
            for (int c0 = 0; c0 < 64; c0 += 16) { float sr[16], si[16];
#pragma unroll
                for (int k = 0; k < 16; ++k) { sr[k] = Sp[(size_t)(c0 + k) * 128]; si[k] = Sp[(size_t)(c0 + k) * 128 + 64]; }
#pragma unroll
                for (int k = 0; k < 16; ++k) { const float n_r = c_r * hr - c_i * hi + sr[k], n_i = c_r * hi + c_i * hr + si[k]; hr = n_r; hi = n_i; } }
            ex[(wave * 64 + lane) * 2] = hr; ex[(wave * 64 + lane) * 2 + 1] = hi;
          }
          __syncthreads();
          if (act) {
            float l_r = c_r, l_i = c_i;
#pragma unroll
            for (int e = 0; e < 6; ++e) { const float t_r = l_r * l_r - l_i * l_i, t_i = 2.f * l_r * l_i; l_r = t_r; l_i = t_i; }
            hr = 0.f; hi = 0.f;
            for (int sg = 0; sg < wave; ++sg) { const float e_r = ex[(sg * 64 + lane) * 2], e_i = ex[(sg * 64 + lane) * 2 + 1];
                const float n_r = l_r * hr - l_i * hi + e_r, n_i = l_r * hi + l_i * hr + e_i; hr = n_r; hi = n_i; }
            for (int c0 = 0; c0 < 64; c0 += 16) { float sr[16], si[16];
#pragma unroll
                for (int k = 0; k < 16; ++k) { sr[k] = Sp[(size_t)(c0 + k) * 128]; si[k] = Sp[(size_t)(c0 + k) * 128 + 64]; }
#pragma unroll
                for (int k = 0; k < 16; ++k) { const unsigned w = pk2(hr, hi); Hp[(size_t)(c0 + k) * 384] = (bf16_t)(w & 0xffffu); Hp[(size_t)(c0 + k) * 384 + 64] = (bf16_t)(w >> 16);
                    const float n_r = c_r * hr - c_i * hi + sr[k], n_i = c_r * hi + c_i * hr + si[k]; hr = n_r; hi = n_i; } }
            if (wave == 7) { float* o = p.out + O_S5P + (((size_t)b * 32 + g) * 64 + lane) * 2; o[0] = hr; o[1] = hi; }
          }
        }
        __syncthreads();
        { UStd<EpiPool> U{dbuf, w_pool_t, (size_t)256 * 512, (size_t)256 * 256, 256, 128, 2, G, bx, EpiPool{ycat, p.in[9], 0, 0}};
          gemm_phase(lds, wave, 512, 256, 256, U); }
        { EpiPool E{ycat, p.in[9], 0, 0}; mini_gemm(dbuf, 512, w_pool_t, 256, 256, 512, 256, E, bx, G, wave, lane); }
    }
    PHASE_END(3)

    PHASE_BEGIN(4)
    { US5<EpiS2> U{Ap, Bt2, (size_t)98304, G, bx, EpiS2{zbuf, Ap, p.in[17], 0, 0}};
      gemm_phase(lds, wave, 384, 384, 384, U); }
    PHASE_END(4)

    PHASE_BEGIN(5)
    { UStd<EpiGlu> U{zbuf, w_glu_t, (size_t)256 * 512, (size_t)256 * 512, 0, 128, 2, G, bx, EpiGlu{ycat, zbuf, p.in[19], 0, 0}};
      gemm_phase(lds, wave, 512, 512, 512, U);
      { EpiGlu E{ycat, zbuf, p.in[19], 0, 0}; mini_gemm(zbuf, 512, w_glu_t, 512, 512, 512, 0, E, bx, G, wave, lane); } }
    PHASE_END(5)

    layer_tail<0>(p, lds, grid, xbar, bx, G, gw, NGW, wave);
            PHASE_BEGIN(11)
            { UStd<EpiQKV> U{xn, w_qkv_t, (size_t)256 * DM, (size_t)256 * DM, 0, 128, 12, G, bx, EpiQKV{Qb, p.out, 0, 0}};
              gemm_phase(lds, wave, DM, DM, DM, U);
              { EpiQKV E{Qb, p.out, 0, 0}; mini_gemm(xn, DM, w_qkv_t, DM, DM, 3072, 0, E, bx, G, wave, lane); } }
            PHASE_END(11)
            PHASE_BEGIN(12)
            {
                attn_prompt_phase(Qb, Kb, Vb, Op, lse, att, xbar, lds, bx, G, wave, lane);
            }
            PHASE_END(12)
            PHASE_BEGIN(13)
            { for (int u = gw; u < 2048; u += NGW) attn_sample_unit(p, u, Qb, Kb, Vb, att, (LAS float*)(lds + wave * 8192), lane); }
            PHASE_END(13)
            layer_tail<1>(p, lds, grid, xbar, bx, G, gw, NGW, wave);
}

constexpr int NPHASES = 19;

extern "C" void kernel_launch(void* const* d_in, const int* in_sizes, int n_in, void* d_out, int out_size, void* d_ws, size_t ws_size, hipStream_t stream) {
    static int grid = 0;
    if (grid == 0) {
        int dev = 0, cus = 0, per_cu = 0;
        hipGetDevice(&dev);
        hipDeviceGetAttribute(&cus, hipDeviceAttributeMultiprocessorCount, dev);
        hipFuncSetAttribute((const void*)mega, hipFuncAttributeMaxDynamicSharedMemorySize, LDS_BYTES);
        hipOccupancyMaxActiveBlocksPerMultiprocessor(&per_cu, (const void*)mega, 512, LDS_BYTES);
        if (per_cu < 1) per_cu = 1;
        grid = cus * 1;
        if (ws_size < WS_END) fprintf(stderr, "kernel_launch: workspace too small: %zu < %zu\n", ws_size, (size_t)WS_END);
        fprintf(stderr, "kernel_launch: cus %d per_cu %d grid %d n_in %d out %d ws %zu\n", cus, per_cu, grid, n_in, out_size, ws_size);
    }
    Params p{};
    for (int i = 0; i < 26; ++i) p.in[i] = (const float*)d_in[i];
    p.out = (float*)d_out; p.ws = (unsigned char*)d_ws; p.ph_lo = 0; p.ph_hi = NPHASES;
    void* args[] = {&p};
    hipError_t e = hipLaunchCooperativeKernel((const void*)mega, dim3(grid), dim3(512), args, LDS_BYTES, stream);
    if (e != hipSuccess) fprintf(stderr, "cooperative launch failed: %s (grid %d)\n", hipGetErrorString(e), grid);
}
```

```cpp
#include <hip/hip_runtime.h>
#include <hip/hip_cooperative_groups.h>
#include <cstdio>
#include <cstdint>
namespace cg = cooperative_groups;

#define LAS __attribute__((address_space(3)))
#define DI __device__ __forceinline__
typedef unsigned short bf16_t;
typedef short bf16x8 __attribute__((ext_vector_type(8)));
typedef short s16x4 __attribute__((ext_vector_type(4)));
typedef float f32x4 __attribute__((ext_vector_type(4)));
typedef unsigned u32x4 __attribute__((ext_vector_type(4)));
typedef unsigned u32x2 __attribute__((ext_vector_type(2)));
typedef __bf16 bf2_t __attribute__((ext_vector_type(2)));

constexpr int NP = 32768, NS = 128, NT = NP + NS, MT = 33024, DM = 1024, FF = 2816, TP = 8192;
constexpr float EPS = 1e-6f;
constexpr int LDS_BYTES = 157696 + 256;
constexpr size_t O_YP = 0, O_YS = 33554432, O_POOLP = 33685504, O_S5P = 33716224, O_KP = 33732608, O_VP = 42121216,
                 O_POOLS = 50509824, O_S5S = 50755584, O_KS = 50886656, O_VS = 51017728;
constexpr size_t MiB = 1u << 20;
constexpr size_t WS_WIN = 0, WS_WOUT = 2 * MiB, WS_WGLU = 4 * MiB, WS_WPOOL = 4 * MiB + 512 * 1024, WS_WO = 5 * MiB, WS_WQKV = 7 * MiB,
                 WS_GU0 = 13 * MiB, WS_GU1 = 24 * MiB, WS_DN0 = 35 * MiB, WS_DN1 = 41 * MiB, WS_BT1 = 47 * MiB, WS_BT2 = 51 * MiB,
                 WS_ROWSS = 57 * MiB, WS_USS = 60 * MiB, WS_LSE = 61 * MiB, WS_XN = 68 * MiB, WS_Y = 133 * MiB, WS_H = 198 * MiB,
                 WS_X = 328 * MiB;
constexpr size_t WS_AP = WS_X, WS_S = WS_X + 48 * MiB, WS_UPOOL = WS_X + 80 * MiB, WS_D = WS_X + 145 * MiB, WS_Z = WS_X + 178 * MiB,
                 WS_YCAT = WS_X + 211 * MiB;
constexpr size_t WS_HACT = WS_X;
constexpr size_t WS_Q = WS_X, WS_K = WS_X + 65 * MiB, WS_V = WS_X + 130 * MiB, WS_OP = WS_X + 195 * MiB, WS_ATT = WS_X + 389 * MiB;
constexpr size_t WS_END = WS_X + 454 * MiB;
constexpr size_t WS_CTL = 60 * MiB + 512 * 1024;

struct Params { const float* in[26]; float* out; unsigned char* ws; int ph_lo, ph_hi; };

DI unsigned pk2(float lo, float hi) { bf2_t v; v.x = (__bf16)lo; v.y = (__bf16)hi; return __builtin_bit_cast(unsigned, v); }
DI float bflo(unsigned w) { return __uint_as_float(w << 16); }
DI float bfhi(unsigned w) { return __uint_as_float(w & 0xffff0000u); }
DI float bf2f(bf16_t b) { return __uint_as_float((unsigned)b << 16); }
DI float wave_sum(float v) {
#pragma unroll
    for (int o = 1; o < 64; o <<= 1) v += __shfl_xor(v, o);
    return v;
}
DI float wave_max(float v) {
#pragma unroll
    for (int o = 1; o < 64; o <<= 1) v = fmaxf(v, __shfl_xor(v, o));
    return v;
}
DI float sigmoidf_(float x) { return __builtin_amdgcn_rcpf(1.0f + __builtin_amdgcn_exp2f(-1.4426950408889634f * x)); }
DI float gelu_tanh(float y) { const float u = 0.7978845608028654f * (y + 0.044715f * y * y * y); return y * __builtin_amdgcn_rcpf(1.0f + __builtin_amdgcn_exp2f(-2.0f * 1.4426950408889634f * u)); }
DI void sincos_acc(float a, float& s, float& c) {
    if (fabsf(a) < 0.5f) {
        const float a2 = a * a;
        s = a * (1.f - a2 * (1.f / 6.f) * (1.f - a2 * (1.f / 20.f) * (1.f - a2 * (1.f / 42.f))));
        c = 1.f - a2 * 0.5f * (1.f - a2 * (1.f / 12.f) * (1.f - a2 * (1.f / 30.f) * (1.f - a2 * (1.f / 56.f))));
    } else {
        float r = a * 0.15915494309189535f; r -= floorf(r);
        s = __builtin_amdgcn_sinf(r); c = __builtin_amdgcn_cosf(r);
    }
}
DI int lane_id() { int l; asm volatile("v_mbcnt_lo_u32_b32 %0, -1, 0\n\tv_mbcnt_hi_u32_b32 %0, -1, %0" : "=v"(l)); return l; }
#define LDS_WAIT() asm volatile("s_waitcnt lgkmcnt(0)" ::: "memory")
#define VM_WAIT() asm volatile("s_waitcnt vmcnt(0)" ::: "memory")

constexpr int BM = 256, BK = 64, HALF = 128, NXCD = 8, WGM = 8;
typedef f32x4 Acc[2][2][4][2];
DI int lds_byte(int r, int c) { const int st = (r >> 4) * 2 + (c >> 5), rr = r & 15, cc = c & 31, ob = rr * 64 + cc * 2; return st * 1024 + (ob ^ (((ob >> 9) & 1) << 5)); }
DI void stage_rc(int b, int& R, int& C) { const int st = b / 1024, sb = b % 1024, swz = sb ^ (((sb >> 9) & 1) << 5); R = (st >> 1) * 16 + swz / 64; C = (st & 1) * 32 + (swz % 64) / 2; }

DI bool unit_next(int i, int G, int c, int nM, int nN, int& pm, int& pn) {
    const int nwg = nM * nN; const long L = (long)i * G + c; if (L >= nwg) return false;
    int wgid = (int)L; { const int q = nwg / NXCD, r = nwg % NXCD, xcd = wgid % NXCD, off = wgid / NXCD; wgid = (xcd < r ? xcd * (q + 1) : r * (q + 1) + (xcd - r) * q) + off; }
    const int nig = WGM * nN, gid = wgid / nig, fm = gid * WGM, gsz = (nM - fm) < WGM ? (nM - fm) : WGM;
    pm = fm + ((wgid % nig) % gsz); pn = (wgid % nig) / gsz; return true;
}

template <class Units>
DI void gemm_phase(LAS unsigned char* lds, const int wid, const int lda, const int ldb, const int K, const Units& U) {
    typedef typename Units::Epi Epi;
    const int lane = lane_id(), tid = wid * 64 + lane, wr = wid >> 2, wc = wid & 3, fr = lane & 15, fq = lane >> 4;
    unsigned offA, offB;
    { int R, C; stage_rc(tid * 16, R, C); offA = (unsigned)(R * lda + C) * 2u;
      const int rho = R & 31, Rb = (R & ~31) + 8 * ((rho & 15) >> 2) + 4 * (rho >> 4) + (rho & 3);
      offB = (unsigned)(Rb * ldb + C) * 2u; }
    const unsigned ldsw = (unsigned)wid * 1024u;
    const unsigned hA = (unsigned)(HALF * lda * 2), hB = (unsigned)(HALF * ldb * 2), dA = (unsigned)(64 * lda * 2), dB = (unsigned)(64 * ldb * 2);
    const int aoff = lds_byte(wr * 64 + fr, fq * 8), boff = lds_byte(wc * 32 + fr, fq * 8);
#define SA(b, h) (((b) * 2 + (h)) * 16384)
#define SB(b, h) ((4 + (b) * 2 + (h)) * 16384)
#define STG(bufoff, gbase, soff, voff, dlt) do { _Pragma("unroll") for (int _i = 0; _i < 2; ++_i) { unsigned _vo = (voff); asm volatile("" : "+v"(_vo)); _vo += (unsigned)(soff) + (unsigned)_i * (dlt); \
        __builtin_amdgcn_global_load_lds((const unsigned*)((gbase) + _vo), (LAS unsigned*)(lds + (bufoff) + ldsw + _i * 8192), 16, 0, 0); } } while (0)
#define STA(b, h, base, kt) STG(SA(b, h), base, (h) * hA + (unsigned)(kt) * 128u, offA, dA)
#define STB(b, h, base, kt) STG(SB(b, h), base, (h) * hB + (unsigned)(kt) * 128u, offB, dB)
#define LDA(dst, b, h) do { _Pragma("unroll") for (int m = 0; m < 4; ++m) _Pragma("unroll") for (int k = 0; k < 2; ++k) dst[m][k] = *(const LAS bf16x8*)(lds + SA(b, h) + aoff + m * 2048 + k * 1024); } while (0)
#define LDB(dst, b, h) do { _Pragma("unroll") for (int n = 0; n < 2; ++n) _Pragma("unroll") for (int k = 0; k < 2; ++k) dst[n][k] = *(const LAS bf16x8*)(lds + SB(b, h) + boff + n * 2048 + k * 1024); } while (0)
#define MMA(ai, bj, Af, Bf) do { __builtin_amdgcn_s_setprio(1); _Pragma("unroll") for (int m = 0; m < 4; ++m) _Pragma("unroll") for (int n = 0; n < 2; ++n) _Pragma("unroll") for (int k = 0; k < 2; ++k) \
        acc[ai][bj][m][n] = __builtin_amdgcn_mfma_f32_16x16x32_bf16(Bf[n][k], Af[m][k], acc[ai][bj][m][n], 0, 0, 0); __builtin_amdgcn_s_setprio(0); } while (0)
#define WAIT_V(n) asm volatile("s_waitcnt vmcnt(" #n ")" ::: "memory")
#define WAIT_L(n) asm volatile("s_waitcnt lgkmcnt(" #n ")" ::: "memory")
#define BAR __builtin_amdgcn_s_barrier()
#define SCHED __builtin_amdgcn_sched_barrier(0)
#define ZERO_ACC() do { _Pragma("unroll") for (int a = 0; a < 2; ++a) _Pragma("unroll") for (int b = 0; b < 2; ++b) _Pragma("unroll") for (int m = 0; m < 4; ++m) _Pragma("unroll") for (int n = 0; n < 2; ++n) acc[a][b][m][n] = (f32x4){0.f, 0.f, 0.f, 0.f}; } while (0)
    const bf16_t* pa; const bf16_t* pb; Epi Ecur, Enxt;
    if (!U.get(0, pa, pb, Ecur)) return;
    const char* cA = (const char*)pa; const char* cB = (const char*)pb;
    Acc acc; ZERO_ACC();
    bf16x8 At[4][2], B0[2][2], B1[2][2];
    const int nt = K / BK;
    STB(0, 0, cB, 0); STB(0, 1, cB, 0); STA(0, 0, cA, 0); STA(0, 1, cA, 0);
    if (wr == 1) BAR;
    WAIT_V(2); BAR;
    STB(1, 0, cB, 1); STA(1, 0, cA, 1); STB(1, 1, cB, 1);
    WAIT_V(6); BAR;
    for (int ui = 0;; ++ui) {
        const bool has_next = U.get(ui + 1, pa, pb, Enxt);
        const char* nA = has_next ? (const char*)pa : cA; const char* nB = has_next ? (const char*)pb : cB;
        for (int t = 0; t < nt; t += 2) {
            const bool last = (t == nt - 2);
            const char* a2 = last ? nA : cA; const char* b2 = last ? nB : cB; const int k2 = last ? 0 : t + 2, k3 = k2 + 1;
            LDB(B0, 0, 0); LDB(B1, 0, 1); SCHED; LDA(At, 0, 0); STA(1, 1, cA, t + 1);
            WAIT_V(8); WAIT_L(0); BAR; MMA(0, 0, At, B0); MMA(0, 1, At, B1); BAR; SCHED;
            LDA(At, 0, 1); STB(0, 0, b2, k2); STB(0, 1, b2, k2); STA(0, 0, a2, k2);
            WAIT_V(8); WAIT_L(0); BAR; MMA(1, 0, At, B0); MMA(1, 1, At, B1); BAR; SCHED;
            LDB(B0, 1, 0); LDB(B1, 1, 1); SCHED; LDA(At, 1, 0); STA(0, 1, a2, k2);
            WAIT_V(8); WAIT_L(0); BAR; MMA(0, 0, At, B0); MMA(0, 1, At, B1); BAR; SCHED;
            LDA(At, 1, 1); STB(1, 0, b2, k3); STB(1, 1, b2, k3); STA(1, 0, a2, k3);
            WAIT_V(8); WAIT_L(0); BAR; MMA(1, 0, At, B0); MMA(1, 1, At, B1); BAR; SCHED;
        }
        if (wr == 0) BAR;
        Ecur(acc, wr, wc, fr, fq);
        if (!has_next) break;
        ZERO_ACC();
        cA = nA; cB = nB; Ecur = Enxt;
        if (wr == 1) BAR;
    }
    WAIT_V(0);
    BAR;
#undef ZERO_ACC
#undef SA
#undef SB
#undef STG
#undef STA
#undef STB
#undef LDA
#undef LDB
#undef MMA
#undef WAIT_V
#undef WAIT_L
#undef BAR
#undef SCHED
}

#define EPI_ROWS(...) _Pragma("unroll") for (int ai = 0; ai < 2; ++ai) _Pragma("unroll") for (int m = 0; m < 4; ++m) { const int rr = ai * 128 + wr * 64 + m * 16 + fr; __VA_ARGS__ }
#define EPI_COLS8(...) _Pragma("unroll") for (int bj = 0; bj < 2; ++bj) { const int cc = bj * 128 + wc * 32 + 8 * fq; const f32x4 v0 = acc[ai][bj][m][0], v1 = acc[ai][bj][m][1]; __VA_ARGS__ }
#define EPI_COLS(...) _Pragma("unroll") for (int bj = 0; bj < 2; ++bj) _Pragma("unroll") for (int n = 0; n < 2; ++n) { const int cc = bj * 128 + wc * 32 + 8 * fq + 4 * n; const f32x4 v = acc[ai][bj][m][n]; __VA_ARGS__ }

struct EpiProj {
    float* upool; bf16_t* Ap; float* uss; int row0, col0;
    DI void set(int pm, int pn) { row0 = pm * 256; col0 = pn * 256; }
    DI void elem(int row, int col, const f32x4 v) const {
        if (col < 512) *(f32x4*)(upool + (size_t)row * 512 + col) = v; else *(f32x4*)(uss + (size_t)(row - NP) * 512 + (col - 512)) = v; }
    DI void operator()(const Acc& acc, int wr, int wc, int fr, int fq) const {
        if (col0 < 512) {
            EPI_ROWS(const size_t row = row0 + rr; EPI_COLS(*(f32x4*)(upool + row * 512 + col0 + cc) = v;))
        } else {
            EPI_ROWS(const int row = row0 + rr;
                EPI_COLS8(const int c2 = col0 - 512 + cc; const int g = c2 >> 4, i = c2 & 15;
                    if (row < NP) { u32x4 w; w.x = pk2(v0[0], v0[1]); w.y = pk2(v0[2], v0[3]); w.z = pk2(v1[0], v1[1]); w.w = pk2(v1[2], v1[3]);
                        *(u32x4*)(Ap + ((size_t)g * 2048 + (row >> 4)) * 384 + 128 + (row & 15) * 16 + i) = w; }
                    else if (row < NT) { *(f32x4*)(uss + (size_t)(row - NP) * 512 + c2) = v0; *(f32x4*)(uss + (size_t)(row - NP) * 512 + c2 + 4) = v1; }))
        }
    }
};
struct EpiS1 {
    float* S; int g, row0;
    DI void set(int mt, int gg) { row0 = mt * 256; g = gg; }
    DI void operator()(const Acc& acc, int wr, int wc, int fr, int fq) const {
        EPI_ROWS(const size_t row = (size_t)g * 2048 + row0 + rr;
            _Pragma("unroll") for (int n = 0; n < 2; ++n) { const int cc = wc * 32 + 8 * fq + 4 * n; *(f32x4*)(S + row * 128 + cc) = acc[ai][0][m][n]; })
    }
};
struct EpiPool {
    bf16_t* ycat; const float* scale; int row0, col0;
    DI void set(int pm, int pn) { row0 = pm * 256; col0 = pn * 256; }
    DI void elem(int row, int col, const f32x4 v) const { const f32x4 s = *(const f32x4*)(scale + col); u32x2 w; w.x = pk2(v[0] * s[0], v[1] * s[1]); w.y = pk2(v[2] * s[2], v[3] * s[3]);
        *(u32x2*)(ycat + (size_t)row * 1024 + col) = w; }
    DI void operator()(const Acc& acc, int wr, int wc, int fr, int fq) const {
        EPI_ROWS(const size_t row = row0 + rr;
            EPI_COLS8(const int col = col0 + cc; const f32x4 s0 = *(const f32x4*)(scale + col), s1 = *(const f32x4*)(scale + col + 4); u32x4 w;
                w.x = pk2(v0[0] * s0[0], v0[1] * s0[1]); w.y = pk2(v0[2] * s0[2], v0[3] * s0[3]); w.z = pk2(v1[0] * s1[0], v1[1] * s1[1]); w.w = pk2(v1[2] * s1[2], v1[3] * s1[3]);
                *(u32x4*)(ycat + row * 1024 + col) = w;))
    }
};
struct EpiS2 {
    bf16_t* z; const bf16_t* Ap; const float* dskip; int g, row0;
    DI void set(int mt, int gg) { row0 = mt * 256; g = gg; }
    DI void operator()(const Acc& acc, int wr, int wc, int fr, int fq) const {
        EPI_ROWS(const int chunk = row0 + rr; const bf16_t* ap = Ap + ((size_t)g * 2048 + chunk) * 384 + 128;
            EPI_COLS8(const int r = cc >> 4, i = cc & 15; const u32x4 uw = *(const u32x4*)(ap + cc); const f32x4 d0 = *(const f32x4*)(dskip + g * 16 + i), d1 = *(const f32x4*)(dskip + g * 16 + i + 4);
                const float y0 = v0[0] + d0[0] * bflo(uw.x), y1 = v0[1] + d0[1] * bfhi(uw.x), y2 = v0[2] + d0[2] * bflo(uw.y), y3 = v0[3] + d0[3] * bfhi(uw.y);
                const float y4 = v1[0] + d1[0] * bflo(uw.z), y5 = v1[1] + d1[1] * bfhi(uw.z), y6 = v1[2] + d1[2] * bflo(uw.w), y7 = v1[3] + d1[3] * bfhi(uw.w);
                u32x4 w; w.x = pk2(gelu_tanh(y0), gelu_tanh(y1)); w.y = pk2(gelu_tanh(y2), gelu_tanh(y3)); w.z = pk2(gelu_tanh(y4), gelu_tanh(y5)); w.w = pk2(gelu_tanh(y6), gelu_tanh(y7));
                *(u32x4*)(z + ((size_t)chunk * 16 + r) * 512 + g * 16 + i) = w;))
    }
};
struct EpiGlu {
    bf16_t* ycat; const bf16_t* z; const float* bglu; int row0, col0;
    DI void set(int pm, int pn) { row0 = pm * 256; col0 = pn * 256; }
    DI void elem(int row, int col, const f32x4 v) const { const u32x2 zw = *(const u32x2*)(z + (size_t)row * 512 + col); const f32x4 b = *(const f32x4*)(bglu + col);
        u32x2 w; w.x = pk2(bflo(zw.x) * sigmoidf_(v[0] + b[0]), bfhi(zw.x) * sigmoidf_(v[1] + b[1])); w.y = pk2(bflo(zw.y) * sigmoidf_(v[2] + b[2]), bfhi(zw.y) * sigmoidf_(v[3] + b[3]));
        *(u32x2*)(ycat + (size_t)row * 1024 + 512 + col) = w; }
    DI void operator()(const Acc& acc, int wr, int wc, int fr, int fq) const {
        EPI_ROWS(const size_t row = row0 + rr;
            EPI_COLS8(const int col = col0 + cc; const u32x4 zw = *(const u32x4*)(z + row * 512 + col); const f32x4 b0 = *(const f32x4*)(bglu + col), b1 = *(const f32x4*)(bglu + col + 4);
                u32x4 w; w.x = pk2(bflo(zw.x) * sigmoidf_(v0[0] + b0[0]), bfhi(zw.x) * sigmoidf_(v0[1] + b0[1]));
                w.y = pk2(bflo(zw.y) * sigmoidf_(v0[2] + b0[2]), bfhi(zw.y) * sigmoidf_(v0[3] + b0[3]));
                w.z = pk2(bflo(zw.z) * sigmoidf_(v1[0] + b1[0]), bfhi(zw.z) * sigmoidf_(v1[1] + b1[1]));
                w.w = pk2(bflo(zw.w) * sigmoidf_(v1[2] + b1[2]), bfhi(zw.w) * sigmoidf_(v1[3] + b1[3]));
                *(u32x4*)(ycat + row * 1024 + 512 + col) = w;))
    }
};
struct EpiY {
    bf16_t* y; int row0, col0;
    DI void set(int pm, int pn) { row0 = pm * 256; col0 = pn * 256; }
    DI void elem(int row, int col, const f32x4 v) const { u32x2 w; w.x = pk2(v[0], v[1]); w.y = pk2(v[2], v[3]); *(u32x2*)(y + (size_t)row * 1024 + col) = w; }
    DI void operator()(const Acc& acc, int wr, int wc, int fr, int fq) const {
        EPI_ROWS(const size_t row = row0 + rr;
            _Pragma("unroll") for (int bj = 0; bj < 2; ++bj) { const int cc = bj * 128 + wc * 32 + 8 * fq; const f32x4 v0 = acc[ai][bj][m][0], v1 = acc[ai][bj][m][1];
                u32x4 w; w.x = pk2(v0[0], v0[1]); w.y = pk2(v0[2], v0[3]); w.z = pk2(v1[0], v1[1]); w.w = pk2(v1[2], v1[3]); *(u32x4*)(y + row * 1024 + col0 + cc) = w; })
    }
};
struct EpiGU {
    bf16_t* hact; int row0, hb;
    DI void set(int pm, int pn) { row0 = pm * 256; hb = pn; }
    DI void elem2(int row, int col, const f32x4 a, const f32x4 u) const { u32x2 w; w.x = pk2(a[0] * sigmoidf_(a[0]) * u[0], a[1] * sigmoidf_(a[1]) * u[1]); w.y = pk2(a[2] * sigmoidf_(a[2]) * u[2], a[3] * sigmoidf_(a[3]) * u[3]);
        *(u32x2*)(hact + (size_t)row * FF + col) = w; }
    DI void operator()(const Acc& acc, int wr, int wc, int fr, int fq) const {
        EPI_ROWS(const size_t row = row0 + rr; const int cc = wc * 32 + 8 * fq; u32x4 w;
            { const f32x4 a = acc[ai][0][m][0], u = acc[ai][1][m][0]; w.x = pk2(a[0] * sigmoidf_(a[0]) * u[0], a[1] * sigmoidf_(a[1]) * u[1]); w.y = pk2(a[2] * sigmoidf_(a[2]) * u[2], a[3] * sigmoidf_(a[3]) * u[3]); }
            { const f32x4 a = acc[ai][0][m][1], u = acc[ai][1][m][1]; w.z = pk2(a[0] * sigmoidf_(a[0]) * u[0], a[1] * sigmoidf_(a[1]) * u[1]); w.w = pk2(a[2] * sigmoidf_(a[2]) * u[2], a[3] * sigmoidf_(a[3]) * u[3]); }
            *(u32x4*)(hact + row * FF + hb * 128 + cc) = w;)
    }
};
struct EpiQKV {
    bf16_t* qkv; float* out; int row0, col0;
    DI void set(int pm, int pn) { row0 = pm * 256; col0 = pn * 256; }
    DI void elem(int row, int colg, const f32x4 v) const {
        const int which = colg >> 10, col = colg & 1023; const float sc = which == 0 ? 0.125f * 1.4426950408889634f : 1.0f;
        u32x2 w; w.x = pk2(v[0] * sc, v[1] * sc); w.y = pk2(v[2] * sc, v[3] * sc);
        *(u32x2*)(qkv + (size_t)which * (65 * MiB / 2) + (size_t)row * 1024 + col) = w;
        if (which != 0) *(f32x4*)(out + (which == 1 ? O_KS : O_VS) + (size_t)(row - NP) * 1024 + col) = v; }
    DI void operator()(const Acc& acc, int wr, int wc, int fr, int fq) const {
        const int which = col0 >> 10; const int cb = col0 & 1023; const float sc = which == 0 ? 0.125f * 1.4426950408889634f : 1.0f;
        bf16_t* dst = qkv + (size_t)which * (65 * MiB / 2);
        float* op = out + (which == 1 ? O_KP : O_VP); float* os = out + (which == 1 ? O_KS : O_VS);
        EPI_ROWS(const int row = row0 + rr;
            EPI_COLS8(const int col = cb + cc; u32x4 w; w.x = pk2(v0[0] * sc, v0[1] * sc); w.y = pk2(v0[2] * sc, v0[3] * sc); w.z = pk2(v1[0] * sc, v1[1] * sc); w.w = pk2(v1[2] * sc, v1[3] * sc);
                *(u32x4*)(dst + (size_t)row * 1024 + col) = w;
                if (which != 0) {
                    if (row < NP) { const int tb = row & (TP - 1); if (tb >= TP - 2048) { float* o = op + ((size_t)(row >> 13) * 2048 + (tb - (TP - 2048))) * 1024 + col; *(f32x4*)o = v0; *(f32x4*)(o + 4) = v1; } }
                    else if (row < NT) { float* o = os + (size_t)(row - NP) * 1024 + col; *(f32x4*)o = v0; *(f32x4*)(o + 4) = v1; }
                }))
    }
};


template <class EpiT> struct UStd {
    typedef EpiT Epi; const bf16_t* A; const bf16_t* Bt; size_t astep, bstep; int acolstep, nM, nN, G, c; EpiT proto;
    DI bool get(int i, const bf16_t*& a, const bf16_t*& b, EpiT& e) const { int pm, pn; if (!unit_next(i, G, c, nM, nN, pm, pn)) return false;
        a = A + (size_t)pm * astep + (size_t)pn * acolstep; b = Bt + (size_t)pn * bstep; e = proto; e.set(pm, pn); return true; }
};
template <class EpiT> struct US5 {
    typedef EpiT Epi; const bf16_t* A; const bf16_t* Bt; size_t bstep; int G, c; EpiT proto;
    DI bool get(int i, const bf16_t*& a, const bf16_t*& b, EpiT& e) const { const int L = c + i * G; if (L >= 256) return false; const int g = L >> 3, mt = L & 7;
        a = A + ((size_t)g * 2048 + mt * 256) * 384; b = Bt + (size_t)g * bstep; e = proto; e.set(mt, g); return true; }
};

DI f32x4 mini_acc(const bf16_t* Arow, const bf16_t* Brow, int K) {
    f32x4 acc = (f32x4){0.f, 0.f, 0.f, 0.f};
    int k0 = 0;
    for (; k0 + 512 <= K; k0 += 512) { bf16x8 a[16], b[16];
#pragma unroll
        for (int e = 0; e < 16; ++e) { a[e] = *(const bf16x8*)(Arow + k0 + 32 * e); b[e] = *(const bf16x8*)(Brow + k0 + 32 * e); }
#pragma unroll
        for (int e = 0; e < 16; ++e) acc = __builtin_amdgcn_mfma_f32_16x16x32_bf16(b[e], a[e], acc, 0, 0, 0); }
    if (k0 < K) { bf16x8 a[8], b[8];
#pragma unroll
        for (int e = 0; e < 8; ++e) { a[e] = *(const bf16x8*)(Arow + k0 + 32 * e); b[e] = *(const bf16x8*)(Brow + k0 + 32 * e); }
#pragma unroll
        for (int e = 0; e < 8; ++e) acc = __builtin_amdgcn_mfma_f32_16x16x32_bf16(b[e], a[e], acc, 0, 0, 0); }
    return acc;
}
DI void mini_acc2(const bf16_t* Arow, const bf16_t* Bg, const bf16_t* Bu, int K, f32x4& ga, f32x4& ua) {
    ga = (f32x4){0.f, 0.f, 0.f, 0.f}; ua = ga;
    for (int k0 = 0; k0 < K; k0 += 256) { bf16x8 a[8], g[8], u[8];
#pragma unroll
        for (int e = 0; e < 8; ++e) { a[e] = *(const bf16x8*)(Arow + k0 + 32 * e); g[e] = *(const bf16x8*)(Bg + k0 + 32 * e); u[e] = *(const bf16x8*)(Bu + k0 + 32 * e); }
#pragma unroll
        for (int e = 0; e < 8; ++e) { ga = __builtin_amdgcn_mfma_f32_16x16x32_bf16(g[e], a[e], ga, 0, 0, 0); ua = __builtin_amdgcn_mfma_f32_16x16x32_bf16(u[e], a[e], ua, 0, 0, 0); } }
}
template <class Epi>
DI void mini_gemm(const bf16_t* A, int lda, const bf16_t* Bt, int ldb, int K, int N, int acol_per_256, const Epi& E, int bx, int G, int wave, int lane) {
    const int fr = lane & 15, fq = lane >> 4; const int row = NP + 16 * wave + fr;
    for (int q = bx; q < N / 16; q += G) {
        const bf16_t* Arow = A + (size_t)row * lda + ((16 * q) >> 8) * acol_per_256 + 8 * fq;
        const bf16_t* Brow = Bt + (size_t)(16 * q + fr) * ldb + 8 * fq;
        const f32x4 acc = mini_acc(Arow, Brow, K);
        E.elem(row, 16 * q + 4 * fq, acc); }
}
DI void mini_gemm_gu(const bf16_t* A, const bf16_t* Bt, const EpiGU& E, int bx, int G, int wave, int lane) {
    const int fr = lane & 15, fq = lane >> 4; const int row = NP + 16 * wave + fr;
    for (int q = bx; q < FF / 16; q += G) { const int hcol = 16 * q; const int brow = (hcol >> 7) * 256 + (hcol & 127) + fr;
        const bf16_t* Arow = A + (size_t)row * DM + 8 * fq;
        f32x4 ga, ua; mini_acc2(Arow, Bt + (size_t)brow * DM + 8 * fq, Bt + (size_t)(brow + 128) * DM + 8 * fq, DM, ga, ua);
        E.elem2(row, hcol + 4 * fq, ga, ua); }
}
DI void transpose_item(const float* W, int N, int k0, int n0, bf16_t* WT, int ldt, int orow0, int ocol0, LAS float* scr, int lane) {
#pragma unroll 16
    for (int i = 0; i < 32; ++i) { const int kk = 2 * i + (lane >> 5); scr[kk * 33 + (lane & 31)] = W[(size_t)(k0 + kk) * N + n0 + (lane & 31)]; }
    LDS_WAIT();
    const int c = lane & 7;
#pragma unroll
    for (int j = 0; j < 4; ++j) { const int n = (lane >> 3) + 8 * j; const LAS float* s = scr + (8 * c) * 33 + n;
        u32x4 o; o.x = pk2(s[0 * 33], s[1 * 33]); o.y = pk2(s[2 * 33], s[3 * 33]); o.z = pk2(s[4 * 33], s[5 * 33]); o.w = pk2(s[6 * 33], s[7 * 33]);
        *(u32x4*)(WT + (size_t)(orow0 + n) * ldt + ocol0 + 8 * c) = o; }
    LDS_WAIT();
}
DI void tr_plain(const float* W, int K, int N, bf16_t* WT, int item, LAS float* scr, int lane) {
    const int nblk = N / 32, kb = item / nblk, nb = item % nblk; transpose_item(W, N, 64 * kb, 32 * nb, WT, K, 32 * nb, 64 * kb, scr, lane);
}

DI const float* in_row(const Params& p, int r) { return r < NP ? p.in[0] + (size_t)r * DM : p.in[1] + (size_t)(r - NP) * DM; }

DI void norm_row(const float* xr, const float* g, bf16_t* o, int lane) {
    f32x4 v[4]; float s = 0.f;
#pragma unroll
    for (int j = 0; j < 4; ++j) { v[j] = *(const f32x4*)(xr + 4 * lane + 256 * j); s += (v[j][0] * v[j][0] + v[j][1] * v[j][1]) + (v[j][2] * v[j][2] + v[j][3] * v[j][3]); }
    const float r = rsqrtf(wave_sum(s) * (1.f / DM) + EPS);
#pragma unroll
    for (int j = 0; j < 4; ++j) { const f32x4 gg = *(const f32x4*)(g + 4 * lane + 256 * j); u32x2 w; w.x = pk2(v[j][0] * r * gg[0], v[j][1] * r * gg[1]); w.y = pk2(v[j][2] * r * gg[2], v[j][3] * r * gg[3]);
        *(u32x2*)(o + 4 * lane + 256 * j) = w; }
}
DI void norm_row2(const float* xa, const float* xb, const float* g, bf16_t* oa, bf16_t* ob, int lane) {
    f32x4 va[4], vb[4]; float sa = 0.f, sb = 0.f;
#pragma unroll
    for (int j = 0; j < 4; ++j) { va[j] = *(const f32x4*)(xa + 4 * lane + 256 * j); vb[j] = *(const f32x4*)(xb + 4 * lane + 256 * j); }
#pragma unroll
    for (int j = 0; j < 4; ++j) { sa += (va[j][0] * va[j][0] + va[j][1] * va[j][1]) + (va[j][2] * va[j][2] + va[j][3] * va[j][3]); sb += (vb[j][0] * vb[j][0] + vb[j][1] * vb[j][1]) + (vb[j][2] * vb[j][2] + vb[j][3] * vb[j][3]); }
    const float ra = rsqrtf(wave_sum(sa) * (1.f / DM) + EPS), rb = rsqrtf(wave_sum(sb) * (1.f / DM) + EPS);
#pragma unroll
    for (int j = 0; j < 4; ++j) { const f32x4 gg = *(const f32x4*)(g + 4 * lane + 256 * j); u32x2 w;
        w.x = pk2(va[j][0] * ra * gg[0], va[j][1] * ra * gg[1]); w.y = pk2(va[j][2] * ra * gg[2], va[j][3] * ra * gg[3]); *(u32x2*)(oa + 4 * lane + 256 * j) = w;
        w.x = pk2(vb[j][0] * rb * gg[0], vb[j][1] * rb * gg[1]); w.y = pk2(vb[j][2] * rb * gg[2], vb[j][3] * rb * gg[3]); *(u32x2*)(ob + 4 * lane + 256 * j) = w; }
}
template <bool INB, bool OUTB>
DI void res_row(const void* hin_, const bf16_t* y, const float* gpost, const float* gnext, void* hout_, bf16_t* xn, int lane) {
    u32x2 yw[4]; float ss = 0.f;
#pragma unroll
    for (int j = 0; j < 4; ++j) { yw[j] = *(const u32x2*)(y + 4 * lane + 256 * j); const float a = bflo(yw[j].x), b = bfhi(yw[j].x), c = bflo(yw[j].y), d = bfhi(yw[j].y); ss += (a * a + b * b) + (c * c + d * d); }
    const float r1 = rsqrtf(wave_sum(ss) * (1.f / DM) + EPS);
    f32x4 h[4]; float s2 = 0.f;
#pragma unroll
    for (int j = 0; j < 4; ++j) { const int c = 4 * lane + 256 * j; f32x4 hv;
        if (INB) { const u32x2 hw = *(const u32x2*)((const bf16_t*)hin_ + c); hv = (f32x4){bflo(hw.x), bfhi(hw.x), bflo(hw.y), bfhi(hw.y)}; } else hv = *(const f32x4*)((const float*)hin_ + c);
        const f32x4 gp = *(const f32x4*)(gpost + c);
        h[j][0] = hv[0] + bflo(yw[j].x) * r1 * gp[0]; h[j][1] = hv[1] + bfhi(yw[j].x) * r1 * gp[1]; h[j][2] = hv[2] + bflo(yw[j].y) * r1 * gp[2]; h[j][3] = hv[3] + bfhi(yw[j].y) * r1 * gp[3];
        if (OUTB) { u32x2 w; w.x = pk2(h[j][0], h[j][1]); w.y = pk2(h[j][2], h[j][3]); *(u32x2*)((bf16_t*)hout_ + c) = w;
            h[j] = (f32x4){bflo(w.x), bfhi(w.x), bflo(w.y), bfhi(w.y)}; }
        else *(f32x4*)((float*)hout_ + c) = h[j];
        s2 += (h[j][0] * h[j][0] + h[j][1] * h[j][1]) + (h[j][2] * h[j][2] + h[j][3] * h[j][3]); }
    if (xn) {
        const float r2 = rsqrtf(wave_sum(s2) * (1.f / DM) + EPS);
#pragma unroll
        for (int j = 0; j < 4; ++j) { const int c = 4 * lane + 256 * j; const f32x4 gn = *(const f32x4*)(gnext + c); u32x2 w; w.x = pk2(h[j][0] * r2 * gn[0], h[j][1] * r2 * gn[1]); w.y = pk2(h[j][2] * r2 * gn[2], h[j][3] * r2 * gn[3]);
            *(u32x2*)(xn + c) = w; }
    }
}

template <bool INB, bool OUTB, int R>
DI void res_rows(const void* const (&hin_)[R], const bf16_t* const (&y)[R], const float* gpost, const float* gnext, void* const (&hout_)[R], bf16_t* const (&xn)[R], const bool has_xn, int lane) {
    u32x4 yw[R][2]; f32x4 hv[R][2][2];
#pragma unroll
    for (int q = 0; q < R; ++q)
#pragma unroll
        for (int j = 0; j < 2; ++j) { const int c = 8 * lane + 512 * j; yw[q][j] = *(const u32x4*)(y[q] + c);
            if (INB) { const u32x4 hw = *(const u32x4*)((const bf16_t*)hin_[q] + c); hv[q][j][0] = (f32x4){bflo(hw.x), bfhi(hw.x), bflo(hw.y), bfhi(hw.y)}; hv[q][j][1] = (f32x4){bflo(hw.z), bfhi(hw.z), bflo(hw.w), bfhi(hw.w)}; }
            else { hv[q][j][0] = *(const f32x4*)((const float*)hin_[q] + c); hv[q][j][1] = *(const f32x4*)((const float*)hin_[q] + c + 4); } }
    f32x4 gp[2][2];
#pragma unroll
    for (int j = 0; j < 2; ++j) { gp[j][0] = *(const f32x4*)(gpost + 8 * lane + 512 * j); gp[j][1] = *(const f32x4*)(gpost + 8 * lane + 512 * j + 4); }
#pragma unroll
    for (int q = 0; q < R; ++q) {
        f32x4 yv[2][2]; float ss = 0.f;
#pragma unroll
        for (int j = 0; j < 2; ++j) { yv[j][0] = (f32x4){bflo(yw[q][j].x), bfhi(yw[q][j].x), bflo(yw[q][j].y), bfhi(yw[q][j].y)}; yv[j][1] = (f32x4){bflo(yw[q][j].z), bfhi(yw[q][j].z), bflo(yw[q][j].w), bfhi(yw[q][j].w)};
#pragma unroll
            for (int e = 0; e < 2; ++e) ss += (yv[j][e][0] * yv[j][e][0] + yv[j][e][1] * yv[j][e][1]) + (yv[j][e][2] * yv[j][e][2] + yv[j][e][3] * yv[j][e][3]); }
        const float r1 = rsqrtf(wave_sum(ss) * (1.f / DM) + EPS);
        float s2 = 0.f;
#pragma unroll
        for (int j = 0; j < 2; ++j) { const int c = 8 * lane + 512 * j; f32x4 h0 = hv[q][j][0] + yv[j][0] * r1 * gp[j][0], h1 = hv[q][j][1] + yv[j][1] * r1 * gp[j][1];
            if (OUTB) { u32x4 w; w.x = pk2(h0[0], h0[1]); w.y = pk2(h0[2], h0[3]); w.z = pk2(h1[0], h1[1]); w.w = pk2(h1[2], h1[3]); *(u32x4*)((bf16_t*)hout_[q] + c) = w;
                h0 = (f32x4){bflo(w.x), bfhi(w.x), bflo(w.y), bfhi(w.y)}; h1 = (f32x4){bflo(w.z), bfhi(w.z), bflo(w.w), bfhi(w.w)}; }
            else { *(f32x4*)((float*)hout_[q] + c) = h0; *(f32x4*)((float*)hout_[q] + c + 4) = h1; }
            s2 += (h0[0] * h0[0] + h0[1] * h0[1]) + (h0[2] * h0[2] + h0[3] * h0[3]) + (h1[0] * h1[0] + h1[1] * h1[1]) + (h1[2] * h1[2] + h1[3] * h1[3]);
            hv[q][j][0] = h0; hv[q][j][1] = h1; }
        if (has_xn) { const float r2 = rsqrtf(wave_sum(s2) * (1.f / DM) + EPS);
#pragma unroll
            for (int j = 0; j < 2; ++j) { const int c = 8 * lane + 512 * j; const f32x4 g0 = *(const f32x4*)(gnext + c), g1 = *(const f32x4*)(gnext + c + 4); const f32x4 a = hv[q][j][0] * r2 * g0, bb = hv[q][j][1] * r2 * g1;
                u32x4 w; w.x = pk2(a[0], a[1]); w.y = pk2(a[2], a[3]); w.z = pk2(bb[0], bb[1]); w.w = pk2(bb[2], bb[3]); *(u32x4*)(xn[q] + c) = w; } }
    }
}

struct RowPass { int mode; const float* gpost; const float* gnext; const float* xp; const float* xs; bf16_t* h16; const bf16_t* y; bf16_t* xnp; float* out;
    DI void row(int r, int lane) const {
        const bf16_t* yr = y + (size_t)r * DM; bf16_t* hr = h16 + (size_t)r * DM;
        if (mode == 0) res_row<false, true>(r < NP ? xp + (size_t)r * DM : xs + (size_t)(r - NP) * DM, yr, gpost, gnext, hr, xnp + (size_t)r * DM, lane);
        else if (mode == 1) res_row<true, true>(hr, yr, gpost, gnext, hr, xnp + (size_t)r * DM, lane);
        else res_row<true, false>(hr, yr, gpost, gnext, r < NP ? out + O_YP + (size_t)r * DM : out + O_YS + (size_t)(r - NP) * DM, nullptr, lane);
    }
    DI void rows4(int r0, int lane) const {
        const void* hin[4]; const bf16_t* yr[4]; void* ho[4]; bf16_t* xo[4];
#pragma unroll
        for (int q = 0; q < 4; ++q) { const size_t o = (size_t)(r0 + q) * DM; yr[q] = y + o; xo[q] = xnp + o;
            hin[q] = mode == 0 ? (const void*)(xp + o) : (const void*)(h16 + o); ho[q] = mode == 2 ? (void*)(out + O_YP + o) : (void*)(h16 + o); }
        if (mode == 0) res_rows<false, true, 4>(hin, yr, gpost, gnext, ho, xo, true, lane);
        else if (mode == 1) res_rows<true, true, 4>(hin, yr, gpost, gnext, ho, xo, true, lane);
        else res_rows<true, false, 4>(hin, yr, gpost, gnext, ho, xo, false, lane);
    }
    DI void rows8(int r0, int lane) const {
        const void* hin[8]; const bf16_t* yr[8]; void* ho[8]; bf16_t* xo[8];
#pragma unroll
        for (int q = 0; q < 8; ++q) { const size_t o = (size_t)(r0 + q) * DM; yr[q] = y + o; xo[q] = xnp + o;
            hin[q] = mode == 0 ? (const void*)(xp + o) : (const void*)(h16 + o); ho[q] = mode == 2 ? (void*)(out + O_YP + o) : (void*)(h16 + o); }
        if (mode == 0) res_rows<false, true, 8>(hin, yr, gpost, gnext, ho, xo, true, lane);
        else if (mode == 1) res_rows<true, true, 8>(hin, yr, gpost, gnext, ho, xo, true, lane);
        else res_rows<true, false, 8>(hin, yr, gpost, gnext, ho, xo, false, lane);
    }
};

DI void s5_tables(const Params& p, int g, LAS unsigned char* lds, bf16_t* Bt1, bf16_t* Bt2, const int tid) {
    LAS float* pwr = (LAS float*)lds;
    LAS float* pwi = pwr + 17 * 64;
    LAS float* bbr = pwi + 17 * 64;
    LAS float* bbi = bbr + 1024;
    LAS float* cr = bbi + 1024;
    LAS float* ci = cr + 1024;
    LAS float* Kd = ci + 1024;
    const float dt = __expf(p.in[12][g]);
    const float* lre = p.in[10] + g * 64; const float* lim = p.in[11] + g * 64;
    for (int it = tid; it < 17 * 64; it += 512) { const int d = it >> 6, q = it & 63; const float zr = lre[q] * dt * (float)d, zi = lim[q] * dt * (float)d;
        float s, c; sincos_acc(zi, s, c); const float mag = __expf(zr); pwr[it] = mag * c; pwi[it] = mag * s; }
    for (int it = tid; it < 1024; it += 512) { const int q = it >> 4, i = it & 15;
        const float lr = lre[q], li = lim[q], zr = lr * dt, zi = li * dt;
        float s, c, sh, ch; sincos_acc(zi, s, c); sincos_acc(0.5f * zi, sh, ch);
        const float em1 = expm1f(zr); const float nr = em1 * c - 2.f * sh * sh, ni = (em1 + 1.f) * s;
        const float den = 1.f / (lr * lr + li * li); const float fr_ = (nr * lr + ni * li) * den, fi_ = (ni * lr - nr * li) * den;
        const float br = p.in[13][(size_t)g * 1024 + it], bi = p.in[14][(size_t)g * 1024 + it];
        bbr[it] = fr_ * br - fi_ * bi; bbi[it] = fr_ * bi + fi_ * br;
        cr[it] = p.in[15][(size_t)g * 1024 + it]; ci[it] = p.in[16][(size_t)g * 1024 + it]; }
    __syncthreads();
    for (int it = tid; it < 4096; it += 512) { const int d = it >> 8, i = (it >> 4) & 15, j = it & 15; float a = 0.f;
        for (int q = 0; q < 64; ++q) { const float c_r = cr[i * 64 + q], c_i = ci[i * 64 + q], p_r = pwr[d * 64 + q], p_i = pwi[d * 64 + q];
            const float xr = c_r * p_r - c_i * p_i, xi = c_r * p_i + c_i * p_r; a += xr * bbr[q * 16 + j] - xi * bbi[q * 16 + j]; }
        Kd[it] = a; }
    __syncthreads();
    for (int it = tid; it < 256 * 32; it += 512) { const int n = it >> 5, k0 = (it & 31) * 8; float v[8];
#pragma unroll
        for (int e = 0; e < 8; ++e) { const int k = k0 + e, s = k >> 4, i = k & 15; float val = 0.f;
            if (n < 128) { const int q = n & 63; const float p_r = pwr[(15 - s) * 64 + q], p_i = pwi[(15 - s) * 64 + q], b_r = bbr[q * 16 + i], b_i = bbi[q * 16 + i];
                val = n < 64 ? (p_r * b_r - p_i * b_i) : (p_r * b_i + p_i * b_r); }
            v[e] = val; }
        u32x4 o; o.x = pk2(v[0], v[1]); o.y = pk2(v[2], v[3]); o.z = pk2(v[4], v[5]); o.w = pk2(v[6], v[7]);
        *(u32x4*)(Bt1 + (size_t)n * 256 + k0) = o; }
    for (int it = tid; it < 256 * 48; it += 512) { const int n = it / 48, k0 = (it % 48) * 8; const int r = n >> 4, i = n & 15; float v[8];
#pragma unroll
        for (int e = 0; e < 8; ++e) { const int k = k0 + e; float val;
            if (k < 128) { const int q = k & 63; const float c_r = cr[i * 64 + q], c_i = ci[i * 64 + q], p_r = pwr[(r + 1) * 64 + q], p_i = pwi[(r + 1) * 64 + q];
                val = k < 64 ? (c_r * p_r - c_i * p_i) : -(c_r * p_i + c_i * p_r); }
            else { const int kk = k - 128, s = kk >> 4, j = kk & 15; val = s <= r ? Kd[(r - s) * 256 + i * 16 + j] : 0.f; }
            v[e] = val; }
        u32x4 o; o.x = pk2(v[0], v[1]); o.y = pk2(v[2], v[3]); o.z = pk2(v[4], v[5]); o.w = pk2(v[6], v[7]);
        *(u32x4*)(Bt2 + (size_t)n * 384 + k0) = o; }
    __syncthreads();
}

DI void s5_sample_unit(const Params& p, int u, const float* uss, bf16_t* z, int lane) {
    const int g = u & 31, b = u >> 5;
    const float dt = __expf(p.in[12][g]);
    const float lr = p.in[10][g * 64 + lane], li = p.in[11][g * 64 + lane], zr = lr * dt, zi = li * dt;
    float s, c, sh, ch; sincos_acc(zi, s, c); sincos_acc(0.5f * zi, sh, ch);
    const float em1 = expm1f(zr); const float nr = em1 * c - 2.f * sh * sh, ni = (em1 + 1.f) * s;
    const float lbr = nr + 1.f, lbi = ni;
    const float den = 1.f / (lr * lr + li * li); const float fr_ = (nr * lr + ni * li) * den, fi_ = (ni * lr - nr * li) * den;
    float hr = p.in[3][(((size_t)b * 32 + g) * 64 + lane) * 2], hi = p.in[3][(((size_t)b * 32 + g) * 64 + lane) * 2 + 1];
    const float* bre = p.in[13] + ((size_t)g * 64 + lane) * 16; const float* bim = p.in[14] + ((size_t)g * 64 + lane) * 16;
    const float* cre = p.in[15] + (size_t)g * 1024 + lane; const float* cim = p.in[16] + (size_t)g * 1024 + lane;
    for (int t = 0; t < 4; ++t) {
        const float* ur = uss + (size_t)(b * 4 + t) * 512 + g * 16;
        float bur = 0.f, bui = 0.f;
#pragma unroll
        for (int i = 0; i < 16; ++i) { const float uv = ur[i]; const float br = bre[i], bi = bim[i]; bur += (fr_ * br - fi_ * bi) * uv; bui += (fr_ * bi + fi_ * br) * uv; }
        const float n_r = lbr * hr - lbi * hi + bur, n_i = lbr * hi + lbi * hr + bui; hr = n_r; hi = n_i;
        float yv = 0.f;
#pragma unroll
        for (int i = 0; i < 16; ++i) { float a = cre[i * 64] * hr - cim[i * 64] * hi; a = wave_sum(a); if (lane == i) yv = a; }
        if (lane < 16) { const float y = yv + p.in[17][g * 16 + lane] * ur[lane]; z[(size_t)(NP + b * 4 + t) * 512 + g * 16 + lane] = (bf16_t)(pk2(gelu_tanh(y), 0.f) & 0xffffu); }
    }
    float* o = p.out + O_S5S + (((size_t)b * 32 + g) * 64 + lane) * 2; o[0] = hr; o[1] = hi;
}

constexpr int ATT_BUF = 69632, ATT_VOFF = 34816, ATT_OST = 2 * ATT_BUF, LDS_CTL = ATT_OST + 8 * 2304;
struct AttUnit { int pat, b, h, dil, l0; size_t rowbase; };
DI AttUnit att_decode(int bu) { AttUnit u; const int tile = bu & 63; u.h = (bu >> 6) & 15; u.b = (bu >> 10) & 3; u.pat = bu >> 12; const int dsh = u.pat * 2; u.dil = 1 << dsh;
    const int rho = tile & (u.dil - 1); u.l0 = (tile >> dsh) * 128; u.rowbase = (size_t)u.b * TP + rho; return u; }
DI void att_stage(const AttUnit& u, const bf16_t* Kb, const bf16_t* Vb, LAS unsigned char* buf, int wave, int lane) {
    const int lmax = (TP >> (2 * u.pat)) - 1;
    for (int n = wave; n < 34; n += 8) { const int r0 = n * 8; const int row = r0 + (lane >> 3); const int c = (lane & 7) ^ (row & 7);
        int lk = u.l0 - 128 + row; lk = lk < 0 ? 0 : (lk > lmax ? lmax : lk); const size_t off = (u.rowbase + (size_t)u.dil * lk) * 1024 + u.h * 64 + c * 8;
        __builtin_amdgcn_global_load_lds((const unsigned*)(Kb + off), (LAS unsigned*)(buf + r0 * 128), 16, 0, 0);
        __builtin_amdgcn_global_load_lds((const unsigned*)(Vb + off), (LAS unsigned*)(buf + ATT_VOFF + r0 * 128), 16, 0, 0); }
}
DI void att_loadq(const AttUnit& u, const bf16_t* Q, int wave, int lane, bf16x8 (&qf)[2]) {
    const int i = lane & 15, g = lane >> 4; const bf16_t* q = Q + (u.rowbase + (size_t)u.dil * (u.l0 + 16 * wave + i)) * 1024 + u.h * 64 + 8 * g;
    qf[0] = *(const bf16x8*)q; qf[1] = *(const bf16x8*)(q + 32);
}
DI void att_compute(const AttUnit& u, const bf16x8 (&qf)[2], LAS unsigned char* buf, LAS unsigned char* ost, bf16_t* Op, float* lse, bf16_t* attp, int wave, int lane) {
    const int i = lane & 15, g = lane >> 4;
    const int Lw = u.l0 + 16 * wave;
    unsigned koff[2][2], voff[4];
#pragma unroll
    for (int kbl = 0; kbl < 2; ++kbl)
#pragma unroll
        for (int s = 0; s < 2; ++s) koff[kbl][s] = (unsigned)((16 * wave + 16 * kbl + i) * 128 + (((4 * s + g) ^ (i & 7)) * 16));
    { const int q = i >> 2, pp = i & 3, r = 4 * g + q;
#pragma unroll
      for (int db = 0; db < 4; ++db) voff[db] = (unsigned)((16 * wave + r) * 128 + (((2 * db + (pp >> 1)) ^ (r & 7)) * 16) + 8 * (pp & 1)); }
    u32x4 pa[2], pb[2]; float pl0[2], pl1[2];
    if (u.pat == 2) {
#pragma unroll
        for (int n = 0; n < 2; ++n) { const int c = lane + 64 * n, rr = c >> 3, ch = c & 7; const size_t trow = u.rowbase + (size_t)u.dil * (Lw + rr);
            pl0[n] = lse[trow * 16 + u.h]; pl1[n] = lse[((size_t)MT + trow) * 16 + u.h];
            pa[n] = *(const u32x4*)(Op + trow * 1024 + u.h * 64 + ch * 8); pb[n] = *(const u32x4*)(Op + ((size_t)MT + trow) * 1024 + u.h * 64 + ch * 8); }
    } else { pa[0] = pa[1] = pb[0] = pb[1] = (u32x4){0u, 0u, 0u, 0u}; pl0[0] = pl0[1] = pl1[0] = pl1[1] = 0.f; }
    f32x4 st[5][2];
#pragma unroll
    for (int ks = 0; ks < 5; ++ks)
#pragma unroll
        for (int kbl = 0; kbl < 2; ++kbl) {
            if (ks == 4 && kbl == 1) { st[ks][kbl] = (f32x4){0.f, 0.f, 0.f, 0.f}; continue; }
            const bf16x8 k0 = *(const LAS bf16x8*)(buf + ks * 4096 + koff[kbl][0]), k1 = *(const LAS bf16x8*)(buf + ks * 4096 + koff[kbl][1]);
            f32x4 a = (f32x4){0.f, 0.f, 0.f, 0.f};
            a = __builtin_amdgcn_mfma_f32_16x16x32_bf16(k0, qf[0], a, 0, 0, 0);
            a = __builtin_amdgcn_mfma_f32_16x16x32_bf16(k1, qf[1], a, 0, 0, 0); st[ks][kbl] = a; }
#pragma unroll
    for (int r = 0; r < 4; ++r) { if (i > 4 * g + r) st[0][0][r] = -INFINITY; if (4 * g + r > i) st[4][0][r] = -INFINITY; }
    if (Lw < 128) {
#pragma unroll
        for (int ks = 0; ks < 4; ++ks)
#pragma unroll
            for (int kbl = 0; kbl < 2; ++kbl)
#pragma unroll
                for (int r = 0; r < 4; ++r) if (Lw - 128 + 32 * ks + 16 * kbl + 4 * g + r < 0) st[ks][kbl][r] = -INFINITY; }
    float mx = -INFINITY;
#pragma unroll
    for (int ks = 0; ks < 5; ++ks)
#pragma unroll
        for (int kbl = 0; kbl < 2; ++kbl) { if (ks == 4 && kbl == 1) continue;
#pragma unroll
            for (int r = 0; r < 4; ++r) mx = fmaxf(mx, st[ks][kbl][r]); }
    mx = fmaxf(mx, __shfl_xor(mx, 16)); mx = fmaxf(mx, __shfl_xor(mx, 32));
    float ps = 0.f; bf16x8 pf[5];
#pragma unroll
    for (int ks = 0; ks < 5; ++ks) {
#pragma unroll
        for (int kbl = 0; kbl < 2; ++kbl) { if (ks == 4 && kbl == 1) continue;
#pragma unroll
            for (int r = 0; r < 4; ++r) { const float pv = __builtin_amdgcn_exp2f(st[ks][kbl][r] - mx); st[ks][kbl][r] = pv; ps += pv; } }
        u32x4 pw; pw.x = pk2(st[ks][0][0], st[ks][0][1]); pw.y = pk2(st[ks][0][2], st[ks][0][3]); pw.z = pk2(st[ks][1][0], st[ks][1][1]); pw.w = pk2(st[ks][1][2], st[ks][1][3]);
        pf[ks] = __builtin_bit_cast(bf16x8, pw); }
    ps += __shfl_xor(ps, 16); ps += __shfl_xor(ps, 32);
    f32x4 o[4];
#pragma unroll
    for (int db = 0; db < 4; ++db) o[db] = (f32x4){0.f, 0.f, 0.f, 0.f};
    const unsigned vb = (unsigned)(size_t)buf + (unsigned)ATT_VOFF;
#pragma unroll
    for (int ks = 0; ks < 5; ++ks) {
        s16x4 lo[4], hi[4]; const unsigned va = vb + ks * 4096;
        asm volatile("ds_read_b64_tr_b16 %0, %8\n\tds_read_b64_tr_b16 %1, %9\n\tds_read_b64_tr_b16 %2, %10\n\tds_read_b64_tr_b16 %3, %11\n\t"
                     "ds_read_b64_tr_b16 %4, %8 offset:2048\n\tds_read_b64_tr_b16 %5, %9 offset:2048\n\tds_read_b64_tr_b16 %6, %10 offset:2048\n\tds_read_b64_tr_b16 %7, %11 offset:2048\n\t"
                     "s_waitcnt lgkmcnt(0)"
                     : "=&v"(lo[0]), "=&v"(lo[1]), "=&v"(lo[2]), "=&v"(lo[3]), "=&v"(hi[0]), "=&v"(hi[1]), "=&v"(hi[2]), "=&v"(hi[3])
                     : "v"(va + voff[0]), "v"(va + voff[1]), "v"(va + voff[2]), "v"(va + voff[3]) : "memory");
#pragma unroll
        for (int db = 0; db < 4; ++db) { const bf16x8 vf = __builtin_shufflevector(lo[db], hi[db], 0, 1, 2, 3, 4, 5, 6, 7);
            o[db] = __builtin_amdgcn_mfma_f32_16x16x32_bf16(vf, pf[ks], o[db], 0, 0, 0); }
    }
    const float inv = 1.f / ps;
#pragma unroll
    for (int db = 0; db < 4; ++db) { const f32x4 v = o[db] * inv; u32x2 w; w.x = pk2(v[0], v[1]); w.y = pk2(v[2], v[3]); *(LAS u32x2*)(ost + i * 144 + (16 * db + 4 * g) * 2) = w; }
    if (u.pat == 2) {
        if (g == 0) *(LAS float*)(ost + i * 144 + 128) = mx + __builtin_amdgcn_logf(ps);
        LDS_WAIT();
#pragma unroll
        for (int n = 0; n < 2; ++n) { const int c = lane + 64 * n, rr = c >> 3, ch = c & 7; const size_t trow = u.rowbase + (size_t)u.dil * (Lw + rr);
            const u32x4 v = *(const LAS u32x4*)(ost + rr * 144 + ch * 16); const float l2 = *(const LAS float*)(ost + rr * 144 + 128);
            const float l0 = pl0[n], l1 = pl1[n]; const u32x4 a = pa[n], b = pb[n];
            const float mxl = fmaxf(l0, fmaxf(l1, l2)); float w0 = __builtin_amdgcn_exp2f(l0 - mxl), w1 = __builtin_amdgcn_exp2f(l1 - mxl), w2 = __builtin_amdgcn_exp2f(l2 - mxl);
            const float winv = __builtin_amdgcn_rcpf(w0 + w1 + w2); w0 *= winv; w1 *= winv; w2 *= winv;
            u32x4 r;
            r.x = pk2(w0 * bflo(a.x) + w1 * bflo(b.x) + w2 * bflo(v.x), w0 * bfhi(a.x) + w1 * bfhi(b.x) + w2 * bfhi(v.x));
            r.y = pk2(w0 * bflo(a.y) + w1 * bflo(b.y) + w2 * bflo(v.y), w0 * bfhi(a.y) + w1 * bfhi(b.y) + w2 * bfhi(v.y));
            r.z = pk2(w0 * bflo(a.z) + w1 * bflo(b.z) + w2 * bflo(v.z), w0 * bfhi(a.z) + w1 * bfhi(b.z) + w2 * bfhi(v.z));
            r.w = pk2(w0 * bflo(a.w) + w1 * bflo(b.w) + w2 * bflo(v.w), w0 * bfhi(a.w) + w1 * bfhi(b.w) + w2 * bfhi(v.w));
            *(u32x4*)(attp + trow * 1024 + u.h * 64 + ch * 8) = r; }
        LDS_WAIT();
    } else {
    const size_t orow0 = (size_t)u.pat * MT + u.rowbase;
    if (g == 0) lse[(orow0 + (size_t)u.dil * (Lw + i)) * 16 + u.h] = mx + __builtin_amdgcn_logf(ps);
    LDS_WAIT();
#pragma unroll
    for (int n = 0; n < 2; ++n) { const int c = lane + 64 * n, rr = c >> 3, ch = c & 7; const u32x4 v = *(const LAS u32x4*)(ost + rr * 144 + ch * 16);
        *(u32x4*)(Op + (orow0 + (size_t)u.dil * (Lw + rr)) * 1024 + u.h * 64 + ch * 8) = v; }
    LDS_WAIT();
    }
}
struct XcdBarrier; DI void xcd_barrier(const XcdBarrier& b);
DI void attn_prompt_phase(const bf16_t* Q, const bf16_t* Kb, const bf16_t* Vb, bf16_t* Op, float* lse, bf16_t* attp, const XcdBarrier& xbar, LAS unsigned char* lds, int bx, int G, int wave, int lane) {
    constexpr int NU = 3 * 4096;
    int bu = bx; if (bu >= NU) return;
    AttUnit u = att_decode(bu); bf16x8 qn[2];
    att_stage(u, Kb, Vb, lds, wave, lane); att_loadq(u, Q, wave, lane, qn);
    int par = 0;
    for (;;) {
        asm volatile("s_waitcnt vmcnt(0)" ::: "memory");
        __syncthreads();
        bf16x8 qf[2]; qf[0] = qn[0]; qf[1] = qn[1];
        const AttUnit cur = u; const int nb = bu + G; const bool more = nb < NU;
        if (more) { u = att_decode(nb); att_stage(u, Kb, Vb, lds + (par ^ 1) * ATT_BUF, wave, lane); att_loadq(u, Q, wave, lane, qn); }
        att_compute(cur, qf, lds + par * ATT_BUF, lds + ATT_OST + wave * 2304, Op, lse, attp, wave, lane);
        if (!more) break;
        if (cur.pat == 1 && u.pat == 2) xcd_barrier(xbar);
        bu = nb; par ^= 1;
    }
    __syncthreads();
}

DI void attn_sample_unit(const Params& p, int u, const bf16_t* Q, const bf16_t* Kb, const bf16_t* Vb, bf16_t* att, LAS float* sl, int lane) {
    const int h = u & 15, t = (u >> 4) & 3, b = u >> 6;
    const size_t qrow = (size_t)NP + b * 4 + t;
    const float* ck = p.in[4]; const float* cv = p.in[5];
    sl[lane] = bf2f(Q[qrow * 1024 + h * 64 + lane]);
    LDS_WAIT();
    float mx = -INFINITY;
#pragma unroll 1
    for (int e = 0; e < 9; ++e) { const int pat = e / 3, r = e - 3 * pat; const int dil = 1 << (2 * pat);
        const int j = lane + 64 * r; const bool valid = j <= 128; const int idx = 2048 + t - dil * (valid ? j : 0);
        float dot = 0.f;
        if (idx >= 2048) { const bf16_t* kp = Kb + ((size_t)NP + b * 4 + (idx - 2048)) * 1024 + h * 64;
#pragma unroll
            for (int d8 = 0; d8 < 8; ++d8) { const u32x4 kw = *(const u32x4*)(kp + 8 * d8); const f32x4 q0 = *(const LAS f32x4*)(sl + 8 * d8), q1 = *(const LAS f32x4*)(sl + 8 * d8 + 4);
                dot += (bflo(kw.x) * q0[0] + bfhi(kw.x) * q0[1]) + (bflo(kw.y) * q0[2] + bfhi(kw.y) * q0[3]) + (bflo(kw.z) * q1[0] + bfhi(kw.z) * q1[1]) + (bflo(kw.w) * q1[2] + bfhi(kw.w) * q1[3]); } }
        else { const float* kp = ck + (((size_t)b * 2048 + idx) * 16 + h) * 64;
#pragma unroll
            for (int d4 = 0; d4 < 16; ++d4) { const f32x4 kv = *(const f32x4*)(kp + 4 * d4); const f32x4 qv = *(const LAS f32x4*)(sl + 4 * d4); dot += (kv[0] * qv[0] + kv[1] * qv[1]) + (kv[2] * qv[2] + kv[3] * qv[3]); } }
        if (valid) { sl[64 + pat * 192 + j] = dot; mx = fmaxf(mx, dot); } }
    mx = wave_max(mx);
    LDS_WAIT();
    float ls = 0.f;
#pragma unroll 1
    for (int e = 0; e < 9; ++e) { const int pat = e / 3, r = e - 3 * pat; const int j = lane + 64 * r;
        if (j <= 128) { const float pv = __builtin_amdgcn_exp2f(sl[64 + pat * 192 + j] - mx); sl[64 + pat * 192 + j] = pv; ls += pv; } }
    ls = wave_sum(ls);
    LDS_WAIT();
    { const int kg = lane >> 4, d4 = lane & 15; f32x4 acc = (f32x4){0.f, 0.f, 0.f, 0.f};
#pragma unroll 1
      for (int pat = 0; pat < 3; ++pat) { const int dil = 1 << (2 * pat);
#pragma unroll
        for (int jj = 0; jj < 33; ++jj) { const int j = kg + 4 * jj; int idx = 2048 + t - dil * j; const bool use = (j <= 128) && (idx < 2048);
            idx = idx < 0 ? 0 : (idx > 2047 ? 2047 : idx); const float pv = use ? sl[64 + pat * 192 + (j > 128 ? 128 : j)] : 0.f;
            const f32x4 vv = *(const f32x4*)(cv + (((size_t)b * 2048 + idx) * 16 + h) * 64 + 4 * d4);
            acc += vv * pv; }
        if (kg == 0) { for (int j = 0; dil * j <= t; ++j) { const int idx = 2048 + t - dil * j; const float pv = sl[64 + pat * 192 + j];
            const u32x2 w = *(const u32x2*)(Vb + ((size_t)NP + b * 4 + (idx - 2048)) * 1024 + h * 64 + 4 * d4);
            acc += (f32x4){bflo(w.x), bfhi(w.x), bflo(w.y), bfhi(w.y)} * pv; } } }
#pragma unroll
      for (int e = 0; e < 4; ++e) { float a = acc[e]; a += __shfl_xor(a, 16); a += __shfl_xor(a, 32); acc[e] = a; }
      const float inv = 1.f / ls;
      if (kg == 0) { u32x2 w; w.x = pk2(acc[0] * inv, acc[1] * inv); w.y = pk2(acc[2] * inv, acc[3] * inv); *(u32x2*)(att + qrow * 1024 + h * 64 + 4 * d4) = w; } }
    LDS_WAIT();
}


#define XB_TMO      128
#define XB_XCNT(j)  (256  + 64 * (j))
#define XB_XSUB(j)  (1280 + 64 * (j))
#define XB_XGEN(j)  (2304 + 64 * (j))
#define XB_TOP      3328
#define XB_TOPGEN   3392
#define XCD_BAR_WORDS 3456
#define XB_SPIN_CAP (1u << 22)
DI unsigned xb_ld(unsigned* p)              { return __hip_atomic_load(p, __ATOMIC_RELAXED, __HIP_MEMORY_SCOPE_AGENT); }
DI unsigned xb_add(unsigned* p, unsigned v) { return __hip_atomic_fetch_add(p, v, __ATOMIC_RELAXED, __HIP_MEMORY_SCOPE_AGENT); }
DI unsigned xb_xcc_id() { return (unsigned)__builtin_amdgcn_s_getreg((3 << 11) | 20) & 0xFu; }
#define XB_SPIN(cond, bar) do { unsigned _sp = 0; while (cond) { __builtin_amdgcn_s_sleep(1); \
    if ((++_sp & 255u) == 0u) { if (xb_ld(&(bar)[XB_TMO])) break; if (_sp > XB_SPIN_CAP) { atomicAdd(&(bar)[XB_TMO], 1u); break; } } } } while (0)
struct XcdBarrier { unsigned* bar; unsigned x; volatile LAS unsigned* st; bool w0; };
DI XcdBarrier xcd_barrier_post(unsigned* bar, volatile LAS unsigned* st, const bool w0) {
    XcdBarrier b; b.bar = bar; b.x = xb_xcc_id(); b.st = st; b.w0 = w0;
    if (w0 && lane_id() == 0) (void)xb_add(&bar[XB_XCNT(b.x)], 1u);
    return b;
}
DI void xcd_barrier_complete(unsigned* bar, unsigned x, unsigned& nloc, unsigned& nx) {
    const unsigned G = gridDim.x * gridDim.y * gridDim.z;
    unsigned sum, cnt, mine, sp = 0u;
    for (;;) {
        sum = 0u; cnt = 0u; mine = 0u;
#pragma unroll
        for (unsigned j = 0; j < 16; ++j) { const unsigned c = xb_ld(&bar[XB_XCNT(j)]); sum += c; cnt += (c > 0u) ? 1u : 0u; mine = (j == x) ? c : mine; }
        if (sum == G) break;
        __builtin_amdgcn_s_sleep(1);
        if ((++sp & 255u) == 0u) { if (xb_ld(&bar[XB_TMO])) break; if (sp > XB_SPIN_CAP) { atomicAdd(&bar[XB_TMO], 1u); break; } }
    }
    nloc = mine > 0u ? mine : 1u; nx = cnt > 0u ? cnt : 1u;
}
DI void xcd_barrier(const XcdBarrier& b) {
    asm volatile("s_waitcnt vmcnt(0)" ::: "memory");
    __syncthreads();
    if (b.w0 && lane_id() == 0) {
        unsigned* bar = b.bar;
        __builtin_amdgcn_s_waitcnt(0);
        unsigned nloc = b.st[0], nx = b.st[1];
        if (nloc == 0u) { xcd_barrier_complete(bar, b.x, nloc, nx); b.st[0] = nloc; b.st[1] = nx; }
        const unsigned old = xb_add(&bar[XB_XSUB(b.x)], 1u);
        const unsigned gen = old / nloc;
        if (old + 1u == (gen + 1u) * nloc) {
            __builtin_amdgcn_fence(__ATOMIC_RELEASE, "agent");
            asm volatile("s_waitcnt vmcnt(0)" ::: "memory");
            const unsigned og = xb_add(&bar[XB_TOP], 1u);
            const unsigned tg = og / nx;
            if (og + 1u == (tg + 1u) * nx) xb_add(&bar[XB_TOPGEN], 1u);
            else XB_SPIN(xb_ld(&bar[XB_TOPGEN]) == tg, bar);
            __builtin_amdgcn_fence(__ATOMIC_ACQUIRE, "agent");
            xb_add(&bar[XB_XGEN(b.x)], 1u);
            asm volatile("s_waitcnt vmcnt(0)" ::: "memory");
        } else {
            XB_SPIN(xb_ld(&bar[XB_XGEN(b.x)]) == gen, bar);
            __builtin_amdgcn_fence(__ATOMIC_ACQUIRE, "agent");
            asm volatile("s_waitcnt vmcnt(0)" ::: "memory");
        }
    }
    __syncthreads();
}

#define w_in_t ((bf16_t*)(ws + WS_WIN))
#define w_out_t ((bf16_t*)(ws + WS_WOUT))
#define w_glu_t ((bf16_t*)(ws + WS_WGLU))
#define w_pool_t ((bf16_t*)(ws + WS_WPOOL))
#define w_o_t ((bf16_t*)(ws + WS_WO))
#define w_qkv_t ((bf16_t*)(ws + WS_WQKV))
#define Bt1 ((bf16_t*)(ws + WS_BT1))
#define Bt2 ((bf16_t*)(ws + WS_BT2))
#define rowss ((float*)(ws + WS_ROWSS))
#define uss ((float*)(ws + WS_USS))
#define lse ((float*)(ws + WS_LSE))
#define xn ((bf16_t*)(ws + WS_XN))
#define ybuf ((bf16_t*)(ws + WS_Y))
#define hbuf16 ((bf16_t*)(ws + WS_H))
#define Ap ((bf16_t*)(ws + WS_AP))
#define Sbuf ((float*)(ws + WS_S))
#define upool ((float*)(ws + WS_UPOOL))
#define dbuf ((bf16_t*)(ws + WS_D))
#define zbuf ((bf16_t*)(ws + WS_Z))
#define ycat ((bf16_t*)(ws + WS_YCAT))
#define hact ((bf16_t*)(ws + WS_HACT))
#define Qb ((bf16_t*)(ws + WS_Q))
#define Kb ((bf16_t*)(ws + WS_K))
#define Vb ((bf16_t*)(ws + WS_V))
#define Op ((bf16_t*)(ws + WS_OP))
#define att ((bf16_t*)(ws + WS_ATT))
#define gains (p.in[6])
#ifndef PHMASK
#define PHMASK 0xFFFFFFFFu
#endif
#ifndef DUPMASK
#define DUPMASK 0u
#endif
#define PHASE_BEGIN(k) if (((PHMASK >> (k)) & 1u) && p.ph_lo <= (k) && (k) < p.ph_hi) { for (int _rep = 0; _rep < 1 + (int)((DUPMASK >> (k)) & 1u); ++_rep) { if (_rep) __syncthreads(); const int lane = lane_id(); const int tid = wave * 64 + lane; const int gt = bx * 512 + tid; (void)gt;
#define PHASE_END(k) } } if (p.ph_lo <= (k) && (k) + 1 < p.ph_hi) { if ((k) == 0) { grid.sync(); xbar = xcd_barrier_post((unsigned*)(p.ws + WS_CTL), (volatile LAS unsigned*)(lds + 157696), wave == 0); } else xcd_barrier(xbar); }

template <int layer>
DI void layer_tail(const Params& p, LAS unsigned char* lds, cg::grid_group& grid, XcdBarrier& xbar, const int bx, const int G, const int gw, const int NGW, const int wave) {
    unsigned char* ws = p.ws;
    constexpr int pb = 6 + layer * 8;
    const float* gl = gains + (size_t)layer * 4 * DM;
        PHASE_BEGIN(pb)
        { const bf16_t* A = layer == 0 ? ycat : att; const bf16_t* W = layer == 0 ? w_out_t : w_o_t;
          { UStd<EpiY> U{A, W, (size_t)256 * DM, (size_t)256 * DM, 0, 128, 4, G, bx, EpiY{ybuf, 0, 0}};
            gemm_phase(lds, wave, DM, DM, DM, U); }
          { EpiY E{ybuf, 0, 0}; mini_gemm(A, DM, W, DM, DM, 1024, 0, E, bx, G, wave, lane); } }
        PHASE_END(pb)
        PHASE_BEGIN(pb + 1)
        { const RowPass rp{layer == 0 ? 0 : 1, gl + DM, gl + 2 * DM, p.in[0], p.in[1], hbuf16, ybuf, xn, p.out};
          for (int q = gw; q < NP / 4; q += NGW) rp.rows4(q * 4, lane);
          for (int r = NP + (NGW - 1 - gw); r < NT; r += NGW) rp.row(r, lane); }
        PHASE_END(pb + 1)
        PHASE_BEGIN(pb + 2)
        { const bf16_t* W = (const bf16_t*)(ws + (layer ? WS_GU1 : WS_GU0));
          { UStd<EpiGU> U{xn, W, (size_t)256 * DM, (size_t)256 * DM, 0, 128, 22, G, bx, EpiGU{hact, 0, 0}};
            gemm_phase(lds, wave, DM, DM, DM, U); }
          { EpiGU E{hact, 0, 0}; mini_gemm_gu(xn, W, E, bx, G, wave, lane); } }
        PHASE_END(pb + 2)
        PHASE_BEGIN(pb + 3)
        { const bf16_t* W = (const bf16_t*)(ws + (layer ? WS_DN1 : WS_DN0));
          { UStd<EpiY> U{hact, W, (size_t)256 * FF, (size_t)256 * FF, 0, 128, 4, G, bx, EpiY{ybuf, 0, 0}};
            gemm_phase(lds, wave, FF, FF, FF, U); }
          { EpiY E{ybuf, 0, 0}; mini_gemm(hact, FF, W, FF, FF, 1024, 0, E, bx, G, wave, lane); } }
        PHASE_END(pb + 3)
        PHASE_BEGIN(pb + 4)
        { const RowPass rp{layer == 0 ? 1 : 2, gl + 3 * DM, gains + 4 * DM, p.in[0], p.in[1], hbuf16, ybuf, xn, p.out};
          for (int q = gw; q < NP / 4; q += NGW) rp.rows4(q * 4, lane);
          for (int r = NP + (NGW - 1 - gw); r < NT; r += NGW) rp.row(r, lane); }
        PHASE_END(pb + 4)
    }

__global__ void __launch_bounds__(512, 2) mega(Params p) {
    extern __shared__ __attribute__((aligned(16))) unsigned char lds_raw[];
    LAS unsigned char* lds = (LAS unsigned char*)lds_raw;
    cg::grid_group grid = cg::this_grid();
    const int wave = __builtin_amdgcn_readfirstlane((int)threadIdx.x >> 6);
    const int G = gridDim.x, bx = blockIdx.x;
    const int gw = bx * 8 + wave, NGW = G * 8;
    const int NGT = G * 512;
    unsigned char* ws = p.ws;
    XcdBarrier xbar; xbar.bar = (unsigned*)(ws + WS_CTL); xbar.x = 0; xbar.st = (volatile LAS unsigned*)(lds + 157696); xbar.w0 = wave == 0;
    { const int tid = wave * 64 + lane_id();
      if (tid < 64) ((LAS unsigned*)(lds + 157696))[tid] = 0u;
      if (bx == 0) { for (int i = tid; i < 4096; i += 512) ((unsigned*)(ws + WS_CTL))[i] = 0u; } }
    __syncthreads();

    PHASE_BEGIN(0)
    {
        if (bx < 32) { s5_tables(p, bx, lds, Bt1 + (size_t)bx * 65536, Bt2 + (size_t)bx * 98304, tid); }
        LAS float* scr = (LAS float*)(lds + wave * 16384);
        constexpr int I_IN = 512, I_OUT = 512, I_GLU = 128, I_POOL = 32, I_O = 512, I_QKV = 1536, I_G = 1408, I_D = 1408;
        constexpr int NITEMS = I_IN + I_OUT + I_GLU + I_POOL + I_O + I_QKV + 4 * I_G + 2 * I_D;
        for (int it = gw; it < NITEMS; it += NGW) {
            int r = it;
            if (r < I_IN) { tr_plain(p.in[7], 1024, 1024, w_in_t, r, scr, lane); continue; } r -= I_IN;
            if (r < I_OUT) { tr_plain(p.in[20], 1024, 1024, w_out_t, r, scr, lane); continue; } r -= I_OUT;
            if (r < I_GLU) { tr_plain(p.in[18], 512, 512, w_glu_t, r, scr, lane); continue; } r -= I_GLU;
            if (r < I_POOL) { const int gg = r >> 3, q = r & 7, kb = q >> 2, nb = q & 3;
                transpose_item(p.in[8] + (size_t)gg * 16384, 128, 64 * kb, 32 * nb, w_pool_t, 256, gg * 128 + 32 * nb, (gg & 1) * 128 + 64 * kb, scr, lane); continue; } r -= I_POOL;
            if (r < I_O) { tr_plain(p.in[22], 1024, 1024, w_o_t, r, scr, lane); continue; } r -= I_O;
            if (r < I_QKV) { tr_plain(p.in[21], 1024, 3072, w_qkv_t, r, scr, lane); continue; } r -= I_QKV;
            if (r < 4 * I_G) { const int which = r / I_G, q = r % I_G; const int layer = which >> 1, up = which & 1;
                const float* W = p.in[up ? 24 : 23] + (size_t)layer * 1024 * FF; bf16_t* WT = (bf16_t*)(ws + (layer ? WS_GU1 : WS_GU0));
                const int nblk = FF / 32, kb = q / nblk, nb = q % nblk, n0 = 32 * nb;
                transpose_item(W, FF, 64 * kb, n0, WT, 1024, (n0 >> 7) * 256 + up * 128 + (n0 & 127), 64 * kb, scr, lane); continue; } r -= 4 * I_G;
            { const int layer = r / I_D, q = r % I_D; tr_plain(p.in[25] + (size_t)layer * FF * 1024, FF, 1024, (bf16_t*)(ws + (layer ? WS_DN1 : WS_DN0)), q, scr, lane); }
        }
        for (int it = gt; it < 512 * 16; it += NGT) { const int n = it >> 4, c8 = it & 15; const int gg = n >> 7;
            *(u32x4*)(w_pool_t + (size_t)n * 256 + ((gg & 1) ^ 1) * 128 + c8 * 8) = (u32x4){0u, 0u, 0u, 0u}; }
        if (bx >= 32 || G <= 32) { const int gwn = G > 32 ? (bx - 32) * 8 + wave : gw, ngwn = G > 32 ? (G - 32) * 8 : NGW;
          for (int r = gwn; r < NT; r += 2 * ngwn) { const int r2 = r + ngwn; const bool two = r2 < NT;
            norm_row2(in_row(p, r), in_row(p, two ? r2 : r), gains, xn + (size_t)r * DM, xn + (size_t)(two ? r2 : r) * DM, lane); } }
    }
    PHASE_END(0)

    PHASE_BEGIN(1)
    { UStd<EpiProj> U{xn, w_in_t, (size_t)256 * DM, (size_t)256 * DM, 0, 128, 4, G, bx, EpiProj{upool, Ap, uss, 0, 0}};
      gemm_phase(lds, wave, DM, DM, DM, U);
      { EpiProj E{upool, Ap, uss, 0, 0}; mini_gemm(xn, DM, w_in_t, DM, DM, 1024, 0, E, bx, G, wave, lane); } }
    PHASE_END(1)

    PHASE_BEGIN(2)
    {
        { US5<EpiS1> U{Ap + 128, Bt1, (size_t)65536, G, bx, EpiS1{Sbuf, 0, 0}};
          gemm_phase(lds, wave, 384, 256, 256, U); }
        for (int u = gw; u < 1024; u += NGW) s5_sample_unit(p, u, uss, zbuf, lane);
        for (int it = gt; it < (NP / 16) * 128; it += NGT) { const int cq = it & 127, run = it >> 7; const int c = cq * 4, gi = c >> 7, w = 2 << gi;
            const int t0 = run * 16, tb0 = t0 & (TP - 1); const float* up = upool + (size_t)t0 * 512 + c;
            f32x4 e[31];
#pragma unroll
            for (int k = 0; k < 31; ++k) { const int rel = k - 15; e[k] = (rel >= 1 - w && tb0 + rel >= 0) ? *(const f32x4*)(up + (ptrdiff_t)rel * 512) : (f32x4){0.f, 0.f, 0.f, 0.f}; }
            f32x4 sum = (f32x4){0.f, 0.f, 0.f, 0.f};
#pragma unroll
            for (int k = 0; k < 15; ++k) sum += e[k];
#pragma unroll
            for (int k = 0; k < 16; ++k) { const f32x4 uv = e[15 + k]; sum += uv; const int tb = tb0 + k; const int cnt = tb + 1 < w ? tb + 1 : w;
                const f32x4 dv = sum * (1.0f / (float)cnt) - uv; u32x2 o; o.x = pk2(dv[0], dv[1]); o.y = pk2(dv[2], dv[3]); *(u32x2*)(dbuf + (size_t)(t0 + k) * 512 + c) = o;
                f32x4 out_ = (f32x4){0.f, 0.f, 0.f, 0.f};
                if (w == 2) out_ = e[15 + k - 1]; else if (w == 4) out_ = e[15 + k - 3]; else if (w == 8) out_ = e[15 + k - 7]; else out_ = e[15 + k - 15];
                sum -= out_;
                if (tb >= TP - 15) *(f32x4*)(p.out + O_POOLP + ((size_t)(t0 >> 13) * 15 + (tb - (TP - 15))) * 512 + c) = uv; } }
        for (int it = gt; it < 32 * 128; it += NGT) { const int cq = it & 127, b = it >> 7; const int c = cq * 4, gi = c >> 7, w = 2 << gi;
            const float* sp = p.in[2] + (size_t)b * 15 * 512 + c; const float* up = upool + (size_t)(NP + b * 4) * 512 + c;
            for (int t = 0; t < 4; ++t) { f32x4 sum = (f32x4){0.f, 0.f, 0.f, 0.f};
                for (int s = 0; s < w; ++s) { const int e = 15 + t - s; sum += e >= 15 ? *(const f32x4*)(up + (size_t)(e - 15) * 512) : *(const f32x4*)(sp + (size_t)e * 512); }
                const f32x4 uv = *(const f32x4*)(up + (size_t)t * 512); const f32x4 dv = sum * (1.0f / (float)w) - uv;
                u32x2 o; o.x = pk2(dv[0], dv[1]); o.y = pk2(dv[2], dv[3]); *(u32x2*)(dbuf + (size_t)(NP + b * 4 + t) * 512 + c) = o; }
            for (int r = 0; r < 15; ++r) { const f32x4 v = r < 11 ? *(const f32x4*)(sp + (size_t)(r + 4) * 512) : *(const f32x4*)(up + (size_t)(r - 11) * 512);
                *(f32x4*)(p.out + O_POOLS + ((size_t)b * 15 + r) * 512 + c) = v; } }
    }
    PHASE_END(2)

    PHASE_BEGIN(3)
    {
        { const bool act = bx < 128; const int b = (bx >> 5) & 3, g = bx & 31;
          LAS float* ex = (LAS float*)lds;
          float c_r = 1.f, c_i = 0.f, hr = 0.f, hi = 0.f;
          const float* Sp = Sbuf + ((size_t)g * 2048 + b * 512 + wave * 64) * 128 + lane; bf16_t* Hp = Ap + ((size_t)g * 2048 + b * 512 + wave * 64) * 384 + lane;
          if (act) {
            const float dt = __expf(p.in[12][g]); const float zr = p.in[10][g * 64 + lane] * dt * 16.f, zi = p.in[11][g * 64 + lane] * dt * 16.f;
            float sn, cs; sincos_acc(zi, sn, cs); const float mag = __expf(zr); c_r = mag * cs; c_i = mag * sn;
            for (int c0 = 0; c0 < 64; c0 += 16) { float sr[16], si[16];
#pragma unroll
                for (int k = 0; k < 16; ++k) { sr[k] = Sp[(size_t)(c0 + k) * 128]; si[k] = Sp[(size_t)(c0 + k) * 128 + 64]; }
#pragma unroll
                for (int k = 0; k < 16; ++k) { const float n_r = c_r * hr - c_i * hi + sr[k], n_i = c_r * hi + c_i * hr + si[k]; hr = n_r; hi = n_i; } }
            ex[(wave * 64 + lane) * 2] = hr; ex[(wave * 64 + lane) * 2 + 1] = hi;
          }
          __syncthreads();
          if (act) {
            float l_r = c_r, l_i = c_i;
#pragma unroll
            for (int e = 0; e < 6; ++e) { const float t_r = l_r * l_r - l_i * l_i, t_i = 2.f * l_r * l_i; l_r = t_r; l_i = t_i; }
            hr = 0.f; hi = 0.f;
            for (int sg = 0; sg < wave; ++sg) { const float e_r = ex[(sg * 64 + lane) * 2], e_i = ex[(sg * 64 + lane) * 2 + 1];
                const float n_r = l_r * hr - l_i * hi + e_r, n_i = l_r * hi + l_i * hr + e_i; hr = n_r; hi = n_i; }
            for (int c0 = 0; c0 < 64; c0 += 16) { float sr[16], si[16];
#pragma unroll
                for (int k = 0; k < 16; ++k) { sr[k] = Sp[(size_t)(c0 + k) * 128]; si[k] = Sp[(size_t)(c0 + k) * 128 + 64]; }
#pragma unroll
                for (int k = 0; k < 16; ++k) { const unsigned w = pk2(hr, hi); Hp[(size_t)(c0 + k) * 384] = (bf16_t)(w & 0xffffu); Hp[(size_t)(c0 + k) * 384 + 64] = (bf16_t)(w >> 16);
                    const float n_r = c_r * hr - c_i * hi + sr[k], n_i = c_r * hi + c_i * hr + si[k]; hr = n_r; hi = n_i; } }
            if (wave == 7) { float* o = p.out + O_S5P + (((size_t)b * 32 + g) * 64 + lane) * 2; o[0] = hr; o[1] = hi; }
          }
        }
        __syncthreads();
        { UStd<EpiPool> U{dbuf, w_pool_t, (size_t)256 * 512, (size_t)256 * 256, 256, 128, 2, G, bx, EpiPool{ycat, p.in[9], 0, 0}};
          gemm_phase(lds, wave, 512, 256, 256, U); }
        { EpiPool E{ycat, p.in[9], 0, 0}; mini_gemm(dbuf, 512, w_pool_t, 256, 256, 512, 256, E, bx, G, wave, lane); }
    }
    PHASE_END(3)

    PHASE_BEGIN(4)
    { US5<EpiS2> U{Ap, Bt2, (size_t)98304, G, bx, EpiS2{zbuf, Ap, p.in[17], 0, 0}};
      gemm_phase(lds, wave, 384, 384, 384, U); }
    PHASE_END(4)

    PHASE_BEGIN(5)
    { UStd<EpiGlu> U{zbuf, w_glu_t, (size_t)256 * 512, (size_t)256 * 512, 0, 128, 2, G, bx, EpiGlu{ycat, zbuf, p.in[19], 0, 0}};
      gemm_phase(lds, wave, 512, 512, 512, U);
      { EpiGlu E{ycat, zbuf, p.in[19], 0, 0}; mini_gemm(zbuf, 512, w_glu_t, 512, 512, 512, 0, E, bx, G, wave, lane); } }
    PHASE_END(5)

    layer_tail<0>(p, lds, grid, xbar, bx, G, gw, NGW, wave);
            PHASE_BEGIN(11)
            { UStd<EpiQKV> U{xn, w_qkv_t, (size_t)256 * DM, (size_t)256 * DM, 0, 128, 12, G, bx, EpiQKV{Qb, p.out, 0, 0}};
              gemm_phase(lds, wave, DM, DM, DM, U);
              { EpiQKV E{Qb, p.out, 0, 0}; mini_gemm(xn, DM, w_qkv_t, DM, DM, 3072, 0, E, bx, G, wave, lane); } }
            PHASE_END(11)
            PHASE_BEGIN(12)
            {
                attn_prompt_phase(Qb, Kb, Vb, Op, lse, att, xbar, lds, bx, G, wave, lane);
                for (int u = gw; u < 2048; u += NGW) attn_sample_unit(p, u, Qb, Kb, Vb, att, (LAS float*)(lds + wave * 8192), lane);
            }
            PHASE_END(12)
            layer_tail<1>(p, lds, grid, xbar, bx, G, gw, NGW, wave);
}

constexpr int NPHASES = 19;

extern "C" void kernel_launch(void* const* d_in, const int* in_sizes, int n_in, void* d_out, int out_size, void* d_ws, size_t ws_size, hipStream_t stream) {
    static int grid = 0;
    if (grid == 0) {
        int dev = 0, cus = 0, per_cu = 0;
        hipGetDevice(&dev);
        hipDeviceGetAttribute(&cus, hipDeviceAttributeMultiprocessorCount, dev);
        hipFuncSetAttribute((const void*)mega, hipFuncAttributeMaxDynamicSharedMemorySize, LDS_BYTES);
        hipOccupancyMaxActiveBlocksPerMultiprocessor(&per_cu, (const void*)mega, 512, LDS_BYTES);
        if (per_cu < 1) per_cu = 1;
        grid = cus * 1;
        if (ws_size < WS_END) fprintf(stderr, "kernel_launch: workspace too small: %zu < %zu\n", ws_size, (size_t)WS_END);
        fprintf(stderr, "kernel_launch: cus %d per_cu %d grid %d n_in %d out %d ws %zu\n", cus, per_cu, grid, n_in, out_size, ws_size);
    }
    Params p{};
    for (int i = 0; i < 26; ++i) p.in[i] = (const float*)d_in[i];
    p.out = (float*)d_out; p.ws = (unsigned char*)d_ws; p.ph_lo = 0; p.ph_hi = NPHASES;
    void* args[] = {&p};
    hipError_t e = hipLaunchCooperativeKernel((const void*)mega, dim3(grid), dim3(512), args, LDS_BYTES, stream);
    if (e != hipSuccess) fprintf(stderr, "cooperative launch failed: %s (grid %d)\n", hipGetErrorString(e), grid);
}
```

```cpp
#include <hip/hip_runtime.h>
#include <hip/hip_cooperative_groups.h>
#include <cstdio>
#include <cstdint>
namespace cg = cooperative_groups;

#define LAS __attribute__((address_space(3)))
#define DI __device__ __forceinline__
typedef unsigned short bf16_t;
typedef short bf16x8 __attribute__((ext_vector_type(8)));
typedef short s16x4 __attribute__((ext_vector_type(4)));
typedef float f32x4 __attribute__((ext_vector_type(4)));
typedef unsigned u32x4 __attribute__((ext_vector_type(4)));
typedef unsigned u32x2 __attribute__((ext_vector_type(2)));
typedef __bf16 bf2_t __attribute__((ext_vector_type(2)));

constexpr int NP = 32768, NS = 128, NT = NP + NS, MT = 33024, DM = 1024, FF = 2816, TP = 8192;
constexpr float EPS = 1e-6f;
constexpr int LDS_BYTES = 157696 + 256;
constexpr size_t O_YP = 0, O_YS = 33554432, O_POOLP = 33685504, O_S5P = 33716224, O_KP = 33732608, O_VP = 42121216,
                 O_POOLS = 50509824, O_S5S = 50755584, O_KS = 50886656, O_VS = 51017728;
constexpr size_t MiB = 1u << 20;
constexpr size_t WS_WIN = 0, WS_WOUT = 2 * MiB, WS_WGLU = 4 * MiB, WS_WPOOL = 4 * MiB + 512 * 1024, WS_WO = 5 * MiB, WS_WQKV = 7 * MiB,
                 WS_GU0 = 13 * MiB, WS_GU1 = 24 * MiB, WS_DN0 = 35 * MiB, WS_DN1 = 41 * MiB, WS_BT1 = 47 * MiB, WS_BT2 = 51 * MiB,
                 WS_ROWSS = 57 * MiB, WS_USS = 60 * MiB, WS_LSE = 61 * MiB, WS_XN = 68 * MiB, WS_Y = 133 * MiB, WS_H = 198 * MiB,
                 WS_X = 328 * MiB;
constexpr size_t WS_AP = WS_X, WS_S = WS_X + 48 * MiB, WS_UPOOL = WS_X + 80 * MiB, WS_D = WS_X + 145 * MiB, WS_Z = WS_X + 178 * MiB,
                 WS_YCAT = WS_X + 211 * MiB;
constexpr size_t WS_HACT = WS_X;
constexpr size_t WS_Q = WS_X, WS_K = WS_X + 65 * MiB, WS_V = WS_X + 130 * MiB, WS_OP = WS_X + 195 * MiB, WS_ATT = WS_X + 389 * MiB;
constexpr size_t WS_END = WS_X + 454 * MiB;
constexpr size_t WS_CTL = 60 * MiB + 512 * 1024;

struct Params { const float* in[26]; float* out; unsigned char* ws; int ph_lo, ph_hi; };

DI unsigned pk2(float lo, float hi) { bf2_t v; v.x = (__bf16)lo; v.y = (__bf16)hi; return __builtin_bit_cast(unsigned, v); }
DI float bflo(unsigned w) { return __uint_as_float(w << 16); }
DI float bfhi(unsigned w) { return __uint_as_float(w & 0xffff0000u); }
DI float bf2f(bf16_t b) { return __uint_as_float((unsigned)b << 16); }
DI float wave_sum(float v) {
#pragma unroll
    for (int o = 1; o < 64; o <<= 1) v += __shfl_xor(v, o);
    return v;
}
DI float wave_max(float v) {
#pragma unroll
    for (int o = 1; o < 64; o <<= 1) v = fmaxf(v, __shfl_xor(v, o));
    return v;
}
DI float sigmoidf_(float x) { return __builtin_amdgcn_rcpf(1.0f + __builtin_amdgcn_exp2f(-1.4426950408889634f * x)); }
DI float gelu_tanh(float y) { const float u = 0.7978845608028654f * (y + 0.044715f * y * y * y); return y * __builtin_amdgcn_rcpf(1.0f + __builtin_amdgcn_exp2f(-2.0f * 1.4426950408889634f * u)); }
DI void sincos_acc(float a, float& s, float& c) {
    if (fabsf(a) < 0.5f) {
        const float a2 = a * a;
        s = a * (1.f - a2 * (1.f / 6.f) * (1.f - a2 * (1.f / 20.f) * (1.f - a2 * (1.f / 42.f))));
        c = 1.f - a2 * 0.5f * (1.f - a2 * (1.f / 12.f) * (1.f - a2 * (1.f / 30.f) * (1.f - a2 * (1.f / 56.f))));
    } else {
        float r = a * 0.15915494309189535f; r -= floorf(r);
        s = __builtin_amdgcn_sinf(r); c = __builtin_amdgcn_cosf(r);
    }
}
DI int lane_id() { int l; asm volatile("v_mbcnt_lo_u32_b32 %0, -1, 0\n\tv_mbcnt_hi_u32_b32 %0, -1, %0" : "=v"(l)); return l; }
#define LDS_WAIT() asm volatile("s_waitcnt lgkmcnt(0)" ::: "memory")
#define VM_WAIT() asm volatile("s_waitcnt vmcnt(0)" ::: "memory")

constexpr int BM = 256, BK = 64, HALF = 128, NXCD = 8, WGM = 8;
typedef f32x4 Acc[2][2][4][2];
DI int lds_byte(int r, int c) { const int st = (r >> 4) * 2 + (c >> 5), rr = r & 15, cc = c & 31, ob = rr * 64 + cc * 2; return st * 1024 + (ob ^ (((ob >> 9) & 1) << 5)); }
DI void stage_rc(int b, int& R, int& C) { const int st = b / 1024, sb = b % 1024, swz = sb ^ (((sb >> 9) & 1) << 5); R = (st >> 1) * 16 + swz / 64; C = (st & 1) * 32 + (swz % 64) / 2; }

DI bool unit_next(int i, int G, int c, int nM, int nN, int& pm, int& pn) {
    const int nwg = nM * nN; const long L = (long)i * G + c; if (L >= nwg) return false;
    int wgid = (int)L; { const int q = nwg / NXCD, r = nwg % NXCD, xcd = wgid % NXCD, off = wgid / NXCD; wgid = (xcd < r ? xcd * (q + 1) : r * (q + 1) + (xcd - r) * q) + off; }
    const int nig = WGM * nN, gid = wgid / nig, fm = gid * WGM, gsz = (nM - fm) < WGM ? (nM - fm) : WGM;
    pm = fm + ((wgid % nig) % gsz); pn = (wgid % nig) / gsz; return true;
}

template <class Units>
DI void gemm_phase(LAS unsigned char* lds, const int wid, const int lda, const int ldb, const int K, const Units& U) {
    typedef typename Units::Epi Epi;
    const int lane = lane_id(), tid = wid * 64 + lane, wr = wid >> 2, wc = wid & 3, fr = lane & 15, fq = lane >> 4;
    unsigned offA, offB;
    { int R, C; stage_rc(tid * 16, R, C); offA = (unsigned)(R * lda + C) * 2u;
      const int rho = R & 31, Rb = (R & ~31) + 8 * ((rho & 15) >> 2) + 4 * (rho >> 4) + (rho & 3);
      offB = (unsigned)(Rb * ldb + C) * 2u; }
    const unsigned ldsw = (unsigned)wid * 1024u;
    const unsigned hA = (unsigned)(HALF * lda * 2), hB = (unsigned)(HALF * ldb * 2), dA = (unsigned)(64 * lda * 2), dB = (unsigned)(64 * ldb * 2);
    const int aoff = lds_byte(wr * 64 + fr, fq * 8), boff = lds_byte(wc * 32 + fr, fq * 8);
#define SA(b, h) (((b) * 2 + (h)) * 16384)
#define SB(b, h) ((4 + (b) * 2 + (h)) * 16384)
#define STG(bufoff, gbase, soff, voff, dlt) do { _Pragma("unroll") for (int _i = 0; _i < 2; ++_i) { unsigned _vo = (voff); asm volatile("" : "+v"(_vo)); _vo += (unsigned)(soff) + (unsigned)_i * (dlt); \
        __builtin_amdgcn_global_load_lds((const unsigned*)((gbase) + _vo), (LAS unsigned*)(lds + (bufoff) + ldsw + _i * 8192), 16, 0, 0); } } while (0)
#define STA(b, h, base, kt) STG(SA(b, h), base, (h) * hA + (unsigned)(kt) * 128u, offA, dA)
#define STB(b, h, base, kt) STG(SB(b, h), base, (h) * hB + (unsigned)(kt) * 128u, offB, dB)
#define LDA(dst, b, h) do { _Pragma("unroll") for (int m = 0; m < 4; ++m) _Pragma("unroll") for (int k = 0; k < 2; ++k) dst[m][k] = *(const LAS bf16x8*)(lds + SA(b, h) + aoff + m * 2048 + k * 1024); } while (0)
#define LDB(dst, b, h) do { _Pragma("unroll") for (int n = 0; n < 2; ++n) _Pragma("unroll") for (int k = 0; k < 2; ++k) dst[n][k] = *(const LAS bf16x8*)(lds + SB(b, h) + boff + n * 2048 + k * 1024); } while (0)
#define MMA(ai, bj, Af, Bf) do { __builtin_amdgcn_s_setprio(1); _Pragma("unroll") for (int m = 0; m < 4; ++m) _Pragma("unroll") for (int n = 0; n < 2; ++n) _Pragma("unroll") for (int k = 0; k < 2; ++k) \
        acc[ai][bj][m][n] = __builtin_amdgcn_mfma_f32_16x16x32_bf16(Bf[n][k], Af[m][k], acc[ai][bj][m][n], 0, 0, 0); __builtin_amdgcn_s_setprio(0); } while (0)
#define WAIT_V(n) asm volatile("s_waitcnt vmcnt(" #n ")" ::: "memory")
#define WAIT_L(n) asm volatile("s_waitcnt lgkmcnt(" #n ")" ::: "memory")
#define BAR __builtin_amdgcn_s_barrier()
#define SCHED __builtin_amdgcn_sched_barrier(0)
#define ZERO_ACC() do { _Pragma("unroll") for (int a = 0; a < 2; ++a) _Pragma("unroll") for (int b = 0; b < 2; ++b) _Pragma("unroll") for (int m = 0; m < 4; ++m) _Pragma("unroll") for (int n = 0; n < 2; ++n) acc[a][b][m][n] = (f32x4){0.f, 0.f, 0.f, 0.f}; } while (0)
    const bf16_t* pa; const bf16_t* pb; Epi Ecur, Enxt;
    if (!U.get(0, pa, pb, Ecur)) return;
    const char* cA = (const char*)pa; const char* cB = (const char*)pb;
    Acc acc; ZERO_ACC();
    bf16x8 At[4][2], B0[2][2], B1[2][2];
    const int nt = K / BK;
    STB(0, 0, cB, 0); STB(0, 1, cB, 0); STA(0, 0, cA, 0); STA(0, 1, cA, 0);
    if (wr == 1) BAR;
    WAIT_V(2); BAR;
    STB(1, 0, cB, 1); STA(1, 0, cA, 1); STB(1, 1, cB, 1);
    WAIT_V(6); BAR;
    for (int ui = 0;; ++ui) {
        const bool has_next = U.get(ui + 1, pa, pb, Enxt);
        const char* nA = has_next ? (const char*)pa : cA; const char* nB = has_next ? (const char*)pb : cB;
        for (int t = 0; t < nt; t += 2) {
            const bool last = (t == nt - 2);
            const char* a2 = last ? nA : cA; const char* b2 = last ? nB : cB; const int k2 = last ? 0 : t + 2, k3 = k2 + 1;
            LDB(B0, 0, 0); LDB(B1, 0, 1); SCHED; LDA(At, 0, 0); STA(1, 1, cA, t + 1);
            WAIT_V(8); WAIT_L(0); BAR; MMA(0, 0, At, B0); MMA(0, 1, At, B1); BAR; SCHED;
            LDA(At, 0, 1); STB(0, 0, b2, k2); STB(0, 1, b2, k2); STA(0, 0, a2, k2);
            WAIT_V(8); WAIT_L(0); BAR; MMA(1, 0, At, B0); MMA(1, 1, At, B1); BAR; SCHED;
            LDB(B0, 1, 0); LDB(B1, 1, 1); SCHED; LDA(At, 1, 0); STA(0, 1, a2, k2);
            WAIT_V(8); WAIT_L(0); BAR; MMA(0, 0, At, B0); MMA(0, 1, At, B1); BAR; SCHED;
            LDA(At, 1, 1); STB(1, 0, b2, k3); STB(1, 1, b2, k3); STA(1, 0, a2, k3);
            WAIT_V(8); WAIT_L(0); BAR; MMA(1, 0, At, B0); MMA(1, 1, At, B1); BAR; SCHED;
        }
        if (wr == 0) BAR;
        Ecur(acc, wr, wc, fr, fq);
        if (!has_next) break;
        ZERO_ACC();
        cA = nA; cB = nB; Ecur = Enxt;
        if (wr == 1) BAR;
    }
    WAIT_V(0);
    BAR;
#undef ZERO_ACC
#undef SA
#undef SB
#undef STG
#undef STA
#undef STB
#undef LDA
#undef LDB
#undef MMA
#undef WAIT_V
#undef WAIT_L
#undef BAR
#undef SCHED
}

#define EPI_ROWS(...) _Pragma("unroll") for (int ai = 0; ai < 2; ++ai) _Pragma("unroll") for (int m = 0; m < 4; ++m) { const int rr = ai * 128 + wr * 64 + m * 16 + fr; __VA_ARGS__ }
#define EPI_COLS8(...) _Pragma("unroll") for (int bj = 0; bj < 2; ++bj) { const int cc = bj * 128 + wc * 32 + 8 * fq; const f32x4 v0 = acc[ai][bj][m][0], v1 = acc[ai][bj][m][1]; __VA_ARGS__ }
#define EPI_COLS(...) _Pragma("unroll") for (int bj = 0; bj < 2; ++bj) _Pragma("unroll") for (int n = 0; n < 2; ++n) { const int cc = bj * 128 + wc * 32 + 8 * fq + 4 * n; const f32x4 v = acc[ai][bj][m][n]; __VA_ARGS__ }

struct EpiProj {
    float* upool; bf16_t* Ap; float* uss; int row0, col0;
    DI void set(int pm, int pn) { row0 = pm * 256; col0 = pn * 256; }
    DI void elem(int row, int col, const f32x4 v) const {
        if (col < 512) *(f32x4*)(upool + (size_t)row * 512 + col) = v; else *(f32x4*)(uss + (size_t)(row - NP) * 512 + (col - 512)) = v; }
    DI void operator()(const Acc& acc, int wr, int wc, int fr, int fq) const {
        if (col0 < 512) {
            EPI_ROWS(const size_t row = row0 + rr; EPI_COLS(*(f32x4*)(upool + row * 512 + col0 + cc) = v;))
        } else {
            EPI_ROWS(const int row = row0 + rr;
                EPI_COLS8(const int c2 = col0 - 512 + cc; const int g = c2 >> 4, i = c2 & 15;
                    if (row < NP) { u32x4 w; w.x = pk2(v0[0], v0[1]); w.y = pk2(v0[2], v0[3]); w.z = pk2(v1[0], v1[1]); w.w = pk2(v1[2], v1[3]);
                        *(u32x4*)(Ap + ((size_t)g * 2048 + (row >> 4)) * 384 + 128 + (row & 15) * 16 + i) = w; }
                    else if (row < NT) { *(f32x4*)(uss + (size_t)(row - NP) * 512 + c2) = v0; *(f32x4*)(uss + (size_t)(row - NP) * 512 + c2 + 4) = v1; }))
        }
    }
};
struct EpiS1 {
    float* S; int g, row0;
    DI void set(int mt, int gg) { row0 = mt * 256; g = gg; }
    DI void operator()(const Acc& acc, int wr, int wc, int fr, int fq) const {
        EPI_ROWS(const size_t row = (size_t)g * 2048 + row0 + rr;
            _Pragma("unroll") for (int n = 0; n < 2; ++n) { const int cc = wc * 32 + 8 * fq + 4 * n; *(f32x4*)(S + row * 128 + cc) = acc[ai][0][m][n]; })
    }
};
struct EpiPool {
    bf16_t* ycat; const float* scale; int row0, col0;
    DI void set(int pm, int pn) { row0 = pm * 256; col0 = pn * 256; }
    DI void elem(int row, int col, const f32x4 v) const { const f32x4 s = *(const f32x4*)(scale + col); u32x2 w; w.x = pk2(v[0] * s[0], v[1] * s[1]); w.y = pk2(v[2] * s[2], v[3] * s[3]);
        *(u32x2*)(ycat + (size_t)row * 1024 + col) = w; }
    DI void operator()(const Acc& acc, int wr, int wc, int fr, int fq) const {
        EPI_ROWS(const size_t row = row0 + rr;
            EPI_COLS8(const int col = col0 + cc; const f32x4 s0 = *(const f32x4*)(scale + col), s1 = *(const f32x4*)(scale + col + 4); u32x4 w;
                w.x = pk2(v0[0] * s0[0], v0[1] * s0[1]); w.y = pk2(v0[2] * s0[2], v0[3] * s0[3]); w.z = pk2(v1[0] * s1[0], v1[1] * s1[1]); w.w = pk2(v1[2] * s1[2], v1[3] * s1[3]);
                *(u32x4*)(ycat + row * 1024 + col) = w;))
    }
};
struct EpiS2 {
    bf16_t* z; const bf16_t* Ap; const float* dskip; int g, row0;
    DI void set(int mt, int gg) { row0 = mt * 256; g = gg; }
    DI void operator()(const Acc& acc, int wr, int wc, int fr, int fq) const {
        EPI_ROWS(const int chunk = row0 + rr; const bf16_t* ap = Ap + ((size_t)g * 2048 + chunk) * 384 + 128;
            EPI_COLS8(const int r = cc >> 4, i = cc & 15; const u32x4 uw = *(const u32x4*)(ap + cc); const f32x4 d0 = *(const f32x4*)(dskip + g * 16 + i), d1 = *(const f32x4*)(dskip + g * 16 + i + 4);
                const float y0 = v0[0] + d0[0] * bflo(uw.x), y1 = v0[1] + d0[1] * bfhi(uw.x), y2 = v0[2] + d0[2] * bflo(uw.y), y3 = v0[3] + d0[3] * bfhi(uw.y);
                const float y4 = v1[0] + d1[0] * bflo(uw.z), y5 = v1[1] + d1[1] * bfhi(uw.z), y6 = v1[2] + d1[2] * bflo(uw.w), y7 = v1[3] + d1[3] * bfhi(uw.w);
                u32x4 w; w.x = pk2(gelu_tanh(y0), gelu_tanh(y1)); w.y = pk2(gelu_tanh(y2), gelu_tanh(y3)); w.z = pk2(gelu_tanh(y4), gelu_tanh(y5)); w.w = pk2(gelu_tanh(y6), gelu_tanh(y7));
                *(u32x4*)(z + ((size_t)chunk * 16 + r) * 512 + g * 16 + i) = w;))
    }
};
struct EpiGlu {
    bf16_t* ycat; const bf16_t* z; const float* bglu; int row0, col0;
    DI void set(int pm, int pn) { row0 = pm * 256; col0 = pn * 256; }
    DI void elem(int row, int col, const f32x4 v) const { const u32x2 zw = *(const u32x2*)(z + (size_t)row * 512 + col); const f32x4 b = *(const f32x4*)(bglu + col);
        u32x2 w; w.x = pk2(bflo(zw.x) * sigmoidf_(v[0] + b[0]), bfhi(zw.x) * sigmoidf_(v[1] + b[1])); w.y = pk2(bflo(zw.y) * sigmoidf_(v[2] + b[2]), bfhi(zw.y) * sigmoidf_(v[3] + b[3]));
        *(u32x2*)(ycat + (size_t)row * 1024 + 512 + col) = w; }
    DI void operator()(const Acc& acc, int wr, int wc, int fr, int fq) const {
        EPI_ROWS(const size_t row = row0 + rr;
            EPI_COLS8(const int col = col0 + cc; const u32x4 zw = *(const u32x4*)(z + row * 512 + col); const f32x4 b0 = *(const f32x4*)(bglu + col), b1 = *(const f32x4*)(bglu + col + 4);
                u32x4 w; w.x = pk2(bflo(zw.x) * sigmoidf_(v0[0] + b0[0]), bfhi(zw.x) * sigmoidf_(v0[1] + b0[1]));
                w.y = pk2(bflo(zw.y) * sigmoidf_(v0[2] + b0[2]), bfhi(zw.y) * sigmoidf_(v0[3] + b0[3]));
                w.z = pk2(bflo(zw.z) * sigmoidf_(v1[0] + b1[0]), bfhi(zw.z) * sigmoidf_(v1[1] + b1[1]));
                w.w = pk2(bflo(zw.w) * sigmoidf_(v1[2] + b1[2]), bfhi(zw.w) * sigmoidf_(v1[3] + b1[3]));
                *(u32x4*)(ycat + row * 1024 + 512 + col) = w;))
    }
};
struct EpiY {
    bf16_t* y; int row0, col0;
    DI void set(int pm, int pn) { row0 = pm * 256; col0 = pn * 256; }
    DI void elem(int row, int col, const f32x4 v) const { u32x2 w; w.x = pk2(v[0], v[1]); w.y = pk2(v[2], v[3]); *(u32x2*)(y + (size_t)row * 1024 + col) = w; }
    DI void operator()(const Acc& acc, int wr, int wc, int fr, int fq) const {
        EPI_ROWS(const size_t row = row0 + rr;
            _Pragma("unroll") for (int bj = 0; bj < 2; ++bj) { const int cc = bj * 128 + wc * 32 + 8 * fq; const f32x4 v0 = acc[ai][bj][m][0], v1 = acc[ai][bj][m][1];
                u32x4 w; w.x = pk2(v0[0], v0[1]); w.y = pk2(v0[2], v0[3]); w.z = pk2(v1[0], v1[1]); w.w = pk2(v1[2], v1[3]); *(u32x4*)(y + row * 1024 + col0 + cc) = w; })
    }
};
struct EpiGU {
    bf16_t* hact; int row0, hb;
    DI void set(int pm, int pn) { row0 = pm * 256; hb = pn; }
    DI void elem2(int row, int col, const f32x4 a, const f32x4 u) const { u32x2 w; w.x = pk2(a[0] * sigmoidf_(a[0]) * u[0], a[1] * sigmoidf_(a[1]) * u[1]); w.y = pk2(a[2] * sigmoidf_(a[2]) * u[2], a[3] * sigmoidf_(a[3]) * u[3]);
        *(u32x2*)(hact + (size_t)row * FF + col) = w; }
    DI void operator()(const Acc& acc, int wr, int wc, int fr, int fq) const {
        EPI_ROWS(const size_t row = row0 + rr; const int cc = wc * 32 + 8 * fq; u32x4 w;
            { const f32x4 a = acc[ai][0][m][0], u = acc[ai][1][m][0]; w.x = pk2(a[0] * sigmoidf_(a[0]) * u[0], a[1] * sigmoidf_(a[1]) * u[1]); w.y = pk2(a[2] * sigmoidf_(a[2]) * u[2], a[3] * sigmoidf_(a[3]) * u[3]); }
            { const f32x4 a = acc[ai][0][m][1], u = acc[ai][1][m][1]; w.z = pk2(a[0] * sigmoidf_(a[0]) * u[0], a[1] * sigmoidf_(a[1]) * u[1]); w.w = pk2(a[2] * sigmoidf_(a[2]) * u[2], a[3] * sigmoidf_(a[3]) * u[3]); }
            *(u32x4*)(hact + row * FF + hb * 128 + cc) = w;)
    }
};
struct EpiQKV {
    bf16_t* qkv; float* out; int row0, col0;
    DI void set(int pm, int pn) { row0 = pm * 256; col0 = pn * 256; }
    DI void elem(int row, int colg, const f32x4 v) const {
        const int which = colg >> 10, col = colg & 1023; const float sc = which == 0 ? 0.125f * 1.4426950408889634f : 1.0f;
        u32x2 w; w.x = pk2(v[0] * sc, v[1] * sc); w.y = pk2(v[2] * sc, v[3] * sc);
        *(u32x2*)(qkv + (size_t)which * (65 * MiB / 2) + (size_t)row * 1024 + col) = w;
        if (which != 0) *(f32x4*)(out + (which == 1 ? O_KS : O_VS) + (size_t)(row - NP) * 1024 + col) = v; }
    DI void operator()(const Acc& acc, int wr, int wc, int fr, int fq) const {
        const int which = col0 >> 10; const int cb = col0 & 1023; const float sc = which == 0 ? 0.125f * 1.4426950408889634f : 1.0f;
        bf16_t* dst = qkv + (size_t)which * (65 * MiB / 2);
        float* op = out + (which == 1 ? O_KP : O_VP); float* os = out + (which == 1 ? O_KS : O_VS);
        EPI_ROWS(const int row = row0 + rr;
            EPI_COLS8(const int col = cb + cc; u32x4 w; w.x = pk2(v0[0] * sc, v0[1] * sc); w.y = pk2(v0[2] * sc, v0[3] * sc); w.z = pk2(v1[0] * sc, v1[1] * sc); w.w = pk2(v1[2] * sc, v1[3] * sc);
                *(u32x4*)(dst + (size_t)row * 1024 + col) = w;
                if (which != 0) {
                    if (row < NP) { const int tb = row & (TP - 1); if (tb >= TP - 2048) { float* o = op + ((size_t)(row >> 13) * 2048 + (tb - (TP - 2048))) * 1024 + col; *(f32x4*)o = v0; *(f32x4*)(o + 4) = v1; } }
                    else if (row < NT) { float* o = os + (size_t)(row - NP) * 1024 + col; *(f32x4*)o = v0; *(f32x4*)(o + 4) = v1; }
                }))
    }
};


template <class EpiT> struct UStd {
    typedef EpiT Epi; const bf16_t* A; const bf16_t* Bt; size_t astep, bstep; int acolstep, nM, nN, G, c; EpiT proto;
    DI bool get(int i, const bf16_t*& a, const bf16_t*& b, EpiT& e) const { int pm, pn; if (!unit_next(i, G, c, nM, nN, pm, pn)) return false;
        a = A + (size_t)pm * astep + (size_t)pn * acolstep; b = Bt + (size_t)pn * bstep; e = proto; e.set(pm, pn); return true; }
};
template <class EpiT> struct US5Own {
    typedef EpiT Epi; const bf16_t* A; const bf16_t* Bt; size_t bstep; int g, b; EpiT proto;
    DI bool get(int i, const bf16_t*& a, const bf16_t*& bb, EpiT& e) const { if (i >= 2) return false; const int mt = 2 * b + i;
        a = A + ((size_t)g * 2048 + mt * 256) * 384; bb = Bt + (size_t)g * bstep; e = proto; e.set(mt, g); return true; }
};
template <class EpiT> struct US5 {
    typedef EpiT Epi; const bf16_t* A; const bf16_t* Bt; size_t bstep; int G, c; EpiT proto;
    DI bool get(int i, const bf16_t*& a, const bf16_t*& b, EpiT& e) const { const int L = c + i * G; if (L >= 256) return false; const int g = L >> 3, mt = L & 7;
        a = A + ((size_t)g * 2048 + mt * 256) * 384; b = Bt + (size_t)g * bstep; e = proto; e.set(mt, g); return true; }
};

DI f32x4 mini_acc(const bf16_t* Arow, const bf16_t* Brow, int K) {
    f32x4 acc = (f32x4){0.f, 0.f, 0.f, 0.f};
    int k0 = 0;
    for (; k0 + 512 <= K; k0 += 512) { bf16x8 a[16], b[16];
#pragma unroll
        for (int e = 0; e < 16; ++e) { a[e] = *(const bf16x8*)(Arow + k0 + 32 * e); b[e] = *(const bf16x8*)(Brow + k0 + 32 * e); }
#pragma unroll
        for (int e = 0; e < 16; ++e) acc = __builtin_amdgcn_mfma_f32_16x16x32_bf16(b[e], a[e], acc, 0, 0, 0); }
    if (k0 < K) { bf16x8 a[8], b[8];
#pragma unroll
        for (int e = 0; e < 8; ++e) { a[e] = *(const bf16x8*)(Arow + k0 + 32 * e); b[e] = *(const bf16x8*)(Brow + k0 + 32 * e); }
#pragma unroll
        for (int e = 0; e < 8; ++e) acc = __builtin_amdgcn_mfma_f32_16x16x32_bf16(b[e], a[e], acc, 0, 0, 0); }
    return acc;
}
DI void mini_acc2(const bf16_t* Arow, const bf16_t* Bg, const bf16_t* Bu, int K, f32x4& ga, f32x4& ua) {
    ga = (f32x4){0.f, 0.f, 0.f, 0.f}; ua = ga;
    for (int k0 = 0; k0 < K; k0 += 256) { bf16x8 a[8], g[8], u[8];
#pragma unroll
        for (int e = 0; e < 8; ++e) { a[e] = *(const bf16x8*)(Arow + k0 + 32 * e); g[e] = *(const bf16x8*)(Bg + k0 + 32 * e); u[e] = *(const bf16x8*)(Bu + k0 + 32 * e); }
#pragma unroll
        for (int e = 0; e < 8; ++e) { ga = __builtin_amdgcn_mfma_f32_16x16x32_bf16(g[e], a[e], ga, 0, 0, 0); ua = __builtin_amdgcn_mfma_f32_16x16x32_bf16(u[e], a[e], ua, 0, 0, 0); } }
}
template <class Epi>
DI void mini_gemm(const bf16_t* A, int lda, const bf16_t* Bt, int ldb, int K, int N, int acol_per_256, const Epi& E, int bx, int G, int wave, int lane) {
    const int fr = lane & 15, fq = lane >> 4; const int row = NP + 16 * wave + fr;
    for (int q = bx; q < N / 16; q += G) {
        const bf16_t* Arow = A + (size_t)row * lda + ((16 * q) >> 8) * acol_per_256 + 8 * fq;
        const bf16_t* Brow = Bt + (size_t)(16 * q + fr) * ldb + 8 * fq;
        const f32x4 acc = mini_acc(Arow, Brow, K);
        E.elem(row, 16 * q + 4 * fq, acc); }
}
DI void mini_gemm_gu(const bf16_t* A, const bf16_t* Bt, const EpiGU& E, int bx, int G, int wave, int lane) {
    const int fr = lane & 15, fq = lane >> 4; const int row = NP + 16 * wave + fr;
    for (int q = bx; q < FF / 16; q += G) { const int hcol = 16 * q; const int brow = (hcol >> 7) * 256 + (hcol & 127) + fr;
        const bf16_t* Arow = A + (size_t)row * DM + 8 * fq;
        f32x4 ga, ua; mini_acc2(Arow, Bt + (size_t)brow * DM + 8 * fq, Bt + (size_t)(brow + 128) * DM + 8 * fq, DM, ga, ua);
        E.elem2(row, hcol + 4 * fq, ga, ua); }
}
DI void transpose_item(const float* W, int N, int k0, int n0, bf16_t* WT, int ldt, int orow0, int ocol0, LAS float* scr, int lane) {
#pragma unroll 16
    for (int i = 0; i < 32; ++i) { const int kk = 2 * i + (lane >> 5); scr[kk * 33 + (lane & 31)] = W[(size_t)(k0 + kk) * N + n0 + (lane & 31)]; }
    LDS_WAIT();
    const int c = lane & 7;
#pragma unroll
    for (int j = 0; j < 4; ++j) { const int n = (lane >> 3) + 8 * j; const LAS float* s = scr + (8 * c) * 33 + n;
        u32x4 o; o.x = pk2(s[0 * 33], s[1 * 33]); o.y = pk2(s[2 * 33], s[3 * 33]); o.z = pk2(s[4 * 33], s[5 * 33]); o.w = pk2(s[6 * 33], s[7 * 33]);
        *(u32x4*)(WT + (size_t)(orow0 + n) * ldt + ocol0 + 8 * c) = o; }
    LDS_WAIT();
}
DI void tr_plain(const float* W, int K, int N, bf16_t* WT, int item, LAS float* scr, int lane) {
    const int nblk = N / 32, kb = item / nblk, nb = item % nblk; transpose_item(W, N, 64 * kb, 32 * nb, WT, K, 32 * nb, 64 * kb, scr, lane);
}

DI const float* in_row(const Params& p, int r) { return r < NP ? p.in[0] + (size_t)r * DM : p.in[1] + (size_t)(r - NP) * DM; }

DI void norm_row(const float* xr, const float* g, bf16_t* o, int lane) {
    f32x4 v[4]; float s = 0.f;
#pragma unroll
    for (int j = 0; j < 4; ++j) { v[j] = *(const f32x4*)(xr + 4 * lane + 256 * j); s += (v[j][0] * v[j][0] + v[j][1] * v[j][1]) + (v[j][2] * v[j][2] + v[j][3] * v[j][3]); }
    const float r = rsqrtf(wave_sum(s) * (1.f / DM) + EPS);
#pragma unroll
    for (int j = 0; j < 4; ++j) { const f32x4 gg = *(const f32x4*)(g + 4 * lane + 256 * j); u32x2 w; w.x = pk2(v[j][0] * r * gg[0], v[j][1] * r * gg[1]); w.y = pk2(v[j][2] * r * gg[2], v[j][3] * r * gg[3]);
        *(u32x2*)(o + 4 * lane + 256 * j) = w; }
}
DI void norm_row2(const float* xa, const float* xb, const float* g, bf16_t* oa, bf16_t* ob, int lane) {
    f32x4 va[4], vb[4]; float sa = 0.f, sb = 0.f;
#pragma unroll
    for (int j = 0; j < 4; ++j) { va[j] = *(const f32x4*)(xa + 4 * lane + 256 * j); vb[j] = *(const f32x4*)(xb + 4 * lane + 256 * j); }
#pragma unroll
    for (int j = 0; j < 4; ++j) { sa += (va[j][0] * va[j][0] + va[j][1] * va[j][1]) + (va[j][2] * va[j][2] + va[j][3] * va[j][3]); sb += (vb[j][0] * vb[j][0] + vb[j][1] * vb[j][1]) + (vb[j][2] * vb[j][2] + vb[j][3] * vb[j][3]); }
    const float ra = rsqrtf(wave_sum(sa) * (1.f / DM) + EPS), rb = rsqrtf(wave_sum(sb) * (1.f / DM) + EPS);
#pragma unroll
    for (int j = 0; j < 4; ++j) { const f32x4 gg = *(const f32x4*)(g + 4 * lane + 256 * j); u32x2 w;
        w.x = pk2(va[j][0] * ra * gg[0], va[j][1] * ra * gg[1]); w.y = pk2(va[j][2] * ra * gg[2], va[j][3] * ra * gg[3]); *(u32x2*)(oa + 4 * lane + 256 * j) = w;
        w.x = pk2(vb[j][0] * rb * gg[0], vb[j][1] * rb * gg[1]); w.y = pk2(vb[j][2] * rb * gg[2], vb[j][3] * rb * gg[3]); *(u32x2*)(ob + 4 * lane + 256 * j) = w; }
}
template <bool INB, bool OUTB>
DI void res_row(const void* hin_, const bf16_t* y, const float* gpost, const float* gnext, void* hout_, bf16_t* xn, int lane) {
    u32x2 yw[4]; float ss = 0.f;
#pragma unroll
    for (int j = 0; j < 4; ++j) { yw[j] = *(const u32x2*)(y + 4 * lane + 256 * j); const float a = bflo(yw[j].x), b = bfhi(yw[j].x), c = bflo(yw[j].y), d = bfhi(yw[j].y); ss += (a * a + b * b) + (c * c + d * d); }
    const float r1 = rsqrtf(wave_sum(ss) * (1.f / DM) + EPS);
    f32x4 h[4]; float s2 = 0.f;
#pragma unroll
    for (int j = 0; j < 4; ++j) { const int c = 4 * lane + 256 * j; f32x4 hv;
        if (INB) { const u32x2 hw = *(const u32x2*)((const bf16_t*)hin_ + c); hv = (f32x4){bflo(hw.x), bfhi(hw.x), bflo(hw.y), bfhi(hw.y)}; } else hv = *(const f32x4*)((const float*)hin_ + c);
        const f32x4 gp = *(const f32x4*)(gpost + c);
        h[j][0] = hv[0] + bflo(yw[j].x) * r1 * gp[0]; h[j][1] = hv[1] + bfhi(yw[j].x) * r1 * gp[1]; h[j][2] = hv[2] + bflo(yw[j].y) * r1 * gp[2]; h[j][3] = hv[3] + bfhi(yw[j].y) * r1 * gp[3];
        if (OUTB) { u32x2 w; w.x = pk2(h[j][0], h[j][1]); w.y = pk2(h[j][2], h[j][3]); *(u32x2*)((bf16_t*)hout_ + c) = w;
            h[j] = (f32x4){bflo(w.x), bfhi(w.x), bflo(w.y), bfhi(w.y)}; }
        else *(f32x4*)((float*)hout_ + c) = h[j];
        s2 += (h[j][0] * h[j][0] + h[j][1] * h[j][1]) + (h[j][2] * h[j][2] + h[j][3] * h[j][3]); }
    if (xn) {
        const float r2 = rsqrtf(wave_sum(s2) * (1.f / DM) + EPS);
#pragma unroll
        for (int j = 0; j < 4; ++j) { const int c = 4 * lane + 256 * j; const f32x4 gn = *(const f32x4*)(gnext + c); u32x2 w; w.x = pk2(h[j][0] * r2 * gn[0], h[j][1] * r2 * gn[1]); w.y = pk2(h[j][2] * r2 * gn[2], h[j][3] * r2 * gn[3]);
            *(u32x2*)(xn + c) = w; }
    }
}

template <bool INB, bool OUTB, int R>
DI void res_rows(const void* const (&hin_)[R], const bf16_t* const (&y)[R], const float* gpost, const float* gnext, void* const (&hout_)[R], bf16_t* const (&xn)[R], const bool has_xn, int lane) {
    u32x4 yw[R][2]; f32x4 hv[R][2][2];
#pragma unroll
    for (int q = 0; q < R; ++q)
#pragma unroll
        for (int j = 0; j < 2; ++j) { const int c = 8 * lane + 512 * j; yw[q][j] = *(const u32x4*)(y[q] + c);
            if (INB) { const u32x4 hw = *(const u32x4*)((const bf16_t*)hin_[q] + c); hv[q][j][0] = (f32x4){bflo(hw.x), bfhi(hw.x), bflo(hw.y), bfhi(hw.y)}; hv[q][j][1] = (f32x4){bflo(hw.z), bfhi(hw.z), bflo(hw.w), bfhi(hw.w)}; }
            else { hv[q][j][0] = *(const f32x4*)((const float*)hin_[q] + c); hv[q][j][1] = *(const f32x4*)((const float*)hin_[q] + c + 4); } }
    f32x4 gp[2][2];
#pragma unroll
    for (int j = 0; j < 2; ++j) { gp[j][0] = *(const f32x4*)(gpost + 8 * lane + 512 * j); gp[j][1] = *(const f32x4*)(gpost + 8 * lane + 512 * j + 4); }
#pragma unroll
    for (int q = 0; q < R; ++q) {
        f32x4 yv[2][2]; float ss = 0.f;
#pragma unroll
        for (int j = 0; j < 2; ++j) { yv[j][0] = (f32x4){bflo(yw[q][j].x), bfhi(yw[q][j].x), bflo(yw[q][j].y), bfhi(yw[q][j].y)}; yv[j][1] = (f32x4){bflo(yw[q][j].z), bfhi(yw[q][j].z), bflo(yw[q][j].w), bfhi(yw[q][j].w)};
#pragma unroll
            for (int e = 0; e < 2; ++e) ss += (yv[j][e][0] * yv[j][e][0] + yv[j][e][1] * yv[j][e][1]) + (yv[j][e][2] * yv[j][e][2] + yv[j][e][3] * yv[j][e][3]); }
        const float r1 = rsqrtf(wave_sum(ss) * (1.f / DM) + EPS);
        float s2 = 0.f;
#pragma unroll
        for (int j = 0; j < 2; ++j) { const int c = 8 * lane + 512 * j; f32x4 h0 = hv[q][j][0] + yv[j][0] * r1 * gp[j][0], h1 = hv[q][j][1] + yv[j][1] * r1 * gp[j][1];
            if (OUTB) { u32x4 w; w.x = pk2(h0[0], h0[1]); w.y = pk2(h0[2], h0[3]); w.z = pk2(h1[0], h1[1]); w.w = pk2(h1[2], h1[3]); *(u32x4*)((bf16_t*)hout_[q] + c) = w;
                h0 = (f32x4){bflo(w.x), bfhi(w.x), bflo(w.y), bfhi(w.y)}; h1 = (f32x4){bflo(w.z), bfhi(w.z), bflo(w.w), bfhi(w.w)}; }
            else { *(f32x4*)((float*)hout_[q] + c) = h0; *(f32x4*)((float*)hout_[q] + c + 4) = h1; }
            s2 += (h0[0] * h0[0] + h0[1] * h0[1]) + (h0[2] * h0[2] + h0[3] * h0[3]) + (h1[0] * h1[0] + h1[1] * h1[1]) + (h1[2] * h1[2] + h1[3] * h1[3]);
            hv[q][j][0] = h0; hv[q][j][1] = h1; }
        if (has_xn) { const float r2 = rsqrtf(wave_sum(s2) * (1.f / DM) + EPS);
#pragma unroll
            for (int j = 0; j < 2; ++j) { const int c = 8 * lane + 512 * j; const f32x4 g0 = *(const f32x4*)(gnext + c), g1 = *(const f32x4*)(gnext + c + 4); const f32x4 a = hv[q][j][0] * r2 * g0, bb = hv[q][j][1] * r2 * g1;
                u32x4 w; w.x = pk2(a[0], a[1]); w.y = pk2(a[2], a[3]); w.z = pk2(bb[0], bb[1]); w.w = pk2(bb[2], bb[3]); *(u32x4*)(xn[q] + c) = w; } }
    }
}

struct RowPass { int mode; const float* gpost; const float* gnext; const float* xp; const float* xs; bf16_t* h16; const bf16_t* y; bf16_t* xnp; float* out;
    DI void row(int r, int lane) const {
        const bf16_t* yr = y + (size_t)r * DM; bf16_t* hr = h16 + (size_t)r * DM;
        if (mode == 0) res_row<false, true>(r < NP ? xp + (size_t)r * DM : xs + (size_t)(r - NP) * DM, yr, gpost, gnext, hr, xnp + (size_t)r * DM, lane);
        else if (mode == 1) res_row<true, true>(hr, yr, gpost, gnext, hr, xnp + (size_t)r * DM, lane);
        else res_row<true, false>(hr, yr, gpost, gnext, r < NP ? out + O_YP + (size_t)r * DM : out + O_YS + (size_t)(r - NP) * DM, nullptr, lane);
    }
    DI void rows4(int r0, int lane) const {
        const void* hin[4]; const bf16_t* yr[4]; void* ho[4]; bf16_t* xo[4];
#pragma unroll
        for (int q = 0; q < 4; ++q) { const size_t o = (size_t)(r0 + q) * DM; yr[q] = y + o; xo[q] = xnp + o;
            hin[q] = mode == 0 ? (const void*)(xp + o) : (const void*)(h16 + o); ho[q] = mode == 2 ? (void*)(out + O_YP + o) : (void*)(h16 + o); }
        if (mode == 0) res_rows<false, true, 4>(hin, yr, gpost, gnext, ho, xo, true, lane);
        else if (mode == 1) res_rows<true, true, 4>(hin, yr, gpost, gnext, ho, xo, true, lane);
        else res_rows<true, false, 4>(hin, yr, gpost, gnext, ho, xo, false, lane);
    }
    DI void rows8(int r0, int lane) const {
        const void* hin[8]; const bf16_t* yr[8]; void* ho[8]; bf16_t* xo[8];
#pragma unroll
        for (int q = 0; q < 8; ++q) { const size_t o = (size_t)(r0 + q) * DM; yr[q] = y + o; xo[q] = xnp + o;
            hin[q] = mode == 0 ? (const void*)(xp + o) : (const void*)(h16 + o); ho[q] = mode == 2 ? (void*)(out + O_YP + o) : (void*)(h16 + o); }
        if (mode == 0) res_rows<false, true, 8>(hin, yr, gpost, gnext, ho, xo, true, lane);
        else if (mode == 1) res_rows<true, true, 8>(hin, yr, gpost, gnext, ho, xo, true, lane);
        else res_rows<true, false, 8>(hin, yr, gpost, gnext, ho, xo, false, lane);
    }
};

DI void s5_tables(const Params& p, int g, LAS unsigned char* lds, bf16_t* Bt1, bf16_t* Bt2, const int tid) {
    LAS float* pwr = (LAS float*)lds;
    LAS float* pwi = pwr + 17 * 64;
    LAS float* bbr = pwi + 17 * 64;
    LAS float* bbi = bbr + 1024;
    LAS float* cr = bbi + 1024;
    LAS float* ci = cr + 1024;
    LAS float* Kd = ci + 1024;
    const float dt = __expf(p.in[12][g]);
    const float* lre = p.in[10] + g * 64; const float* lim = p.in[11] + g * 64;
    for (int it = tid; it < 17 * 64; it += 512) { const int d = it >> 6, q = it & 63; const float zr = lre[q] * dt * (float)d, zi = lim[q] * dt * (float)d;
        float s, c; sincos_acc(zi, s, c); const float mag = __expf(zr); pwr[it] = mag * c; pwi[it] = mag * s; }
    for (int it = tid; it < 1024; it += 512) { const int q = it >> 4, i = it & 15;
        const float lr = lre[q], li = lim[q], zr = lr * dt, zi = li * dt;
        float s, c, sh, ch; sincos_acc(zi, s, c); sincos_acc(0.5f * zi, sh, ch);
        const float em1 = expm1f(zr); const float nr = em1 * c - 2.f * sh * sh, ni = (em1 + 1.f) * s;
        const float den = 1.f / (lr * lr + li * li); const float fr_ = (nr * lr + ni * li) * den, fi_ = (ni * lr - nr * li) * den;
        const float br = p.in[13][(size_t)g * 1024 + it], bi = p.in[14][(size_t)g * 1024 + it];
        bbr[it] = fr_ * br - fi_ * bi; bbi[it] = fr_ * bi + fi_ * br;
        cr[it] = p.in[15][(size_t)g * 1024 + it]; ci[it] = p.in[16][(size_t)g * 1024 + it]; }
    __syncthreads();
    for (int it = tid; it < 4096; it += 512) { const int d = it >> 8, i = (it >> 4) & 15, j = it & 15; float a = 0.f;
        for (int q = 0; q < 64; ++q) { const float c_r = cr[i * 64 + q], c_i = ci[i * 64 + q], p_r = pwr[d * 64 + q], p_i = pwi[d * 64 + q];
            const float xr = c_r * p_r - c_i * p_i, xi = c_r * p_i + c_i * p_r; a += xr * bbr[q * 16 + j] - xi * bbi[q * 16 + j]; }
        Kd[it] = a; }
    __syncthreads();
    for (int it = tid; it < 256 * 32; it += 512) { const int n = it >> 5, k0 = (it & 31) * 8; float v[8];
#pragma unroll
        for (int e = 0; e < 8; ++e) { const int k = k0 + e, s = k >> 4, i = k & 15; float val = 0.f;
            if (n < 128) { const int q = n & 63; const float p_r = pwr[(15 - s) * 64 + q], p_i = pwi[(15 - s) * 64 + q], b_r = bbr[q * 16 + i], b_i = bbi[q * 16 + i];
                val = n < 64 ? (p_r * b_r - p_i * b_i) : (p_r * b_i + p_i * b_r); }
            v[e] = val; }
        u32x4 o; o.x = pk2(v[0], v[1]); o.y = pk2(v[2], v[3]); o.z = pk2(v[4], v[5]); o.w = pk2(v[6], v[7]);
        *(u32x4*)(Bt1 + (size_t)n * 256 + k0) = o; }
    for (int it = tid; it < 256 * 48; it += 512) { const int n = it / 48, k0 = (it % 48) * 8; const int r = n >> 4, i = n & 15; float v[8];
#pragma unroll
        for (int e = 0; e < 8; ++e) { const int k = k0 + e; float val;
            if (k < 128) { const int q = k & 63; const float c_r = cr[i * 64 + q], c_i = ci[i * 64 + q], p_r = pwr[(r + 1) * 64 + q], p_i = pwi[(r + 1) * 64 + q];
                val = k < 64 ? (c_r * p_r - c_i * p_i) : -(c_r * p_i + c_i * p_r); }
            else { const int kk = k - 128, s = kk >> 4, j = kk & 15; val = s <= r ? Kd[(r - s) * 256 + i * 16 + j] : 0.f; }
            v[e] = val; }
        u32x4 o; o.x = pk2(v[0], v[1]); o.y = pk2(v[2], v[3]); o.z = pk2(v[4], v[5]); o.w = pk2(v[6], v[7]);
        *(u32x4*)(Bt2 + (size_t)n * 384 + k0) = o; }
    __syncthreads();
}

DI void s5_sample_unit(const Params& p, int u, const float* uss, bf16_t* z, int lane) {
    const int g = u & 31, b = u >> 5;
    const float dt = __expf(p.in[12][g]);
    const float lr = p.in[10][g * 64 + lane], li = p.in[11][g * 64 + lane], zr = lr * dt, zi = li * dt;
    float s, c, sh, ch; sincos_acc(zi, s, c); sincos_acc(0.5f * zi, sh, ch);
    const float em1 = expm1f(zr); const float nr = em1 * c - 2.f * sh * sh, ni = (em1 + 1.f) * s;
    const float lbr = nr + 1.f, lbi = ni;
    const float den = 1.f / (lr * lr + li * li); const float fr_ = (nr * lr + ni * li) * den, fi_ = (ni * lr - nr * li) * den;
    float hr = p.in[3][(((size_t)b * 32 + g) * 64 + lane) * 2], hi = p.in[3][(((size_t)b * 32 + g) * 64 + lane) * 2 + 1];
    const float* bre = p.in[13] + ((size_t)g * 64 + lane) * 16; const float* bim = p.in[14] + ((size_t)g * 64 + lane) * 16;
    const float* cre = p.in[15] + (size_t)g * 1024 + lane; const float* cim = p.in[16] + (size_t)g * 1024 + lane;
    for (int t = 0; t < 4; ++t) {
        const float* ur = uss + (size_t)(b * 4 + t) * 512 + g * 16;
        float bur = 0.f, bui = 0.f;
#pragma unroll
        for (int i = 0; i < 16; ++i) { const float uv = ur[i]; const float br = bre[i], bi = bim[i]; bur += (fr_ * br - fi_ * bi) * uv; bui += (fr_ * bi + fi_ * br) * uv; }
        const float n_r = lbr * hr - lbi * hi + bur, n_i = lbr * hi + lbi * hr + bui; hr = n_r; hi = n_i;
        float yv = 0.f;
#pragma unroll
        for (int i = 0; i < 16; ++i) { float a = cre[i * 64] * hr - cim[i * 64] * hi; a = wave_sum(a); if (lane == i) yv = a; }
        if (lane < 16) { const float y = yv + p.in[17][g * 16 + lane] * ur[lane]; z[(size_t)(NP + b * 4 + t) * 512 + g * 16 + lane] = (bf16_t)(pk2(gelu_tanh(y), 0.f) & 0xffffu); }
    }
    float* o = p.out + O_S5S + (((size_t)b * 32 + g) * 64 + lane) * 2; o[0] = hr; o[1] = hi;
}

constexpr int ATT_BUF = 69632, ATT_VOFF = 34816, ATT_OST = 2 * ATT_BUF, LDS_CTL = ATT_OST + 8 * 2304;
struct AttUnit { int pat, b, h, dil, l0; size_t rowbase; };
DI AttUnit att_decode(int bu) { AttUnit u; const int tile = bu & 63; u.h = (bu >> 6) & 15; u.b = (bu >> 10) & 3; u.pat = bu >> 12; const int dsh = u.pat * 2; u.dil = 1 << dsh;
    const int rho = tile & (u.dil - 1); u.l0 = (tile >> dsh) * 128; u.rowbase = (size_t)u.b * TP + rho; return u; }
DI void att_stage(const AttUnit& u, const bf16_t* Kb, const bf16_t* Vb, LAS unsigned char* buf, int wave, int lane) {
    const int lmax = (TP >> (2 * u.pat)) - 1;
    for (int n = wave; n < 34; n += 8) { const int r0 = n * 8; const int row = r0 + (lane >> 3); const int c = (lane & 7) ^ (row & 7);
        int lk = u.l0 - 128 + row; lk = lk < 0 ? 0 : (lk > lmax ? lmax : lk); const size_t off = (u.rowbase + (size_t)u.dil * lk) * 1024 + u.h * 64 + c * 8;
        __builtin_amdgcn_global_load_lds((const unsigned*)(Kb + off), (LAS unsigned*)(buf + r0 * 128), 16, 0, 0);
        __builtin_amdgcn_global_load_lds((const unsigned*)(Vb + off), (LAS unsigned*)(buf + ATT_VOFF + r0 * 128), 16, 0, 0); }
}
DI void att_loadq(const AttUnit& u, const bf16_t* Q, int wave, int lane, bf16x8 (&qf)[2]) {
    const int i = lane & 15, g = lane >> 4; const bf16_t* q = Q + (u.rowbase + (size_t)u.dil * (u.l0 + 16 * wave + i)) * 1024 + u.h * 64 + 8 * g;
    qf[0] = *(const bf16x8*)q; qf[1] = *(const bf16x8*)(q + 32);
}
DI void att_compute(const AttUnit& u, const bf16x8 (&qf)[2], LAS unsigned char* buf, LAS unsigned char* ost, bf16_t* Op, float* lse, bf16_t* attp, int wave, int lane) {
    const int i = lane & 15, g = lane >> 4;
    const int Lw = u.l0 + 16 * wave;
    unsigned koff[2][2], voff[4];
#pragma unroll
    for (int kbl = 0; kbl < 2; ++kbl)
#pragma unroll
        for (int s = 0; s < 2; ++s) koff[kbl][s] = (unsigned)((16 * wave + 16 * kbl + i) * 128 + (((4 * s + g) ^ (i & 7)) * 16));
    { const int q = i >> 2, pp = i & 3, r = 4 * g + q;
#pragma unroll
      for (int db = 0; db < 4; ++db) voff[db] = (unsigned)((16 * wave + r) * 128 + (((2 * db + (pp >> 1)) ^ (r & 7)) * 16) + 8 * (pp & 1)); }
    u32x4 pa[2], pb[2]; float pl0[2], pl1[2];
    if (u.pat == 2) {
#pragma unroll
        for (int n = 0; n < 2; ++n) { const int c = lane + 64 * n, rr = c >> 3, ch = c & 7; const size_t trow = u.rowbase + (size_t)u.dil * (Lw + rr);
            pl0[n] = lse[trow * 16 + u.h]; pl1[n] = lse[((size_t)MT + trow) * 16 + u.h];
            pa[n] = *(const u32x4*)(Op + trow * 1024 + u.h * 64 + ch * 8); pb[n] = *(const u32x4*)(Op + ((size_t)MT + trow) * 1024 + u.h * 64 + ch * 8); }
    } else { pa[0] = pa[1] = pb[0] = pb[1] = (u32x4){0u, 0u, 0u, 0u}; pl0[0] = pl0[1] = pl1[0] = pl1[1] = 0.f; }
    f32x4 st[5][2];
#pragma unroll
    for (int ks = 0; ks < 5; ++ks)
#pragma unroll
        for (int kbl = 0; kbl < 2; ++kbl) {
            if (ks == 4 && kbl == 1) { st[ks][kbl] = (f32x4){0.f, 0.f, 0.f, 0.f}; continue; }
            const bf16x8 k0 = *(const LAS bf16x8*)(buf + ks * 4096 + koff[kbl][0]), k1 = *(const LAS bf16x8*)(buf + ks * 4096 + koff[kbl][1]);
            f32x4 a = (f32x4){0.f, 0.f, 0.f, 0.f};
            a = __builtin_amdgcn_mfma_f32_16x16x32_bf16(k0, qf[0], a, 0, 0, 0);
            a = __builtin_amdgcn_mfma_f32_16x16x32_bf16(k1, qf[1], a, 0, 0, 0); st[ks][kbl] = a; }
#pragma unroll
    for (int r = 0; r < 4; ++r) { if (i > 4 * g + r) st[0][0][r] = -INFINITY; if (4 * g + r > i) st[4][0][r] = -INFINITY; }
    if (Lw < 128) {
#pragma unroll
        for (int ks = 0; ks < 4; ++ks)
#pragma unroll
            for (int kbl = 0; kbl < 2; ++kbl)
#pragma unroll
                for (int r = 0; r < 4; ++r) if (Lw - 128 + 32 * ks + 16 * kbl + 4 * g + r < 0) st[ks][kbl][r] = -INFINITY; }
    float mx = -INFINITY;
#pragma unroll
    for (int ks = 0; ks < 5; ++ks)
#pragma unroll
        for (int kbl = 0; kbl < 2; ++kbl) { if (ks == 4 && kbl == 1) continue;
#pragma unroll
            for (int r = 0; r < 4; ++r) mx = fmaxf(mx, st[ks][kbl][r]); }
    mx = fmaxf(mx, __shfl_xor(mx, 16)); mx = fmaxf(mx, __shfl_xor(mx, 32));
    float ps = 0.f; bf16x8 pf[5];
#pragma unroll
    for (int ks = 0; ks < 5; ++ks) {
#pragma unroll
        for (int kbl = 0; kbl < 2; ++kbl) { if (ks == 4 && kbl == 1) continue;
#pragma unroll
            for (int r = 0; r < 4; ++r) { const float pv = __builtin_amdgcn_exp2f(st[ks][kbl][r] - mx); st[ks][kbl][r] = pv; ps += pv; } }
        u32x4 pw; pw.x = pk2(st[ks][0][0], st[ks][0][1]); pw.y = pk2(st[ks][0][2], st[ks][0][3]); pw.z = pk2(st[ks][1][0], st[ks][1][1]); pw.w = pk2(st[ks][1][2], st[ks][1][3]);
        pf[ks] = __builtin_bit_cast(bf16x8, pw); }
    ps += __shfl_xor(ps, 16); ps += __shfl_xor(ps, 32);
    f32x4 o[4];
#pragma unroll
    for (int db = 0; db < 4; ++db) o[db] = (f32x4){0.f, 0.f, 0.f, 0.f};
    const unsigned vb = (unsigned)(size_t)buf + (unsigned)ATT_VOFF;
#pragma unroll
    for (int ks = 0; ks < 5; ++ks) {
        s16x4 lo[4], hi[4]; const unsigned va = vb + ks * 4096;
        asm volatile("ds_read_b64_tr_b16 %0, %8\n\tds_read_b64_tr_b16 %1, %9\n\tds_read_b64_tr_b16 %2, %10\n\tds_read_b64_tr_b16 %3, %11\n\t"
                     "ds_read_b64_tr_b16 %4, %8 offset:2048\n\tds_read_b64_tr_b16 %5, %9 offset:2048\n\tds_read_b64_tr_b16 %6, %10 offset:2048\n\tds_read_b64_tr_b16 %7, %11 offset:2048\n\t"
                     "s_waitcnt lgkmcnt(0)"
                     : "=&v"(lo[0]), "=&v"(lo[1]), "=&v"(lo[2]), "=&v"(lo[3]), "=&v"(hi[0]), "=&v"(hi[1]), "=&v"(hi[2]), "=&v"(hi[3])
                     : "v"(va + voff[0]), "v"(va + voff[1]), "v"(va + voff[2]), "v"(va + voff[3]) : "memory");
#pragma unroll
        for (int db = 0; db < 4; ++db) { const bf16x8 vf = __builtin_shufflevector(lo[db], hi[db], 0, 1, 2, 3, 4, 5, 6, 7);
            o[db] = __builtin_amdgcn_mfma_f32_16x16x32_bf16(vf, pf[ks], o[db], 0, 0, 0); }
    }
    const float inv = 1.f / ps;
#pragma unroll
    for (int db = 0; db < 4; ++db) { const f32x4 v = o[db] * inv; u32x2 w; w.x = pk2(v[0], v[1]); w.y = pk2(v[2], v[3]); *(LAS u32x2*)(ost + i * 144 + (16 * db + 4 * g) * 2) = w; }
    if (u.pat == 2) {
        if (g == 0) *(LAS float*)(ost + i * 144 + 128) = mx + __builtin_amdgcn_logf(ps);
        LDS_WAIT();
#pragma unroll
        for (int n = 0; n < 2; ++n) { const int c = lane + 64 * n, rr = c >> 3, ch = c & 7; const size_t trow = u.rowbase + (size_t)u.dil * (Lw + rr);
            const u32x4 v = *(const LAS u32x4*)(ost + rr * 144 + ch * 16); const float l2 = *(const LAS float*)(ost + rr * 144 + 128);
            const float l0 = pl0[n], l1 = pl1[n]; const u32x4 a = pa[n], b = pb[n];
            const float mxl = fmaxf(l0, fmaxf(l1, l2)); float w0 = __builtin_amdgcn_exp2f(l0 - mxl), w1 = __builtin_amdgcn_exp2f(l1 - mxl), w2 = __builtin_amdgcn_exp2f(l2 - mxl);
            const float winv = __builtin_amdgcn_rcpf(w0 + w1 + w2); w0 *= winv; w1 *= winv; w2 *= winv;
            u32x4 r;
            r.x = pk2(w0 * bflo(a.x) + w1 * bflo(b.x) + w2 * bflo(v.x), w0 * bfhi(a.x) + w1 * bfhi(b.x) + w2 * bfhi(v.x));
            r.y = pk2(w0 * bflo(a.y) + w1 * bflo(b.y) + w2 * bflo(v.y), w0 * bfhi(a.y) + w1 * bfhi(b.y) + w2 * bfhi(v.y));
            r.z = pk2(w0 * bflo(a.z) + w1 * bflo(b.z) + w2 * bflo(v.z), w0 * bfhi(a.z) + w1 * bfhi(b.z) + w2 * bfhi(v.z));
            r.w = pk2(w0 * bflo(a.w) + w1 * bflo(b.w) + w2 * bflo(v.w), w0 * bfhi(a.w) + w1 * bfhi(b.w) + w2 * bfhi(v.w));
            *(u32x4*)(attp + trow * 1024 + u.h * 64 + ch * 8) = r; }
        LDS_WAIT();
    } else {
    const size_t orow0 = (size_t)u.pat * MT + u.rowbase;
    if (g == 0) lse[(orow0 + (size_t)u.dil * (Lw + i)) * 16 + u.h] = mx + __builtin_amdgcn_logf(ps);
    LDS_WAIT();
#pragma unroll
    for (int n = 0; n < 2; ++n) { const int c = lane + 64 * n, rr = c >> 3, ch = c & 7; const u32x4 v = *(const LAS u32x4*)(ost + rr * 144 + ch * 16);
        *(u32x4*)(Op + (orow0 + (size_t)u.dil * (Lw + rr)) * 1024 + u.h * 64 + ch * 8) = v; }
    LDS_WAIT();
    }
}
struct XcdBarrier; DI void xcd_barrier(const XcdBarrier& b);
DI void attn_prompt_phase(const bf16_t* Q, const bf16_t* Kb, const bf16_t* Vb, bf16_t* Op, float* lse, bf16_t* attp, const XcdBarrier& xbar, LAS unsigned char* lds, int bx, int G, int wave, int lane) {
    constexpr int NU = 3 * 4096;
    int bu = bx; if (bu >= NU) return;
    AttUnit u = att_decode(bu); bf16x8 qn[2];
    att_stage(u, Kb, Vb, lds, wave, lane); att_loadq(u, Q, wave, lane, qn);
    int par = 0;
    for (;;) {
        asm volatile("s_waitcnt vmcnt(0)" ::: "memory");
        __syncthreads();
        bf16x8 qf[2]; qf[0] = qn[0]; qf[1] = qn[1];
        const AttUnit cur = u; const int nb = bu + G; const bool more = nb < NU;
        if (more) { u = att_decode(nb); att_stage(u, Kb, Vb, lds + (par ^ 1) * ATT_BUF, wave, lane); att_loadq(u, Q, wave, lane, qn); }
        att_compute(cur, qf, lds + par * ATT_BUF, lds + ATT_OST + wave * 2304, Op, lse, attp, wave, lane);
        if (!more) break;
        if (cur.pat == 1 && u.pat == 2) xcd_barrier(xbar);
        bu = nb; par ^= 1;
    }
    __syncthreads();
}

DI void attn_sample_unit(const Params& p, int u, const bf16_t* Q, const bf16_t* Kb, const bf16_t* Vb, bf16_t* att, LAS float* sl, int lane) {
    const int h = u & 15, t = (u >> 4) & 3, b = u >> 6;
    const size_t qrow = (size_t)NP + b * 4 + t;
    const float* ck = p.in[4]; const float* cv = p.in[5];
    sl[lane] = bf2f(Q[qrow * 1024 + h * 64 + lane]);
    LDS_WAIT();
    float mx = -INFINITY;
#pragma unroll 1
    for (int e = 0; e < 9; ++e) { const int pat = e / 3, r = e - 3 * pat; const int dil = 1 << (2 * pat);
        const int j = lane + 64 * r; const bool valid = j <= 128; const int idx = 2048 + t - dil * (valid ? j : 0);
        float dot = 0.f;
        if (idx >= 2048) { const bf16_t* kp = Kb + ((size_t)NP + b * 4 + (idx - 2048)) * 1024 + h * 64;
#pragma unroll
            for (int d8 = 0; d8 < 8; ++d8) { const u32x4 kw = *(const u32x4*)(kp + 8 * d8); const f32x4 q0 = *(const LAS f32x4*)(sl + 8 * d8), q1 = *(const LAS f32x4*)(sl + 8 * d8 + 4);
                dot += (bflo(kw.x) * q0[0] + bfhi(kw.x) * q0[1]) + (bflo(kw.y) * q0[2] + bfhi(kw.y) * q0[3]) + (bflo(kw.z) * q1[0] + bfhi(kw.z) * q1[1]) + (bflo(kw.w) * q1[2] + bfhi(kw.w) * q1[3]); } }
        else { const float* kp = ck + (((size_t)b * 2048 + idx) * 16 + h) * 64;
#pragma unroll
            for (int d4 = 0; d4 < 16; ++d4) { const f32x4 kv = *(const f32x4*)(kp + 4 * d4); const f32x4 qv = *(const LAS f32x4*)(sl + 4 * d4); dot += (kv[0] * qv[0] + kv[1] * qv[1]) + (kv[2] * qv[2] + kv[3] * qv[3]); } }
        if (valid) { sl[64 + pat * 192 + j] = dot; mx = fmaxf(mx, dot); } }
    mx = wave_max(mx);
    LDS_WAIT();
    float ls = 0.f;
#pragma unroll 1
    for (int e = 0; e < 9; ++e) { const int pat = e / 3, r = e - 3 * pat; const int j = lane + 64 * r;
        if (j <= 128) { const float pv = __builtin_amdgcn_exp2f(sl[64 + pat * 192 + j] - mx); sl[64 + pat * 192 + j] = pv; ls += pv; } }
    ls = wave_sum(ls);
    LDS_WAIT();
    { const int kg = lane >> 4, d4 = lane & 15; f32x4 acc = (f32x4){0.f, 0.f, 0.f, 0.f};
#pragma unroll 1
      for (int pat = 0; pat < 3; ++pat) { const int dil = 1 << (2 * pat);
#pragma unroll
        for (int jj = 0; jj < 33; ++jj) { const int j = kg + 4 * jj; int idx = 2048 + t - dil * j; const bool use = (j <= 128) && (idx < 2048);
            idx = idx < 0 ? 0 : (idx > 2047 ? 2047 : idx); const float pv = use ? sl[64 + pat * 192 + (j > 128 ? 128 : j)] : 0.f;
            const f32x4 vv = *(const f32x4*)(cv + (((size_t)b * 2048 + idx) * 16 + h) * 64 + 4 * d4);
            acc += vv * pv; }
        if (kg == 0) { for (int j = 0; dil * j <= t; ++j) { const int idx = 2048 + t - dil * j; const float pv = sl[64 + pat * 192 + j];
            const u32x2 w = *(const u32x2*)(Vb + ((size_t)NP + b * 4 + (idx - 2048)) * 1024 + h * 64 + 4 * d4);
            acc += (f32x4){bflo(w.x), bfhi(w.x), bflo(w.y), bfhi(w.y)} * pv; } } }
#pragma unroll
      for (int e = 0; e < 4; ++e) { float a = acc[e]; a += __shfl_xor(a, 16); a += __shfl_xor(a, 32); acc[e] = a; }
      const float inv = 1.f / ls;
      if (kg == 0) { u32x2 w; w.x = pk2(acc[0] * inv, acc[1] * inv); w.y = pk2(acc[2] * inv, acc[3] * inv); *(u32x2*)(att + qrow * 1024 + h * 64 + 4 * d4) = w; } }
    LDS_WAIT();
}


#define XB_TMO      128
#define XB_XCNT(j)  (256  + 64 * (j))
#define XB_XSUB(j)  (1280 + 64 * (j))
#define XB_XGEN(j)  (2304 + 64 * (j))
#define XB_TOP      3328
#define XB_TOPGEN   3392
#define XCD_BAR_WORDS 3456
#define XB_SPIN_CAP (1u << 22)
DI unsigned xb_ld(unsigned* p)              { return __hip_atomic_load(p, __ATOMIC_RELAXED, __HIP_MEMORY_SCOPE_AGENT); }
DI unsigned xb_add(unsigned* p, unsigned v) { return __hip_atomic_fetch_add(p, v, __ATOMIC_RELAXED, __HIP_MEMORY_SCOPE_AGENT); }
DI unsigned xb_xcc_id() { return (unsigned)__builtin_amdgcn_s_getreg((3 << 11) | 20) & 0xFu; }
#define XB_SPIN(cond, bar) do { unsigned _sp = 0; while (cond) { __builtin_amdgcn_s_sleep(1); \
    if ((++_sp & 255u) == 0u) { if (xb_ld(&(bar)[XB_TMO])) break; if (_sp > XB_SPIN_CAP) { atomicAdd(&(bar)[XB_TMO], 1u); break; } } } } while (0)
struct XcdBarrier { unsigned* bar; unsigned x; volatile LAS unsigned* st; bool w0; };
DI XcdBarrier xcd_barrier_post(unsigned* bar, volatile LAS unsigned* st, const bool w0) {
    XcdBarrier b; b.bar = bar; b.x = xb_xcc_id(); b.st = st; b.w0 = w0;
    if (w0 && lane_id() == 0) (void)xb_add(&bar[XB_XCNT(b.x)], 1u);
    return b;
}
DI void xcd_barrier_complete(unsigned* bar, unsigned x, unsigned& nloc, unsigned& nx) {
    const unsigned G = gridDim.x * gridDim.y * gridDim.z;
    unsigned sum, cnt, mine, sp = 0u;
    for (;;) {
        sum = 0u; cnt = 0u; mine = 0u;
#pragma unroll
        for (unsigned j = 0; j < 16; ++j) { const unsigned c = xb_ld(&bar[XB_XCNT(j)]); sum += c; cnt += (c > 0u) ? 1u : 0u; mine = (j == x) ? c : mine; }
        if (sum == G) break;
        __builtin_amdgcn_s_sleep(1);
        if ((++sp & 255u) == 0u) { if (xb_ld(&bar[XB_TMO])) break; if (sp > XB_SPIN_CAP) { atomicAdd(&bar[XB_TMO], 1u); break; } }
    }
    nloc = mine > 0u ? mine : 1u; nx = cnt > 0u ? cnt : 1u;
}
DI void xcd_barrier(const XcdBarrier& b) {
    asm volatile("s_waitcnt vmcnt(0)" ::: "memory");
    __syncthreads();
    if (b.w0 && lane_id() == 0) {
        unsigned* bar = b.bar;
        __builtin_amdgcn_s_waitcnt(0);
        unsigned nloc = b.st[0], nx = b.st[1];
        if (nloc == 0u) { xcd_barrier_complete(bar, b.x, nloc, nx); b.st[0] = nloc; b.st[1] = nx; }
        const unsigned old = xb_add(&bar[XB_XSUB(b.x)], 1u);
        const unsigned gen = old / nloc;
        if (old + 1u == (gen + 1u) * nloc) {
            __builtin_amdgcn_fence(__ATOMIC_RELEASE, "agent");
            asm volatile("s_waitcnt vmcnt(0)" ::: "memory");
            const unsigned og = xb_add(&bar[XB_TOP], 1u);
            const unsigned tg = og / nx;
            if (og + 1u == (tg + 1u) * nx) xb_add(&bar[XB_TOPGEN], 1u);
            else XB_SPIN(xb_ld(&bar[XB_TOPGEN]) == tg, bar);
            __builtin_amdgcn_fence(__ATOMIC_ACQUIRE, "agent");
            xb_add(&bar[XB_XGEN(b.x)], 1u);
            asm volatile("s_waitcnt vmcnt(0)" ::: "memory");
        } else {
            XB_SPIN(xb_ld(&bar[XB_XGEN(b.x)]) == gen, bar);
            __builtin_amdgcn_fence(__ATOMIC_ACQUIRE, "agent");
            asm volatile("s_waitcnt vmcnt(0)" ::: "memory");
        }
    }
    __syncthreads();
}

#define w_in_t ((bf16_t*)(ws + WS_WIN))
#define w_out_t ((bf16_t*)(ws + WS_WOUT))
#define w_glu_t ((bf16_t*)(ws + WS_WGLU))
#define w_pool_t ((bf16_t*)(ws + WS_WPOOL))
#define w_o_t ((bf16_t*)(ws + WS_WO))
#define w_qkv_t ((bf16_t*)(ws + WS_WQKV))
#define Bt1 ((bf16_t*)(ws + WS_BT1))
#define Bt2 ((bf16_t*)(ws + WS_BT2))
#define rowss ((float*)(ws + WS_ROWSS))
#define uss ((float*)(ws + WS_USS))
#define lse ((float*)(ws + WS_LSE))
#define xn ((bf16_t*)(ws + WS_XN))
#define ybuf ((bf16_t*)(ws + WS_Y))
#define hbuf16 ((bf16_t*)(ws + WS_H))
#define Ap ((bf16_t*)(ws + WS_AP))
#define Sbuf ((float*)(ws + WS_S))
#define upool ((float*)(ws + WS_UPOOL))
#define dbuf ((bf16_t*)(ws + WS_D))
#define zbuf ((bf16_t*)(ws + WS_Z))
#define ycat ((bf16_t*)(ws + WS_YCAT))
#define hact ((bf16_t*)(ws + WS_HACT))
#define Qb ((bf16_t*)(ws + WS_Q))
#define Kb ((bf16_t*)(ws + WS_K))
#define Vb ((bf16_t*)(ws + WS_V))
#define Op ((bf16_t*)(ws + WS_OP))
#define att ((bf16_t*)(ws + WS_ATT))
#define gains (p.in[6])
#ifndef PHMASK
#define PHMASK 0xFFFFFFFFu
#endif
#ifndef DUPMASK
#define DUPMASK 0u
#endif
#define PHASE_BEGIN(k) if (((PHMASK >> (k)) & 1u) && p.ph_lo <= (k) && (k) < p.ph_hi) { for (int _rep = 0; _rep < 1 + (int)((DUPMASK >> (k)) & 1u); ++_rep) { if (_rep) __syncthreads(); const int lane = lane_id(); const int tid = wave * 64 + lane; const int gt = bx * 512 + tid; (void)gt;
#define PHASE_END(k) } } if (p.ph_lo <= (k) && (k) + 1 < p.ph_hi) { if ((k) == 0) { grid.sync(); xbar = xcd_barrier_post((unsigned*)(p.ws + WS_CTL), (volatile LAS unsigned*)(lds + 157696), wave == 0); } else xcd_barrier(xbar); }

template <int layer>
DI void layer_tail(const Params& p, LAS unsigned char* lds, cg::grid_group& grid, XcdBarrier& xbar, const int bx, const int G, const int gw, const int NGW, const int wave) {
    unsigned char* ws = p.ws;
    constexpr int pb = 6 + layer * 8;
    const float* gl = gains + (size_t)layer * 4 * DM;
        PHASE_BEGIN(pb)
        { const bf16_t* A = layer == 0 ? ycat : att; const bf16_t* W = layer == 0 ? w_out_t : w_o_t;
          { UStd<EpiY> U{A, W, (size_t)256 * DM, (size_t)256 * DM, 0, 128, 4, G, bx, EpiY{ybuf, 0, 0}};
            gemm_phase(lds, wave, DM, DM, DM, U); }
          { EpiY E{ybuf, 0, 0}; mini_gemm(A, DM, W, DM, DM, 1024, 0, E, bx, G, wave, lane); } }
        PHASE_END(pb)
        PHASE_BEGIN(pb + 1)
        { const RowPass rp{layer == 0 ? 0 : 1, gl + DM, gl + 2 * DM, p.in[0], p.in[1], hbuf16, ybuf, xn, p.out};
          for (int q = gw; q < NP / 4; q += NGW) rp.rows4(q * 4, lane);
          for (int r = NP + (NGW - 1 - gw); r < NT; r += NGW) rp.row(r, lane); }
        PHASE_END(pb + 1)
        PHASE_BEGIN(pb + 2)
        { const bf16_t* W = (const bf16_t*)(ws + (layer ? WS_GU1 : WS_GU0));
          { UStd<EpiGU> U{xn, W, (size_t)256 * DM, (size_t)256 * DM, 0, 128, 22, G, bx, EpiGU{hact, 0, 0}};
            gemm_phase(lds, wave, DM, DM, DM, U); }
          { EpiGU E{hact, 0, 0}; mini_gemm_gu(xn, W, E, bx, G, wave, lane); } }
        PHASE_END(pb + 2)
        PHASE_BEGIN(pb + 3)
        { const bf16_t* W = (const bf16_t*)(ws + (layer ? WS_DN1 : WS_DN0));
          { UStd<EpiY> U{hact, W, (size_t)256 * FF, (size_t)256 * FF, 0, 128, 4, G, bx, EpiY{ybuf, 0, 0}};
            gemm_phase(lds, wave, FF, FF, FF, U); }
          { EpiY E{ybuf, 0, 0}; mini_gemm(hact, FF, W, FF, FF, 1024, 0, E, bx, G, wave, lane); } }
        PHASE_END(pb + 3)
        PHASE_BEGIN(pb + 4)
        { const RowPass rp{layer == 0 ? 1 : 2, gl + 3 * DM, gains + 4 * DM, p.in[0], p.in[1], hbuf16, ybuf, xn, p.out};
          for (int q = gw; q < NP / 4; q += NGW) rp.rows4(q * 4, lane);
          for (int r = NP + (NGW - 1 - gw); r < NT; r += NGW) rp.row(r, lane); }
        PHASE_END(pb + 4)
    }

__global__ void __launch_bounds__(512, 2) mega(Params p) {
    extern __shared__ __attribute__((aligned(16))) unsigned char lds_raw[];
    LAS unsigned char* lds = (LAS unsigned char*)lds_raw;
    cg::grid_group grid = cg::this_grid();
    const int wave = __builtin_amdgcn_readfirstlane((int)threadIdx.x >> 6);
    const int G = gridDim.x, bx = blockIdx.x;
    const int gw = bx * 8 + wave, NGW = G * 8;
    const int NGT = G * 512;
    unsigned char* ws = p.ws;
    XcdBarrier xbar; xbar.bar = (unsigned*)(ws + WS_CTL); xbar.x = 0; xbar.st = (volatile LAS unsigned*)(lds + 157696); xbar.w0 = wave == 0;
    { const int tid = wave * 64 + lane_id();
      if (tid < 64) ((LAS unsigned*)(lds + 157696))[tid] = 0u;
      if (bx == 0) { for (int i = tid; i < 4096; i += 512) ((unsigned*)(ws + WS_CTL))[i] = 0u; } }
    __syncthreads();

    PHASE_BEGIN(0)
    {
        if (bx < 32) { s5_tables(p, bx, lds, Bt1 + (size_t)bx * 65536, Bt2 + (size_t)bx * 98304, tid); }
        LAS float* scr = (LAS float*)(lds + wave * 16384);
        constexpr int I_IN = 512, I_OUT = 512, I_GLU = 128, I_POOL = 32, I_O = 512, I_QKV = 1536, I_G = 1408, I_D = 1408;
        constexpr int NITEMS = I_IN + I_OUT + I_GLU + I_POOL + I_O + I_QKV + 4 * I_G + 2 * I_D;
        for (int it = gw; it < NITEMS; it += NGW) {
            int r = it;
            if (r < I_IN) { tr_plain(p.in[7], 1024, 1024, w_in_t, r, scr, lane); continue; } r -= I_IN;
            if (r < I_OUT) { tr_plain(p.in[20], 1024, 1024, w_out_t, r, scr, lane); continue; } r -= I_OUT;
            if (r < I_GLU) { tr_plain(p.in[18], 512, 512, w_glu_t, r, scr, lane); continue; } r -= I_GLU;
            if (r < I_POOL) { const int gg = r >> 3, q = r & 7, kb = q >> 2, nb = q & 3;
                transpose_item(p.in[8] + (size_t)gg * 16384, 128, 64 * kb, 32 * nb, w_pool_t, 256, gg * 128 + 32 * nb, (gg & 1) * 128 + 64 * kb, scr, lane); continue; } r -= I_POOL;
            if (r < I_O) { tr_plain(p.in[22], 1024, 1024, w_o_t, r, scr, lane); continue; } r -= I_O;
            if (r < I_QKV) { tr_plain(p.in[21], 1024, 3072, w_qkv_t, r, scr, lane); continue; } r -= I_QKV;
            if (r < 4 * I_G) { const int which = r / I_G, q = r % I_G; const int layer = which >> 1, up = which & 1;
                const float* W = p.in[up ? 24 : 23] + (size_t)layer * 1024 * FF; bf16_t* WT = (bf16_t*)(ws + (layer ? WS_GU1 : WS_GU0));
                const int nblk = FF / 32, kb = q / nblk, nb = q % nblk, n0 = 32 * nb;
                transpose_item(W, FF, 64 * kb, n0, WT, 1024, (n0 >> 7) * 256 + up * 128 + (n0 & 127), 64 * kb, scr, lane); continue; } r -= 4 * I_G;
            { const int layer = r / I_D, q = r % I_D; tr_plain(p.in[25] + (size_t)layer * FF * 1024, FF, 1024, (bf16_t*)(ws + (layer ? WS_DN1 : WS_DN0)), q, scr, lane); }
        }
        for (int it = gt; it < 512 * 16; it += NGT) { const int n = it >> 4, c8 = it & 15; const int gg = n >> 7;
            *(u32x4*)(w_pool_t + (size_t)n * 256 + ((gg & 1) ^ 1) * 128 + c8 * 8) = (u32x4){0u, 0u, 0u, 0u}; }
        if (bx >= 32 || G <= 32) { const int gwn = G > 32 ? (bx - 32) * 8 + wave : gw, ngwn = G > 32 ? (G - 32) * 8 : NGW;
          for (int r = gwn; r < NT; r += 2 * ngwn) { const int r2 = r + ngwn; const bool two = r2 < NT;
            norm_row2(in_row(p, r), in_row(p, two ? r2 : r), gains, xn + (size_t)r * DM, xn + (size_t)(two ? r2 : r) * DM, lane); } }
    }
    PHASE_END(0)

    PHASE_BEGIN(1)
    { UStd<EpiProj> U{xn, w_in_t, (size_t)256 * DM, (size_t)256 * DM, 0, 128, 4, G, bx, EpiProj{upool, Ap, uss, 0, 0}};
      gemm_phase(lds, wave, DM, DM, DM, U);
      { EpiProj E{upool, Ap, uss, 0, 0}; mini_gemm(xn, DM, w_in_t, DM, DM, 1024, 0, E, bx, G, wave, lane); } }
    PHASE_END(1)

    PHASE_BEGIN(2)
    {
        { US5<EpiS1> U{Ap + 128, Bt1, (size_t)65536, G, bx, EpiS1{Sbuf, 0, 0}};
          gemm_phase(lds, wave, 384, 256, 256, U); }
        for (int u = gw; u < 1024; u += NGW) s5_sample_unit(p, u, uss, zbuf, lane);
        for (int it = gt; it < (NP / 16) * 128; it += NGT) { const int cq = it & 127, run = it >> 7; const int c = cq * 4, gi = c >> 7, w = 2 << gi;
            const int t0 = run * 16, tb0 = t0 & (TP - 1); const float* up = upool + (size_t)t0 * 512 + c;
            f32x4 e[31];
#pragma unroll
            for (int k = 0; k < 31; ++k) { const int rel = k - 15; e[k] = (rel >= 1 - w && tb0 + rel >= 0) ? *(const f32x4*)(up + (ptrdiff_t)rel * 512) : (f32x4){0.f, 0.f, 0.f, 0.f}; }
            f32x4 sum = (f32x4){0.f, 0.f, 0.f, 0.f};
#pragma unroll
            for (int k = 0; k < 15; ++k) sum += e[k];
#pragma unroll
            for (int k = 0; k < 16; ++k) { const f32x4 uv = e[15 + k]; sum += uv; const int tb = tb0 + k; const int cnt = tb + 1 < w ? tb + 1 : w;
                const f32x4 dv = sum * (1.0f / (float)cnt) - uv; u32x2 o; o.x = pk2(dv[0], dv[1]); o.y = pk2(dv[2], dv[3]); *(u32x2*)(dbuf + (size_t)(t0 + k) * 512 + c) = o;
                f32x4 out_ = (f32x4){0.f, 0.f, 0.f, 0.f};
                if (w == 2) out_ = e[15 + k - 1]; else if (w == 4) out_ = e[15 + k - 3]; else if (w == 8) out_ = e[15 + k - 7]; else out_ = e[15 + k - 15];
                sum -= out_;
                if (tb >= TP - 15) *(f32x4*)(p.out + O_POOLP + ((size_t)(t0 >> 13) * 15 + (tb - (TP - 15))) * 512 + c) = uv; } }
        for (int it = gt; it < 32 * 128; it += NGT) { const int cq = it & 127, b = it >> 7; const int c = cq * 4, gi = c >> 7, w = 2 << gi;
            const float* sp = p.in[2] + (size_t)b * 15 * 512 + c; const float* up = upool + (size_t)(NP + b * 4) * 512 + c;
            for (int t = 0; t < 4; ++t) { f32x4 sum = (f32x4){0.f, 0.f, 0.f, 0.f};
                for (int s = 0; s < w; ++s) { const int e = 15 + t - s; sum += e >= 15 ? *(const f32x4*)(up + (size_t)(e - 15) * 512) : *(const f32x4*)(sp + (size_t)e * 512); }
                const f32x4 uv = *(const f32x4*)(up + (size_t)t * 512); const f32x4 dv = sum * (1.0f / (float)w) - uv;
                u32x2 o; o.x = pk2(dv[0], dv[1]); o.y = pk2(dv[2], dv[3]); *(u32x2*)(dbuf + (size_t)(NP + b * 4 + t) * 512 + c) = o; }
            for (int r = 0; r < 15; ++r) { const f32x4 v = r < 11 ? *(const f32x4*)(sp + (size_t)(r + 4) * 512) : *(const f32x4*)(up + (size_t)(r - 11) * 512);
                *(f32x4*)(p.out + O_POOLS + ((size_t)b * 15 + r) * 512 + c) = v; } }
    }
    PHASE_END(2)

    PHASE_BEGIN(3)
    {
        { const bool act = bx < 128; const int b = (bx >> 5) & 3, g = bx & 31;
          LAS float* ex = (LAS float*)lds;
          float c_r = 1.f, c_i = 0.f, hr = 0.f, hi = 0.f;
          const float* Sp = Sbuf + ((size_t)g * 2048 + b * 512 + wave * 64) * 128 + lane; bf16_t* Hp = Ap + ((size_t)g * 2048 + b * 512 + wave * 64) * 384 + lane;
          if (act) {
            const float dt = __expf(p.in[12][g]); const float zr = p.in[10][g * 64 + lane] * dt * 16.f, zi = p.in[11][g * 64 + lane] * dt * 16.f;
            float sn, cs; sincos_acc(zi, sn, cs); const float mag = __expf(zr); c_r = mag * cs; c_i = mag * sn;
            for (int c0 = 0; c0 < 64; c0 += 16) { float sr[16], si[16];
#pragma unroll
                for (int k = 0; k < 16; ++k) { sr[k] = Sp[(size_t)(c0 + k) * 128]; si[k] = Sp[(size_t)(c0 + k) * 128 + 64]; }
#pragma unroll
                for (int k = 0; k < 16; ++k) { const float n_r = c_r * hr - c_i * hi + sr[k], n_i = c_r * hi + c_i * hr + si[k]; hr = n_r; hi = n_i; } }
            ex[(wave * 64 + lane) * 2] = hr; ex[(wave * 64 + lane) * 2 + 1] = hi;
          }
          __syncthreads();
          if (act) {
            float l_r = c_r, l_i = c_i;
#pragma unroll
            for (int e = 0; e < 6; ++e) { const float t_r = l_r * l_r - l_i * l_i, t_i = 2.f * l_r * l_i; l_r = t_r; l_i = t_i; }
            hr = 0.f; hi = 0.f;
            for (int sg = 0; sg < wave; ++sg) { const float e_r = ex[(sg * 64 + lane) * 2], e_i = ex[(sg * 64 + lane) * 2 + 1];
                const float n_r = l_r * hr - l_i * hi + e_r, n_i = l_r * hi + l_i * hr + e_i; hr = n_r; hi = n_i; }
            for (int c0 = 0; c0 < 64; c0 += 16) { float sr[16], si[16];
#pragma unroll
                for (int k = 0; k < 16; ++k) { sr[k] = Sp[(size_t)(c0 + k) * 128]; si[k] = Sp[(size_t)(c0 + k) * 128 + 64]; }
#pragma unroll
                for (int k = 0; k < 16; ++k) { const unsigned w = pk2(hr, hi); Hp[(size_t)(c0 + k) * 384] = (bf16_t)(w & 0xffffu); Hp[(size_t)(c0 + k) * 384 + 64] = (bf16_t)(w >> 16);
                    const float n_r = c_r * hr - c_i * hi + sr[k], n_i = c_r * hi + c_i * hr + si[k]; hr = n_r; hi = n_i; } }
            if (wave == 7) { float* o = p.out + O_S5P + (((size_t)b * 32 + g) * 64 + lane) * 2; o[0] = hr; o[1] = hi; }
          }
        }
        asm volatile("s_waitcnt vmcnt(0)" ::: "memory");
        __syncthreads();
        if (G == 256) {
            if (bx < 128) { US5Own<EpiS2> U{Ap, Bt2, (size_t)98304, bx & 31, (bx >> 5) & 3, EpiS2{zbuf, Ap, p.in[17], 0, 0}};
                gemm_phase(lds, wave, 384, 384, 384, U); }
            else { UStd<EpiPool> U{dbuf, w_pool_t, (size_t)256 * 512, (size_t)256 * 256, 256, 128, 2, 128, bx - 128, EpiPool{ycat, p.in[9], 0, 0}};
                gemm_phase(lds, wave, 512, 256, 256, U); }
            { EpiPool E{ycat, p.in[9], 0, 0}; mini_gemm(dbuf, 512, w_pool_t, 256, 256, 512, 256, E, bx, G, wave, lane); }
        } else {
            { UStd<EpiPool> U{dbuf, w_pool_t, (size_t)256 * 512, (size_t)256 * 256, 256, 128, 2, G, bx, EpiPool{ycat, p.in[9], 0, 0}};
              gemm_phase(lds, wave, 512, 256, 256, U); }
            { EpiPool E{ycat, p.in[9], 0, 0}; mini_gemm(dbuf, 512, w_pool_t, 256, 256, 512, 256, E, bx, G, wave, lane); }
            xcd_barrier(xbar);
            { US5<EpiS2> U{Ap, Bt2, (size_t)98304, G, bx, EpiS2{zbuf, Ap, p.in[17], 0, 0}};
              gemm_phase(lds, wave, 384, 384, 384, U); }
        }
    }
    PHASE_END(3)

    PHASE_BEGIN(5)
    { UStd<EpiGlu> U{zbuf, w_glu_t, (size_t)256 * 512, (size_t)256 * 512, 0, 128, 2, G, bx, EpiGlu{ycat, zbuf, p.in[19], 0, 0}};
      gemm_phase(lds, wave, 512, 512, 512, U);
      { EpiGlu E{ycat, zbuf, p.in[19], 0, 0}; mini_gemm(zbuf, 512, w_glu_t, 512, 512, 512, 0, E, bx, G, wave, lane); } }
    PHASE_END(5)

    layer_tail<0>(p, lds, grid, xbar, bx, G, gw, NGW, wave);
            PHASE_BEGIN(11)
            { UStd<EpiQKV> U{xn, w_qkv_t, (size_t)256 * DM, (size_t)256 * DM, 0, 128, 12, G, bx, EpiQKV{Qb, p.out, 0, 0}};
              gemm_phase(lds, wave, DM, DM, DM, U);
              { EpiQKV E{Qb, p.out, 0, 0}; mini_gemm(xn, DM, w_qkv_t, DM, DM, 3072, 0, E, bx, G, wave, lane); } }
            PHASE_END(11)
            PHASE_BEGIN(12)
            {
                attn_prompt_phase(Qb, Kb, Vb, Op, lse, att, xbar, lds, bx, G, wave, lane);
                for (int u = gw; u < 2048; u += NGW) attn_sample_unit(p, u, Qb, Kb, Vb, att, (LAS float*)(lds + wave * 8192), lane);
            }
            PHASE_END(12)
            layer_tail<1>(p, lds, grid, xbar, bx, G, gw, NGW, wave);
}

constexpr int NPHASES = 19;

extern "C" void kernel_launch(void* const* d_in, const int* in_sizes, int n_in, void* d_out, int out_size, void* d_ws, size_t ws_size, hipStream_t stream) {
    static int grid = 0;
    if (grid == 0) {
        int dev = 0, cus = 0, per_cu = 0;
        hipGetDevice(&dev);
        hipDeviceGetAttribute(&cus, hipDeviceAttributeMultiprocessorCount, dev);
        hipFuncSetAttribute((const void*)mega, hipFuncAttributeMaxDynamicSharedMemorySize, LDS_BYTES);
        hipOccupancyMaxActiveBlocksPerMultiprocessor(&per_cu, (const void*)mega, 512, LDS_BYTES);
        if (per_cu < 1) per_cu = 1;
        grid = cus * 1;
        if (ws_size < WS_END) fprintf(stderr, "kernel_launch: workspace too small: %zu < %zu\n", ws_size, (size_t)WS_END);
        fprintf(stderr, "kernel_launch: cus %d per_cu %d grid %d n_in %d out %d ws %zu\n", cus, per_cu, grid, n_in, out_size, ws_size);
    }
    Params p{};
    for (int i = 0; i < 26; ++i) p.in[i] = (const float*)d_in[i];
    p.out = (float*)d_out; p.ws = (unsigned char*)d_ws; p.ph_lo = 0; p.ph_hi = NPHASES;
    void* args[] = {&p};
    hipError_t e = hipLaunchCooperativeKernel((const void*)mega, dim3(grid), dim3(512), args, LDS_BYTES, stream);
    if (e != hipSuccess) fprintf(stderr, "cooperative launch failed: %s (grid %d)\n", hipGetErrorString(e), grid);
}
```
